# Optimizing an MI355X kernel written in HIP

```python
import jax, jax.numpy as jnp
from jax import lax
import numpy as np

D_MODEL = 2048
BATCH = 2
SEQ = 8192
DEPTH = 1

GRID_W = 64
D_MIX = D_MODEL
NH_A = 4
DH_A = D_MIX // 2 // NH_A
W_A = NH_A * DH_A
NH_B = 8
DH_B = (D_MIX - W_A) // NH_B
W_B = NH_B * DH_B
CHUNK = 64
WIN_ROWS_MAX = 8
WIN_COLS = 16
D_FF = ((8 * D_MODEL // 3 + 255) // 256) * 256
CONV_W = 3
N_MOD = 6
N_GATES = 4 * NH_A
IN_SIZES = (W_A, W_A, W_A, W_A, N_GATES, W_B, W_B, W_B)
IN_COLS = sum(IN_SIZES)
IN_SPLITS = tuple(int(s) for s in np.cumsum(IN_SIZES)[:-1])
EPS = 1e-6

kernel_name = 'hybrid_mlstm_natten_convglu_adaln_block'


def rms_norm(x, g):
    xf = x.astype(jnp.float32)
    y = xf * lax.rsqrt(jnp.mean(xf * xf, axis=-1, keepdims=True) + EPS)
    return (y * g.astype(jnp.float32)).astype(x.dtype)


def modulate(h, shift, scale):
    return h * (1 + scale[:, None, :]) + shift[:, None, :]


def to_heads(t, n_heads):
    b, s, _ = t.shape
    return t.reshape(b, s, n_heads, -1).transpose(0, 2, 1, 3)


def from_heads(t):
    b, h, s, d = t.shape
    return t.transpose(0, 2, 1, 3).reshape(b, s, h * d)


def mlstm_scan(q, k, v, log_i, log_f):
    b_, h_, s_, d_ = q.shape
    nc = s_ // CHUNK

    def chunks(t):
        return jnp.moveaxis(t.reshape(t.shape[:2] + (nc, CHUNK) + t.shape[3:]), 2, 0)

    xs = (chunks(q), chunks(k), chunks(v), chunks(log_i), chunks(log_f))
    lower = jnp.tril(jnp.ones((CHUNK, CHUNK), dtype=bool))

    def step(carry, inp):
        C, n, m = carry
        qc, kc, vc, li, lf = inp
        bcum = jnp.cumsum(lf, axis=-1)
        gsum = bcum[..., -1]
        log_d = jnp.where(lower, bcum[..., :, None] - bcum[..., None, :] + li[..., None, :], -jnp.inf)
        m_inter = bcum + m[..., None]
        m_t = jnp.maximum(m_inter, jnp.max(log_d, axis=-1))
        s = jnp.einsum('bhtd,bhsd->bhts', qc, kc) * jnp.exp(log_d - m_t[..., None])
        a = jnp.exp(m_inter - m_t)
        num = jnp.einsum('bhts,bhse->bhte', s, vc) + a[..., None] * jnp.einsum('bhtd,bhde->bhte', qc, C)
        den = jnp.sum(s, axis=-1) + a * jnp.einsum('bhtd,bhd->bht', qc, n)
        h = num / jnp.maximum(jnp.abs(den), jnp.exp(-m_t))[..., None]
        log_w = gsum[..., None] - bcum + li
        m_new = jnp.maximum(gsum + m, jnp.max(log_w, axis=-1))
        decay = jnp.exp(gsum + m - m_new)
        w = jnp.exp(log_w - m_new[..., None])
        C = decay[..., None, None] * C + jnp.einsum('bhs,bhsd,bhse->bhde', w, kc, vc)
        n = decay[..., None] * n + jnp.einsum('bhs,bhsd->bhd', w, kc)
        return (C, n, m_new), h

    init = (jnp.zeros((b_, h_, d_, d_), jnp.float32),
            jnp.zeros((b_, h_, d_), jnp.float32),
            jnp.full((b_, h_), -1e30, jnp.float32))
    _, hs = lax.scan(step, init, xs)
    return jnp.moveaxis(hs, 0, 2).reshape(b_, h_, s_, d_)


def mlstm_bidirectional(q, k, v, gates):
    i_f, f_f, i_b, f_b = jnp.split(gates, 4, axis=1)
    h_fwd = mlstm_scan(q, k, v, i_f, jax.nn.log_sigmoid(f_f))
    flip = lambda t: jnp.flip(t, axis=2)
    h_bwd = flip(mlstm_scan(flip(q), flip(k), flip(v), flip(i_b), flip(jax.nn.log_sigmoid(f_b))))
    return h_fwd + h_bwd


def neighborhood_attention(q, k, v, rpb):
    b_, h_, s_, d_ = q.shape
    rows = s_ // GRID_W
    kr = min(WIN_ROWS_MAX, rows)
    kc = WIN_COLS
    grid = lambda t: t.reshape(b_, h_, rows, GRID_W, d_)
    q, k, v = grid(q), grid(k), grid(v)
    row_start = jnp.clip(jnp.arange(rows) - kr // 2, 0, rows - kr)
    cols = jnp.arange(GRID_W)
    col_idx = jnp.clip(cols - kc // 2, 0, GRID_W - kc)[:, None] + jnp.arange(kc)
    dc = col_idx - cols[:, None] + (WIN_COLS - 1)
    scale = d_ ** -0.5

    def row_block(r):
        rs = row_start[r]
        qr = lax.dynamic_index_in_dim(q, r, axis=2, keepdims=False)
        kb = lax.dynamic_slice_in_dim(k, rs, kr, axis=2)[:, :, :, col_idx]
        vb = lax.dynamic_slice_in_dim(v, rs, kr, axis=2)[:, :, :, col_idx]
        dr = rs + jnp.arange(kr) - r + (WIN_ROWS_MAX - 1)
        bias = rpb[:, dr[None, :, None], dc[:, None, :]]
        s = jnp.einsum('bhcd,bhrcjd->bhcrj', qr, kb).astype(jnp.float32) * scale + bias.astype(jnp.float32)
        p = jax.nn.softmax(s.reshape(b_, h_, GRID_W, kr * kc), axis=-1).reshape(s.shape)
        return jnp.einsum('bhcrj,bhrcjd->bhcd', p.astype(v.dtype), vb)

    out = lax.map(row_block, jnp.arange(rows))
    return jnp.moveaxis(out, 0, 2).reshape(b_, h_, s_, d_)


def conv_glu(h, w_up, conv_w, conv_b, w_down):
    u, g = jnp.split(h @ w_up, 2, axis=-1)
    s_ = g.shape[1]
    pad = CONV_W // 2
    gp = jnp.pad(g, ((0, 0), (pad, pad), (0, 0)))
    g = sum(gp[:, j:j + s_] * conv_w[j] for j in range(CONV_W)) + conv_b
    return (jax.nn.gelu(g, approximate=False) * u) @ w_down


def setup_inputs(seed: int = 0) -> dict:
    key = jax.random.key(seed)
    ks = jax.random.split(key, 20)
    nrm = jax.random.normal
    f32 = jnp.float32
    x = nrm(ks[0], (BATCH, SEQ, D_MODEL), f32)
    c = nrm(ks[1], (BATCH, D_MODEL), f32)
    w_ada = nrm(ks[2], (DEPTH, D_MODEL, N_MOD * D_MODEL), f32) * (0.5 * D_MODEL ** -0.5)
    b_ada = nrm(ks[3], (DEPTH, N_MOD * D_MODEL), f32) * 0.02
    g_norm1 = 1.0 + 0.02 * nrm(ks[4], (DEPTH, D_MODEL), f32)
    w_in = nrm(ks[5], (DEPTH, D_MODEL, IN_COLS), f32) * D_MODEL ** -0.5
    gk = jax.random.split(ks[6], 4)
    b_gates = jnp.concatenate([
        0.1 * nrm(gk[0], (DEPTH, NH_A), f32),
        3.0 + 0.5 * nrm(gk[1], (DEPTH, NH_A), f32),
        0.1 * nrm(gk[2], (DEPTH, NH_A), f32),
        3.0 + 0.5 * nrm(gk[3], (DEPTH, NH_A), f32),
    ], axis=-1)
    g_head_a = 1.0 + 0.02 * nrm(ks[7], (DEPTH, W_A), f32)
    rpb = 0.1 * nrm(ks[8], (DEPTH, NH_B, 2 * WIN_ROWS_MAX - 1, 2 * WIN_COLS - 1), f32)
    w_out = nrm(ks[9], (DEPTH, D_MIX, D_MODEL), f32) * D_MIX ** -0.5
    g_norm2 = 1.0 + 0.02 * nrm(ks[10], (DEPTH, D_MODEL), f32)
    w_up = nrm(ks[11], (DEPTH, D_MODEL, 2 * D_FF), f32) * D_MODEL ** -0.5
    conv_w = nrm(ks[12], (DEPTH, CONV_W, D_FF), f32) * CONV_W ** -0.5
    conv_b = 0.02 * nrm(ks[13], (DEPTH, D_FF), f32)
    w_down = nrm(ks[14], (DEPTH, D_FF, D_MODEL), f32) * D_FF ** -0.5
    g_final = 1.0 + 0.02 * nrm(ks[15], (D_MODEL,), f32)
    return {'x': x, 'c': c, 'w_ada': w_ada, 'b_ada': b_ada, 'g_norm1': g_norm1, 'w_in': w_in,
            'b_gates': b_gates, 'g_head_a': g_head_a, 'rpb': rpb, 'w_out': w_out, 'g_norm2': g_norm2,
            'w_up': w_up, 'conv_w': conv_w, 'conv_b': conv_b, 'w_down': w_down, 'g_final': g_final}


def reference(x, c, w_ada, b_ada, g_norm1, w_in, b_gates, g_head_a, rpb, w_out, g_norm2,
              w_up, conv_w, conv_b, w_down, g_final):
    f32 = jnp.float32
    for l in range(DEPTH):
        mod = jax.nn.silu(c) @ w_ada[l] + b_ada[l]
        sh1, sc1, ga1, sh2, sc2, ga2 = jnp.split(mod, N_MOD, axis=-1)

        h = modulate(rms_norm(x, g_norm1[l]), sh1, sc1)
        qa, ka, va, oa, gates, qb, kb, vb = jnp.split(h @ w_in[l], IN_SPLITS, axis=-1)

        q_a = to_heads(qa, NH_A).astype(f32)
        k_a = to_heads(ka, NH_A).astype(f32) * (DH_A ** -0.5)
        v_a = to_heads(va, NH_A).astype(f32)
        g_a = (gates.astype(f32) + b_gates[l].astype(f32)).transpose(0, 2, 1)
        h_a = mlstm_bidirectional(q_a, k_a, v_a, g_a)
        h_a = h_a * lax.rsqrt(jnp.mean(h_a * h_a, axis=-1, keepdims=True) + EPS)
        h_a = (from_heads(h_a) * g_head_a[l] * jax.nn.sigmoid(oa.astype(f32))).astype(x.dtype)

        h_b = from_heads(neighborhood_attention(to_heads(qb, NH_B), to_heads(kb, NH_B),
                                                to_heads(vb, NH_B), rpb[l])).astype(x.dtype)

        mixed = jnp.concatenate([h_a, h_b], axis=-1) @ w_out[l]
        x = x + ga1[:, None, :] * mixed

        h = modulate(rms_norm(x, g_norm2[l]), sh2, sc2)
        x = x + ga2[:, None, :] * conv_glu(h, w_up[l], conv_w[l], conv_b[l], w_down[l])
    return rms_norm(x, g_final)
```

```cpp
#include <hip/hip_runtime.h>
#include <hip/hip_cooperative_groups.h>
#include <cstdio>
#include <cstdint>
namespace cg = cooperative_groups;
#define MK_PER_PHASE 1
namespace pg8 {
#define PG8_LAS __attribute__((address_space(3)))
typedef unsigned short bf16_t;
typedef short bf16x8 __attribute__((ext_vector_type(8)));
typedef float f32x4 __attribute__((ext_vector_type(4)));
typedef unsigned u32x4 __attribute__((ext_vector_type(4)));
constexpr int BM = 256, BK = 64, HALF = 128, HTB = HALF * BK * 2  , STAGE_BYTES = 8 * HTB, NXCD = 8, WGM = 8;

__host__ __device__ __forceinline__ int lds_byte(int r, int c) { const int st = (r >> 4) * 2 + (c >> 5), rr = r & 15, cc = c & 31, ob = rr * 64 + cc * 2; return st * 1024 + (ob ^ (((ob >> 9) & 1) << 5)); }
__host__ __device__ __forceinline__ void stage_rc(int b, int& R, int& C) { const int st = b / 1024, sb = b % 1024, swz = sb ^ (((sb >> 9) & 1) << 5); R = (st >> 1) * 16 + swz / 64; C = (st & 1) * 32 + (swz % 64) / 2; }
__host__ __device__ __forceinline__ int perm32(int rho) { const int n = rho >> 4, i = rho & 15; return 8 * (i >> 2) + 4 * n + (i & 3); }

struct Unit { int pm, pn; };
struct Gemm { const bf16_t* A; const bf16_t* Bt; int M, N, K, lda; };

struct StaticOrder {
    int nM, nN, nwg, G, c;
    __host__ __device__ void init(int M, int N, int G_, int c_) { nM = M / BM; nN = N / BM; nwg = nM * nN; G = G_; c = c_; }
    __host__ __device__ bool next(int i, Unit& u) const {
        const long L = (long)i * G + c; if (L >= nwg) return false;
        int wgid = (int)L; { const int q = nwg / NXCD, r = nwg % NXCD, xcd = wgid % NXCD, off = wgid / NXCD; wgid = (xcd < r ? xcd * (q + 1) : r * (q + 1) + (xcd - r) * q) + off; }
        const int nig = WGM * nN, gid = wgid / nig, fm = gid * WGM, gsz = (nM - fm) < WGM ? (nM - fm) : WGM;
        u.pm = fm + ((wgid % nig) % gsz); u.pn = (wgid % nig) / gsz; return true;
    }
    __device__ __forceinline__ void a_ready(const Unit&) const {}
    __device__ __forceinline__ void done(const Unit&) const {}
};

__device__ __forceinline__ unsigned cvt_pk_bf16(float lo, float hi) { unsigned r; asm volatile("v_cvt_pk_bf16_f32 %0, %1, %2" : "=v"(r) : "v"(lo), "v"(hi)); return r; }
typedef float f32x2 __attribute__((ext_vector_type(2)));
__device__ __forceinline__ f32x2 gelu_pk(f32x2 v) {
    const f32x2 av = __builtin_elementwise_abs(v), d = av * 0.2316418882f + 1.0f;
    f32x2 t; t.x = __builtin_amdgcn_rcpf(d.x); t.y = __builtin_amdgcn_rcpf(d.y);
    f32x2 q = t * 0.5307027145f + (-0.7265760135f); q = q * t + 0.7107068705f; q = q * t + (-0.142248368f); q = q * t + 0.127414796f; q = q * t;
    const f32x2 s = (v * v) * (-0.72134752044f);
    f32x2 e; e.x = __builtin_amdgcn_exp2f(s.x); e.y = __builtin_amdgcn_exp2f(s.y);
    const f32x2 m = v * (q * e), r = v - m;
    f32x2 o; o.x = v.x < 0.f ? m.x : r.x; o.y = v.y < 0.f ? m.y : r.y; return o;
}

template <int ACT  > struct EpiBf16 {
    static constexpr bool PERM = true, AFTER_DRAIN = false; static_assert(ACT == 0 || ACT == 1, "EpiBf16: ACT is 0 (none) or 1 (gelu_pk)");
    bf16_t* O; int ldc; const float* bias; int split_cols; size_t split_stride; float scale0;
    __device__ __forceinline__ void operator()(const f32x4 (&acc)[2][2][4][2], const Unit& u, int wr, int wc, int fr, int fq) const {
        const int row0 = u.pm * BM + wr * 64 + fr; int colt = u.pn * BM; bf16_t* base = O;
        float sc = 1.f; if (split_cols) { const int t = colt / split_cols; base += (size_t)t * split_stride; colt -= t * split_cols; if (t == 0) sc = scale0; }
        const int col0 = colt + wc * 32 + 8 * fq, bcol0 = u.pn * BM + wc * 32 + 8 * fq;
        f32x4 bv[2][2];
#pragma unroll
        for (int bj = 0; bj < 2; ++bj)
#pragma unroll
            for (int n = 0; n < 2; ++n) bv[bj][n] = bias ? *(const f32x4*)(bias + bcol0 + bj * HALF + 4 * n) : (f32x4){0.f, 0.f, 0.f, 0.f};
#pragma unroll
        for (int ai = 0; ai < 2; ++ai)
#pragma unroll
            for (int m = 0; m < 4; ++m) { bf16_t* rowp = base + (size_t)(row0 + ai * HALF + m * 16) * ldc + col0;
#pragma unroll
                for (int bj = 0; bj < 2; ++bj) { f32x4 v0 = acc[ai][bj][m][0] + bv[bj][0], v1 = acc[ai][bj][m][1] + bv[bj][1];
                    if (ACT == 1) { f32x2 a = gelu_pk((f32x2){v0[0], v0[1]}), b = gelu_pk((f32x2){v0[2], v0[3]}), c = gelu_pk((f32x2){v1[0], v1[1]}), d = gelu_pk((f32x2){v1[2], v1[3]});
                        v0 = (f32x4){a.x, a.y, b.x, b.y}; v1 = (f32x4){c.x, c.y, d.x, d.y}; }
                    v0 = v0 * sc; v1 = v1 * sc; u32x4 w; w.x = cvt_pk_bf16(v0[0], v0[1]); w.y = cvt_pk_bf16(v0[2], v0[3]); w.z = cvt_pk_bf16(v1[0], v1[1]); w.w = cvt_pk_bf16(v1[2], v1[3]);
                    *(u32x4*)(rowp + bj * HALF) = w; } }
    }
};

template <class Epi, class Sched, bool ALIGN_EPI = false, bool SP2 = false>
__device__ __forceinline__ void gemm_phase(PG8_LAS unsigned char* lds, const Gemm g, const Sched& S, const Epi& E) {
    const int tid = threadIdx.x, wid = __builtin_amdgcn_readfirstlane(tid >> 6), lane = tid & 63, wr = wid >> 2, wc = wid & 3, fr = lane & 15, fq = lane >> 4;
    const int K = g.K, nt = K / BK;
    unsigned voffA[2], voffB[2];
#pragma unroll
    for (int i = 0; i < 2; ++i) { int R, C; stage_rc(tid * 16 + i * 8192, R, C); const int Rb = Epi::PERM ? ((R & ~31) + perm32(R & 31)) : R;
        voffA[i] = (unsigned)(R * g.lda + C) * 2u; voffB[i] = (unsigned)(Rb * K + C) * 2u; }
    const size_t kstep = (size_t)(BK * 2);
    const size_t hstep = (size_t)HALF * K * 2;
    const size_t tstep = 2 * hstep; const size_t hstepA = (size_t)HALF * g.lda * 2, tstepA = 2 * hstepA;
    const unsigned ldsw = (unsigned)wid * 1024u;
    const int aoff = lds_byte(wr * 64 + fr, fq * 8), boff = lds_byte(wc * 32 + fr, fq * 8);
#define PG8_SA(b, h) (((b) * 2 + (h)) * HTB)
#define PG8_SB(b, h) ((4 + (b) * 2 + (h)) * HTB)
#define PG8_STAGE(bufoff, gbase, voff) do { _Pragma("unroll") for (int _i = 0; _i < 2; ++_i) \
        __builtin_amdgcn_global_load_lds((const unsigned*)((const char*)(gbase) + (voff)[_i]), (PG8_LAS unsigned*)(lds + (bufoff) + ldsw + _i * 8192), 16, 0, 0); } while (0)
#define PG8_LDA(dst, b, h) do { _Pragma("unroll") for (int m = 0; m < 4; ++m) _Pragma("unroll") for (int k = 0; k < 2; ++k) dst[m][k] = *(const PG8_LAS bf16x8*)(lds + PG8_SA(b, h) + aoff + m * 2048 + k * 1024); } while (0)
#define PG8_LDB(dst, b, h) do { _Pragma("unroll") for (int n = 0; n < 2; ++n) _Pragma("unroll") for (int k = 0; k < 2; ++k) dst[n][k] = *(const PG8_LAS bf16x8*)(lds + PG8_SB(b, h) + boff + n * 2048 + k * 1024); } while (0)
#define PG8_MMA(ai, bj, At, Bt) do { __builtin_amdgcn_s_setprio(1); _Pragma("unroll") for (int m = 0; m < 4; ++m) _Pragma("unroll") for (int n = 0; n < 2; ++n) _Pragma("unroll") for (int k = 0; k < 2; ++k) \
        acc[ai][bj][m][n] = __builtin_amdgcn_mfma_f32_16x16x32_bf16(Bt[n][k], At[m][k], acc[ai][bj][m][n], 0, 0, 0); __builtin_amdgcn_s_setprio(0); } while (0)
#define PG8_WAIT_V(n) asm volatile("s_waitcnt vmcnt(" #n ")" ::: "memory")
#define PG8_WAIT_L(n) asm volatile("s_waitcnt lgkmcnt(" #n ")" ::: "memory")
#define PG8_BAR __builtin_amdgcn_s_barrier()
#define PG8_SCHED __builtin_amdgcn_sched_barrier(0)
    Unit cur, nxt; int ui = 0;
    if (!S.next(0, cur)) return;
    f32x4 acc[2][2][4][2];
#pragma unroll
    for (int a = 0; a < 2; ++a)
#pragma unroll
        for (int b = 0; b < 2; ++b)
#pragma unroll
            for (int m = 0; m < 4; ++m)
#pragma unroll
                for (int n = 0; n < 2; ++n) acc[a][b][m][n] = (f32x4){0.f, 0.f, 0.f, 0.f};
    bf16x8 At[4][2], B0[2][2], B1[2][2];
    const char* cA = (const char*)g.A + (size_t)cur.pm * tstepA; const char* cB = (const char*)g.Bt + (size_t)cur.pn * tstep;
    S.a_ready(cur);
    if constexpr (SP2) {
        PG8_STAGE(PG8_SB(0, 0), cB, voffB); PG8_STAGE(PG8_SB(0, 1), cB + hstep, voffB); PG8_STAGE(PG8_SA(0, 0), cA, voffA); PG8_STAGE(PG8_SA(0, 1), cA + hstepA, voffA);
        if (wr == 1) PG8_BAR;
        PG8_WAIT_V(2); PG8_BAR;
        PG8_STAGE(PG8_SB(1, 0), cB + kstep, voffB); PG8_STAGE(PG8_SA(1, 0), cA + kstep, voffA); PG8_STAGE(PG8_SB(1, 1), cB + hstep + kstep, voffB);
        PG8_WAIT_V(6); PG8_BAR;
    } else {
        PG8_STAGE(PG8_SB(0, 0), cB, voffB); PG8_STAGE(PG8_SA(0, 0), cA, voffA); PG8_STAGE(PG8_SB(0, 1), cB + hstep, voffB); PG8_STAGE(PG8_SA(0, 1), cA + hstepA, voffA);
        if (wr == 1) PG8_BAR;
        PG8_WAIT_V(4); PG8_BAR;
        PG8_STAGE(PG8_SB(1, 0), cB + kstep, voffB); PG8_STAGE(PG8_SA(1, 0), cA + kstep, voffA); PG8_STAGE(PG8_SB(1, 1), cB + hstep + kstep, voffB);
        PG8_WAIT_V(6); PG8_BAR;
    }
    for (;;) {
        const bool has_next = S.next(ui + 1, nxt);
        const char* nA = has_next ? (const char*)g.A + (size_t)nxt.pm * tstepA : cA; const char* nB = has_next ? (const char*)g.Bt + (size_t)nxt.pn * tstep : cB;
        for (int t = 0; t < nt; t += 2) {
            const bool last = (t == nt - 2);
            const char* a1 = cA + (size_t)(t + 1) * kstep;
            const char* a2 = last ? nA : cA + (size_t)(t + 2) * kstep; const char* b2 = last ? nB : cB + (size_t)(t + 2) * kstep;
            const char* a3 = a2 + kstep; const char* b3 = b2 + kstep;
            if (last && has_next) S.a_ready(nxt);
            if constexpr (SP2) {
            PG8_LDB(B0, 0, 0); PG8_LDB(B1, 0, 1); PG8_SCHED; PG8_LDA(At, 0, 0); PG8_STAGE(PG8_SA(1, 1), a1 + hstepA, voffA);
            PG8_WAIT_V(8); PG8_WAIT_L(0); PG8_BAR; PG8_MMA(0, 0, At, B0); PG8_MMA(0, 1, At, B1); PG8_BAR; PG8_SCHED;
            PG8_LDA(At, 0, 1); PG8_STAGE(PG8_SB(0, 0), b2, voffB); PG8_STAGE(PG8_SB(0, 1), b2 + hstep, voffB); PG8_STAGE(PG8_SA(0, 0), a2, voffA);
            PG8_WAIT_V(8); PG8_WAIT_L(0); PG8_BAR; PG8_MMA(1, 0, At, B0); PG8_MMA(1, 1, At, B1); PG8_BAR; PG8_SCHED;
            PG8_LDB(B0, 1, 0); PG8_LDB(B1, 1, 1); PG8_SCHED; PG8_LDA(At, 1, 0); PG8_STAGE(PG8_SA(0, 1), a2 + hstepA, voffA);
            PG8_WAIT_V(8); PG8_WAIT_L(0); PG8_BAR; PG8_MMA(0, 0, At, B0); PG8_MMA(0, 1, At, B1); PG8_BAR; PG8_SCHED;
            PG8_LDA(At, 1, 1); PG8_STAGE(PG8_SB(1, 0), b3, voffB); PG8_STAGE(PG8_SB(1, 1), b3 + hstep, voffB); PG8_STAGE(PG8_SA(1, 0), a3, voffA);
            PG8_WAIT_V(8); PG8_WAIT_L(0); PG8_BAR; PG8_MMA(1, 0, At, B0); PG8_MMA(1, 1, At, B1); PG8_BAR; PG8_SCHED;
            } else {
            PG8_LDB(B0, 0, 0); PG8_SCHED; PG8_LDA(At, 0, 0); PG8_STAGE(PG8_SA(1, 1), a1 + hstepA, voffA);
            PG8_WAIT_L(8); PG8_BAR; PG8_WAIT_L(0); PG8_MMA(0, 0, At, B0); PG8_BAR; PG8_SCHED;
            PG8_LDB(B1, 0, 1); PG8_STAGE(PG8_SB(0, 0), b2, voffB);
            PG8_BAR; PG8_WAIT_L(0); PG8_MMA(0, 1, At, B1); PG8_BAR;
            PG8_LDA(At, 0, 1); PG8_STAGE(PG8_SA(0, 0), a2, voffA);
            PG8_BAR; PG8_WAIT_L(0); PG8_MMA(1, 0, At, B0); PG8_BAR; PG8_SCHED;
            PG8_STAGE(PG8_SB(0, 1), b2 + hstep, voffB);
            PG8_WAIT_V(6); PG8_BAR; PG8_MMA(1, 1, At, B1); PG8_BAR;
            PG8_LDB(B0, 1, 0); PG8_SCHED; PG8_LDA(At, 1, 0); PG8_STAGE(PG8_SA(0, 1), a2 + hstepA, voffA);
            PG8_WAIT_L(8); PG8_BAR; PG8_WAIT_L(0); PG8_MMA(0, 0, At, B0); PG8_BAR; PG8_SCHED;
            PG8_LDB(B1, 1, 1); PG8_STAGE(PG8_SB(1, 0), b3, voffB);
            PG8_BAR; PG8_WAIT_L(0); PG8_MMA(0, 1, At, B1); PG8_BAR;
            PG8_LDA(At, 1, 1); PG8_STAGE(PG8_SA(1, 0), a3, voffA);
            PG8_BAR; PG8_WAIT_L(0); PG8_MMA(1, 0, At, B0); PG8_BAR; PG8_SCHED;
            PG8_STAGE(PG8_SB(1, 1), b3 + hstep, voffB);
            PG8_WAIT_V(6); PG8_BAR; PG8_MMA(1, 1, At, B1); PG8_BAR;
            }
        }
        if constexpr (ALIGN_EPI) { if (wr == 0) PG8_BAR; }
        if constexpr (!Epi::AFTER_DRAIN) { E(acc, cur, wr, wc, fr, fq); S.done(cur); }
        if (!has_next) break;
#pragma unroll
        for (int a = 0; a < 2; ++a)
#pragma unroll
            for (int b = 0; b < 2; ++b)
#pragma unroll
                for (int m = 0; m < 4; ++m)
#pragma unroll
                    for (int n = 0; n < 2; ++n) acc[a][b][m][n] = (f32x4){0.f, 0.f, 0.f, 0.f};
        cur = nxt; cA = nA; cB = nB; ++ui;
        if constexpr (ALIGN_EPI) { if (wr == 1) PG8_BAR; }
    }
    PG8_WAIT_V(0);
    if constexpr (!ALIGN_EPI) { if (wr == 0) PG8_BAR; }
    PG8_BAR;
    if constexpr (Epi::AFTER_DRAIN) { E.fused(acc, cur, wr, wc, fr, fq, lds, wid, lane); S.done(cur); }
#undef PG8_SA
#undef PG8_SB
#undef PG8_STAGE
#undef PG8_LDA
#undef PG8_LDB
#undef PG8_MMA
#undef PG8_WAIT_V
#undef PG8_WAIT_L
#undef PG8_BAR
#undef PG8_SCHED
}
}

#define DI __device__ __forceinline__
#define LAS __attribute__((address_space(3)))
typedef unsigned short bf16_t;
typedef short bf16x8 __attribute__((ext_vector_type(8)));
typedef short s16x4 __attribute__((ext_vector_type(4)));
typedef short v4i16_t __attribute__((ext_vector_type(4)));
typedef float f32x4 __attribute__((ext_vector_type(4)));
typedef unsigned u32x4 __attribute__((ext_vector_type(4)));
typedef unsigned u32x2 __attribute__((ext_vector_type(2)));

constexpr int NB = 2, SEQ = 8192, DM = 2048, MTOK = NB * SEQ, NPC = 7168, WIN_LD = 7184, DFF = 5632, NUP = 2 * DFF, NMOD = 6 * DM;
constexpr int LCH = 256, NCH = SEQ / LCH, EEXT = 272, ST_ELEMS = EEXT * 256, NCOMBO = 16;
constexpr float EPSN = 1e-6f;
#ifndef MK_PER_PHASE
#define MK_PER_PHASE 0
#endif
constexpr int NPH = 12;
constexpr int LDS_BYTES = 147456;

constexpr size_t OFF_P = 0;
constexpr size_t OFF_CST = OFF_P + (size_t)MTOK * NPC * 2;
constexpr size_t OFF_WIN = OFF_CST + (size_t)NCOMBO * NCH * ST_ELEMS * 2;
constexpr size_t OFF_WOUT = OFF_WIN + (size_t)NPC * DM * 2;
constexpr size_t OFF_R0END = OFF_WOUT + (size_t)DM * DM * 2;
constexpr size_t OFF_UG = 0;
constexpr size_t OFF_WUP = OFF_UG + (size_t)MTOK * NUP * 2;
constexpr size_t OFF_WDN = OFF_WUP + (size_t)NUP * DM * 2;
constexpr size_t OFF_HB = OFF_WDN + (size_t)DM * DFF * 2;
constexpr size_t OFF_MOD = OFF_HB + (size_t)MTOK * DM * 2;
constexpr size_t OFF_GATES = OFF_MOD + 131072;
constexpr size_t OFF_UL = OFF_GATES + (size_t)MTOK * 16 * 4;
constexpr size_t OFF_ML = OFF_UL + (size_t)NCOMBO * SEQ * 4;
constexpr size_t OFF_EMT = OFF_ML + (size_t)NCOMBO * SEQ * 4;
constexpr size_t OFF_MPREV = OFF_EMT + (size_t)NCOMBO * SEQ * 4;
constexpr size_t OFF_MEND = OFF_MPREV + 4096;
constexpr size_t WS_NEED = OFF_MEND + 4096;
static_assert(OFF_R0END <= OFF_WUP, "overlay region");
static_assert(WS_NEED <= 536870912ull, "workspace budget");

struct Args {
    const float *x, *c, *w_ada, *b_ada, *g_norm1, *w_in, *b_gates, *g_head_a, *rpb, *w_out, *g_norm2, *w_up, *conv_w, *conv_b, *w_down, *g_final;
    float* out; unsigned char* ws; int ph_lo, ph_hi;
};

DI float bf2f(unsigned v) { return __uint_as_float(v << 16); }
DI unsigned f2bf(float f) { unsigned u = __float_as_uint(f); return (u + 0x7fffu + ((u >> 16) & 1u)) >> 16; }
DI unsigned pk2(float lo, float hi) { return f2bf(lo) | (f2bf(hi) << 16); }
DI float wave_sum(float v) {
#pragma unroll
    for (int o = 1; o < 64; o <<= 1) v += __shfl_xor(v, o);
    return v;
}
DI s16x4 tr_read(const LAS unsigned char* p) { return __builtin_bit_cast(s16x4, __builtin_amdgcn_ds_read_tr16_b64_v4i16((LAS v4i16_t*)p)); }
DI bf16x8 tr_frag(const LAS unsigned char* base, int pitch, int rowA, int rowB, int col, int qin, int pin) {
    const s16x4 lo = tr_read(base + (rowA + qin) * pitch + (col + 4 * pin) * 2);
    const s16x4 hi = tr_read(base + (rowB + qin) * pitch + (col + 4 * pin) * 2);
    return (bf16x8){lo[0], lo[1], lo[2], lo[3], hi[0], hi[1], hi[2], hi[3]};
}
DI bf16x8 ld_frag(const LAS unsigned char* p) { return *(const LAS bf16x8*)p; }
#define MFMA16(a, b, c) __builtin_amdgcn_mfma_f32_16x16x32_bf16((a), (b), (c), 0, 0, 0)
DI bf16x8 pack8(const f32x4& a, const f32x4& b) {
    u32x4 w; w.x = pk2(a[0], a[1]); w.y = pk2(a[2], a[3]); w.z = pk2(b[0], b[1]); w.w = pk2(b[2], b[3]);
    return __builtin_bit_cast(bf16x8, w);
}
DI bf16x8 scale8(const bf16x8& q, float s) {
    const u32x4 u = __builtin_bit_cast(u32x4, q); u32x4 w;
#pragma unroll
    for (int i = 0; i < 4; ++i) w[i] = pk2(bf2f(u[i] & 0xffffu) * s, bf2f(u[i] >> 16) * s);
    return __builtin_bit_cast(bf16x8, w);
}
template <int ROWS, int COLS> DI void stage_tile(LAS unsigned char* dst, int lp, const bf16_t* src, int gp, int tid, int nthr) {
    constexpr int VPR = COLS / 8, NV = ROWS * VPR;
    int t0 = tid; asm volatile("" : "+v"(t0));
#pragma unroll 2
    for (int v = t0; v < NV; v += nthr) { const int r = v / VPR, cv = v % VPR;
        const u32x4 d = *(const u32x4*)(src + (r * gp + cv * 8)); *(LAS u32x4*)(dst + r * lp + cv * 16) = d; }
}

struct EpiResid {
    static constexpr bool PERM = false, AFTER_DRAIN = false;
    const float* res; float* out; const float* gate;
    __device__ __forceinline__ void operator()(const pg8::f32x4 (&acc)[2][2][4][2], const pg8::Unit& u, int wr, int wc, int fr, int fq) const {
        const int row0 = u.pm * 256 + wr * 64 + fr, col0 = u.pn * 256 + wc * 32 + 4 * fq, bb = u.pm >> 5;
        f32x4 gv[2][2];
#pragma unroll
        for (int bj = 0; bj < 2; ++bj)
#pragma unroll
            for (int n = 0; n < 2; ++n) gv[bj][n] = *(const f32x4*)(gate + (size_t)bb * NMOD + col0 + bj * 128 + n * 16);
#pragma unroll
        for (int ai = 0; ai < 2; ++ai)
#pragma unroll
            for (int m = 0; m < 4; ++m) { const size_t ro = (size_t)(row0 + ai * 128 + m * 16) * DM + col0;
#pragma unroll
                for (int bj = 0; bj < 2; ++bj)
#pragma unroll
                    for (int n = 0; n < 2; ++n) { const size_t o = ro + bj * 128 + n * 16; const f32x4 r = *(const f32x4*)(res + o); *(f32x4*)(out + o) = r + gv[bj][n] * acc[ai][bj][m][n]; } }
    }
};

DI void tr_block(const float* src, int ldw, bf16_t* dst, int ldd, float scale, LAS float* scr, int lane) {
#pragma unroll 8
    for (int i = 0; i < 32; ++i) { const int kk = 2 * i + (lane >> 5); scr[kk * 33 + (lane & 31)] = src[(size_t)kk * ldw + (lane & 31)]; }
    asm volatile("s_waitcnt lgkmcnt(0)" ::: "memory");
    const int c = lane & 7;
#pragma unroll
    for (int j = 0; j < 4; ++j) { const int n = (lane >> 3) + 8 * j; const LAS float* s = scr + (8 * c) * 33 + n;
        u32x4 o; o.x = pk2(s[0 * 33] * scale, s[1 * 33] * scale); o.y = pk2(s[2 * 33] * scale, s[3 * 33] * scale); o.z = pk2(s[4 * 33] * scale, s[5 * 33] * scale); o.w = pk2(s[6 * 33] * scale, s[7 * 33] * scale);
        *(u32x4*)(dst + (size_t)n * ldd + 8 * c) = o; }
    asm volatile("s_waitcnt lgkmcnt(0)" ::: "memory");
}
DI void phase0(const Args& a, LAS unsigned char* lds, int tid, int lane, int wave) {
    LAS float* sc = (LAS float*)lds;
    LAS float* red = sc + 4096;
    float* mod = (float*)(a.ws + OFF_MOD);
    for (int i = tid; i < 4096; i += 512) { const float v = a.c[i]; sc[i] = v / (1.f + __expf(-v)); }
    __syncthreads();
    for (int item = blockIdx.x; item < 256; item += gridDim.x) {
        const int n0 = item * 48;
        if (tid < 384) {
            const int cq = tid % 12, ks = tid / 12;
            f32x4 a0 = {0.f, 0.f, 0.f, 0.f}, a1 = {0.f, 0.f, 0.f, 0.f};
            const float* wp = a.w_ada + (size_t)(ks * 64) * NMOD + n0 + 4 * cq;
#pragma unroll 8
            for (int kk = 0; kk < 64; ++kk) { const f32x4 w = *(const f32x4*)(wp + (size_t)kk * NMOD); const float s0 = sc[ks * 64 + kk], s1 = sc[2048 + ks * 64 + kk]; a0 += s0 * w; a1 += s1 * w; }
            LAS float* rp = red + (ks * 12 + cq) * 8;
            *(LAS f32x4*)rp = a0; *(LAS f32x4*)(rp + 4) = a1;
        }
        __syncthreads();
        if (tid < 96) { const int cq = tid >> 3, j = tid & 7; float s = 0.f;
            for (int ks = 0; ks < 32; ++ks) s += red[(ks * 12 + cq) * 8 + j];
            const int bb = j >> 2, col = n0 + 4 * cq + (j & 3); mod[bb * NMOD + col] = s + a.b_ada[col]; }
        __syncthreads();
    }
    LAS float* scr = (LAS float*)(lds + 32768 + wave * 8448);
    bf16_t* WinT = (bf16_t*)(a.ws + OFF_WIN); bf16_t* WoutT = (bf16_t*)(a.ws + OFF_WOUT); bf16_t* WupT = (bf16_t*)(a.ws + OFF_WUP); bf16_t* WdnT = (bf16_t*)(a.ws + OFF_WDN);
    constexpr int I_IN = 32 * (NPC / 32), I_OUT = 32 * (DM / 32), I_UP = 32 * (NUP / 32), I_DN = (DFF / 64) * (DM / 32);
    const int gw = blockIdx.x * 8 + wave, NGW = gridDim.x * 8;
    for (int it = gw; it < I_IN + I_OUT + I_UP + I_DN; it += NGW) {
        int r = it;
        if (r < I_IN) { const int nblk = NPC / 32, kb = r / nblk, nb = r % nblk, n0 = nb * 32, ns = n0 < 4096 ? n0 : n0 + 16;
            tr_block(a.w_in + (size_t)(kb * 64) * WIN_LD + ns, WIN_LD, WinT + (size_t)n0 * DM + kb * 64, DM, (n0 >= 1024 && n0 < 2048) ? 0.0625f : 1.f, scr, lane); continue; }
        r -= I_IN;
        if (r < I_OUT) { const int nblk = DM / 32, kb = r / nblk, nb = r % nblk;
            tr_block(a.w_out + (size_t)(kb * 64) * DM + nb * 32, DM, WoutT + (size_t)(nb * 32) * DM + kb * 64, DM, 1.f, scr, lane); continue; }
        r -= I_OUT;
        if (r < I_UP) { const int nblk = NUP / 32, kb = r / nblk, nb = r % nblk;
            tr_block(a.w_up + (size_t)(kb * 64) * NUP + nb * 32, NUP, WupT + (size_t)(nb * 32) * DM + kb * 64, DM, 1.f, scr, lane); continue; }
        r -= I_UP;
        { const int nblk = DM / 32, kb = r / nblk, nb = r % nblk;
            tr_block(a.w_down + (size_t)(kb * 64) * DM + nb * 32, DM, WdnT + (size_t)(nb * 32) * DFF + kb * 64, DFF, 1.f, scr, lane); }
    }
}

template <bool GATES> DI void phase_norm(const Args& a, LAS unsigned char* lds, const float* xin, const float* gn, int sh_off, int sc_off, int tid, int lane, int wave) {
    const float* mod = (const float*)(a.ws + OFF_MOD);
    bf16_t* Hb = (bf16_t*)(a.ws + OFF_HB);
    float* gates = (float*)(a.ws + OFF_GATES);
    LAS float* wg = (LAS float*)lds;
    if (GATES) {
        for (int idx = tid; idx < 2048 * 16; idx += 512) { const int k = idx >> 4, i = idx & 15; wg[i * 2052 + k] = a.w_in[(size_t)k * WIN_LD + 4096 + i]; }
        __syncthreads();
    }
    const int gw = blockIdx.x * 8 + wave, NGW = gridDim.x * 8;
    int curb = -1; f32x4 gs[8], sh[8];
    for (int m = gw; m < MTOK; m += NGW) {
        const int bb = m >> 13;
        if (bb != curb) { curb = bb;
#pragma unroll
            for (int j = 0; j < 8; ++j) { const int k = 4 * lane + 256 * j; const f32x4 g = *(const f32x4*)(gn + k), s = *(const f32x4*)(mod + bb * NMOD + sc_off + k);
                gs[j] = g * (1.f + s); sh[j] = *(const f32x4*)(mod + bb * NMOD + sh_off + k); } }
        f32x4 v[8]; float ss = 0.f;
#pragma unroll
        for (int j = 0; j < 8; ++j) { v[j] = *(const f32x4*)(xin + (size_t)m * DM + 4 * lane + 256 * j); ss += (v[j].x * v[j].x + v[j].y * v[j].y) + (v[j].z * v[j].z + v[j].w * v[j].w); }
        const float rstd = rsqrtf(wave_sum(ss) * (1.f / DM) + EPSN);
#pragma unroll
        for (int j = 0; j < 8; ++j) { v[j] = v[j] * rstd * gs[j] + sh[j];
            u32x2 o; o.x = pk2(v[j].x, v[j].y); o.y = pk2(v[j].z, v[j].w); *(u32x2*)(Hb + (size_t)m * DM + 4 * lane + 256 * j) = o; }
        if (GATES) {
            float g16[16];
#pragma unroll
            for (int i = 0; i < 16; ++i) { float s = 0.f;
#pragma unroll
                for (int j = 0; j < 8; ++j) { const f32x4 w = *(const LAS f32x4*)(wg + i * 2052 + 4 * lane + 256 * j); s += (v[j].x * w.x + v[j].y * w.y) + (v[j].z * w.z + v[j].w * w.w); }
                g16[i] = s; __builtin_amdgcn_sched_barrier(0); }
#pragma unroll
            for (int i = 0; i < 8; ++i) { const bool hi = lane & 32; const float snd = hi ? g16[i] : g16[i + 8], keep = hi ? g16[i + 8] : g16[i]; g16[i] = keep + __shfl_xor(snd, 32); }
#pragma unroll
            for (int i = 0; i < 4; ++i) { const bool hi = lane & 16; const float snd = hi ? g16[i] : g16[i + 4], keep = hi ? g16[i + 4] : g16[i]; g16[i] = keep + __shfl_xor(snd, 16); }
#pragma unroll
            for (int i = 0; i < 2; ++i) { const bool hi = lane & 8; const float snd = hi ? g16[i] : g16[i + 2], keep = hi ? g16[i + 2] : g16[i]; g16[i] = keep + __shfl_xor(snd, 8); }
            { const bool hi = lane & 4; const float snd = hi ? g16[0] : g16[1], keep = hi ? g16[1] : g16[0]; g16[0] = keep + __shfl_xor(snd, 4); }
            g16[0] += __shfl_xor(g16[0], 2); g16[0] += __shfl_xor(g16[0], 1);
            if ((lane & 3) == 0) { const int gi = ((lane >> 5) & 1) * 8 + ((lane >> 4) & 1) * 4 + ((lane >> 3) & 1) * 2 + ((lane >> 2) & 1); gates[(size_t)m * 16 + gi] = g16[0] + a.b_gates[gi]; }
        }
    }
}

DI void gate_prep(const Args& a, LAS unsigned char* lds, int combo, int tid) {
    const float* gates = (const float*)(a.ws + OFF_GATES);
    float* ulA = (float*)(a.ws + OFF_UL); float* MlA = (float*)(a.ws + OFF_ML); float* emtA = (float*)(a.ws + OFF_EMT);
    float* mprevA = (float*)(a.ws + OFF_MPREV); float* mendA = (float*)(a.ws + OFF_MEND);
    LAS float* sT = (LAS float*)lds; LAS float* sM = sT + 512; LAS float* sG = sM + 512; LAS float* sX = sG + 32; LAS float* sMp = sX + 32; LAS float* sMe = sMp + 32;
    const int b = combo >> 3, dir = (combo >> 2) & 1, h = combo & 3;
    const int ci = dir * 8 + h, cf = dir * 8 + 4 + h, cs = tid >> 4;
    float li[16], bl[16], cm[16];
    float run = 0.f;
#pragma unroll
    for (int i = 0; i < 16; ++i) { const int tau = tid * 16 + i, t = dir ? SEQ - 1 - tau : tau; const float* gp = gates + (size_t)(b * SEQ + t) * 16;
        li[i] = gp[ci]; const float f = gp[cf]; const float lf = fminf(f, 0.f) - log1pf(__expf(-fabsf(f))); run += lf; bl[i] = run; }
    sT[tid] = run; __syncthreads();
    float base = 0.f; for (int j = cs * 16; j < tid; ++j) base += sT[j];
    float mx = -3.0e38f;
#pragma unroll
    for (int i = 0; i < 16; ++i) { bl[i] += base; li[i] -= bl[i]; mx = fmaxf(mx, li[i]); cm[i] = mx; }
    sM[tid] = mx; __syncthreads();
    float mbase = -3.0e38f; for (int j = cs * 16; j < tid; ++j) mbase = fmaxf(mbase, sM[j]);
    if (tid < 32) { float g = 0.f, xm = -3.0e38f; for (int j = 0; j < 16; ++j) { g += sT[tid * 16 + j]; xm = fmaxf(xm, sM[tid * 16 + j]); } sG[tid] = g; sX[tid] = xm; }
    __syncthreads();
    if (tid == 0) { float m = -1e30f; for (int c = 0; c < 32; ++c) { sMp[c] = m; const float me = fmaxf(m, sX[c]); sMe[c] = me; m = sG[c] + me; } }
    __syncthreads();
    const float mp = sMp[cs];
#pragma unroll
    for (int i = 0; i < 16; ++i) { const int tau = tid * 16 + i, t = dir ? SEQ - 1 - tau : tau; const float Ml = fmaxf(mp, fmaxf(cm[i], mbase));
        ulA[combo * SEQ + t] = li[i]; MlA[combo * SEQ + t] = Ml; emtA[combo * SEQ + t] = __expf(-(bl[i] + Ml)); }
    if ((tid & 15) == 0) { const int c = dir ? NCH - 1 - cs : cs; mprevA[combo * NCH + c] = mp; mendA[combo * NCH + c] = sMe[cs]; }
    __syncthreads();
}

DI void mlstm_delta(const Args& a, LAS unsigned char* lds, int tid, int lane, int wave) {
    const bf16_t* P = (const bf16_t*)(a.ws + OFF_P); bf16_t* cst = (bf16_t*)(a.ws + OFF_CST);
    const float* ulA = (const float*)(a.ws + OFF_UL); const float* mendA = (const float*)(a.ws + OFF_MEND);
    const int l15 = lane & 15, quad = lane >> 4, qin = l15 >> 2, pin = l15 & 3;
    LAS unsigned char* Kt = lds; LAS unsigned char* Vt = lds + 33792; LAS float* wS = (LAS float*)(lds + 67584);
    const short one = (l15 == 0) ? (short)0x3F80 : (short)0;
    const bf16x8 ones = {one, one, one, one, one, one, one, one};
    for (int item = blockIdx.x; item < NCOMBO * NCH; item += gridDim.x) {
        const int combo = item / NCH, c = item % NCH, b = combo >> 3, h = combo & 3;
        const float mend = mendA[combo * NCH + c];
        if (tid < 256) wS[tid] = __expf(ulA[combo * SEQ + c * LCH + tid] - mend);
        f32x4 acc[17][2];
#pragma unroll
        for (int m = 0; m < 17; ++m) { acc[m][0] = (f32x4){0.f, 0.f, 0.f, 0.f}; acc[m][1] = (f32x4){0.f, 0.f, 0.f, 0.f}; }
        const bf16_t* Pk = P + (size_t)(b * SEQ + c * LCH) * NPC + 1024 + h * 256;
        for (int sb = 0; sb < 4; ++sb) {
            __syncthreads();
#pragma unroll 2
            for (int v = tid; v < 64 * 32; v += 512) { const int r = v >> 5, cv = v & 31; const bf16_t* src = Pk + (size_t)(sb * 64 + r) * NPC + cv * 8;
                const u32x4 kd = *(const u32x4*)src, vd = *(const u32x4*)(src + 1024); const float w = wS[sb * 64 + r];
                *(LAS bf16x8*)(Kt + r * 528 + cv * 16) = scale8(__builtin_bit_cast(bf16x8, kd), w); *(LAS u32x4*)(Vt + r * 528 + cv * 16) = vd; }
            __syncthreads();
#pragma unroll 1
            for (int kk = 0; kk < 2; ++kk) {
                bf16x8 bfr[2];
#pragma unroll
                for (int n = 0; n < 2; ++n) bfr[n] = tr_frag(Kt, 528, kk * 32 + 8 * quad, kk * 32 + 8 * quad + 4, wave * 32 + n * 16, qin, pin);
#pragma unroll
                for (int m = 0; m < 16; ++m) { const bf16x8 afr = tr_frag(Vt, 528, kk * 32 + 8 * quad, kk * 32 + 8 * quad + 4, m * 16, qin, pin);
                    acc[m][0] = MFMA16(afr, bfr[0], acc[m][0]); acc[m][1] = MFMA16(afr, bfr[1], acc[m][1]); if ((m & 3) == 3) __builtin_amdgcn_sched_barrier(0); }
                acc[16][0] = MFMA16(ones, bfr[0], acc[16][0]); acc[16][1] = MFMA16(ones, bfr[1], acc[16][1]);
            }
        }
        int loff = 4 * quad * 256 + wave * 32 + l15; asm volatile("" : "+v"(loff));
        bf16_t* dst = cst + (size_t)item * ST_ELEMS + loff;
#pragma unroll
        for (int m = 0; m < 17; ++m)
#pragma unroll
            for (int n = 0; n < 2; ++n)
#pragma unroll
                for (int r = 0; r < 4; ++r) { dst[(16 * m + r) * 256 + 16 * n] = (bf16_t)f2bf(acc[m][n][r]); if (r == 3) __builtin_amdgcn_sched_barrier(0); }
    }
}

DI void mlstm_scan(const Args& a, int tid) {
    bf16_t* cst = (bf16_t*)(a.ws + OFF_CST);
    const float* mprevA = (const float*)(a.ws + OFF_MPREV); const float* mendA = (const float*)(a.ws + OFF_MEND);
    constexpr int VPS = ST_ELEMS / 8;
    const int gt = blockIdx.x * 512 + tid, NT = gridDim.x * 512;
    for (int v = gt; v < NCOMBO * VPS; v += NT) {
        const int combo = v / VPS, vi = v % VPS, dir = (combo >> 2) & 1;
        float st[8];
#pragma unroll
        for (int i = 0; i < 8; ++i) st[i] = 0.f;
        for (int cs0 = 0; cs0 < NCH; cs0 += 4) {
            u32x4 d[4]; float dec[4];
#pragma unroll
            for (int q = 0; q < 4; ++q) { const int c = dir ? NCH - 1 - (cs0 + q) : cs0 + q;
                d[q] = *(const u32x4*)(cst + (size_t)(combo * NCH + c) * ST_ELEMS + vi * 8); dec[q] = __expf(mprevA[combo * NCH + c] - mendA[combo * NCH + c]); }
#pragma unroll
            for (int q = 0; q < 4; ++q) { const int c = dir ? NCH - 1 - (cs0 + q) : cs0 + q;
                u32x4 o;
#pragma unroll
                for (int i = 0; i < 4; ++i) { o[i] = pk2(st[2 * i], st[2 * i + 1]); st[2 * i] = dec[q] * st[2 * i] + bf2f(d[q][i] & 0xffffu); st[2 * i + 1] = dec[q] * st[2 * i + 1] + bf2f(d[q][i] >> 16); }
                *(u32x4*)(cst + (size_t)(combo * NCH + c) * ST_ELEMS + vi * 8) = o; }
        }
    }
}

DI void natten(const Args& a, LAS unsigned char* lds, int tid, int lane, int wave) {
    const bf16_t* P = (const bf16_t*)(a.ws + OFF_P); bf16_t* mixed = (bf16_t*)(a.ws + OFF_HB);
    const int l15 = lane & 15, quad = lane >> 4, qin = l15 >> 2, pin = l15 & 3;
    const int hw = wave >> 2, j = wave & 3, htid = tid & 255;
    LAS unsigned char* T = lds + hw * 69632;
    const int kc0 = (j == 0) ? 0 : (j == 1) ? 8 : (j == 2) ? 24 : 32;
    const float scale = 0.08838834764831845f;
    for (int item = blockIdx.x; item < 1024; item += gridDim.x) {
        const int b = item >> 9, r = (item >> 2) & 127, hp = item & 3, h = hp * 2 + hw;
        const int rs = min(max(r - 4, 0), 120), qcol = 16 * j + l15;
        const size_t tokq = (size_t)b * SEQ + r * 64 + qcol;
        bf16x8 qf[4];
#pragma unroll
        for (int ks = 0; ks < 4; ++ks) qf[ks] = *(const bf16x8*)(P + tokq * NPC + 4096 + h * 128 + ks * 32 + quad * 8);
        f32x4 st[8][2];
#pragma unroll
        for (int g = 0; g < 2; ++g) {
            __syncthreads();
            stage_tile<256, 128>(T, 272, P + ((size_t)b * SEQ + (rs + 4 * g) * 64) * NPC + 5120 + h * 128, NPC, htid, 256);
            __syncthreads();
#pragma unroll
            for (int k4 = 0; k4 < 4; ++k4)
#pragma unroll
                for (int mi = 0; mi < 2; ++mi) { f32x4 s = {0.f, 0.f, 0.f, 0.f};
#pragma unroll
                    for (int ks = 0; ks < 4; ++ks) s = MFMA16(ld_frag(T + (k4 * 64 + kc0 + 16 * mi + l15) * 272 + (ks * 32 + quad * 8) * 2), qf[ks], s);
                    st[4 * g + k4][mi] = s; }
        }
        const int cs = min(max(qcol - 8, 0), 48);
        float mx = -3.0e38f;
#pragma unroll
        for (int kr = 0; kr < 8; ++kr)
#pragma unroll
            for (int mi = 0; mi < 2; ++mi)
#pragma unroll
                for (int rr = 0; rr < 4; ++rr) { const int kc = kc0 + 16 * mi + 4 * quad + rr; const bool valid = (kc >= cs) && (kc < cs + 16);
                    const int dr = rs + kr - r + 7, dc = kc - qcol + 15;
                    const float bias = valid ? a.rpb[(h * 15 + dr) * 31 + dc] : 0.f;
                    const float s = valid ? st[kr][mi][rr] * scale + bias : -3.0e38f; st[kr][mi][rr] = s; mx = fmaxf(mx, s); }
        mx = fmaxf(mx, __shfl_xor(mx, 16)); mx = fmaxf(mx, __shfl_xor(mx, 32));
        float sum = 0.f;
#pragma unroll
        for (int kr = 0; kr < 8; ++kr)
#pragma unroll
            for (int mi = 0; mi < 2; ++mi)
#pragma unroll
                for (int rr = 0; rr < 4; ++rr) { const float s = st[kr][mi][rr]; const float p = (s > -1.0e38f) ? __expf(s - mx) : 0.f; st[kr][mi][rr] = p; sum += p; }
        sum += __shfl_xor(sum, 16); sum += __shfl_xor(sum, 32);
        const float inv = 1.f / sum;
        f32x4 o[8];
#pragma unroll
        for (int n = 0; n < 8; ++n) o[n] = (f32x4){0.f, 0.f, 0.f, 0.f};
#pragma unroll
        for (int g = 0; g < 2; ++g) {
            __syncthreads();
            stage_tile<256, 128>(T, 272, P + ((size_t)b * SEQ + (rs + 4 * g) * 64) * NPC + 6144 + h * 128, NPC, htid, 256);
            __syncthreads();
#pragma unroll
            for (int k4 = 0; k4 < 4; ++k4) { const bf16x8 pf = pack8(st[4 * g + k4][0], st[4 * g + k4][1]);
#pragma unroll
                for (int n = 0; n < 8; ++n) o[n] = MFMA16(tr_frag(T + k4 * 64 * 272, 272, kc0 + 4 * quad, kc0 + 16 + 4 * quad, 16 * n, qin, pin), pf, o[n]); }
        }
#pragma unroll
        for (int n = 0; n < 8; ++n) { u32x2 w; w.x = pk2(o[n][0] * inv, o[n][1] * inv); w.y = pk2(o[n][2] * inv, o[n][3] * inv);
            *(u32x2*)(mixed + tokq * DM + 1024 + h * 128 + 16 * n + 4 * quad) = w; }
    }
}

DI void mlstm_out(const Args& a, LAS unsigned char* lds, int tid, int lane, int wave) {
    const bf16_t* P = (const bf16_t*)(a.ws + OFF_P); const bf16_t* cst = (const bf16_t*)(a.ws + OFF_CST); bf16_t* mixed = (bf16_t*)(a.ws + OFF_HB);
    const float* ulA = (const float*)(a.ws + OFF_UL); const float* MlA = (const float*)(a.ws + OFF_ML); const float* emtA = (const float*)(a.ws + OFF_EMT);
    const float* mprevA = (const float*)(a.ws + OFF_MPREV);
    const int l15 = lane & 15, quad = lane >> 4, qin = l15 >> 2, pin = l15 & 3;
    LAS unsigned char* T0 = lds; LAS unsigned char* T1 = lds + 40960; LAS float* ulS = (LAS float*)(lds + 40960 + 33792);
    const short one = (l15 == 0) ? (short)0x3F80 : (short)0;
    const bf16x8 ones = {one, one, one, one, one, one, one, one};
    for (int item = blockIdx.x; item < 512; item += gridDim.x) {
        const int bh = item >> 6, c = (item >> 1) & 31, half = item & 1, b = bh >> 2, h = bh & 3;
        const int t_loc = 128 * half + 16 * wave + l15;
        const size_t tok = (size_t)b * SEQ + c * LCH + t_loc;
#pragma unroll 1
        for (int dir = 0; dir < 2; ++dir) {
            const int combo = (b * 2 + dir) * 4 + h;
            const float Ml = MlA[combo * SEQ + c * LCH + t_loc], emt = emtA[combo * SEQ + c * LCH + t_loc], aa = __expf(mprevA[combo * NCH + c] - Ml);
            __syncthreads();
            if (tid < 256) ulS[tid] = ulA[combo * SEQ + c * LCH + tid];
            f32x4 acc[17];
#pragma unroll
            for (int m = 0; m < 17; ++m) acc[m] = (f32x4){0.f, 0.f, 0.f, 0.f};
            const int jlo = dir ? 2 * half : 0, jhi = dir ? 3 : 2 * half + 1;
            for (int jb = jlo; jb <= jhi; ++jb) {
                __syncthreads();
                { const bf16_t* src = P + ((size_t)b * SEQ + c * LCH + 64 * jb) * NPC + 1024 + h * 256;
                  stage_tile<64, 256>(T0, 528, src, NPC, tid, 512); stage_tile<64, 256>(T1, 528, src + 1024, NPC, tid, 512); }
                __syncthreads();
                f32x4 s[4];
#pragma unroll
                for (int mi = 0; mi < 4; ++mi) s[mi] = (f32x4){0.f, 0.f, 0.f, 0.f};
#pragma unroll 1
                for (int kh = 0; kh < 2; ++kh) {
                    bf16x8 qf[4];
                    { int qo = h * 256 + quad * 8 + kh * 128; asm volatile("" : "+v"(qo)); const bf16_t* qp = P + tok * NPC + qo;
#pragma unroll
                      for (int ks = 0; ks < 4; ++ks) qf[ks] = *(const bf16x8*)(qp + ks * 32); }
#pragma unroll
                    for (int mi = 0; mi < 4; ++mi) {
#pragma unroll
                        for (int ks = 0; ks < 4; ++ks) s[mi] = MFMA16(ld_frag(T0 + (16 * mi + l15) * 528 + (32 * (4 * kh + ks) + 8 * quad) * 2), qf[ks], s[mi]);
                        __builtin_amdgcn_sched_barrier(0); }
                }
#pragma unroll
                for (int mi = 0; mi < 4; ++mi)
#pragma unroll
                    for (int rr = 0; rr < 4; ++rr) { const int s_loc = 64 * jb + 16 * mi + 4 * quad + rr; const bool valid = dir ? (s_loc >= t_loc) : (s_loc <= t_loc);
                        const float wgt = valid ? __expf(ulS[s_loc] - Ml) : 0.f; s[mi][rr] *= wgt; }
#pragma unroll
                for (int kk = 0; kk < 2; ++kk) { const bf16x8 pf = pack8(s[2 * kk], s[2 * kk + 1]);
#pragma unroll
                    for (int n = 0; n < 16; ++n) { acc[n] = MFMA16(tr_frag(T1, 528, 32 * kk + 4 * quad, 32 * kk + 16 + 4 * quad, 16 * n, qin, pin), pf, acc[n]); if ((n & 3) == 3) __builtin_amdgcn_sched_barrier(0); }
                    acc[16] = MFMA16(ones, pf, acc[16]); }
            }
            const bf16_t* stp = cst + (size_t)(combo * NCH + c) * ST_ELEMS;
#pragma unroll 1
            for (int db = 0; db < 4; ++db) {
                __syncthreads();
                stage_tile<EEXT, 64>(T0, 144, stp + 64 * db, 256, tid, 512);
                __syncthreads();
#pragma unroll 1
                for (int kk = 0; kk < 2; ++kk) { const bf16x8 aq = scale8(*(const bf16x8*)(P + tok * NPC + h * 256 + (2 * db + kk) * 32 + quad * 8), aa);
#pragma unroll
                    for (int m = 0; m < 17; ++m) { acc[m] = MFMA16(ld_frag(T0 + (16 * m + l15) * 144 + (32 * kk + 8 * quad) * 2), aq, acc[m]); if ((m & 3) == 3) __builtin_amdgcn_sched_barrier(0); } }
            }
            const float den = __shfl(acc[16][0], l15);
            const float dn = 1.f / fmaxf(fabsf(den), emt);
            int moff = h * 256 + 4 * quad; asm volatile("" : "+v"(moff));
            bf16_t* mrow = mixed + tok * DM + moff;
            if (dir == 0) {
#pragma unroll
                for (int n = 0; n < 16; ++n) { u32x2 w; w.x = pk2(acc[n][0] * dn, acc[n][1] * dn); w.y = pk2(acc[n][2] * dn, acc[n][3] * dn); *(u32x2*)(mrow + 16 * n) = w; }
            } else {
                float ss = 0.f;
#pragma unroll
                for (int n = 0; n < 16; ++n) { const u32x2 hf = *(const u32x2*)(mrow + 16 * n);
                    acc[n][0] = acc[n][0] * dn + bf2f(hf.x & 0xffffu); acc[n][1] = acc[n][1] * dn + bf2f(hf.x >> 16);
                    acc[n][2] = acc[n][2] * dn + bf2f(hf.y & 0xffffu); acc[n][3] = acc[n][3] * dn + bf2f(hf.y >> 16);
                    ss += (acc[n][0] * acc[n][0] + acc[n][1] * acc[n][1]) + (acc[n][2] * acc[n][2] + acc[n][3] * acc[n][3]); }
                ss += __shfl_xor(ss, 16); ss += __shfl_xor(ss, 32);
                const float rstd = rsqrtf(ss * (1.f / 256.f) + EPSN);
#pragma unroll
                for (int n = 0; n < 16; ++n) { const int e0 = h * 256 + 16 * n + 4 * quad; const f32x4 g = *(const f32x4*)(a.g_head_a + e0);
                    const u32x2 ov = *(const u32x2*)(P + tok * NPC + 3072 + e0);
                    const float o0 = bf2f(ov.x & 0xffffu), o1 = bf2f(ov.x >> 16), o2 = bf2f(ov.y & 0xffffu), o3 = bf2f(ov.y >> 16);
                    u32x2 w; w.x = pk2(acc[n][0] * rstd * g.x / (1.f + __expf(-o0)), acc[n][1] * rstd * g.y / (1.f + __expf(-o1)));
                    w.y = pk2(acc[n][2] * rstd * g.z / (1.f + __expf(-o2)), acc[n][3] * rstd * g.w / (1.f + __expf(-o3)));
                    *(u32x2*)(mixed + tok * DM + e0) = w; __builtin_amdgcn_sched_barrier(0); }
            }
        }
    }
}

DI void phase_act(const Args& a, int tid) {
    bf16_t* UG = (bf16_t*)(a.ws + OFF_UG);
    constexpr int NV = DFF / 8, RUN = 16, NRUN = MTOK / RUN;
    const int gt = blockIdx.x * 512 + tid, NT = gridDim.x * 512;
    for (int it = gt; it < NRUN * NV; it += NT) {
        const int vv = it % NV, run = it / NV, f0 = vv * 8, t0 = run * RUN;
        float w0[8], w1[8], w2[8], cb[8];
#pragma unroll
        for (int i = 0; i < 8; ++i) { w0[i] = a.conv_w[f0 + i]; w1[i] = a.conv_w[DFF + f0 + i]; w2[i] = a.conv_w[2 * DFF + f0 + i]; cb[i] = a.conv_b[f0 + i]; }
        const u32x4 zero = {0u, 0u, 0u, 0u};
        const bf16_t* G = UG + DFF + f0;
        u32x4 gp = ((t0 & (SEQ - 1)) == 0) ? zero : *(const u32x4*)(G + (size_t)(t0 - 1) * NUP);
        u32x4 gc = *(const u32x4*)(G + (size_t)t0 * NUP);
        for (int i = 0; i < RUN; ++i) { const int t = t0 + i;
            const u32x4 gn = (((t + 1) & (SEQ - 1)) == 0) ? zero : *(const u32x4*)(G + (size_t)(t + 1) * NUP);
            const u32x4 uv = *(const u32x4*)(UG + (size_t)t * NUP + f0);
            u32x4 o;
#pragma unroll
            for (int q = 0; q < 4; ++q) { float r[2];
#pragma unroll
                for (int e = 0; e < 2; ++e) { const int k = 2 * q + e; const unsigned sh = e ? 16u : 0u;
                    const float g = w0[k] * bf2f((gp[q] >> sh) & 0xffffu) + w1[k] * bf2f((gc[q] >> sh) & 0xffffu) + w2[k] * bf2f((gn[q] >> sh) & 0xffffu) + cb[k];
                    r[e] = 0.5f * g * (1.f + erff(g * 0.70710678118654752f)) * bf2f((uv[q] >> sh) & 0xffffu); }
                o[q] = pk2(r[0], r[1]); }
            *(u32x4*)(UG + (size_t)t * NUP + f0) = o;
            gp = gc; gc = gn; }
    }
}

DI void phase_final(const Args& a, int lane, int wave) {
    const int gw = blockIdx.x * 8 + wave, NGW = gridDim.x * 8;
    f32x4 g[8];
#pragma unroll
    for (int j = 0; j < 8; ++j) g[j] = *(const f32x4*)(a.g_final + 4 * lane + 256 * j);
    for (int m = gw; m < MTOK; m += NGW) {
        f32x4 v[8]; float ss = 0.f;
#pragma unroll
        for (int j = 0; j < 8; ++j) { v[j] = *(const f32x4*)(a.out + (size_t)m * DM + 4 * lane + 256 * j); ss += (v[j].x * v[j].x + v[j].y * v[j].y) + (v[j].z * v[j].z + v[j].w * v[j].w); }
        const float rstd = rsqrtf(wave_sum(ss) * (1.f / DM) + EPSN);
#pragma unroll
        for (int j = 0; j < 8; ++j) *(f32x4*)(a.out + (size_t)m * DM + 4 * lane + 256 * j) = v[j] * rstd * g[j];
    }
}

__global__ void __launch_bounds__(512, 2) mega(Args a) {
    extern __shared__ __attribute__((aligned(16))) unsigned char lds_raw[];
    LAS unsigned char* lds = (LAS unsigned char*)lds_raw;
    cg::grid_group grid = cg::this_grid();
    const int tid = threadIdx.x, lane = tid & 63, wave = __builtin_amdgcn_readfirstlane(tid >> 6);
    const int lo = a.ph_lo, hi = a.ph_hi;
    const float* mod = (const float*)(a.ws + OFF_MOD);
#ifndef PHMASK
#define PHMASK 0xfff
#endif
#define PH(k) (((PHMASK >> (k)) & 1) && lo <= (k) && (k) < hi)
#define SEAM(k) do { if (PH(k) && PH((k) + 1)) grid.sync(); } while (0)
    if (PH(0)) phase0(a, lds, tid, lane, wave);
    SEAM(0);
    if (PH(1)) phase_norm<true>(a, lds, a.x, a.g_norm1, 0, DM, tid, lane, wave);
    SEAM(1);
    if (PH(2)) {
        if (blockIdx.x < NCOMBO) gate_prep(a, lds, blockIdx.x, tid);
        pg8::Gemm g{(const bf16_t*)(a.ws + OFF_HB), (const bf16_t*)(a.ws + OFF_WIN), MTOK, NPC, DM, DM}; pg8::StaticOrder S; S.init(MTOK, NPC, gridDim.x, blockIdx.x);
        pg8::EpiBf16<0> E{(bf16_t*)(a.ws + OFF_P), NPC, nullptr, 0, 0, 1.f};
        pg8::gemm_phase<pg8::EpiBf16<0>, pg8::StaticOrder, true, true>(lds, g, S, E);
    }
    SEAM(2);
    if (PH(3)) mlstm_delta(a, lds, tid, lane, wave);
    SEAM(3);
    if (PH(4)) { mlstm_scan(a, tid); natten(a, lds, tid, lane, wave); }
    SEAM(4);
    if (PH(5)) mlstm_out(a, lds, tid, lane, wave);
    SEAM(5);
    if (PH(6)) {
        __syncthreads();
        pg8::Gemm g{(const bf16_t*)(a.ws + OFF_HB), (const bf16_t*)(a.ws + OFF_WOUT), MTOK, DM, DM, DM}; pg8::StaticOrder S; S.init(MTOK, DM, gridDim.x, blockIdx.x);
        EpiResid E{a.x, a.out, mod + 2 * DM};
        pg8::gemm_phase<EpiResid, pg8::StaticOrder, true, true>(lds, g, S, E);
    }
    SEAM(6);
    if (PH(7)) phase_norm<false>(a, lds, a.out, a.g_norm2, 3 * DM, 4 * DM, tid, lane, wave);
    SEAM(7);
    if (PH(8)) {
        pg8::Gemm g{(const bf16_t*)(a.ws + OFF_HB), (const bf16_t*)(a.ws + OFF_WUP), MTOK, NUP, DM, DM}; pg8::StaticOrder S; S.init(MTOK, NUP, gridDim.x, blockIdx.x);
        pg8::EpiBf16<0> E{(bf16_t*)(a.ws + OFF_UG), NUP, nullptr, 0, 0, 1.f};
        pg8::gemm_phase<pg8::EpiBf16<0>, pg8::StaticOrder, true, true>(lds, g, S, E);
    }
    SEAM(8);
    if (PH(9)) phase_act(a, tid);
    SEAM(9);
    if (PH(10)) {
        pg8::Gemm g{(const bf16_t*)(a.ws + OFF_UG), (const bf16_t*)(a.ws + OFF_WDN), MTOK, DM, DFF, NUP}; pg8::StaticOrder S; S.init(MTOK, DM, gridDim.x, blockIdx.x);
        EpiResid E{a.out, a.out, mod + 5 * DM};
        pg8::gemm_phase<EpiResid, pg8::StaticOrder, true, true>(lds, g, S, E);
    }
    SEAM(10);
    if (PH(11)) phase_final(a, lane, wave);
#undef PH
#undef SEAM
}

extern "C" void kernel_launch(void* const* d_in, const int* in_sizes, int n_in, void* d_out, int out_size, void* d_ws, size_t ws_size, hipStream_t stream) {
    static int grid = 0;
    if (grid == 0) {
        if (n_in != 16 || out_size != MTOK * DM || ws_size < WS_NEED) { fprintf(stderr, "kernel_launch: unexpected problem (n_in %d out %d ws %zu need %zu)\n", n_in, out_size, ws_size, (size_t)WS_NEED); grid = -1; return; }
        int dev = 0, cus = 0, per_cu = 0;
        hipGetDevice(&dev); hipDeviceGetAttribute(&cus, hipDeviceAttributeMultiprocessorCount, dev);
        if (hipFuncSetAttribute((const void*)mega, hipFuncAttributeMaxDynamicSharedMemorySize, LDS_BYTES) != hipSuccess) { fprintf(stderr, "kernel_launch: hipFuncSetAttribute failed\n"); grid = -1; return; }
        if (hipOccupancyMaxActiveBlocksPerMultiprocessor(&per_cu, (const void*)mega, 512, LDS_BYTES) != hipSuccess || per_cu < 1) { fprintf(stderr, "kernel_launch: occupancy query failed (%d)\n", per_cu); (void)hipGetLastError(); per_cu = 1; }
        grid = cus * (per_cu > 1 ? 1 : per_cu);
        fprintf(stderr, "kernel_launch: grid %d (cus %d, per_cu %d)\n", grid, cus, per_cu);
    }
    if (grid < 0) return;
    Args a{};
    a.x = (const float*)d_in[0]; a.c = (const float*)d_in[1]; a.w_ada = (const float*)d_in[2]; a.b_ada = (const float*)d_in[3]; a.g_norm1 = (const float*)d_in[4];
    a.w_in = (const float*)d_in[5]; a.b_gates = (const float*)d_in[6]; a.g_head_a = (const float*)d_in[7]; a.rpb = (const float*)d_in[8]; a.w_out = (const float*)d_in[9];
    a.g_norm2 = (const float*)d_in[10]; a.w_up = (const float*)d_in[11]; a.conv_w = (const float*)d_in[12]; a.conv_b = (const float*)d_in[13]; a.w_down = (const float*)d_in[14];
    a.g_final = (const float*)d_in[15]; a.out = (float*)d_out; a.ws = (unsigned char*)d_ws;
#if MK_PER_PHASE
    for (int p = 0; p < NPH; ++p) { a.ph_lo = p; a.ph_hi = p + 1; hipLaunchKernelGGL(mega, dim3(grid), dim3(512), LDS_BYTES, stream, a); }
#else
    a.ph_lo = 0; a.ph_hi = NPH;
    void* args[] = {&a};
    hipError_t e = hipLaunchCooperativeKernel((const void*)mega, dim3(grid), dim3(512), args, LDS_BYTES, stream);
    if (e != hipSuccess) fprintf(stderr, "kernel_launch: cooperative launch failed: %s (grid %d)\n", hipGetErrorString(e), grid);
#endif
}
```

```cpp
#include <hip/hip_runtime.h>
#include <hip/hip_cooperative_groups.h>
#include <cstdio>
#include <cstdint>
namespace cg = cooperative_groups;
#define MK_PER_PHASE 0
namespace pg8 {
#define PG8_LAS __attribute__((address_space(3)))
typedef unsigned short bf16_t;
typedef short bf16x8 __attribute__((ext_vector_type(8)));
typedef float f32x4 __attribute__((ext_vector_type(4)));
typedef unsigned u32x4 __attribute__((ext_vector_type(4)));
constexpr int BM = 256, BK = 64, HALF = 128, HTB = HALF * BK * 2  , STAGE_BYTES = 8 * HTB, NXCD = 8, WGM = 8;

__host__ __device__ __forceinline__ int lds_byte(int r, int c) { const int st = (r >> 4) * 2 + (c >> 5), rr = r & 15, cc = c & 31, ob = rr * 64 + cc * 2; return st * 1024 + (ob ^ (((ob >> 9) & 1) << 5)); }
__host__ __device__ __forceinline__ void stage_rc(int b, int& R, int& C) { const int st = b / 1024, sb = b % 1024, swz = sb ^ (((sb >> 9) & 1) << 5); R = (st >> 1) * 16 + swz / 64; C = (st & 1) * 32 + (swz % 64) / 2; }
__host__ __device__ __forceinline__ int perm32(int rho) { const int n = rho >> 4, i = rho & 15; return 8 * (i >> 2) + 4 * n + (i & 3); }

struct Unit { int pm, pn; };
struct Gemm { const bf16_t* A; const bf16_t* Bt; int M, N, K, lda; };

struct StaticOrder {
    int nM, nN, nwg, G, c;
    __host__ __device__ void init(int M, int N, int G_, int c_) { nM = M / BM; nN = N / BM; nwg = nM * nN; G = G_; c = c_; }
    __host__ __device__ bool next(int i, Unit& u) const {
        const long L = (long)i * G + c; if (L >= nwg) return false;
        int wgid = (int)L; { const int q = nwg / NXCD, r = nwg % NXCD, xcd = wgid % NXCD, off = wgid / NXCD; wgid = (xcd < r ? xcd * (q + 1) : r * (q + 1) + (xcd - r) * q) + off; }
        const int nig = WGM * nN, gid = wgid / nig, fm = gid * WGM, gsz = (nM - fm) < WGM ? (nM - fm) : WGM;
        u.pm = fm + ((wgid % nig) % gsz); u.pn = (wgid % nig) / gsz; return true;
    }
    __device__ __forceinline__ void a_ready(const Unit&) const {}
    __device__ __forceinline__ void done(const Unit&) const {}
};

__device__ __forceinline__ unsigned cvt_pk_bf16(float lo, float hi) { unsigned r; asm volatile("v_cvt_pk_bf16_f32 %0, %1, %2" : "=v"(r) : "v"(lo), "v"(hi)); return r; }
typedef float f32x2 __attribute__((ext_vector_type(2)));
__device__ __forceinline__ f32x2 gelu_pk(f32x2 v) {
    const f32x2 av = __builtin_elementwise_abs(v), d = av * 0.2316418882f + 1.0f;
    f32x2 t; t.x = __builtin_amdgcn_rcpf(d.x); t.y = __builtin_amdgcn_rcpf(d.y);
    f32x2 q = t * 0.5307027145f + (-0.7265760135f); q = q * t + 0.7107068705f; q = q * t + (-0.142248368f); q = q * t + 0.127414796f; q = q * t;
    const f32x2 s = (v * v) * (-0.72134752044f);
    f32x2 e; e.x = __builtin_amdgcn_exp2f(s.x); e.y = __builtin_amdgcn_exp2f(s.y);
    const f32x2 m = v * (q * e), r = v - m;
    f32x2 o; o.x = v.x < 0.f ? m.x : r.x; o.y = v.y < 0.f ? m.y : r.y; return o;
}

template <int ACT  > struct EpiBf16 {
    static constexpr bool PERM = true, AFTER_DRAIN = false; static_assert(ACT == 0 || ACT == 1, "EpiBf16: ACT is 0 (none) or 1 (gelu_pk)");
    bf16_t* O; int ldc; const float* bias; int split_cols; size_t split_stride; float scale0;
    __device__ __forceinline__ void operator()(const f32x4 (&acc)[2][2][4][2], const Unit& u, int wr, int wc, int fr, int fq) const {
        const int row0 = u.pm * BM + wr * 64 + fr; int colt = u.pn * BM; bf16_t* base = O;
        float sc = 1.f; if (split_cols) { const int t = colt / split_cols; base += (size_t)t * split_stride; colt -= t * split_cols; if (t == 0) sc = scale0; }
        const int col0 = colt + wc * 32 + 8 * fq, bcol0 = u.pn * BM + wc * 32 + 8 * fq;
        f32x4 bv[2][2];
#pragma unroll
        for (int bj = 0; bj < 2; ++bj)
#pragma unroll
            for (int n = 0; n < 2; ++n) bv[bj][n] = bias ? *(const f32x4*)(bias + bcol0 + bj * HALF + 4 * n) : (f32x4){0.f, 0.f, 0.f, 0.f};
#pragma unroll
        for (int ai = 0; ai < 2; ++ai)
#pragma unroll
            for (int m = 0; m < 4; ++m) { bf16_t* rowp = base + (size_t)(row0 + ai * HALF + m * 16) * ldc + col0;
#pragma unroll
                for (int bj = 0; bj < 2; ++bj) { f32x4 v0 = acc[ai][bj][m][0] + bv[bj][0], v1 = acc[ai][bj][m][1] + bv[bj][1];
                    if (ACT == 1) { f32x2 a = gelu_pk((f32x2){v0[0], v0[1]}), b = gelu_pk((f32x2){v0[2], v0[3]}), c = gelu_pk((f32x2){v1[0], v1[1]}), d = gelu_pk((f32x2){v1[2], v1[3]});
                        v0 = (f32x4){a.x, a.y, b.x, b.y}; v1 = (f32x4){c.x, c.y, d.x, d.y}; }
                    v0 = v0 * sc; v1 = v1 * sc; u32x4 w; w.x = cvt_pk_bf16(v0[0], v0[1]); w.y = cvt_pk_bf16(v0[2], v0[3]); w.z = cvt_pk_bf16(v1[0], v1[1]); w.w = cvt_pk_bf16(v1[2], v1[3]);
                    *(u32x4*)(rowp + bj * HALF) = w; } }
    }
};

template <class Epi, class Sched, bool ALIGN_EPI = false, bool SP2 = false>
__device__ __forceinline__ void gemm_phase(PG8_LAS unsigned char* lds, const Gemm g, const Sched& S, const Epi& E) {
    const int tid = threadIdx.x, wid = __builtin_amdgcn_readfirstlane(tid >> 6), lane = tid & 63, wr = wid >> 2, wc = wid & 3, fr = lane & 15, fq = lane >> 4;
    const int K = g.K, nt = K / BK;
    unsigned voffA[2], voffB[2];
#pragma unroll
    for (int i = 0; i < 2; ++i) { int R, C; stage_rc(tid * 16 + i * 8192, R, C); const int Rb = Epi::PERM ? ((R & ~31) + perm32(R & 31)) : R;
        voffA[i] = (unsigned)(R * g.lda + C) * 2u; voffB[i] = (unsigned)(Rb * K + C) * 2u; }
    const size_t kstep = (size_t)(BK * 2);
    const size_t hstep = (size_t)HALF * K * 2;
    const size_t tstep = 2 * hstep; const size_t hstepA = (size_t)HALF * g.lda * 2, tstepA = 2 * hstepA;
    const unsigned ldsw = (unsigned)wid * 1024u;
    const int aoff = lds_byte(wr * 64 + fr, fq * 8), boff = lds_byte(wc * 32 + fr, fq * 8);
#define PG8_SA(b, h) (((b) * 2 + (h)) * HTB)
#define PG8_SB(b, h) ((4 + (b) * 2 + (h)) * HTB)
#define PG8_STAGE(bufoff, gbase, voff) do { _Pragma("unroll") for (int _i = 0; _i < 2; ++_i) \
        __builtin_amdgcn_global_load_lds((const unsigned*)((const char*)(gbase) + (voff)[_i]), (PG8_LAS unsigned*)(lds + (bufoff) + ldsw + _i * 8192), 16, 0, 0); } while (0)
#define PG8_LDA(dst, b, h) do { _Pragma("unroll") for (int m = 0; m < 4; ++m) _Pragma("unroll") for (int k = 0; k < 2; ++k) dst[m][k] = *(const PG8_LAS bf16x8*)(lds + PG8_SA(b, h) + aoff + m * 2048 + k * 1024); } while (0)
#define PG8_LDB(dst, b, h) do { _Pragma("unroll") for (int n = 0; n < 2; ++n) _Pragma("unroll") for (int k = 0; k < 2; ++k) dst[n][k] = *(const PG8_LAS bf16x8*)(lds + PG8_SB(b, h) + boff + n * 2048 + k * 1024); } while (0)
#define PG8_MMA(ai, bj, At, Bt) do { __builtin_amdgcn_s_setprio(1); _Pragma("unroll") for (int m = 0; m < 4; ++m) _Pragma("unroll") for (int n = 0; n < 2; ++n) _Pragma("unroll") for (int k = 0; k < 2; ++k) \
        acc[ai][bj][m][n] = __builtin_amdgcn_mfma_f32_16x16x32_bf16(Bt[n][k], At[m][k], acc[ai][bj][m][n], 0, 0, 0); __builtin_amdgcn_s_setprio(0); } while (0)
#define PG8_WAIT_V(n) asm volatile("s_waitcnt vmcnt(" #n ")" ::: "memory")
#define PG8_WAIT_L(n) asm volatile("s_waitcnt lgkmcnt(" #n ")" ::: "memory")
#define PG8_BAR __builtin_amdgcn_s_barrier()
#define PG8_SCHED __builtin_amdgcn_sched_barrier(0)
    Unit cur, nxt; int ui = 0;
    if (!S.next(0, cur)) return;
    f32x4 acc[2][2][4][2];
#pragma unroll
    for (int a = 0; a < 2; ++a)
#pragma unroll
        for (int b = 0; b < 2; ++b)
#pragma unroll
            for (int m = 0; m < 4; ++m)
#pragma unroll
                for (int n = 0; n < 2; ++n) acc[a][b][m][n] = (f32x4){0.f, 0.f, 0.f, 0.f};
    bf16x8 At[4][2], B0[2][2], B1[2][2];
    const char* cA = (const char*)g.A + (size_t)cur.pm * tstepA; const char* cB = (const char*)g.Bt + (size_t)cur.pn * tstep;
    S.a_ready(cur);
    if constexpr (SP2) {
        PG8_STAGE(PG8_SB(0, 0), cB, voffB); PG8_STAGE(PG8_SB(0, 1), cB + hstep, voffB); PG8_STAGE(PG8_SA(0, 0), cA, voffA); PG8_STAGE(PG8_SA(0, 1), cA + hstepA, voffA);
        if (wr == 1) PG8_BAR;
        PG8_WAIT_V(2); PG8_BAR;
        PG8_STAGE(PG8_SB(1, 0), cB + kstep, voffB); PG8_STAGE(PG8_SA(1, 0), cA + kstep, voffA); PG8_STAGE(PG8_SB(1, 1), cB + hstep + kstep, voffB);
        PG8_WAIT_V(6); PG8_BAR;
    } else {
        PG8_STAGE(PG8_SB(0, 0), cB, voffB); PG8_STAGE(PG8_SA(0, 0), cA, voffA); PG8_STAGE(PG8_SB(0, 1), cB + hstep, voffB); PG8_STAGE(PG8_SA(0, 1), cA + hstepA, voffA);
        if (wr == 1) PG8_BAR;
        PG8_WAIT_V(4); PG8_BAR;
        PG8_STAGE(PG8_SB(1, 0), cB + kstep, voffB); PG8_STAGE(PG8_SA(1, 0), cA + kstep, voffA); PG8_STAGE(PG8_SB(1, 1), cB + hstep + kstep, voffB);
        PG8_WAIT_V(6); PG8_BAR;
    }
    for (;;) {
        const bool has_next = S.next(ui + 1, nxt);
        const char* nA = has_next ? (const char*)g.A + (size_t)nxt.pm * tstepA : cA; const char* nB = has_next ? (const char*)g.Bt + (size_t)nxt.pn * tstep : cB;
        for (int t = 0; t < nt; t += 2) {
            const bool last = (t == nt - 2);
            const char* a1 = cA + (size_t)(t + 1) * kstep;
            const char* a2 = last ? nA : cA + (size_t)(t + 2) * kstep; const char* b2 = last ? nB : cB + (size_t)(t + 2) * kstep;
            const char* a3 = a2 + kstep; const char* b3 = b2 + kstep;
            if (last && has_next) S.a_ready(nxt);
            if constexpr (SP2) {
            PG8_LDB(B0, 0, 0); PG8_LDB(B1, 0, 1); PG8_SCHED; PG8_LDA(At, 0, 0); PG8_STAGE(PG8_SA(1, 1), a1 + hstepA, voffA);
            PG8_WAIT_V(8); PG8_WAIT_L(0); PG8_BAR; PG8_MMA(0, 0, At, B0); PG8_MMA(0, 1, At, B1); PG8_BAR; PG8_SCHED;
            PG8_LDA(At, 0, 1); PG8_STAGE(PG8_SB(0, 0), b2, voffB); PG8_STAGE(PG8_SB(0, 1), b2 + hstep, voffB); PG8_STAGE(PG8_SA(0, 0), a2, voffA);
            PG8_WAIT_V(8); PG8_WAIT_L(0); PG8_BAR; PG8_MMA(1, 0, At, B0); PG8_MMA(1, 1, At, B1); PG8_BAR; PG8_SCHED;
            PG8_LDB(B0, 1, 0); PG8_LDB(B1, 1, 1); PG8_SCHED; PG8_LDA(At, 1, 0); PG8_STAGE(PG8_SA(0, 1), a2 + hstepA, voffA);
            PG8_WAIT_V(8); PG8_WAIT_L(0); PG8_BAR; PG8_MMA(0, 0, At, B0); PG8_MMA(0, 1, At, B1); PG8_BAR; PG8_SCHED;
            PG8_LDA(At, 1, 1); PG8_STAGE(PG8_SB(1, 0), b3, voffB); PG8_STAGE(PG8_SB(1, 1), b3 + hstep, voffB); PG8_STAGE(PG8_SA(1, 0), a3, voffA);
            PG8_WAIT_V(8); PG8_WAIT_L(0); PG8_BAR; PG8_MMA(1, 0, At, B0); PG8_MMA(1, 1, At, B1); PG8_BAR; PG8_SCHED;
            } else {
            PG8_LDB(B0, 0, 0); PG8_SCHED; PG8_LDA(At, 0, 0); PG8_STAGE(PG8_SA(1, 1), a1 + hstepA, voffA);
            PG8_WAIT_L(8); PG8_BAR; PG8_WAIT_L(0); PG8_MMA(0, 0, At, B0); PG8_BAR; PG8_SCHED;
            PG8_LDB(B1, 0, 1); PG8_STAGE(PG8_SB(0, 0), b2, voffB);
            PG8_BAR; PG8_WAIT_L(0); PG8_MMA(0, 1, At, B1); PG8_BAR;
            PG8_LDA(At, 0, 1); PG8_STAGE(PG8_SA(0, 0), a2, voffA);
            PG8_BAR; PG8_WAIT_L(0); PG8_MMA(1, 0, At, B0); PG8_BAR; PG8_SCHED;
            PG8_STAGE(PG8_SB(0, 1), b2 + hstep, voffB);
            PG8_WAIT_V(6); PG8_BAR; PG8_MMA(1, 1, At, B1); PG8_BAR;
            PG8_LDB(B0, 1, 0); PG8_SCHED; PG8_LDA(At, 1, 0); PG8_STAGE(PG8_SA(0, 1), a2 + hstepA, voffA);
            PG8_WAIT_L(8); PG8_BAR; PG8_WAIT_L(0); PG8_MMA(0, 0, At, B0); PG8_BAR; PG8_SCHED;
            PG8_LDB(B1, 1, 1); PG8_STAGE(PG8_SB(1, 0), b3, voffB);
            PG8_BAR; PG8_WAIT_L(0); PG8_MMA(0, 1, At, B1); PG8_BAR;
            PG8_LDA(At, 1, 1); PG8_STAGE(PG8_SA(1, 0), a3, voffA);
            PG8_BAR; PG8_WAIT_L(0); PG8_MMA(1, 0, At, B0); PG8_BAR; PG8_SCHED;
            PG8_STAGE(PG8_SB(1, 1), b3 + hstep, voffB);
            PG8_WAIT_V(6); PG8_BAR; PG8_MMA(1, 1, At, B1); PG8_BAR;
            }
        }
        if constexpr (ALIGN_EPI) { if (wr == 0) PG8_BAR; }
        if constexpr (!Epi::AFTER_DRAIN) { E(acc, cur, wr, wc, fr, fq); S.done(cur); }
        if (!has_next) break;
#pragma unroll
        for (int a = 0; a < 2; ++a)
#pragma unroll
            for (int b = 0; b < 2; ++b)
#pragma unroll
                for (int m = 0; m < 4; ++m)
#pragma unroll
                    for (int n = 0; n < 2; ++n) acc[a][b][m][n] = (f32x4){0.f, 0.f, 0.f, 0.f};
        cur = nxt; cA = nA; cB = nB; ++ui;
        if constexpr (ALIGN_EPI) { if (wr == 1) PG8_BAR; }
    }
    PG8_WAIT_V(0);
    if constexpr (!ALIGN_EPI) { if (wr == 0) PG8_BAR; }
    PG8_BAR;
    if constexpr (Epi::AFTER_DRAIN) { E.fused(acc, cur, wr, wc, fr, fq, lds, wid, lane); S.done(cur); }
#undef PG8_SA
#undef PG8_SB
#undef PG8_STAGE
#undef PG8_LDA
#undef PG8_LDB
#undef PG8_MMA
#undef PG8_WAIT_V
#undef PG8_WAIT_L
#undef PG8_BAR
#undef PG8_SCHED
}
}

#define DI __device__ __forceinline__
#define LAS __attribute__((address_space(3)))
typedef unsigned short bf16_t;
typedef short bf16x8 __attribute__((ext_vector_type(8)));
typedef short s16x4 __attribute__((ext_vector_type(4)));
typedef short v4i16_t __attribute__((ext_vector_type(4)));
typedef float f32x4 __attribute__((ext_vector_type(4)));
typedef unsigned u32x4 __attribute__((ext_vector_type(4)));
typedef unsigned u32x2 __attribute__((ext_vector_type(2)));

constexpr int NB = 2, SEQ = 8192, DM = 2048, MTOK = NB * SEQ, NPC = 7168, WIN_LD = 7184, DFF = 5632, NUP = 2 * DFF, NMOD = 6 * DM;
constexpr int LCH = 256, NCH = SEQ / LCH, EEXT = 272, ST_ELEMS = EEXT * 256, NCOMBO = 16;
constexpr float EPSN = 1e-6f;
#ifndef MK_PER_PHASE
#define MK_PER_PHASE 0
#endif
constexpr int NPH = 12;
constexpr int LDS_BYTES = 147456;

constexpr size_t OFF_P = 0;
constexpr size_t OFF_CST = OFF_P + (size_t)MTOK * NPC * 2;
constexpr size_t OFF_WIN = OFF_CST + (size_t)NCOMBO * NCH * ST_ELEMS * 2;
constexpr size_t OFF_WOUT = OFF_WIN + (size_t)NPC * DM * 2;
constexpr size_t OFF_R0END = OFF_WOUT + (size_t)DM * DM * 2;
constexpr size_t OFF_UG = 0;
constexpr size_t OFF_WUP = OFF_UG + (size_t)MTOK * NUP * 2;
constexpr size_t OFF_WDN = OFF_WUP + (size_t)NUP * DM * 2;
constexpr size_t OFF_HB = OFF_WDN + (size_t)DM * DFF * 2;
constexpr size_t OFF_MOD = OFF_HB + (size_t)MTOK * DM * 2;
constexpr size_t OFF_GATES = OFF_MOD + 131072;
constexpr size_t OFF_UL = OFF_GATES + (size_t)MTOK * 16 * 4;
constexpr size_t OFF_ML = OFF_UL + (size_t)NCOMBO * SEQ * 4;
constexpr size_t OFF_EMT = OFF_ML + (size_t)NCOMBO * SEQ * 4;
constexpr size_t OFF_MPREV = OFF_EMT + (size_t)NCOMBO * SEQ * 4;
constexpr size_t OFF_MEND = OFF_MPREV + 4096;
constexpr size_t WS_NEED = OFF_MEND + 4096;
static_assert(OFF_R0END <= OFF_WUP, "overlay region");
static_assert(WS_NEED <= 536870912ull, "workspace budget");

struct Args {
    const float *x, *c, *w_ada, *b_ada, *g_norm1, *w_in, *b_gates, *g_head_a, *rpb, *w_out, *g_norm2, *w_up, *conv_w, *conv_b, *w_down, *g_final;
    float* out; unsigned char* ws; int ph_lo, ph_hi;
};

DI float bf2f(unsigned v) { return __uint_as_float(v << 16); }
DI unsigned f2bf(float f) { unsigned u = __float_as_uint(f); return (u + 0x7fffu + ((u >> 16) & 1u)) >> 16; }
DI unsigned pk2(float lo, float hi) { return f2bf(lo) | (f2bf(hi) << 16); }
DI float wave_sum(float v) {
#pragma unroll
    for (int o = 1; o < 64; o <<= 1) v += __shfl_xor(v, o);
    return v;
}
DI s16x4 tr_read(const LAS unsigned char* p) { return __builtin_bit_cast(s16x4, __builtin_amdgcn_ds_read_tr16_b64_v4i16((LAS v4i16_t*)p)); }
DI bf16x8 tr_frag(const LAS unsigned char* base, int pitch, int rowA, int rowB, int col, int qin, int pin) {
    const s16x4 lo = tr_read(base + (rowA + qin) * pitch + (col + 4 * pin) * 2);
    const s16x4 hi = tr_read(base + (rowB + qin) * pitch + (col + 4 * pin) * 2);
    return (bf16x8){lo[0], lo[1], lo[2], lo[3], hi[0], hi[1], hi[2], hi[3]};
}
DI bf16x8 ld_frag(const LAS unsigned char* p) { return *(const LAS bf16x8*)p; }
#define MFMA16(a, b, c) __builtin_amdgcn_mfma_f32_16x16x32_bf16((a), (b), (c), 0, 0, 0)
DI bf16x8 pack8(const f32x4& a, const f32x4& b) {
    u32x4 w; w.x = pk2(a[0], a[1]); w.y = pk2(a[2], a[3]); w.z = pk2(b[0], b[1]); w.w = pk2(b[2], b[3]);
    return __builtin_bit_cast(bf16x8, w);
}
DI bf16x8 scale8(const bf16x8& q, float s) {
    const u32x4 u = __builtin_bit_cast(u32x4, q); u32x4 w;
#pragma unroll
    for (int i = 0; i < 4; ++i) w[i] = pk2(bf2f(u[i] & 0xffffu) * s, bf2f(u[i] >> 16) * s);
    return __builtin_bit_cast(bf16x8, w);
}
template <int ROWS, int COLS> DI void stage_tile(LAS unsigned char* dst, int lp, const bf16_t* src, int gp, int tid, int nthr) {
    constexpr int VPR = COLS / 8, NV = ROWS * VPR;
    int t0 = tid; asm volatile("" : "+v"(t0));
#pragma unroll 2
    for (int v = t0; v < NV; v += nthr) { const int r = v / VPR, cv = v % VPR;
        const u32x4 d = *(const u32x4*)(src + (r * gp + cv * 8)); *(LAS u32x4*)(dst + r * lp + cv * 16) = d; }
}

struct EpiResid {
    static constexpr bool PERM = false, AFTER_DRAIN = false;
    const float* res; float* out; const float* gate;
    __device__ __forceinline__ void operator()(const pg8::f32x4 (&acc)[2][2][4][2], const pg8::Unit& u, int wr, int wc, int fr, int fq) const {
        const int row0 = u.pm * 256 + wr * 64 + fr, col0 = u.pn * 256 + wc * 32 + 4 * fq, bb = u.pm >> 5;
        f32x4 gv[2][2];
#pragma unroll
        for (int bj = 0; bj < 2; ++bj)
#pragma unroll
            for (int n = 0; n < 2; ++n) gv[bj][n] = *(const f32x4*)(gate + (size_t)bb * NMOD + col0 + bj * 128 + n * 16);
#pragma unroll
        for (int ai = 0; ai < 2; ++ai)
#pragma unroll
            for (int m = 0; m < 4; ++m) { const size_t ro = (size_t)(row0 + ai * 128 + m * 16) * DM + col0;
#pragma unroll
                for (int bj = 0; bj < 2; ++bj)
#pragma unroll
                    for (int n = 0; n < 2; ++n) { const size_t o = ro + bj * 128 + n * 16; const f32x4 r = *(const f32x4*)(res + o); *(f32x4*)(out + o) = r + gv[bj][n] * acc[ai][bj][m][n]; } }
    }
};

DI void tr_block(const float* src, int ldw, bf16_t* dst, int ldd, float scale, LAS float* scr, int lane) {
#pragma unroll 8
    for (int i = 0; i < 32; ++i) { const int kk = 2 * i + (lane >> 5); scr[kk * 33 + (lane & 31)] = src[(size_t)kk * ldw + (lane & 31)]; }
    asm volatile("s_waitcnt lgkmcnt(0)" ::: "memory");
    const int c = lane & 7;
#pragma unroll
    for (int j = 0; j < 4; ++j) { const int n = (lane >> 3) + 8 * j; const LAS float* s = scr + (8 * c) * 33 + n;
        u32x4 o; o.x = pk2(s[0 * 33] * scale, s[1 * 33] * scale); o.y = pk2(s[2 * 33] * scale, s[3 * 33] * scale); o.z = pk2(s[4 * 33] * scale, s[5 * 33] * scale); o.w = pk2(s[6 * 33] * scale, s[7 * 33] * scale);
        *(u32x4*)(dst + (size_t)n * ldd + 8 * c) = o; }
    asm volatile("s_waitcnt lgkmcnt(0)" ::: "memory");
}
DI void phase0(const Args& a, LAS unsigned char* lds, int tid, int lane, int wave) {
    LAS float* sc = (LAS float*)lds;
    LAS float* red = sc + 4096;
    float* mod = (float*)(a.ws + OFF_MOD);
    for (int i = tid; i < 4096; i += 512) { const float v = a.c[i]; sc[i] = v / (1.f + __expf(-v)); }
    __syncthreads();
    for (int item = blockIdx.x; item < 256; item += gridDim.x) {
        const int n0 = item * 48;
        if (tid < 384) {
            const int cq = tid % 12, ks = tid / 12;
            f32x4 a0 = {0.f, 0.f, 0.f, 0.f}, a1 = {0.f, 0.f, 0.f, 0.f};
            const float* wp = a.w_ada + (size_t)(ks * 64) * NMOD + n0 + 4 * cq;
#pragma unroll 8
            for (int kk = 0; kk < 64; ++kk) { const f32x4 w = *(const f32x4*)(wp + (size_t)kk * NMOD); const float s0 = sc[ks * 64 + kk], s1 = sc[2048 + ks * 64 + kk]; a0 += s0 * w; a1 += s1 * w; }
            LAS float* rp = red + (ks * 12 + cq) * 8;
            *(LAS f32x4*)rp = a0; *(LAS f32x4*)(rp + 4) = a1;
        }
        __syncthreads();
        if (tid < 96) { const int cq = tid >> 3, j = tid & 7; float s = 0.f;
            for (int ks = 0; ks < 32; ++ks) s += red[(ks * 12 + cq) * 8 + j];
            const int bb = j >> 2, col = n0 + 4 * cq + (j & 3); mod[bb * NMOD + col] = s + a.b_ada[col]; }
        __syncthreads();
    }
    LAS float* scr = (LAS float*)(lds + 32768 + wave * 8448);
    bf16_t* WinT = (bf16_t*)(a.ws + OFF_WIN); bf16_t* WoutT = (bf16_t*)(a.ws + OFF_WOUT); bf16_t* WupT = (bf16_t*)(a.ws + OFF_WUP); bf16_t* WdnT = (bf16_t*)(a.ws + OFF_WDN);
    constexpr int I_IN = 32 * (NPC / 32), I_OUT = 32 * (DM / 32), I_UP = 32 * (NUP / 32), I_DN = (DFF / 64) * (DM / 32);
    const int gw = blockIdx.x * 8 + wave, NGW = gridDim.x * 8;
    for (int it = gw; it < I_IN + I_OUT + I_UP + I_DN; it += NGW) {
        int r = it;
        if (r < I_IN) { const int nblk = NPC / 32, kb = r / nblk, nb = r % nblk, n0 = nb * 32, ns = n0 < 4096 ? n0 : n0 + 16;
            tr_block(a.w_in + (size_t)(kb * 64) * WIN_LD + ns, WIN_LD, WinT + (size_t)n0 * DM + kb * 64, DM, (n0 >= 1024 && n0 < 2048) ? 0.0625f : 1.f, scr, lane); continue; }
        r -= I_IN;
        if (r < I_OUT) { const int nblk = DM / 32, kb = r / nblk, nb = r % nblk;
            tr_block(a.w_out + (size_t)(kb * 64) * DM + nb * 32, DM, WoutT + (size_t)(nb * 32) * DM + kb * 64, DM, 1.f, scr, lane); continue; }
        r -= I_OUT;
        if (r < I_UP) { const int nblk = NUP / 32, kb = r / nblk, nb = r % nblk;
            tr_block(a.w_up + (size_t)(kb * 64) * NUP + nb * 32, NUP, WupT + (size_t)(nb * 32) * DM + kb * 64, DM, 1.f, scr, lane); continue; }
        r -= I_UP;
        { const int nblk = DM / 32, kb = r / nblk, nb = r % nblk;
            tr_block(a.w_down + (size_t)(kb * 64) * DM + nb * 32, DM, WdnT + (size_t)(nb * 32) * DFF + kb * 64, DFF, 1.f, scr, lane); }
    }
}

template <bool GATES> DI void phase_norm(const Args& a, LAS unsigned char* lds, const float* xin, const float* gn, int sh_off, int sc_off, int tid, int lane, int wave) {
    const float* mod = (const float*)(a.ws + OFF_MOD);
    bf16_t* Hb = (bf16_t*)(a.ws + OFF_HB);
    float* gates = (float*)(a.ws + OFF_GATES);
    LAS float* wg = (LAS float*)lds;
    if (GATES) {
        for (int idx = tid; idx < 2048 * 16; idx += 512) { const int k = idx >> 4, i = idx & 15; wg[i * 2052 + k] = a.w_in[(size_t)k * WIN_LD + 4096 + i]; }
        __syncthreads();
    }
    const int gw = blockIdx.x * 8 + wave, NGW = gridDim.x * 8;
    int curb = -1; f32x4 gs[8], sh[8];
    for (int m = gw; m < MTOK; m += NGW) {
        const int bb = m >> 13;
        if (bb != curb) { curb = bb;
#pragma unroll
            for (int j = 0; j < 8; ++j) { const int k = 4 * lane + 256 * j; const f32x4 g = *(const f32x4*)(gn + k), s = *(const f32x4*)(mod + bb * NMOD + sc_off + k);
                gs[j] = g * (1.f + s); sh[j] = *(const f32x4*)(mod + bb * NMOD + sh_off + k); } }
        f32x4 v[8]; float ss = 0.f;
#pragma unroll
        for (int j = 0; j < 8; ++j) { v[j] = *(const f32x4*)(xin + (size_t)m * DM + 4 * lane + 256 * j); ss += (v[j].x * v[j].x + v[j].y * v[j].y) + (v[j].z * v[j].z + v[j].w * v[j].w); }
        const float rstd = rsqrtf(wave_sum(ss) * (1.f / DM) + EPSN);
#pragma unroll
        for (int j = 0; j < 8; ++j) { v[j] = v[j] * rstd * gs[j] + sh[j];
            u32x2 o; o.x = pk2(v[j].x, v[j].y); o.y = pk2(v[j].z, v[j].w); *(u32x2*)(Hb + (size_t)m * DM + 4 * lane + 256 * j) = o; }
        if (GATES) {
            float g16[16];
#pragma unroll
            for (int i = 0; i < 16; ++i) { float s = 0.f;
#pragma unroll
                for (int j = 0; j < 8; ++j) { const f32x4 w = *(const LAS f32x4*)(wg + i * 2052 + 4 * lane + 256 * j); s += (v[j].x * w.x + v[j].y * w.y) + (v[j].z * w.z + v[j].w * w.w); }
                g16[i] = s; __builtin_amdgcn_sched_barrier(0); }
#pragma unroll
            for (int i = 0; i < 8; ++i) { const bool hi = lane & 32; const float snd = hi ? g16[i] : g16[i + 8], keep = hi ? g16[i + 8] : g16[i]; g16[i] = keep + __shfl_xor(snd, 32); }
#pragma unroll
            for (int i = 0; i < 4; ++i) { const bool hi = lane & 16; const float snd = hi ? g16[i] : g16[i + 4], keep = hi ? g16[i + 4] : g16[i]; g16[i] = keep + __shfl_xor(snd, 16); }
#pragma unroll
            for (int i = 0; i < 2; ++i) { const bool hi = lane & 8; const float snd = hi ? g16[i] : g16[i + 2], keep = hi ? g16[i + 2] : g16[i]; g16[i] = keep + __shfl_xor(snd, 8); }
            { const bool hi = lane & 4; const float snd = hi ? g16[0] : g16[1], keep = hi ? g16[1] : g16[0]; g16[0] = keep + __shfl_xor(snd, 4); }
            g16[0] += __shfl_xor(g16[0], 2); g16[0] += __shfl_xor(g16[0], 1);
            if ((lane & 3) == 0) { const int gi = ((lane >> 5) & 1) * 8 + ((lane >> 4) & 1) * 4 + ((lane >> 3) & 1) * 2 + ((lane >> 2) & 1); gates[(size_t)m * 16 + gi] = g16[0] + a.b_gates[gi]; }
        }
    }
}

DI void gate_prep(const Args& a, LAS unsigned char* lds, int combo, int tid) {
    const float* gates = (const float*)(a.ws + OFF_GATES);
    float* ulA = (float*)(a.ws + OFF_UL); float* MlA = (float*)(a.ws + OFF_ML); float* emtA = (float*)(a.ws + OFF_EMT);
    float* mprevA = (float*)(a.ws + OFF_MPREV); float* mendA = (float*)(a.ws + OFF_MEND);
    LAS float* sT = (LAS float*)lds; LAS float* sM = sT + 512; LAS float* sG = sM + 512; LAS float* sX = sG + 32; LAS float* sMp = sX + 32; LAS float* sMe = sMp + 32;
    const int b = combo >> 3, dir = (combo >> 2) & 1, h = combo & 3;
    const int ci = dir * 8 + h, cf = dir * 8 + 4 + h, cs = tid >> 4;
    float li[16], bl[16], cm[16];
    float run = 0.f;
#pragma unroll
    for (int i = 0; i < 16; ++i) { const int tau = tid * 16 + i, t = dir ? SEQ - 1 - tau : tau; const float* gp = gates + (size_t)(b * SEQ + t) * 16;
        li[i] = gp[ci]; const float f = gp[cf]; const float lf = fminf(f, 0.f) - log1pf(__expf(-fabsf(f))); run += lf; bl[i] = run; }
    sT[tid] = run; __syncthreads();
    float base = 0.f; for (int j = cs * 16; j < tid; ++j) base += sT[j];
    float mx = -3.0e38f;
#pragma unroll
    for (int i = 0; i < 16; ++i) { bl[i] += base; li[i] -= bl[i]; mx = fmaxf(mx, li[i]); cm[i] = mx; }
    sM[tid] = mx; __syncthreads();
    float mbase = -3.0e38f; for (int j = cs * 16; j < tid; ++j) mbase = fmaxf(mbase, sM[j]);
    if (tid < 32) { float g = 0.f, xm = -3.0e38f; for (int j = 0; j < 16; ++j) { g += sT[tid * 16 + j]; xm = fmaxf(xm, sM[tid * 16 + j]); } sG[tid] = g; sX[tid] = xm; }
    __syncthreads();
    if (tid == 0) { float m = -1e30f; for (int c = 0; c < 32; ++c) { sMp[c] = m; const float me = fmaxf(m, sX[c]); sMe[c] = me; m = sG[c] + me; } }
    __syncthreads();
    const float mp = sMp[cs];
#pragma unroll
    for (int i = 0; i < 16; ++i) { const int tau = tid * 16 + i, t = dir ? SEQ - 1 - tau : tau; const float Ml = fmaxf(mp, fmaxf(cm[i], mbase));
        ulA[combo * SEQ + t] = li[i]; MlA[combo * SEQ + t] = Ml; emtA[combo * SEQ + t] = __expf(-(bl[i] + Ml)); }
    if ((tid & 15) == 0) { const int c = dir ? NCH - 1 - cs : cs; mprevA[combo * NCH + c] = mp; mendA[combo * NCH + c] = sMe[cs]; }
    __syncthreads();
}

DI void mlstm_delta(const Args& a, LAS unsigned char* lds, int tid, int lane, int wave) {
    const bf16_t* P = (const bf16_t*)(a.ws + OFF_P); bf16_t* cst = (bf16_t*)(a.ws + OFF_CST);
    const float* ulA = (const float*)(a.ws + OFF_UL); const float* mendA = (const float*)(a.ws + OFF_MEND);
    const int l15 = lane & 15, quad = lane >> 4, qin = l15 >> 2, pin = l15 & 3;
    LAS unsigned char* Kt = lds; LAS unsigned char* Vt = lds + 33792; LAS float* wS = (LAS float*)(lds + 67584);
    const short one = (l15 == 0) ? (short)0x3F80 : (short)0;
    const bf16x8 ones = {one, one, one, one, one, one, one, one};
    for (int item = blockIdx.x; item < NCOMBO * NCH; item += gridDim.x) {
        const int combo = item / NCH, c = item % NCH, b = combo >> 3, h = combo & 3;
        const float mend = mendA[combo * NCH + c];
        if (tid < 256) wS[tid] = __expf(ulA[combo * SEQ + c * LCH + tid] - mend);
        f32x4 acc[17][2];
#pragma unroll
        for (int m = 0; m < 17; ++m) { acc[m][0] = (f32x4){0.f, 0.f, 0.f, 0.f}; acc[m][1] = (f32x4){0.f, 0.f, 0.f, 0.f}; }
        const bf16_t* Pk = P + (size_t)(b * SEQ + c * LCH) * NPC + 1024 + h * 256;
        for (int sb = 0; sb < 4; ++sb) {
            __syncthreads();
#pragma unroll 2
            for (int v = tid; v < 64 * 32; v += 512) { const int r = v >> 5, cv = v & 31; const bf16_t* src = Pk + (size_t)(sb * 64 + r) * NPC + cv * 8;
                const u32x4 kd = *(const u32x4*)src, vd = *(const u32x4*)(src + 1024); const float w = wS[sb * 64 + r];
                *(LAS bf16x8*)(Kt + r * 528 + cv * 16) = scale8(__builtin_bit_cast(bf16x8, kd), w); *(LAS u32x4*)(Vt + r * 528 + cv * 16) = vd; }
            __syncthreads();
#pragma unroll 1
            for (int kk = 0; kk < 2; ++kk) {
                bf16x8 bfr[2];
#pragma unroll
                for (int n = 0; n < 2; ++n) bfr[n] = tr_frag(Kt, 528, kk * 32 + 8 * quad, kk * 32 + 8 * quad + 4, wave * 32 + n * 16, qin, pin);
#pragma unroll
                for (int m = 0; m < 16; ++m) { const bf16x8 afr = tr_frag(Vt, 528, kk * 32 + 8 * quad, kk * 32 + 8 * quad + 4, m * 16, qin, pin);
                    acc[m][0] = MFMA16(afr, bfr[0], acc[m][0]); acc[m][1] = MFMA16(afr, bfr[1], acc[m][1]); if ((m & 3) == 3) __builtin_amdgcn_sched_barrier(0); }
                acc[16][0] = MFMA16(ones, bfr[0], acc[16][0]); acc[16][1] = MFMA16(ones, bfr[1], acc[16][1]);
            }
        }
        int loff = 4 * quad * 256 + wave * 32 + l15; asm volatile("" : "+v"(loff));
        bf16_t* dst = cst + (size_t)item * ST_ELEMS + loff;
#pragma unroll
        for (int m = 0; m < 17; ++m)
#pragma unroll
            for (int n = 0; n < 2; ++n)
#pragma unroll
                for (int r = 0; r < 4; ++r) { dst[(16 * m + r) * 256 + 16 * n] = (bf16_t)f2bf(acc[m][n][r]); if (r == 3) __builtin_amdgcn_sched_barrier(0); }
    }
}

DI void mlstm_scan(const Args& a, int tid) {
    bf16_t* cst = (bf16_t*)(a.ws + OFF_CST);
    const float* mprevA = (const float*)(a.ws + OFF_MPREV); const float* mendA = (const float*)(a.ws + OFF_MEND);
    constexpr int VPS = ST_ELEMS / 8;
    const int gt = blockIdx.x * 512 + tid, NT = gridDim.x * 512;
    for (int v = gt; v < NCOMBO * VPS; v += NT) {
        const int combo = v / VPS, vi = v % VPS, dir = (combo >> 2) & 1;
        float st[8];
#pragma unroll
        for (int i = 0; i < 8; ++i) st[i] = 0.f;
        for (int cs0 = 0; cs0 < NCH; cs0 += 4) {
            u32x4 d[4]; float dec[4];
#pragma unroll
            for (int q = 0; q < 4; ++q) { const int c = dir ? NCH - 1 - (cs0 + q) : cs0 + q;
                d[q] = *(const u32x4*)(cst + (size_t)(combo * NCH + c) * ST_ELEMS + vi * 8); dec[q] = __expf(mprevA[combo * NCH + c] - mendA[combo * NCH + c]); }
#pragma unroll
            for (int q = 0; q < 4; ++q) { const int c = dir ? NCH - 1 - (cs0 + q) : cs0 + q;
                u32x4 o;
#pragma unroll
                for (int i = 0; i < 4; ++i) { o[i] = pk2(st[2 * i], st[2 * i + 1]); st[2 * i] = dec[q] * st[2 * i] + bf2f(d[q][i] & 0xffffu); st[2 * i + 1] = dec[q] * st[2 * i + 1] + bf2f(d[q][i] >> 16); }
                *(u32x4*)(cst + (size_t)(combo * NCH + c) * ST_ELEMS + vi * 8) = o; }
        }
    }
}

DI void natten(const Args& a, LAS unsigned char* lds, int tid, int lane, int wave) {
    const bf16_t* P = (const bf16_t*)(a.ws + OFF_P); bf16_t* mixed = (bf16_t*)(a.ws + OFF_HB);
    const int l15 = lane & 15, quad = lane >> 4, qin = l15 >> 2, pin = l15 & 3;
    const int hw = wave >> 2, j = wave & 3, htid = tid & 255;
    LAS unsigned char* T = lds + hw * 69632;
    const int kc0 = (j == 0) ? 0 : (j == 1) ? 8 : (j == 2) ? 24 : 32;
    const float scale = 0.08838834764831845f;
    for (int item = blockIdx.x; item < 1024; item += gridDim.x) {
        const int b = item >> 9, r = (item >> 2) & 127, hp = item & 3, h = hp * 2 + hw;
        const int rs = min(max(r - 4, 0), 120), qcol = 16 * j + l15;
        const size_t tokq = (size_t)b * SEQ + r * 64 + qcol;
        bf16x8 qf[4];
#pragma unroll
        for (int ks = 0; ks < 4; ++ks) qf[ks] = *(const bf16x8*)(P + tokq * NPC + 4096 + h * 128 + ks * 32 + quad * 8);
        f32x4 st[8][2];
#pragma unroll
        for (int g = 0; g < 2; ++g) {
            __syncthreads();
            stage_tile<256, 128>(T, 272, P + ((size_t)b * SEQ + (rs + 4 * g) * 64) * NPC + 5120 + h * 128, NPC, htid, 256);
            __syncthreads();
#pragma unroll
            for (int k4 = 0; k4 < 4; ++k4)
#pragma unroll
                for (int mi = 0; mi < 2; ++mi) { f32x4 s = {0.f, 0.f, 0.f, 0.f};
#pragma unroll
                    for (int ks = 0; ks < 4; ++ks) s = MFMA16(ld_frag(T + (k4 * 64 + kc0 + 16 * mi + l15) * 272 + (ks * 32 + quad * 8) * 2), qf[ks], s);
                    st[4 * g + k4][mi] = s; }
        }
        const int cs = min(max(qcol - 8, 0), 48);
        float mx = -3.0e38f;
#pragma unroll
        for (int kr = 0; kr < 8; ++kr)
#pragma unroll
            for (int mi = 0; mi < 2; ++mi)
#pragma unroll
                for (int rr = 0; rr < 4; ++rr) { const int kc = kc0 + 16 * mi + 4 * quad + rr; const bool valid = (kc >= cs) && (kc < cs + 16);
                    const int dr = rs + kr - r + 7, dc = kc - qcol + 15;
                    const float bias = valid ? a.rpb[(h * 15 + dr) * 31 + dc] : 0.f;
                    const float s = valid ? st[kr][mi][rr] * scale + bias : -3.0e38f; st[kr][mi][rr] = s; mx = fmaxf(mx, s); }
        mx = fmaxf(mx, __shfl_xor(mx, 16)); mx = fmaxf(mx, __shfl_xor(mx, 32));
        float sum = 0.f;
#pragma unroll
        for (int kr = 0; kr < 8; ++kr)
#pragma unroll
            for (int mi = 0; mi < 2; ++mi)
#pragma unroll
                for (int rr = 0; rr < 4; ++rr) { const float s = st[kr][mi][rr]; const float p = (s > -1.0e38f) ? __expf(s - mx) : 0.f; st[kr][mi][rr] = p; sum += p; }
        sum += __shfl_xor(sum, 16); sum += __shfl_xor(sum, 32);
        const float inv = 1.f / sum;
        f32x4 o[8];
#pragma unroll
        for (int n = 0; n < 8; ++n) o[n] = (f32x4){0.f, 0.f, 0.f, 0.f};
#pragma unroll
        for (int g = 0; g < 2; ++g) {
            __syncthreads();
            stage_tile<256, 128>(T, 272, P + ((size_t)b * SEQ + (rs + 4 * g) * 64) * NPC + 6144 + h * 128, NPC, htid, 256);
            __syncthreads();
#pragma unroll
            for (int k4 = 0; k4 < 4; ++k4) { const bf16x8 pf = pack8(st[4 * g + k4][0], st[4 * g + k4][1]);
#pragma unroll
                for (int n = 0; n < 8; ++n) o[n] = MFMA16(tr_frag(T + k4 * 64 * 272, 272, kc0 + 4 * quad, kc0 + 16 + 4 * quad, 16 * n, qin, pin), pf, o[n]); }
        }
#pragma unroll
        for (int n = 0; n < 8; ++n) { u32x2 w; w.x = pk2(o[n][0] * inv, o[n][1] * inv); w.y = pk2(o[n][2] * inv, o[n][3] * inv);
            *(u32x2*)(mixed + tokq * DM + 1024 + h * 128 + 16 * n + 4 * quad) = w; }
    }
}

DI void mlstm_out(const Args& a, LAS unsigned char* lds, int tid, int lane, int wave) {
    const bf16_t* P = (const bf16_t*)(a.ws + OFF_P); const bf16_t* cst = (const bf16_t*)(a.ws + OFF_CST); bf16_t* mixed = (bf16_t*)(a.ws + OFF_HB);
    const float* ulA = (const float*)(a.ws + OFF_UL); const float* MlA = (const float*)(a.ws + OFF_ML); const float* emtA = (const float*)(a.ws + OFF_EMT);
    const float* mprevA = (const float*)(a.ws + OFF_MPREV);
    const int l15 = lane & 15, quad = lane >> 4, qin = l15 >> 2, pin = l15 & 3;
    LAS unsigned char* T0 = lds; LAS unsigned char* T1 = lds + 40960; LAS float* ulS = (LAS float*)(lds + 40960 + 33792);
    const short one = (l15 == 0) ? (short)0x3F80 : (short)0;
    const bf16x8 ones = {one, one, one, one, one, one, one, one};
    for (int item = blockIdx.x; item < 512; item += gridDim.x) {
        const int bh = item >> 6, c = (item >> 1) & 31, half = item & 1, b = bh >> 2, h = bh & 3;
        const int t_loc = 128 * half + 16 * wave + l15;
        const size_t tok = (size_t)b * SEQ + c * LCH + t_loc;
#pragma unroll 1
        for (int dir = 0; dir < 2; ++dir) {
            const int combo = (b * 2 + dir) * 4 + h;
            const float Ml = MlA[combo * SEQ + c * LCH + t_loc], emt = emtA[combo * SEQ + c * LCH + t_loc], aa = __expf(mprevA[combo * NCH + c] - Ml);
            __syncthreads();
            if (tid < 256) ulS[tid] = ulA[combo * SEQ + c * LCH + tid];
            f32x4 acc[17];
#pragma unroll
            for (int m = 0; m < 17; ++m) acc[m] = (f32x4){0.f, 0.f, 0.f, 0.f};
            const int jlo = dir ? 2 * half : 0, jhi = dir ? 3 : 2 * half + 1;
            for (int jb = jlo; jb <= jhi; ++jb) {
                __syncthreads();
                { const bf16_t* src = P + ((size_t)b * SEQ + c * LCH + 64 * jb) * NPC + 1024 + h * 256;
                  stage_tile<64, 256>(T0, 528, src, NPC, tid, 512); stage_tile<64, 256>(T1, 528, src + 1024, NPC, tid, 512); }
                __syncthreads();
                f32x4 s[4];
#pragma unroll
                for (int mi = 0; mi < 4; ++mi) s[mi] = (f32x4){0.f, 0.f, 0.f, 0.f};
#pragma unroll 1
                for (int kh = 0; kh < 2; ++kh) {
                    bf16x8 qf[4];
                    { int qo = h * 256 + quad * 8 + kh * 128; asm volatile("" : "+v"(qo)); const bf16_t* qp = P + tok * NPC + qo;
#pragma unroll
                      for (int ks = 0; ks < 4; ++ks) qf[ks] = *(const bf16x8*)(qp + ks * 32); }
#pragma unroll
                    for (int mi = 0; mi < 4; ++mi) {
#pragma unroll
                        for (int ks = 0; ks < 4; ++ks) s[mi] = MFMA16(ld_frag(T0 + (16 * mi + l15) * 528 + (32 * (4 * kh + ks) + 8 * quad) * 2), qf[ks], s[mi]);
                        __builtin_amdgcn_sched_barrier(0); }
                }
#pragma unroll
                for (int mi = 0; mi < 4; ++mi)
#pragma unroll
                    for (int rr = 0; rr < 4; ++rr) { const int s_loc = 64 * jb + 16 * mi + 4 * quad + rr; const bool valid = dir ? (s_loc >= t_loc) : (s_loc <= t_loc);
                        const float wgt = valid ? __expf(ulS[s_loc] - Ml) : 0.f; s[mi][rr] *= wgt; }
#pragma unroll
                for (int kk = 0; kk < 2; ++kk) { const bf16x8 pf = pack8(s[2 * kk], s[2 * kk + 1]);
#pragma unroll
                    for (int n = 0; n < 16; ++n) { acc[n] = MFMA16(tr_frag(T1, 528, 32 * kk + 4 * quad, 32 * kk + 16 + 4 * quad, 16 * n, qin, pin), pf, acc[n]); if ((n & 3) == 3) __builtin_amdgcn_sched_barrier(0); }
                    acc[16] = MFMA16(ones, pf, acc[16]); }
            }
            const bf16_t* stp = cst + (size_t)(combo * NCH + c) * ST_ELEMS;
#pragma unroll 1
            for (int db = 0; db < 4; ++db) {
                __syncthreads();
                stage_tile<EEXT, 64>(T0, 144, stp + 64 * db, 256, tid, 512);
                __syncthreads();
#pragma unroll 1
                for (int kk = 0; kk < 2; ++kk) { const bf16x8 aq = scale8(*(const bf16x8*)(P + tok * NPC + h * 256 + (2 * db + kk) * 32 + quad * 8), aa);
#pragma unroll
                    for (int m = 0; m < 17; ++m) { acc[m] = MFMA16(ld_frag(T0 + (16 * m + l15) * 144 + (32 * kk + 8 * quad) * 2), aq, acc[m]); if ((m & 3) == 3) __builtin_amdgcn_sched_barrier(0); } }
            }
            const float den = __shfl(acc[16][0], l15);
            const float dn = 1.f / fmaxf(fabsf(den), emt);
            int moff = h * 256 + 4 * quad; asm volatile("" : "+v"(moff));
            bf16_t* mrow = mixed + tok * DM + moff;
            if (dir == 0) {
#pragma unroll
                for (int n = 0; n < 16; ++n) { u32x2 w; w.x = pk2(acc[n][0] * dn, acc[n][1] * dn); w.y = pk2(acc[n][2] * dn, acc[n][3] * dn); *(u32x2*)(mrow + 16 * n) = w; }
            } else {
                float ss = 0.f;
#pragma unroll
                for (int n = 0; n < 16; ++n) { const u32x2 hf = *(const u32x2*)(mrow + 16 * n);
                    acc[n][0] = acc[n][0] * dn + bf2f(hf.x & 0xffffu); acc[n][1] = acc[n][1] * dn + bf2f(hf.x >> 16);
                    acc[n][2] = acc[n][2] * dn + bf2f(hf.y & 0xffffu); acc[n][3] = acc[n][3] * dn + bf2f(hf.y >> 16);
                    ss += (acc[n][0] * acc[n][0] + acc[n][1] * acc[n][1]) + (acc[n][2] * acc[n][2] + acc[n][3] * acc[n][3]); }
                ss += __shfl_xor(ss, 16); ss += __shfl_xor(ss, 32);
                const float rstd = rsqrtf(ss * (1.f / 256.f) + EPSN);
#pragma unroll
                for (int n = 0; n < 16; ++n) { const int e0 = h * 256 + 16 * n + 4 * quad; const f32x4 g = *(const f32x4*)(a.g_head_a + e0);
                    const u32x2 ov = *(const u32x2*)(P + tok * NPC + 3072 + e0);
                    const float o0 = bf2f(ov.x & 0xffffu), o1 = bf2f(ov.x >> 16), o2 = bf2f(ov.y & 0xffffu), o3 = bf2f(ov.y >> 16);
                    u32x2 w; w.x = pk2(acc[n][0] * rstd * g.x / (1.f + __expf(-o0)), acc[n][1] * rstd * g.y / (1.f + __expf(-o1)));
                    w.y = pk2(acc[n][2] * rstd * g.z / (1.f + __expf(-o2)), acc[n][3] * rstd * g.w / (1.f + __expf(-o3)));
                    *(u32x2*)(mixed + tok * DM + e0) = w; __builtin_amdgcn_sched_barrier(0); }
            }
        }
    }
}

DI void phase_act(const Args& a, int tid) {
    bf16_t* UG = (bf16_t*)(a.ws + OFF_UG);
    constexpr int NV = DFF / 8, RUN = 16, NRUN = MTOK / RUN;
    const int gt = blockIdx.x * 512 + tid, NT = gridDim.x * 512;
    for (int it = gt; it < NRUN * NV; it += NT) {
        const int vv = it % NV, run = it / NV, f0 = vv * 8, t0 = run * RUN;
        float w0[8], w1[8], w2[8], cb[8];
#pragma unroll
        for (int i = 0; i < 8; ++i) { w0[i] = a.conv_w[f0 + i]; w1[i] = a.conv_w[DFF + f0 + i]; w2[i] = a.conv_w[2 * DFF + f0 + i]; cb[i] = a.conv_b[f0 + i]; }
        const u32x4 zero = {0u, 0u, 0u, 0u};
        const bf16_t* G = UG + DFF + f0;
        u32x4 gp = ((t0 & (SEQ - 1)) == 0) ? zero : *(const u32x4*)(G + (size_t)(t0 - 1) * NUP);
        u32x4 gc = *(const u32x4*)(G + (size_t)t0 * NUP);
        for (int i = 0; i < RUN; ++i) { const int t = t0 + i;
            const u32x4 gn = (((t + 1) & (SEQ - 1)) == 0) ? zero : *(const u32x4*)(G + (size_t)(t + 1) * NUP);
            const u32x4 uv = *(const u32x4*)(UG + (size_t)t * NUP + f0);
            u32x4 o;
#pragma unroll
            for (int q = 0; q < 4; ++q) { float r[2];
#pragma unroll
                for (int e = 0; e < 2; ++e) { const int k = 2 * q + e; const unsigned sh = e ? 16u : 0u;
                    const float g = w0[k] * bf2f((gp[q] >> sh) & 0xffffu) + w1[k] * bf2f((gc[q] >> sh) & 0xffffu) + w2[k] * bf2f((gn[q] >> sh) & 0xffffu) + cb[k];
                    r[e] = 0.5f * g * (1.f + erff(g * 0.70710678118654752f)) * bf2f((uv[q] >> sh) & 0xffffu); }
                o[q] = pk2(r[0], r[1]); }
            *(u32x4*)(UG + (size_t)t * NUP + f0) = o;
            gp = gc; gc = gn; }
    }
}

DI void phase_final(const Args& a, int lane, int wave) {
    const int gw = blockIdx.x * 8 + wave, NGW = gridDim.x * 8;
    f32x4 g[8];
#pragma unroll
    for (int j = 0; j < 8; ++j) g[j] = *(const f32x4*)(a.g_final + 4 * lane + 256 * j);
    for (int m = gw; m < MTOK; m += NGW) {
        f32x4 v[8]; float ss = 0.f;
#pragma unroll
        for (int j = 0; j < 8; ++j) { v[j] = *(const f32x4*)(a.out + (size_t)m * DM + 4 * lane + 256 * j); ss += (v[j].x * v[j].x + v[j].y * v[j].y) + (v[j].z * v[j].z + v[j].w * v[j].w); }
        const float rstd = rsqrtf(wave_sum(ss) * (1.f / DM) + EPSN);
#pragma unroll
        for (int j = 0; j < 8; ++j) *(f32x4*)(a.out + (size_t)m * DM + 4 * lane + 256 * j) = v[j] * rstd * g[j];
    }
}

__global__ void __launch_bounds__(512, 2) mega(Args a) {
    extern __shared__ __attribute__((aligned(16))) unsigned char lds_raw[];
    LAS unsigned char* lds = (LAS unsigned char*)lds_raw;
    cg::grid_group grid = cg::this_grid();
    const int tid = threadIdx.x, lane = tid & 63, wave = __builtin_amdgcn_readfirstlane(tid >> 6);
    const int lo = a.ph_lo, hi = a.ph_hi;
    const float* mod = (const float*)(a.ws + OFF_MOD);
#ifndef PHMASK
#define PHMASK 0xfff
#endif
#define PH(k) (((PHMASK >> (k)) & 1) && lo <= (k) && (k) < hi)
#define SEAM(k) do { if (PH(k) && PH((k) + 1)) grid.sync(); } while (0)
    if (PH(0)) phase0(a, lds, tid, lane, wave);
    SEAM(0);
    if (PH(1)) phase_norm<true>(a, lds, a.x, a.g_norm1, 0, DM, tid, lane, wave);
    SEAM(1);
    if (PH(2)) {
        if (blockIdx.x < NCOMBO) gate_prep(a, lds, blockIdx.x, tid);
        pg8::Gemm g{(const bf16_t*)(a.ws + OFF_HB), (const bf16_t*)(a.ws + OFF_WIN), MTOK, NPC, DM, DM}; pg8::StaticOrder S; S.init(MTOK, NPC, gridDim.x, blockIdx.x);
        pg8::EpiBf16<0> E{(bf16_t*)(a.ws + OFF_P), NPC, nullptr, 0, 0, 1.f};
        pg8::gemm_phase<pg8::EpiBf16<0>, pg8::StaticOrder, true, true>(lds, g, S, E);
    }
    SEAM(2);
    if (PH(3)) mlstm_delta(a, lds, tid, lane, wave);
    SEAM(3);
    if (PH(4)) { mlstm_scan(a, tid); natten(a, lds, tid, lane, wave); }
    SEAM(4);
    if (PH(5)) mlstm_out(a, lds, tid, lane, wave);
    SEAM(5);
    if (PH(6)) {
        __syncthreads();
        pg8::Gemm g{(const bf16_t*)(a.ws + OFF_HB), (const bf16_t*)(a.ws + OFF_WOUT), MTOK, DM, DM, DM}; pg8::StaticOrder S; S.init(MTOK, DM, gridDim.x, blockIdx.x);
        EpiResid E{a.x, a.out, mod + 2 * DM};
        pg8::gemm_phase<EpiResid, pg8::StaticOrder, true, true>(lds, g, S, E);
    }
    SEAM(6);
    if (PH(7)) phase_norm<false>(a, lds, a.out, a.g_norm2, 3 * DM, 4 * DM, tid, lane, wave);
    SEAM(7);
    if (PH(8)) {
        pg8::Gemm g{(const bf16_t*)(a.ws + OFF_HB), (const bf16_t*)(a.ws + OFF_WUP), MTOK, NUP, DM, DM}; pg8::StaticOrder S; S.init(MTOK, NUP, gridDim.x, blockIdx.x);
        pg8::EpiBf16<0> E{(bf16_t*)(a.ws + OFF_UG), NUP, nullptr, 0, 0, 1.f};
        pg8::gemm_phase<pg8::EpiBf16<0>, pg8::StaticOrder, true, true>(lds, g, S, E);
    }
    SEAM(8);
    if (PH(9)) phase_act(a, tid);
    SEAM(9);
    if (PH(10)) {
        pg8::Gemm g{(const bf16_t*)(a.ws + OFF_UG), (const bf16_t*)(a.ws + OFF_WDN), MTOK, DM, DFF, NUP}; pg8::StaticOrder S; S.init(MTOK, DM, gridDim.x, blockIdx.x);
        EpiResid E{a.out, a.out, mod + 5 * DM};
        pg8::gemm_phase<EpiResid, pg8::StaticOrder, true, true>(lds, g, S, E);
    }
    SEAM(10);
    if (PH(11)) phase_final(a, lane, wave);
#undef PH
#undef SEAM
}

extern "C" void kernel_launch(void* const* d_in, const int* in_sizes, int n_in, void* d_out, int out_size, void* d_ws, size_t ws_size, hipStream_t stream) {
    static int grid = 0;
    if (grid == 0) {
        if (n_in != 16 || out_size != MTOK * DM || ws_size < WS_NEED) { fprintf(stderr, "kernel_launch: unexpected problem (n_in %d out %d ws %zu need %zu)\n", n_in, out_size, ws_size, (size_t)WS_NEED); grid = -1; return; }
        int dev = 0, cus = 0, per_cu = 0;
        hipGetDevice(&dev); hipDeviceGetAttribute(&cus, hipDeviceAttributeMultiprocessorCount, dev);
        if (hipFuncSetAttribute((const void*)mega, hipFuncAttributeMaxDynamicSharedMemorySize, LDS_BYTES) != hipSuccess) { fprintf(stderr, "kernel_launch: hipFuncSetAttribute failed\n"); grid = -1; return; }
        if (hipOccupancyMaxActiveBlocksPerMultiprocessor(&per_cu, (const void*)mega, 512, LDS_BYTES) != hipSuccess || per_cu < 1) { fprintf(stderr, "kernel_launch: occupancy query failed (%d)\n", per_cu); (void)hipGetLastError(); per_cu = 1; }
        grid = cus * (per_cu > 1 ? 1 : per_cu);
        fprintf(stderr, "kernel_launch: grid %d (cus %d, per_cu %d)\n", grid, cus, per_cu);
    }
    if (grid < 0) return;
    Args a{};
    a.x = (const float*)d_in[0]; a.c = (const float*)d_in[1]; a.w_ada = (const float*)d_in[2]; a.b_ada = (const float*)d_in[3]; a.g_norm1 = (const float*)d_in[4];
    a.w_in = (const float*)d_in[5]; a.b_gates = (const float*)d_in[6]; a.g_head_a = (const float*)d_in[7]; a.rpb = (const float*)d_in[8]; a.w_out = (const float*)d_in[9];
    a.g_norm2 = (const float*)d_in[10]; a.w_up = (const float*)d_in[11]; a.conv_w = (const float*)d_in[12]; a.conv_b = (const float*)d_in[13]; a.w_down = (const float*)d_in[14];
    a.g_final = (const float*)d_in[15]; a.out = (float*)d_out; a.ws = (unsigned char*)d_ws;
#if MK_PER_PHASE
    for (int p = 0; p < NPH; ++p) { a.ph_lo = p; a.ph_hi = p + 1; hipLaunchKernelGGL(mega, dim3(grid), dim3(512), LDS_BYTES, stream, a); }
#else
    a.ph_lo = 0; a.ph_hi = NPH;
    void* args[] = {&a};
    hipError_t e = hipLaunchCooperativeKernel((const void*)mega, dim3(grid), dim3(512), args, LDS_BYTES, stream);
    if (e != hipSuccess) fprintf(stderr, "kernel_launch: cooperative launch failed: %s (grid %d)\n", hipGetErrorString(e), grid);
#endif
}
```

```cpp
#include <hip/hip_runtime.h>
#include <hip/hip_cooperative_groups.h>
#include <cstdio>
#include <cstdint>
namespace cg = cooperative_groups;
#define MK_PER_PHASE 0
namespace pg8 {
#define PG8_LAS __attribute__((address_space(3)))
typedef unsigned short bf16_t;
typedef short bf16x8 __attribute__((ext_vector_type(8)));
typedef float f32x4 __attribute__((ext_vector_type(4)));
typedef unsigned u32x4 __attribute__((ext_vector_type(4)));
constexpr int BM = 256, BK = 64, HALF = 128, HTB = HALF * BK * 2  , STAGE_BYTES = 8 * HTB, NXCD = 8, WGM = 8;

__host__ __device__ __forceinline__ int lds_byte(int r, int c) { const int st = (r >> 4) * 2 + (c >> 5), rr = r & 15, cc = c & 31, ob = rr * 64 + cc * 2; return st * 1024 + (ob ^ (((ob >> 9) & 1) << 5)); }
__host__ __device__ __forceinline__ void stage_rc(int b, int& R, int& C) { const int st = b / 1024, sb = b % 1024, swz = sb ^ (((sb >> 9) & 1) << 5); R = (st >> 1) * 16 + swz / 64; C = (st & 1) * 32 + (swz % 64) / 2; }
__host__ __device__ __forceinline__ int perm32(int rho) { const int n = rho >> 4, i = rho & 15; return 8 * (i >> 2) + 4 * n + (i & 3); }

struct Unit { int pm, pn; };
struct Gemm { const bf16_t* A; const bf16_t* Bt; int M, N, K, lda; };

struct StaticOrder {
    int nM, nN, nwg, G, c;
    __host__ __device__ void init(int M, int N, int G_, int c_) { nM = M / BM; nN = N / BM; nwg = nM * nN; G = G_; c = c_; }
    __host__ __device__ bool next(int i, Unit& u) const {
        const long L = (long)i * G + c; if (L >= nwg) return false;
        int wgid = (int)L; { const int q = nwg / NXCD, r = nwg % NXCD, xcd = wgid % NXCD, off = wgid / NXCD; wgid = (xcd < r ? xcd * (q + 1) : r * (q + 1) + (xcd - r) * q) + off; }
        const int nig = WGM * nN, gid = wgid / nig, fm = gid * WGM, gsz = (nM - fm) < WGM ? (nM - fm) : WGM;
        u.pm = fm + ((wgid % nig) % gsz); u.pn = (wgid % nig) / gsz; return true;
    }
    __device__ __forceinline__ void a_ready(const Unit&) const {}
    __device__ __forceinline__ void done(const Unit&) const {}
};

__device__ __forceinline__ unsigned cvt_pk_bf16(float lo, float hi) { unsigned r; asm volatile("v_cvt_pk_bf16_f32 %0, %1, %2" : "=v"(r) : "v"(lo), "v"(hi)); return r; }
typedef float f32x2 __attribute__((ext_vector_type(2)));
__device__ __forceinline__ f32x2 gelu_pk(f32x2 v) {
    const f32x2 av = __builtin_elementwise_abs(v), d = av * 0.2316418882f + 1.0f;
    f32x2 t; t.x = __builtin_amdgcn_rcpf(d.x); t.y = __builtin_amdgcn_rcpf(d.y);
    f32x2 q = t * 0.5307027145f + (-0.7265760135f); q = q * t + 0.7107068705f; q = q * t + (-0.142248368f); q = q * t + 0.127414796f; q = q * t;
    const f32x2 s = (v * v) * (-0.72134752044f);
    f32x2 e; e.x = __builtin_amdgcn_exp2f(s.x); e.y = __builtin_amdgcn_exp2f(s.y);
    const f32x2 m = v * (q * e), r = v - m;
    f32x2 o; o.x = v.x < 0.f ? m.x : r.x; o.y = v.y < 0.f ? m.y : r.y; return o;
}

template <int ACT  > struct EpiBf16 {
    static constexpr bool PERM = true, AFTER_DRAIN = false; static_assert(ACT == 0 || ACT == 1, "EpiBf16: ACT is 0 (none) or 1 (gelu_pk)");
    bf16_t* O; int ldc; const float* bias; int split_cols; size_t split_stride; float scale0;
    __device__ __forceinline__ void operator()(const f32x4 (&acc)[2][2][4][2], const Unit& u, int wr, int wc, int fr, int fq) const {
        const int row0 = u.pm * BM + wr * 64 + fr; int colt = u.pn * BM; bf16_t* base = O;
        float sc = 1.f; if (split_cols) { const int t = colt / split_cols; base += (size_t)t * split_stride; colt -= t * split_cols; if (t == 0) sc = scale0; }
        const int col0 = colt + wc * 32 + 8 * fq, bcol0 = u.pn * BM + wc * 32 + 8 * fq;
        f32x4 bv[2][2];
#pragma unroll
        for (int bj = 0; bj < 2; ++bj)
#pragma unroll
            for (int n = 0; n < 2; ++n) bv[bj][n] = bias ? *(const f32x4*)(bias + bcol0 + bj * HALF + 4 * n) : (f32x4){0.f, 0.f, 0.f, 0.f};
#pragma unroll
        for (int ai = 0; ai < 2; ++ai)
#pragma unroll
            for (int m = 0; m < 4; ++m) { bf16_t* rowp = base + (size_t)(row0 + ai * HALF + m * 16) * ldc + col0;
#pragma unroll
                for (int bj = 0; bj < 2; ++bj) { f32x4 v0 = acc[ai][bj][m][0] + bv[bj][0], v1 = acc[ai][bj][m][1] + bv[bj][1];
                    if (ACT == 1) { f32x2 a = gelu_pk((f32x2){v0[0], v0[1]}), b = gelu_pk((f32x2){v0[2], v0[3]}), c = gelu_pk((f32x2){v1[0], v1[1]}), d = gelu_pk((f32x2){v1[2], v1[3]});
                        v0 = (f32x4){a.x, a.y, b.x, b.y}; v1 = (f32x4){c.x, c.y, d.x, d.y}; }
                    v0 = v0 * sc; v1 = v1 * sc; u32x4 w; w.x = cvt_pk_bf16(v0[0], v0[1]); w.y = cvt_pk_bf16(v0[2], v0[3]); w.z = cvt_pk_bf16(v1[0], v1[1]); w.w = cvt_pk_bf16(v1[2], v1[3]);
                    *(u32x4*)(rowp + bj * HALF) = w; } }
    }
};

template <class Epi, class Sched, bool ALIGN_EPI = false, bool SP2 = false>
__device__ __forceinline__ void gemm_phase(PG8_LAS unsigned char* lds, const Gemm g, const Sched& S, const Epi& E) {
    const int tid = threadIdx.x, wid = __builtin_amdgcn_readfirstlane(tid >> 6), lane = tid & 63, wr = wid >> 2, wc = wid & 3, fr = lane & 15, fq = lane >> 4;
    const int K = g.K, nt = K / BK;
    unsigned voffA[2], voffB[2];
#pragma unroll
    for (int i = 0; i < 2; ++i) { int R, C; stage_rc(tid * 16 + i * 8192, R, C); const int Rb = Epi::PERM ? ((R & ~31) + perm32(R & 31)) : R;
        voffA[i] = (unsigned)(R * g.lda + C) * 2u; voffB[i] = (unsigned)(Rb * K + C) * 2u; }
    const size_t kstep = (size_t)(BK * 2);
    const size_t hstep = (size_t)HALF * K * 2;
    const size_t tstep = 2 * hstep; const size_t hstepA = (size_t)HALF * g.lda * 2, tstepA = 2 * hstepA;
    const unsigned ldsw = (unsigned)wid * 1024u;
    const int aoff = lds_byte(wr * 64 + fr, fq * 8), boff = lds_byte(wc * 32 + fr, fq * 8);
#define PG8_SA(b, h) (((b) * 2 + (h)) * HTB)
#define PG8_SB(b, h) ((4 + (b) * 2 + (h)) * HTB)
#define PG8_STAGE(bufoff, gbase, voff) do { _Pragma("unroll") for (int _i = 0; _i < 2; ++_i) \
        __builtin_amdgcn_global_load_lds((const unsigned*)((const char*)(gbase) + (voff)[_i]), (PG8_LAS unsigned*)(lds + (bufoff) + ldsw + _i * 8192), 16, 0, 0); } while (0)
#define PG8_LDA(dst, b, h) do { _Pragma("unroll") for (int m = 0; m < 4; ++m) _Pragma("unroll") for (int k = 0; k < 2; ++k) dst[m][k] = *(const PG8_LAS bf16x8*)(lds + PG8_SA(b, h) + aoff + m * 2048 + k * 1024); } while (0)
#define PG8_LDB(dst, b, h) do { _Pragma("unroll") for (int n = 0; n < 2; ++n) _Pragma("unroll") for (int k = 0; k < 2; ++k) dst[n][k] = *(const PG8_LAS bf16x8*)(lds + PG8_SB(b, h) + boff + n * 2048 + k * 1024); } while (0)
#define PG8_MMA(ai, bj, At, Bt) do { __builtin_amdgcn_s_setprio(1); _Pragma("unroll") for (int m = 0; m < 4; ++m) _Pragma("unroll") for (int n = 0; n < 2; ++n) _Pragma("unroll") for (int k = 0; k < 2; ++k) \
        acc[ai][bj][m][n] = __builtin_amdgcn_mfma_f32_16x16x32_bf16(Bt[n][k], At[m][k], acc[ai][bj][m][n], 0, 0, 0); __builtin_amdgcn_s_setprio(0); } while (0)
#define PG8_WAIT_V(n) asm volatile("s_waitcnt vmcnt(" #n ")" ::: "memory")
#define PG8_WAIT_L(n) asm volatile("s_waitcnt lgkmcnt(" #n ")" ::: "memory")
#define PG8_BAR __builtin_amdgcn_s_barrier()
#define PG8_SCHED __builtin_amdgcn_sched_barrier(0)
    Unit cur, nxt; int ui = 0;
    if (!S.next(0, cur)) return;
    f32x4 acc[2][2][4][2];
#pragma unroll
    for (int a = 0; a < 2; ++a)
#pragma unroll
        for (int b = 0; b < 2; ++b)
#pragma unroll
            for (int m = 0; m < 4; ++m)
#pragma unroll
                for (int n = 0; n < 2; ++n) acc[a][b][m][n] = (f32x4){0.f, 0.f, 0.f, 0.f};
    bf16x8 At[4][2], B0[2][2], B1[2][2];
    const char* cA = (const char*)g.A + (size_t)cur.pm * tstepA; const char* cB = (const char*)g.Bt + (size_t)cur.pn * tstep;
    S.a_ready(cur);
    if constexpr (SP2) {
        PG8_STAGE(PG8_SB(0, 0), cB, voffB); PG8_STAGE(PG8_SB(0, 1), cB + hstep, voffB); PG8_STAGE(PG8_SA(0, 0), cA, voffA); PG8_STAGE(PG8_SA(0, 1), cA + hstepA, voffA);
        if (wr == 1) PG8_BAR;
        PG8_WAIT_V(2); PG8_BAR;
        PG8_STAGE(PG8_SB(1, 0), cB + kstep, voffB); PG8_STAGE(PG8_SA(1, 0), cA + kstep, voffA); PG8_STAGE(PG8_SB(1, 1), cB + hstep + kstep, voffB);
        PG8_WAIT_V(6); PG8_BAR;
    } else {
        PG8_STAGE(PG8_SB(0, 0), cB, voffB); PG8_STAGE(PG8_SA(0, 0), cA, voffA); PG8_STAGE(PG8_SB(0, 1), cB + hstep, voffB); PG8_STAGE(PG8_SA(0, 1), cA + hstepA, voffA);
        if (wr == 1) PG8_BAR;
        PG8_WAIT_V(4); PG8_BAR;
        PG8_STAGE(PG8_SB(1, 0), cB + kstep, voffB); PG8_STAGE(PG8_SA(1, 0), cA + kstep, voffA); PG8_STAGE(PG8_SB(1, 1), cB + hstep + kstep, voffB);
        PG8_WAIT_V(6); PG8_BAR;
    }
    for (;;) {
        const bool has_next = S.next(ui + 1, nxt);
        const char* nA = has_next ? (const char*)g.A + (size_t)nxt.pm * tstepA : cA; const char* nB = has_next ? (const char*)g.Bt + (size_t)nxt.pn * tstep : cB;
        for (int t = 0; t < nt; t += 2) {
            const bool last = (t == nt - 2);
            const char* a1 = cA + (size_t)(t + 1) * kstep;
            const char* a2 = last ? nA : cA + (size_t)(t + 2) * kstep; const char* b2 = last ? nB : cB + (size_t)(t + 2) * kstep;
            const char* a3 = a2 + kstep; const char* b3 = b2 + kstep;
            if (last && has_next) S.a_ready(nxt);
            if constexpr (SP2) {
            PG8_LDB(B0, 0, 0); PG8_LDB(B1, 0, 1); PG8_SCHED; PG8_LDA(At, 0, 0); PG8_STAGE(PG8_SA(1, 1), a1 + hstepA, voffA);
            PG8_WAIT_V(8); PG8_WAIT_L(0); PG8_BAR; PG8_MMA(0, 0, At, B0); PG8_MMA(0, 1, At, B1); PG8_BAR; PG8_SCHED;
            PG8_LDA(At, 0, 1); PG8_STAGE(PG8_SB(0, 0), b2, voffB); PG8_STAGE(PG8_SB(0, 1), b2 + hstep, voffB); PG8_STAGE(PG8_SA(0, 0), a2, voffA);
            PG8_WAIT_V(8); PG8_WAIT_L(0); PG8_BAR; PG8_MMA(1, 0, At, B0); PG8_MMA(1, 1, At, B1); PG8_BAR; PG8_SCHED;
            PG8_LDB(B0, 1, 0); PG8_LDB(B1, 1, 1); PG8_SCHED; PG8_LDA(At, 1, 0); PG8_STAGE(PG8_SA(0, 1), a2 + hstepA, voffA);
            PG8_WAIT_V(8); PG8_WAIT_L(0); PG8_BAR; PG8_MMA(0, 0, At, B0); PG8_MMA(0, 1, At, B1); PG8_BAR; PG8_SCHED;
            PG8_LDA(At, 1, 1); PG8_STAGE(PG8_SB(1, 0), b3, voffB); PG8_STAGE(PG8_SB(1, 1), b3 + hstep, voffB); PG8_STAGE(PG8_SA(1, 0), a3, voffA);
            PG8_WAIT_V(8); PG8_WAIT_L(0); PG8_BAR; PG8_MMA(1, 0, At, B0); PG8_MMA(1, 1, At, B1); PG8_BAR; PG8_SCHED;
            } else {
            PG8_LDB(B0, 0, 0); PG8_SCHED; PG8_LDA(At, 0, 0); PG8_STAGE(PG8_SA(1, 1), a1 + hstepA, voffA);
            PG8_WAIT_L(8); PG8_BAR; PG8_WAIT_L(0); PG8_MMA(0, 0, At, B0); PG8_BAR; PG8_SCHED;
            PG8_LDB(B1, 0, 1); PG8_STAGE(PG8_SB(0, 0), b2, voffB);
            PG8_BAR; PG8_WAIT_L(0); PG8_MMA(0, 1, At, B1); PG8_BAR;
            PG8_LDA(At, 0, 1); PG8_STAGE(PG8_SA(0, 0), a2, voffA);
            PG8_BAR; PG8_WAIT_L(0); PG8_MMA(1, 0, At, B0); PG8_BAR; PG8_SCHED;
            PG8_STAGE(PG8_SB(0, 1), b2 + hstep, voffB);
            PG8_WAIT_V(6); PG8_BAR; PG8_MMA(1, 1, At, B1); PG8_BAR;
            PG8_LDB(B0, 1, 0); PG8_SCHED; PG8_LDA(At, 1, 0); PG8_STAGE(PG8_SA(0, 1), a2 + hstepA, voffA);
            PG8_WAIT_L(8); PG8_BAR; PG8_WAIT_L(0); PG8_MMA(0, 0, At, B0); PG8_BAR; PG8_SCHED;
            PG8_LDB(B1, 1, 1); PG8_STAGE(PG8_SB(1, 0), b3, voffB);
            PG8_BAR; PG8_WAIT_L(0); PG8_MMA(0, 1, At, B1); PG8_BAR;
            PG8_LDA(At, 1, 1); PG8_STAGE(PG8_SA(1, 0), a3, voffA);
            PG8_BAR; PG8_WAIT_L(0); PG8_MMA(1, 0, At, B0); PG8_BAR; PG8_SCHED;
            PG8_STAGE(PG8_SB(1, 1), b3 + hstep, voffB);
            PG8_WAIT_V(6); PG8_BAR; PG8_MMA(1, 1, At, B1); PG8_BAR;
            }
        }
        if constexpr (ALIGN_EPI) { if (wr == 0) PG8_BAR; }
        if constexpr (!Epi::AFTER_DRAIN) { E(acc, cur, wr, wc, fr, fq); S.done(cur); }
        if (!has_next) break;
#pragma unroll
        for (int a = 0; a < 2; ++a)
#pragma unroll
            for (int b = 0; b < 2; ++b)
#pragma unroll
                for (int m = 0; m < 4; ++m)
#pragma unroll
                    for (int n = 0; n < 2; ++n) acc[a][b][m][n] = (f32x4){0.f, 0.f, 0.f, 0.f};
        cur = nxt; cA = nA; cB = nB; ++ui;
        if constexpr (ALIGN_EPI) { if (wr == 1) PG8_BAR; }
    }
    PG8_WAIT_V(0);
    if constexpr (!ALIGN_EPI) { if (wr == 0) PG8_BAR; }
    PG8_BAR;
    if constexpr (Epi::AFTER_DRAIN) { E.fused(acc, cur, wr, wc, fr, fq, lds, wid, lane); S.done(cur); }
#undef PG8_SA
#undef PG8_SB
#undef PG8_STAGE
#undef PG8_LDA
#undef PG8_LDB
#undef PG8_MMA
#undef PG8_WAIT_V
#undef PG8_WAIT_L
#undef PG8_BAR
#undef PG8_SCHED
}
}

#define DI __device__ __forceinline__
#define LAS __attribute__((address_space(3)))
typedef unsigned short bf16_t;
typedef short bf16x8 __attribute__((ext_vector_type(8)));
typedef short s16x4 __attribute__((ext_vector_type(4)));
typedef short v4i16_t __attribute__((ext_vector_type(4)));
typedef float f32x4 __attribute__((ext_vector_type(4)));
typedef unsigned u32x4 __attribute__((ext_vector_type(4)));
typedef unsigned u32x2 __attribute__((ext_vector_type(2)));

constexpr int NB = 2, SEQ = 8192, DM = 2048, MTOK = NB * SEQ, NPC = 7168, WIN_LD = 7184, DFF = 5632, NUP = 2 * DFF, NMOD = 6 * DM;
constexpr int LCH = 256, NCH = SEQ / LCH, EEXT = 272, ST_ELEMS = EEXT * 256, NCOMBO = 16;
constexpr float EPSN = 1e-6f;
#ifndef MK_PER_PHASE
#define MK_PER_PHASE 0
#endif
#ifndef GEMM_ALIGN
#define GEMM_ALIGN true
#endif
constexpr int NPH = 12;
constexpr int LDS_BYTES = 147456;

constexpr size_t OFF_P = 0;
constexpr size_t OFF_CST = OFF_P + (size_t)MTOK * NPC * 2;
constexpr size_t OFF_WIN = OFF_CST + (size_t)NCOMBO * NCH * ST_ELEMS * 2;
constexpr size_t OFF_WOUT = OFF_WIN + (size_t)NPC * DM * 2;
constexpr size_t OFF_R0END = OFF_WOUT + (size_t)DM * DM * 2;
constexpr size_t OFF_UG = 0;
constexpr size_t OFF_ACT = 0;
constexpr size_t OFF_EDGE = OFF_ACT + (size_t)MTOK * DFF * 2;
constexpr size_t OFF_X1B = OFF_EDGE + (size_t)3 * 64 * 2 * DFF * 4;
static_assert(OFF_X1B + (size_t)MTOK * DM * 2 <= OFF_CST + (size_t)NCOMBO * NCH * ST_ELEMS * 2, "x1b must stay below the weight copies that are still live in phase 6");
constexpr size_t OFF_WUP = OFF_UG + (size_t)MTOK * NUP * 2;
constexpr size_t OFF_WDN = OFF_WUP + (size_t)NUP * DM * 2;
constexpr size_t OFF_HB = OFF_WDN + (size_t)DM * DFF * 2;
constexpr size_t OFF_MOD = OFF_HB + (size_t)MTOK * DM * 2;
constexpr size_t OFF_GATES = OFF_MOD + 131072;
constexpr size_t OFF_UL = OFF_GATES + (size_t)MTOK * 16 * 4;
constexpr size_t OFF_ML = OFF_UL + (size_t)NCOMBO * SEQ * 4;
constexpr size_t OFF_EMT = OFF_ML + (size_t)NCOMBO * SEQ * 4;
constexpr size_t OFF_MPREV = OFF_EMT + (size_t)NCOMBO * SEQ * 4;
constexpr size_t OFF_MEND = OFF_MPREV + 4096;
constexpr size_t WS_NEED = OFF_MEND + 4096;
constexpr size_t OFF_BAR = WS_NEED + 4096;
constexpr size_t BAR_BYTES = 16384;
static_assert(OFF_R0END <= OFF_WUP, "overlay region");
static_assert(OFF_BAR + BAR_BYTES <= 536870912ull, "workspace budget");

struct Args {
    const float *x, *c, *w_ada, *b_ada, *g_norm1, *w_in, *b_gates, *g_head_a, *rpb, *w_out, *g_norm2, *w_up, *conv_w, *conv_b, *w_down, *g_final;
    float* out; unsigned char* ws; int ph_lo, ph_hi;
};

DI float bf2f(unsigned v) { return __uint_as_float(v << 16); }
DI unsigned f2bf(float f) { unsigned u = __float_as_uint(f); return (u + 0x7fffu + ((u >> 16) & 1u)) >> 16; }
DI unsigned pk2(float lo, float hi) { return f2bf(lo) | (f2bf(hi) << 16); }
DI float wave_sum(float v) {
#pragma unroll
    for (int o = 1; o < 64; o <<= 1) v += __shfl_xor(v, o);
    return v;
}
DI s16x4 tr_read(const LAS unsigned char* p) { return __builtin_bit_cast(s16x4, __builtin_amdgcn_ds_read_tr16_b64_v4i16((LAS v4i16_t*)p)); }
DI bf16x8 tr_frag(const LAS unsigned char* base, int pitch, int rowA, int rowB, int col, int qin, int pin) {
    const s16x4 lo = tr_read(base + (rowA + qin) * pitch + (col + 4 * pin) * 2);
    const s16x4 hi = tr_read(base + (rowB + qin) * pitch + (col + 4 * pin) * 2);
    return (bf16x8){lo[0], lo[1], lo[2], lo[3], hi[0], hi[1], hi[2], hi[3]};
}
DI bf16x8 ld_frag(const LAS unsigned char* p) { return *(const LAS bf16x8*)p; }
#define MFMA16(a, b, c) __builtin_amdgcn_mfma_f32_16x16x32_bf16((a), (b), (c), 0, 0, 0)
DI bf16x8 pack8(const f32x4& a, const f32x4& b) {
    u32x4 w; w.x = pk2(a[0], a[1]); w.y = pk2(a[2], a[3]); w.z = pk2(b[0], b[1]); w.w = pk2(b[2], b[3]);
    return __builtin_bit_cast(bf16x8, w);
}
DI bf16x8 scale8(const bf16x8& q, float s) {
    const u32x4 u = __builtin_bit_cast(u32x4, q); u32x4 w;
#pragma unroll
    for (int i = 0; i < 4; ++i) w[i] = pk2(bf2f(u[i] & 0xffffu) * s, bf2f(u[i] >> 16) * s);
    return __builtin_bit_cast(bf16x8, w);
}
template <int ROWS, int COLS> DI void stage_tile(LAS unsigned char* dst, int lp, const bf16_t* src, int gp, int tid, int nthr) {
    constexpr int VPR = COLS / 8, NV = ROWS * VPR;
    int t0 = tid; asm volatile("" : "+v"(t0));
#pragma unroll 2
    for (int v = t0; v < NV; v += nthr) { const int r = v / VPR, cv = v % VPR;
        const u32x4 d = *(const u32x4*)(src + (r * gp + cv * 8)); *(LAS u32x4*)(dst + r * lp + cv * 16) = d; }
}

struct EpiResid {
    static constexpr bool PERM = false, AFTER_DRAIN = false;
    const float* res; float* out; const float* gate;
    __device__ __forceinline__ void operator()(const pg8::f32x4 (&acc)[2][2][4][2], const pg8::Unit& u, int wr, int wc, int fr, int fq) const {
        const int row0 = u.pm * 256 + wr * 64 + fr, col0 = u.pn * 256 + wc * 32 + 4 * fq, bb = u.pm >> 5;
        f32x4 gv[2][2];
#pragma unroll
        for (int bj = 0; bj < 2; ++bj)
#pragma unroll
            for (int n = 0; n < 2; ++n) gv[bj][n] = *(const f32x4*)(gate + (size_t)bb * NMOD + col0 + bj * 128 + n * 16);
#pragma unroll
        for (int ai = 0; ai < 2; ++ai)
#pragma unroll
            for (int m = 0; m < 4; ++m) { const size_t ro = (size_t)(row0 + ai * 128 + m * 16) * DM + col0;
#pragma unroll
                for (int bj = 0; bj < 2; ++bj)
#pragma unroll
                    for (int n = 0; n < 2; ++n) { const size_t o = ro + bj * 128 + n * 16; const f32x4 r = *(const f32x4*)(res + o); *(f32x4*)(out + o) = r + gv[bj][n] * acc[ai][bj][m][n]; } }
    }
};

template <bool RES_BF16> struct EpiResid16 {
    static constexpr bool PERM = true, AFTER_DRAIN = false;
    const void* res; bf16_t* out; const float* gate;
    __device__ __forceinline__ void operator()(const pg8::f32x4 (&acc)[2][2][4][2], const pg8::Unit& u, int wr, int wc, int fr, int fq) const {
        const int row0 = u.pm * 256 + wr * 64 + fr, col0 = u.pn * 256 + wc * 32 + 8 * fq, bb = u.pm >> 5;
        f32x4 gv[2][2];
#pragma unroll
        for (int bj = 0; bj < 2; ++bj)
#pragma unroll
            for (int n = 0; n < 2; ++n) gv[bj][n] = *(const f32x4*)(gate + (size_t)bb * NMOD + col0 + bj * 128 + 4 * n);
#pragma unroll
        for (int ai = 0; ai < 2; ++ai)
#pragma unroll
            for (int m = 0; m < 4; ++m) { const size_t ro = (size_t)(row0 + ai * 128 + m * 16) * DM + col0;
#pragma unroll
                for (int bj = 0; bj < 2; ++bj) { const size_t o = ro + bj * 128; f32x4 r0, r1;
                    if (RES_BF16) { const u32x4 rv = *(const u32x4*)((const bf16_t*)res + o);
                        r0 = (f32x4){bf2f(rv.x & 0xffffu), bf2f(rv.x >> 16), bf2f(rv.y & 0xffffu), bf2f(rv.y >> 16)}; r1 = (f32x4){bf2f(rv.z & 0xffffu), bf2f(rv.z >> 16), bf2f(rv.w & 0xffffu), bf2f(rv.w >> 16)}; }
                    else { r0 = *(const f32x4*)((const float*)res + o); r1 = *(const f32x4*)((const float*)res + o + 4); }
                    r0 = r0 + gv[bj][0] * acc[ai][bj][m][0]; r1 = r1 + gv[bj][1] * acc[ai][bj][m][1];
                    u32x4 w; w.x = pg8::cvt_pk_bf16(r0[0], r0[1]); w.y = pg8::cvt_pk_bf16(r0[2], r0[3]); w.z = pg8::cvt_pk_bf16(r1[0], r1[1]); w.w = pg8::cvt_pk_bf16(r1[2], r1[3]);
                    *(u32x4*)(out + o) = w; } }
    }
};

constexpr size_t EDGE_STRIDE = (size_t)64 * 2 * DFF;
struct EpiGlu {
    static constexpr bool PERM = true, AFTER_DRAIN = false;
    bf16_t* ACT; const float* cw; const float* cb; float* edge; LAS float* xg;
    __device__ __forceinline__ void operator()(const pg8::f32x4 (&acc)[2][2][4][2], const pg8::Unit& u, int wr, int wc, int fr, int fq) const {
        const int lane = threadIdx.x & 63, fl = wc * 32 + 8 * fq, f0 = u.pn * 128 + fl;
        float w0[8], w1[8], w2[8], bb[8];
#pragma unroll
        for (int k = 0; k < 8; k += 4) { const f32x4 a0 = *(const f32x4*)(cw + f0 + k), a1 = *(const f32x4*)(cw + DFF + f0 + k), a2 = *(const f32x4*)(cw + 2 * DFF + f0 + k), a3 = *(const f32x4*)(cb + f0 + k);
#pragma unroll
            for (int i = 0; i < 4; ++i) { w0[k + i] = a0[i]; w1[k + i] = a1[i]; w2[k + i] = a2[i]; bb[k + i] = a3[i]; } }
#pragma unroll
        for (int ai = 0; ai < 2; ++ai) { const int bi = 2 * ai + wr;
            if (fr == 0) { *(LAS f32x4*)(xg + bi * 128 + fl) = acc[ai][1][0][0]; *(LAS f32x4*)(xg + bi * 128 + fl + 4) = acc[ai][1][0][1]; }
            if (fr == 15) { *(LAS f32x4*)(xg + (4 + bi) * 128 + fl) = acc[ai][1][3][0]; *(LAS f32x4*)(xg + (4 + bi) * 128 + fl + 4) = acc[ai][1][3][1]; } }
        asm volatile("s_waitcnt lgkmcnt(0)" ::: "memory"); __builtin_amdgcn_s_barrier(); asm volatile("" ::: "memory");
#pragma unroll
        for (int ai = 0; ai < 2; ++ai) { const int bi = 2 * ai + wr;
            f32x4 xp[2], xn[2];
#pragma unroll
            for (int n = 0; n < 2; ++n) { xp[n] = (f32x4){0.f, 0.f, 0.f, 0.f}; xn[n] = (f32x4){0.f, 0.f, 0.f, 0.f};
                if (fr == 0 && bi > 0) xp[n] = *(const LAS f32x4*)(xg + (4 + bi - 1) * 128 + fl + 4 * n);
                if (fr == 15 && bi < 3) xn[n] = *(const LAS f32x4*)(xg + (bi + 1) * 128 + fl + 4 * n); }
            unsigned o[4][4];
#pragma unroll
            for (int n = 0; n < 2; ++n)
#pragma unroll
                for (int i = 0; i < 4; i += 2) {
                    float r[4][2];
#pragma unroll
                    for (int e = 0; e < 2; ++e) { const int k = 4 * n + i + e;
                        float g[4], up[4], dn[4];
#pragma unroll
                        for (int m = 0; m < 4; ++m) { g[m] = acc[ai][1][m][n][i + e];
                            up[m] = __int_as_float(__builtin_amdgcn_update_dpp(0, __float_as_int(g[m]), 0x121, 0xf, 0xf, false));
                            dn[m] = __int_as_float(__builtin_amdgcn_update_dpp(0, __float_as_int(g[m]), 0x12F, 0xf, 0xf, false)); }
#pragma unroll
                        for (int m = 0; m < 4; ++m) { const float pv = (fr == 0) ? (m > 0 ? up[m > 0 ? m - 1 : 0] : xp[n][i + e]) : up[m];
                            const float nv = (fr == 15) ? (m < 3 ? dn[m < 3 ? m + 1 : 3] : xn[n][i + e]) : dn[m];
                            r[m][e] = w0[k] * pv + w1[k] * g[m] + w2[k] * nv + bb[k]; } }
#pragma unroll
                    for (int m = 0; m < 4; ++m) { const pg8::f32x2 gl = pg8::gelu_pk((pg8::f32x2){r[m][0], r[m][1]});
                        const bool e0 = (bi == 0 && m == 0 && fr == 0), e1 = (bi == 3 && m == 3 && fr == 15);
                        if (e0 || e1) { float* ep = edge + ((size_t)(u.pm * 2 + (e1 ? 1 : 0)) * DFF + f0 + 4 * n + i);
                            ep[0] = r[m][0]; ep[1] = r[m][1]; ep[EDGE_STRIDE] = acc[ai][1][m][n][i]; ep[EDGE_STRIDE + 1] = acc[ai][1][m][n][i + 1];
                            ep[2 * EDGE_STRIDE] = acc[ai][0][m][n][i]; ep[2 * EDGE_STRIDE + 1] = acc[ai][0][m][n][i + 1]; }
                        o[m][2 * n + (i >> 1)] = pg8::cvt_pk_bf16(gl.x * acc[ai][0][m][n][i], gl.y * acc[ai][0][m][n][i + 1]); }
                }
#pragma unroll
            for (int m = 0; m < 4; ++m) { const int row = u.pm * 256 + ai * 128 + wr * 64 + m * 16 + fr;
                u32x4 w; w.x = o[m][0]; w.y = o[m][1]; w.z = o[m][2]; w.w = o[m][3];
                *(u32x4*)(ACT + (size_t)row * DFF + f0) = w; }
        }
    }
};
DI void glu_fixup(const Args& a, int pm, int tid) {
    const float* edge = (const float*)(a.ws + OFF_EDGE); bf16_t* ACT = (bf16_t*)(a.ws + OFF_ACT);
    for (int idx = tid; idx < 2 * DFF; idx += 512) { const int e = idx / DFF, f = idx % DFF, t = pm * 256 + 255 * e;
        const float part = edge[(size_t)(pm * 2 + e) * DFF + f], uu = edge[2 * EDGE_STRIDE + (size_t)(pm * 2 + e) * DFF + f];
        float miss = 0.f;
        if (e == 0) { if ((t & (SEQ - 1)) != 0) miss = a.conv_w[f] * edge[EDGE_STRIDE + (size_t)((pm - 1) * 2 + 1) * DFF + f]; }
        else { if (((t + 1) & (SEQ - 1)) != 0) miss = a.conv_w[2 * DFF + f] * edge[EDGE_STRIDE + (size_t)((pm + 1) * 2) * DFF + f]; }
        const float g = part + miss;
        ACT[(size_t)t * DFF + f] = (bf16_t)f2bf(0.5f * g * (1.f + erff(g * 0.70710678118654752f)) * uu); }
}

DI void tr_block(const float* src, int ldw, bf16_t* dst, int ldd, float scale, LAS float* scr, int lane) {
#pragma unroll 8
    for (int i = 0; i < 32; ++i) { const int kk = 2 * i + (lane >> 5); scr[kk * 33 + (lane & 31)] = src[(size_t)kk * ldw + (lane & 31)]; }
    asm volatile("s_waitcnt lgkmcnt(0)" ::: "memory");
    const int c = lane & 7;
#pragma unroll
    for (int j = 0; j < 4; ++j) { const int n = (lane >> 3) + 8 * j; const LAS float* s = scr + (8 * c) * 33 + n;
        u32x4 o; o.x = pk2(s[0 * 33] * scale, s[1 * 33] * scale); o.y = pk2(s[2 * 33] * scale, s[3 * 33] * scale); o.z = pk2(s[4 * 33] * scale, s[5 * 33] * scale); o.w = pk2(s[6 * 33] * scale, s[7 * 33] * scale);
        *(u32x4*)(dst + (size_t)n * ldd + 8 * c) = o; }
    asm volatile("s_waitcnt lgkmcnt(0)" ::: "memory");
}
DI void phase0(const Args& a, LAS unsigned char* lds, int tid, int lane, int wave) {
    LAS float* sc = (LAS float*)lds;
    LAS float* red = sc + 4096;
    float* mod = (float*)(a.ws + OFF_MOD);
    for (int i = tid; i < 4096; i += 512) { const float v = a.c[i]; sc[i] = v / (1.f + __expf(-v)); }
    __syncthreads();
    for (int item = blockIdx.x; item < 256; item += gridDim.x) {
        const int n0 = item * 48;
        if (tid < 384) {
            const int cq = tid % 12, ks = tid / 12;
            f32x4 a0 = {0.f, 0.f, 0.f, 0.f}, a1 = {0.f, 0.f, 0.f, 0.f};
            const float* wp = a.w_ada + (size_t)(ks * 64) * NMOD + n0 + 4 * cq;
#pragma unroll 8
            for (int kk = 0; kk < 64; ++kk) { const f32x4 w = *(const f32x4*)(wp + (size_t)kk * NMOD); const float s0 = sc[ks * 64 + kk], s1 = sc[2048 + ks * 64 + kk]; a0 += s0 * w; a1 += s1 * w; }
            LAS float* rp = red + (ks * 12 + cq) * 8;
            *(LAS f32x4*)rp = a0; *(LAS f32x4*)(rp + 4) = a1;
        }
        __syncthreads();
        if (tid < 96) { const int cq = tid >> 3, j = tid & 7; float s = 0.f;
            for (int ks = 0; ks < 32; ++ks) s += red[(ks * 12 + cq) * 8 + j];
            const int bb = j >> 2, col = n0 + 4 * cq + (j & 3); mod[bb * NMOD + col] = s + a.b_ada[col]; }
        __syncthreads();
    }
    LAS float* scr = (LAS float*)(lds + 32768 + wave * 8448);
    bf16_t* WinT = (bf16_t*)(a.ws + OFF_WIN); bf16_t* WoutT = (bf16_t*)(a.ws + OFF_WOUT); bf16_t* WupT = (bf16_t*)(a.ws + OFF_WUP); bf16_t* WdnT = (bf16_t*)(a.ws + OFF_WDN);
    constexpr int I_IN = 32 * (NPC / 32), I_OUT = 32 * (DM / 32), I_UP = 32 * (NUP / 32), I_DN = (DFF / 64) * (DM / 32);
    const int gw = blockIdx.x * 8 + wave, NGW = gridDim.x * 8;
    for (int it = gw; it < I_IN + I_OUT + I_UP + I_DN; it += NGW) {
        int r = it;
        if (r < I_IN) { const int nblk = NPC / 32, kb = r / nblk, nb = r % nblk, n0 = nb * 32, ns = n0 < 4096 ? n0 : n0 + 16;
            tr_block(a.w_in + (size_t)(kb * 64) * WIN_LD + ns, WIN_LD, WinT + (size_t)n0 * DM + kb * 64, DM, (n0 >= 1024 && n0 < 2048) ? 0.0625f : 1.f, scr, lane); continue; }
        r -= I_IN;
        if (r < I_OUT) { const int nblk = DM / 32, kb = r / nblk, nb = r % nblk;
            tr_block(a.w_out + (size_t)(kb * 64) * DM + nb * 32, DM, WoutT + (size_t)(nb * 32) * DM + kb * 64, DM, 1.f, scr, lane); continue; }
        r -= I_OUT;
        if (r < I_UP) { const int nblk = NUP / 32, kb = r / nblk, nb = r % nblk, n0 = nb * 32, pn = n0 >> 8, j0 = n0 & 255, ns = (j0 < 128) ? pn * 128 + j0 : DFF + pn * 128 + j0 - 128;
            tr_block(a.w_up + (size_t)(kb * 64) * NUP + ns, NUP, WupT + (size_t)n0 * DM + kb * 64, DM, 1.f, scr, lane); continue; }
        r -= I_UP;
        { const int nblk = DM / 32, kb = r / nblk, nb = r % nblk;
            tr_block(a.w_down + (size_t)(kb * 64) * DM + nb * 32, DM, WdnT + (size_t)(nb * 32) * DFF + kb * 64, DFF, 1.f, scr, lane); }
    }
}

DI float gate_reduce16(float (&g16)[16], int lane) {
#pragma unroll
    for (int i = 0; i < 8; ++i) { const bool hi = lane & 32; const float snd = hi ? g16[i] : g16[i + 8], keep = hi ? g16[i + 8] : g16[i]; g16[i] = keep + __shfl_xor(snd, 32); }
#pragma unroll
    for (int i = 0; i < 4; ++i) { const bool hi = lane & 16; const float snd = hi ? g16[i] : g16[i + 4], keep = hi ? g16[i + 4] : g16[i]; g16[i] = keep + __shfl_xor(snd, 16); }
#pragma unroll
    for (int i = 0; i < 2; ++i) { const bool hi = lane & 8; const float snd = hi ? g16[i] : g16[i + 2], keep = hi ? g16[i + 2] : g16[i]; g16[i] = keep + __shfl_xor(snd, 8); }
    { const bool hi = lane & 4; const float snd = hi ? g16[0] : g16[1], keep = hi ? g16[1] : g16[0]; g16[0] = keep + __shfl_xor(snd, 4); }
    g16[0] += __shfl_xor(g16[0], 2); g16[0] += __shfl_xor(g16[0], 1);
    return g16[0];
}
template <bool GATES, bool IN_BF16> DI void phase_norm(const Args& a, LAS unsigned char* lds, const void* xin_, const float* gn, int sh_off, int sc_off, int tid, int lane, int wave) {
    const float* xin = (const float*)xin_; const bf16_t* xin16 = (const bf16_t*)xin_;
    const float* mod = (const float*)(a.ws + OFF_MOD);
    bf16_t* Hb = (bf16_t*)(a.ws + OFF_HB);
    float* gates = (float*)(a.ws + OFF_GATES);
    LAS float* wg = (LAS float*)lds;
    if (GATES) {
        __syncthreads();
        for (int idx = tid; idx < 2048 * 16; idx += 512) { const int k = idx >> 4, i = idx & 15; wg[i * 2052 + k] = a.w_in[(size_t)k * WIN_LD + 4096 + i]; }
        __syncthreads();
    }
    const int gw = blockIdx.x * 8 + wave, NGW = gridDim.x * 8;
    int curb = -1; f32x4 gs[8], sh[8];
    for (int m = 2 * gw; m < MTOK; m += 2 * NGW) {
        const int bb = m >> 13;
        if (bb != curb) { curb = bb;
#pragma unroll
            for (int j = 0; j < 8; ++j) { const int k = 4 * lane + 256 * j; const f32x4 g = *(const f32x4*)(gn + k), s = *(const f32x4*)(mod + bb * NMOD + sc_off + k);
                gs[j] = g * (1.f + s); sh[j] = *(const f32x4*)(mod + bb * NMOD + sh_off + k); } }
        f32x4 v0[8], v1[8]; float ss0 = 0.f, ss1 = 0.f;
#pragma unroll
        for (int j = 0; j < 8; ++j) {
            if (IN_BF16) { const u32x2 p0 = *(const u32x2*)(xin16 + (size_t)m * DM + 4 * lane + 256 * j), p1 = *(const u32x2*)(xin16 + (size_t)(m + 1) * DM + 4 * lane + 256 * j);
                v0[j] = (f32x4){bf2f(p0.x & 0xffffu), bf2f(p0.x >> 16), bf2f(p0.y & 0xffffu), bf2f(p0.y >> 16)}; v1[j] = (f32x4){bf2f(p1.x & 0xffffu), bf2f(p1.x >> 16), bf2f(p1.y & 0xffffu), bf2f(p1.y >> 16)}; }
            else { v0[j] = *(const f32x4*)(xin + (size_t)m * DM + 4 * lane + 256 * j); v1[j] = *(const f32x4*)(xin + (size_t)(m + 1) * DM + 4 * lane + 256 * j); } }
#pragma unroll
        for (int j = 0; j < 8; ++j) { ss0 += (v0[j].x * v0[j].x + v0[j].y * v0[j].y) + (v0[j].z * v0[j].z + v0[j].w * v0[j].w); ss1 += (v1[j].x * v1[j].x + v1[j].y * v1[j].y) + (v1[j].z * v1[j].z + v1[j].w * v1[j].w); }
        const float rstd0 = rsqrtf(wave_sum(ss0) * (1.f / DM) + EPSN), rstd1 = rsqrtf(wave_sum(ss1) * (1.f / DM) + EPSN);
#pragma unroll
        for (int j = 0; j < 8; ++j) { v0[j] = v0[j] * rstd0 * gs[j] + sh[j]; v1[j] = v1[j] * rstd1 * gs[j] + sh[j];
            u32x2 o; o.x = pk2(v0[j].x, v0[j].y); o.y = pk2(v0[j].z, v0[j].w); *(u32x2*)(Hb + (size_t)m * DM + 4 * lane + 256 * j) = o;
            o.x = pk2(v1[j].x, v1[j].y); o.y = pk2(v1[j].z, v1[j].w); *(u32x2*)(Hb + (size_t)(m + 1) * DM + 4 * lane + 256 * j) = o; }
        if (GATES) {
            float ga[16], gb[16];
#pragma unroll
            for (int i = 0; i < 16; ++i) { float s0 = 0.f, s1 = 0.f;
#pragma unroll
                for (int j = 0; j < 8; ++j) { const f32x4 w = *(const LAS f32x4*)(wg + i * 2052 + 4 * lane + 256 * j);
                    s0 += (v0[j].x * w.x + v0[j].y * w.y) + (v0[j].z * w.z + v0[j].w * w.w); s1 += (v1[j].x * w.x + v1[j].y * w.y) + (v1[j].z * w.z + v1[j].w * w.w); }
                ga[i] = s0; gb[i] = s1; __builtin_amdgcn_sched_barrier(0); }
            const float r0 = gate_reduce16(ga, lane), r1 = gate_reduce16(gb, lane);
            if ((lane & 3) == 0) { const int gi = ((lane >> 5) & 1) * 8 + ((lane >> 4) & 1) * 4 + ((lane >> 3) & 1) * 2 + ((lane >> 2) & 1); const float bg = a.b_gates[gi];
                gates[(size_t)m * 16 + gi] = r0 + bg; gates[(size_t)(m + 1) * 16 + gi] = r1 + bg; }
        }
    }
}

DI void gate_prep(const Args& a, LAS unsigned char* lds, int combo, int tid) {
    const float* gates = (const float*)(a.ws + OFF_GATES);
    float* ulA = (float*)(a.ws + OFF_UL); float* MlA = (float*)(a.ws + OFF_ML); float* emtA = (float*)(a.ws + OFF_EMT);
    float* mprevA = (float*)(a.ws + OFF_MPREV); float* mendA = (float*)(a.ws + OFF_MEND);
    LAS float* sT = (LAS float*)lds; LAS float* sM = sT + 512; LAS float* sG = sM + 512; LAS float* sX = sG + 32; LAS float* sMp = sX + 32; LAS float* sMe = sMp + 32;
    const int b = combo >> 3, dir = (combo >> 2) & 1, h = combo & 3;
    const int ci = dir * 8 + h, cf = dir * 8 + 4 + h, cs = tid >> 4;
    float li[16], bl[16], cm[16];
    float run = 0.f;
#pragma unroll
    for (int i = 0; i < 16; ++i) { const int tau = tid * 16 + i, t = dir ? SEQ - 1 - tau : tau; const float* gp = gates + (size_t)(b * SEQ + t) * 16;
        li[i] = gp[ci]; const float f = gp[cf]; const float lf = fminf(f, 0.f) - log1pf(__expf(-fabsf(f))); run += lf; bl[i] = run; }
    sT[tid] = run; __syncthreads();
    float base = 0.f; for (int j = cs * 16; j < tid; ++j) base += sT[j];
    float mx = -3.0e38f;
#pragma unroll
    for (int i = 0; i < 16; ++i) { bl[i] += base; li[i] -= bl[i]; mx = fmaxf(mx, li[i]); cm[i] = mx; }
    sM[tid] = mx; __syncthreads();
    float mbase = -3.0e38f; for (int j = cs * 16; j < tid; ++j) mbase = fmaxf(mbase, sM[j]);
    if (tid < 32) { float g = 0.f, xm = -3.0e38f; for (int j = 0; j < 16; ++j) { g += sT[tid * 16 + j]; xm = fmaxf(xm, sM[tid * 16 + j]); } sG[tid] = g; sX[tid] = xm; }
    __syncthreads();
    if (tid == 0) { float m = -1e30f; for (int c = 0; c < 32; ++c) { sMp[c] = m; const float me = fmaxf(m, sX[c]); sMe[c] = me; m = sG[c] + me; } }
    __syncthreads();
    const float mp = sMp[cs];
#pragma unroll
    for (int i = 0; i < 16; ++i) { const int tau = tid * 16 + i, t = dir ? SEQ - 1 - tau : tau; const float Ml = fmaxf(mp, fmaxf(cm[i], mbase));
        ulA[combo * SEQ + t] = li[i]; MlA[combo * SEQ + t] = Ml; emtA[combo * SEQ + t] = __expf(-(bl[i] + Ml)); }
    if ((tid & 15) == 0) { const int c = dir ? NCH - 1 - cs : cs; mprevA[combo * NCH + c] = mp; mendA[combo * NCH + c] = sMe[cs]; }
    __syncthreads();
}

DI void mlstm_delta(const Args& a, LAS unsigned char* lds, int tid, int lane, int wave) {
    const bf16_t* P = (const bf16_t*)(a.ws + OFF_P); bf16_t* cst = (bf16_t*)(a.ws + OFF_CST);
    const float* ulA = (const float*)(a.ws + OFF_UL); const float* mendA = (const float*)(a.ws + OFF_MEND);
    const int l15 = lane & 15, quad = lane >> 4, qin = l15 >> 2, pin = l15 & 3;
    constexpr int BUFB = 2 * 34816;
    LAS float* wS = (LAS float*)(lds + 2 * BUFB);
    const short one = (l15 == 0) ? (short)0x3F80 : (short)0;
    const bf16x8 ones = {one, one, one, one, one, one, one, one};
    for (int item = blockIdx.x; item < NCOMBO * NCH; item += gridDim.x) {
        const int combo = item / NCH, c = item % NCH, b = combo >> 3, h = combo & 3;
        const float mend = mendA[combo * NCH + c];
        __syncthreads();
        if (tid < 256) wS[tid] = __expf(ulA[combo * SEQ + c * LCH + tid] - mend);
        f32x4 acc[17][2];
#pragma unroll
        for (int m = 0; m < 17; ++m) { acc[m][0] = (f32x4){0.f, 0.f, 0.f, 0.f}; acc[m][1] = (f32x4){0.f, 0.f, 0.f, 0.f}; }
        const bf16_t* Pk = P + (size_t)(b * SEQ + c * LCH) * NPC + 1024 + h * 256;
        u32x4 pre[8];
#define DL_LOAD(sb_) do { int t0_ = tid; asm volatile("" : "+v"(t0_)); const bf16_t* src_ = Pk + (unsigned)(((sb_) * 64 + (t0_ >> 5)) * NPC + (t0_ & 31) * 8); \
        _Pragma("unroll") for (int i_ = 0; i_ < 4; ++i_) { pre[i_] = *(const u32x4*)(src_ + i_ * 16 * NPC); pre[4 + i_] = *(const u32x4*)(src_ + i_ * 16 * NPC + 1024); } } while (0)
#define DL_STORE(sb_) do { int t0_ = tid; asm volatile("" : "+v"(t0_)); LAS unsigned char* d_ = lds + ((sb_) & 1) * BUFB + (t0_ >> 5) * 544 + (t0_ & 31) * 16; \
        _Pragma("unroll") for (int i_ = 0; i_ < 4; ++i_) { const float w_ = wS[(sb_) * 64 + (t0_ >> 5) + 16 * i_]; \
            *(LAS bf16x8*)(d_ + i_ * 16 * 544) = scale8(__builtin_bit_cast(bf16x8, pre[i_]), w_); *(LAS u32x4*)(d_ + 34816 + i_ * 16 * 544) = pre[4 + i_]; } } while (0)
        DL_LOAD(0);
        __syncthreads();
        DL_STORE(0);
        __syncthreads();
#pragma unroll 1
        for (int sb = 0; sb < 4; ++sb) {
            const LAS unsigned char* Kt = lds + (sb & 1) * BUFB; const LAS unsigned char* Vt = Kt + 34816;
            if (sb + 1 < 4) DL_LOAD(sb + 1);
#pragma unroll 1
            for (int kk = 0; kk < 2; ++kk) {
                bf16x8 bfr[2];
#pragma unroll
                for (int n = 0; n < 2; ++n) bfr[n] = tr_frag(Kt, 544, kk * 32 + 4 * quad, kk * 32 + 16 + 4 * quad, wave * 32 + n * 16, qin, pin);
#pragma unroll
                for (int m = 0; m < 16; ++m) { const bf16x8 afr = tr_frag(Vt, 544, kk * 32 + 4 * quad, kk * 32 + 16 + 4 * quad, m * 16, qin, pin);
                    acc[m][0] = MFMA16(afr, bfr[0], acc[m][0]); acc[m][1] = MFMA16(afr, bfr[1], acc[m][1]); if ((m & 3) == 3) __builtin_amdgcn_sched_barrier(0); }
                acc[16][0] = MFMA16(ones, bfr[0], acc[16][0]); acc[16][1] = MFMA16(ones, bfr[1], acc[16][1]);
            }
            if (sb + 1 < 4) DL_STORE(sb + 1);
            __syncthreads();
        }
#undef DL_LOAD
#undef DL_STORE
        int loff = 4 * quad * 256 + wave * 32 + l15; asm volatile("" : "+v"(loff));
        bf16_t* dst = cst + (size_t)item * ST_ELEMS + loff;
#pragma unroll
        for (int m = 0; m < 17; ++m)
#pragma unroll
            for (int n = 0; n < 2; ++n)
#pragma unroll
                for (int r = 0; r < 4; ++r) { dst[(16 * m + r) * 256 + 16 * n] = (bf16_t)f2bf(acc[m][n][r]); if (r == 3) __builtin_amdgcn_sched_barrier(0); }
    }
}

DI void mlstm_scan(const Args& a, int tid) {
    bf16_t* cst = (bf16_t*)(a.ws + OFF_CST);
    const float* mprevA = (const float*)(a.ws + OFF_MPREV); const float* mendA = (const float*)(a.ws + OFF_MEND);
    constexpr int VPS = ST_ELEMS / 8;
    const int gt = blockIdx.x * 512 + tid, NT = gridDim.x * 512;
    for (int v = gt; v < NCOMBO * VPS; v += NT) {
        const int combo = v / VPS, vi = v % VPS, dir = (combo >> 2) & 1;
        float st[8];
#pragma unroll
        for (int i = 0; i < 8; ++i) st[i] = 0.f;
        bf16_t* base = cst + (size_t)combo * NCH * ST_ELEMS + vi * 8;
        for (int cs0 = 0; cs0 < NCH; cs0 += 8) {
            u32x4 d[8]; float dec[8];
#pragma unroll
            for (int q = 0; q < 8; ++q) { const int c = dir ? NCH - 1 - (cs0 + q) : cs0 + q;
                d[q] = *(const u32x4*)(base + (size_t)c * ST_ELEMS); dec[q] = __expf(mprevA[combo * NCH + c] - mendA[combo * NCH + c]); }
#pragma unroll
            for (int q = 0; q < 8; ++q) { const int c = dir ? NCH - 1 - (cs0 + q) : cs0 + q;
                u32x4 o;
#pragma unroll
                for (int i = 0; i < 4; ++i) { o[i] = pk2(st[2 * i], st[2 * i + 1]); st[2 * i] = dec[q] * st[2 * i] + bf2f(d[q][i] & 0xffffu); st[2 * i + 1] = dec[q] * st[2 * i + 1] + bf2f(d[q][i] >> 16); }
                *(u32x4*)(base + (size_t)c * ST_ELEMS) = o; }
        }
    }
}

DI void nat_scores(f32x4 (&st)[4][2], const LAS unsigned char* T, const bf16x8 (&qf)[4], int kc0, int l15, int quad) {
#pragma unroll
    for (int k4 = 0; k4 < 4; ++k4)
#pragma unroll
        for (int mi = 0; mi < 2; ++mi) { f32x4 s = {0.f, 0.f, 0.f, 0.f};
#pragma unroll
            for (int ks = 0; ks < 4; ++ks) { s = MFMA16(ld_frag(T + (k4 * 64 + kc0 + 16 * mi + l15) * 272 + (ks * 32 + quad * 8) * 2), qf[ks], s); if (ks == 1) __builtin_amdgcn_sched_barrier(0); }
            st[k4][mi] = s; __builtin_amdgcn_sched_barrier(0); }
}
DI float nat_mask(f32x4 (&st)[4][2], const LAS float* rpbS, int kr0, int rs, int r, const bool (&sel)[4], const int (&dcb)[4], float scale) {
    float mx = -3.0e38f;
#pragma unroll
    for (int k4 = 0; k4 < 4; ++k4) { const int dr = rs + kr0 + k4 - r + 7;
#pragma unroll
        for (int rr = 0; rr < 4; ++rr) { const float sv = (sel[rr] ? st[k4][0][rr] : st[k4][1][rr]) * scale + rpbS[dr * 31 + dcb[rr]]; st[k4][0][rr] = sv; mx = fmaxf(mx, sv); } }
    mx = fmaxf(mx, __shfl_xor(mx, 16)); mx = fmaxf(mx, __shfl_xor(mx, 32));
    return mx;
}
DI float nat_exp(bf16x8 (&pf)[4], f32x4 (&st)[4][2], const bool (&sel)[4], float m) {
    float sum = 0.f;
#pragma unroll
    for (int k4 = 0; k4 < 4; ++k4) { f32x4 p0, p1;
#pragma unroll
        for (int rr = 0; rr < 4; ++rr) { const float p = __expf(st[k4][0][rr] - m); sum += p; p0[rr] = sel[rr] ? p : 0.f; p1[rr] = sel[rr] ? 0.f : p; }
        pf[k4] = pack8(p0, p1); }
    return sum;
}
DI void nat_pv(f32x4 (&o)[8], const bf16x8 (&pf)[4], const LAS unsigned char* T, int kc0, int quad, int qin, int pin) {
#pragma unroll
    for (int k4 = 0; k4 < 4; ++k4) {
#pragma unroll
        for (int n = 0; n < 8; ++n) { o[n] = MFMA16(tr_frag(T + k4 * 64 * 272, 272, kc0 + 4 * quad, kc0 + 16 + 4 * quad, 16 * n, qin, pin), pf[k4], o[n]); if ((n & 3) == 3) __builtin_amdgcn_sched_barrier(0); } }
}
DI void natten(const Args& a, LAS unsigned char* lds, int tid, int lane, int wave) {
    const bf16_t* P = (const bf16_t*)(a.ws + OFF_P); bf16_t* mixed = (bf16_t*)(a.ws + OFF_HB);
    const int l15 = lane & 15, quad = lane >> 4, qin = l15 >> 2, pin = l15 & 3;
    const int hw = wave >> 2, j = wave & 3, htid = tid & 255;
    LAS unsigned char* T = lds + hw * 69632;
    LAS float* rpbS = (LAS float*)(lds + 139264) + hw * 480;
    const int kc0 = (j == 0) ? 0 : (j == 1) ? 8 : (j == 2) ? 24 : 32;
    const float scale = 0.08838834764831845f;
    const int nit = (1024 - (int)blockIdx.x + (int)gridDim.x - 1) / (int)gridDim.x;
    if (nit <= 0) return;
    __syncthreads();
    { const int h0 = (blockIdx.x & 3) * 2 + hw; for (int i = htid; i < 465; i += 256) rpbS[i] = a.rpb[h0 * 465 + i]; }
    u32x4 pre[16];
    const bool xmap = (gridDim.x == 256);
#define NAT_ITEM(k_) (xmap ? ((((int)blockIdx.x & 7) >> 2) << 9) | ((32 * (k_) + ((int)blockIdx.x >> 3)) << 2) | ((int)blockIdx.x & 3) : (int)blockIdx.x + (k_) * (int)gridDim.x)
#define NAT_LOAD(g_) do { const int it_ = NAT_ITEM((g_) >> 2), sp_ = (g_) & 3; const int b_ = it_ >> 9, r_ = (it_ >> 2) & 127, h_ = (it_ & 3) * 2 + hw; \
        const int rs_ = min(max(r_ - 4, 0), 120); int t0_ = htid; asm volatile("" : "+v"(t0_)); \
        const bf16_t* src_ = P + (unsigned)((b_ * SEQ + (rs_ + 4 * (sp_ & 1)) * 64) * NPC + ((sp_ >> 1) ? 6144 : 5120) + h_ * 128 + ((t0_ >> 4) * NPC + (t0_ & 15) * 8)); \
        _Pragma("unroll") for (int i_ = 0; i_ < 16; ++i_) pre[i_] = *(const u32x4*)(src_ + i_ * 16 * NPC); } while (0)
#define NAT_STORE() do { int t0_ = htid; asm volatile("" : "+v"(t0_)); LAS unsigned char* d_ = T + (t0_ >> 4) * 272 + (t0_ & 15) * 16; \
        _Pragma("unroll") for (int i_ = 0; i_ < 16; ++i_) *(LAS u32x4*)(d_ + i_ * 16 * 272) = pre[i_]; } while (0)
    NAT_LOAD(0); NAT_STORE();
    __syncthreads();
#pragma unroll 1
    for (int k = 0; k < nit; ++k) {
        const int item = NAT_ITEM(k);
        const int b = item >> 9, r = (item >> 2) & 127, h = (item & 3) * 2 + hw;
        int l15g = l15; asm volatile("" : "+v"(l15g));
        const int rs = min(max(r - 4, 0), 120), qcol = 16 * j + l15g;
        const int tokq = b * SEQ + r * 64 + qcol;
        bf16x8 qf[4]; f32x4 st[4][2]; bf16x8 pf0[4], pf1[4];
#pragma unroll
        for (int ks = 0; ks < 4; ++ks) qf[ks] = *(const bf16x8*)(P + (unsigned)(tokq * NPC + 4096 + h * 128 + ks * 32 + quad * 8));
        const int cs = min(max(qcol - 8, 0), 48);
        bool sel[4]; int dcb[4];
#pragma unroll
        for (int rr = 0; rr < 4; ++rr) { sel[rr] = (4 * quad + rr >= cs - kc0); dcb[rr] = kc0 + 4 * quad + rr + (sel[rr] ? 0 : 16) - qcol + 15; }
        NAT_LOAD(4 * k + 1);
        nat_scores(st, T, qf, kc0, l15, quad);
        const float m0 = nat_mask(st, rpbS, 0, rs, r, sel, dcb, scale);
        float sum0 = nat_exp(pf0, st, sel, m0);
        __syncthreads(); NAT_STORE(); __syncthreads();
        NAT_LOAD(4 * k + 2);
        nat_scores(st, T, qf, kc0, l15, quad);
        const float m1 = nat_mask(st, rpbS, 4, rs, r, sel, dcb, scale);
        const float M = fmaxf(m0, m1), f0 = __expf(m0 - M);
        float sum1 = nat_exp(pf1, st, sel, M);
        float tot = sum0 * f0 + sum1;
        tot += __shfl_xor(tot, 16); tot += __shfl_xor(tot, 32);
        const float inv = 1.f / tot;
        __syncthreads(); NAT_STORE(); __syncthreads();
        f32x4 o[8];
#pragma unroll
        for (int n = 0; n < 8; ++n) o[n] = (f32x4){0.f, 0.f, 0.f, 0.f};
        NAT_LOAD(4 * k + 3);
        nat_pv(o, pf0, T, kc0, quad, qin, pin);
#pragma unroll
        for (int n = 0; n < 8; ++n) o[n] = o[n] * f0;
        __syncthreads(); NAT_STORE(); __syncthreads();
        if (k + 1 < nit) NAT_LOAD(4 * k + 4);
        nat_pv(o, pf1, T, kc0, quad, qin, pin);
#pragma unroll
        for (int n = 0; n < 8; ++n) { u32x2 w; w.x = pk2(o[n][0] * inv, o[n][1] * inv); w.y = pk2(o[n][2] * inv, o[n][3] * inv);
            *(u32x2*)(mixed + (unsigned)(tokq * DM + 1024 + h * 128 + 16 * n + 4 * quad)) = w; }
        __syncthreads();
        if (k + 1 < nit) NAT_STORE();
        __syncthreads();
    }
#undef NAT_LOAD
#undef NAT_ITEM
#undef NAT_STORE
}

DI void mlstm_out(const Args& a, LAS unsigned char* lds, int tid, int lane, int wave) {
    const bf16_t* P = (const bf16_t*)(a.ws + OFF_P); const bf16_t* cst = (const bf16_t*)(a.ws + OFF_CST); bf16_t* mixed = (bf16_t*)(a.ws + OFF_HB);
    const float* ulA = (const float*)(a.ws + OFF_UL); const float* MlA = (const float*)(a.ws + OFF_ML); const float* emtA = (const float*)(a.ws + OFF_EMT);
    const float* mprevA = (const float*)(a.ws + OFF_MPREV);
    const int l15 = lane & 15, quad = lane >> 4, qin = l15 >> 2, pin = l15 & 3;
    constexpr int BUFB = 33792 + 34816;
    LAS float* ulS2 = (LAS float*)(lds + 2 * BUFB);
    const short one = (l15 == 0) ? (short)0x3F80 : (short)0;
    const bf16x8 ones = {one, one, one, one, one, one, one, one};
    for (int item = blockIdx.x; item < 512; item += gridDim.x) {
        const int bh = item >> 6, c = (item >> 1) & 31, half = item & 1, b = bh >> 2, h = bh & 3;
        int l15i = l15, tt = tid; asm volatile("" : "+v"(l15i), "+v"(tt));
        const int t_loc = 128 * half + 16 * wave + l15i;
        const size_t tok = (size_t)b * SEQ + c * LCH + t_loc;
        const int n0 = 2 * half + 2;
        __syncthreads();
        { const int d = tt >> 8; ulS2[tt] = ulA[((b * 2 + d) * 4 + h) * SEQ + c * LCH + (tt & 255)]; }
        u32x4 pre[8];
#define STEP_DEC(s_, dir_, st_, idx_) do { int r_ = (s_); dir_ = 0; if (r_ >= n0 + 4) { r_ -= n0 + 4; dir_ = 1; } const int nk_ = dir_ ? 4 - 2 * half : n0; st_ = (r_ >= nk_); idx_ = st_ ? r_ - nk_ : (dir_ ? 2 * half + r_ : r_); } while (0)
#define STEP_LOAD(s_) do { int dir_, st_, idx_; STEP_DEC(s_, dir_, st_, idx_); int t0_ = tid; asm volatile("" : "+v"(t0_)); \
        if (!st_) { const bf16_t* src_ = P + ((size_t)b * SEQ + c * LCH + 64 * idx_) * NPC + 1024 + h * 256 + ((t0_ >> 5) * NPC + (t0_ & 31) * 8); \
            _Pragma("unroll") for (int i_ = 0; i_ < 4; ++i_) { pre[i_] = *(const u32x4*)(src_ + i_ * 16 * NPC); pre[4 + i_] = *(const u32x4*)(src_ + i_ * 16 * NPC + 1024); } } \
        else { const bf16_t* src_ = cst + (size_t)(((b * 2 + dir_) * 4 + h) * NCH + c) * ST_ELEMS + 64 * idx_ + ((t0_ >> 3) * 256 + (t0_ & 7) * 8); \
            _Pragma("unroll") for (int i_ = 0; i_ < 4; ++i_) pre[i_] = *(const u32x4*)(src_ + i_ * 64 * 256); \
            if (t0_ < 128) pre[4] = *(const u32x4*)(src_ + 4 * 64 * 256); } } while (0)
#define STEP_STORE(s_) do { int dir_, st_, idx_; STEP_DEC(s_, dir_, st_, idx_); LAS unsigned char* bp_ = lds + ((s_) & 1) * BUFB; int t0_ = tid; asm volatile("" : "+v"(t0_)); \
        if (!st_) { LAS unsigned char* d_ = bp_ + (t0_ >> 5) * 528 + (t0_ & 31) * 16; \
            _Pragma("unroll") for (int i_ = 0; i_ < 4; ++i_) { *(LAS u32x4*)(d_ + i_ * 16 * 528) = pre[i_]; *(LAS u32x4*)(bp_ + 33792 + ((t0_ >> 5) + 16 * i_) * 544 + (t0_ & 31) * 16) = pre[4 + i_]; } } \
        else { LAS unsigned char* d_ = bp_ + (t0_ >> 3) * 144 + (t0_ & 7) * 16; \
            _Pragma("unroll") for (int i_ = 0; i_ < 4; ++i_) *(LAS u32x4*)(d_ + i_ * 64 * 144) = pre[i_]; \
            if (t0_ < 128) *(LAS u32x4*)(d_ + 4 * 64 * 144) = pre[4]; } } while (0)
        bf16x8 qf[8];
        { int qo = h * 256 + quad * 8; asm volatile("" : "+v"(qo)); const bf16_t* qp = P + tok * NPC + qo;
#pragma unroll
          for (int ks = 0; ks < 8; ++ks) qf[ks] = *(const bf16x8*)(qp + ks * 32); }
        STEP_LOAD(0); STEP_STORE(0);
        __syncthreads();
        f32x4 acc[17]; float Ml = 0.f, emt = 1.f, aa = 0.f;
#pragma unroll 1
        for (int s = 0; s < 14; ++s) {
            int dir, st, idx; STEP_DEC(s, dir, st, idx);
            const LAS unsigned char* T0 = lds + (s & 1) * BUFB; const LAS unsigned char* T1 = T0 + 33792;
            const LAS float* ulS = ulS2 + dir * 256;
            if (s == 0 || s == n0 + 4) {
                const int combo = (b * 2 + dir) * 4 + h;
                Ml = MlA[combo * SEQ + c * LCH + t_loc]; emt = emtA[combo * SEQ + c * LCH + t_loc]; aa = __expf(mprevA[combo * NCH + c] - Ml);
#pragma unroll
                for (int m = 0; m < 17; ++m) acc[m] = (f32x4){0.f, 0.f, 0.f, 0.f};
            }
            if (s + 1 < 14) STEP_LOAD(s + 1);
            if (!st && (dir ? (64 * idx + 63 >= 128 * half + 16 * wave) : (64 * idx <= 128 * half + 16 * wave + 15))) {
                const int jb = idx;
                f32x4 sc[4];
#pragma unroll
                for (int mi = 0; mi < 4; ++mi) sc[mi] = (f32x4){0.f, 0.f, 0.f, 0.f};
#pragma unroll
                for (int mi = 0; mi < 4; ++mi) {
#pragma unroll
                    for (int ks = 0; ks < 8; ++ks) { sc[mi] = MFMA16(ld_frag(T0 + (16 * mi + l15) * 528 + (32 * ks + 8 * quad) * 2), qf[ks], sc[mi]); if (ks == 3) __builtin_amdgcn_sched_barrier(0); }
                    __builtin_amdgcn_sched_barrier(0); }
#pragma unroll
                for (int mi = 0; mi < 4; ++mi)
#pragma unroll
                    for (int rr = 0; rr < 4; ++rr) { const int s_loc = 64 * jb + 16 * mi + 4 * quad + rr; const bool valid = dir ? (s_loc >= t_loc) : (s_loc <= t_loc);
                        const float wgt = valid ? __expf(ulS[s_loc] - Ml) : 0.f; sc[mi][rr] *= wgt; }
#pragma unroll
                for (int kk = 0; kk < 2; ++kk) { const bf16x8 pf = pack8(sc[2 * kk], sc[2 * kk + 1]);
#pragma unroll
                    for (int n = 0; n < 16; ++n) { acc[n] = MFMA16(tr_frag(T1, 544, 32 * kk + 4 * quad, 32 * kk + 16 + 4 * quad, 16 * n, qin, pin), pf, acc[n]); if ((n & 1) == 1) __builtin_amdgcn_sched_barrier(0); }
                    acc[16] = MFMA16(ones, pf, acc[16]); }
            } else if (st) {
                const int db = idx;
                bf16x8 aq[2];
                aq[0] = (db == 0) ? qf[0] : (db == 1) ? qf[2] : (db == 2) ? qf[4] : qf[6];
                aq[1] = (db == 0) ? qf[1] : (db == 1) ? qf[3] : (db == 2) ? qf[5] : qf[7];
                aq[0] = scale8(aq[0], aa); aq[1] = scale8(aq[1], aa);
#pragma unroll
                for (int kk = 0; kk < 2; ++kk) {
#pragma unroll
                    for (int m = 0; m < 17; ++m) { acc[m] = MFMA16(ld_frag(T0 + (16 * m + l15) * 144 + (32 * kk + 8 * quad) * 2), aq[kk], acc[m]); if ((m & 1) == 1) __builtin_amdgcn_sched_barrier(0); } }
            }
            if (s + 1 < 14) STEP_STORE(s + 1);
            if (s == n0 + 3 || s == 13) {
                const float den = __shfl(acc[16][0], l15);
                const float dn = 1.f / fmaxf(fabsf(den), emt);
                int moff = h * 256 + 4 * quad; asm volatile("" : "+v"(moff));
                bf16_t* mrow = mixed + tok * DM + moff;
                if (dir == 0) {
#pragma unroll
                    for (int n = 0; n < 16; ++n) { u32x2 w; w.x = pk2(acc[n][0] * dn, acc[n][1] * dn); w.y = pk2(acc[n][2] * dn, acc[n][3] * dn); *(u32x2*)(mrow + 16 * n) = w; }
                } else {
                    float ss = 0.f;
#pragma unroll
                    for (int n = 0; n < 16; ++n) { const u32x2 hf = *(const u32x2*)(mrow + 16 * n);
                        acc[n][0] = acc[n][0] * dn + bf2f(hf.x & 0xffffu); acc[n][1] = acc[n][1] * dn + bf2f(hf.x >> 16);
                        acc[n][2] = acc[n][2] * dn + bf2f(hf.y & 0xffffu); acc[n][3] = acc[n][3] * dn + bf2f(hf.y >> 16);
                        ss += (acc[n][0] * acc[n][0] + acc[n][1] * acc[n][1]) + (acc[n][2] * acc[n][2] + acc[n][3] * acc[n][3]); if ((n & 3) == 3) __builtin_amdgcn_sched_barrier(0); }
                    ss += __shfl_xor(ss, 16); ss += __shfl_xor(ss, 32);
                    const float rstd = rsqrtf(ss * (1.f / 256.f) + EPSN);
                    __builtin_amdgcn_sched_barrier(0);
                    int eb = h * 256 + 4 * quad; asm volatile("" : "+v"(eb));
                    const float* gp = a.g_head_a + eb; const bf16_t* ovp = P + tok * NPC + 3072 + eb;
#pragma unroll
                    for (int n = 0; n < 16; ++n) { const f32x4 g = *(const f32x4*)(gp + 16 * n);
                        const u32x2 ov = *(const u32x2*)(ovp + 16 * n);
                        const float o0 = bf2f(ov.x & 0xffffu), o1 = bf2f(ov.x >> 16), o2 = bf2f(ov.y & 0xffffu), o3 = bf2f(ov.y >> 16);
                        u32x2 w; w.x = pk2(acc[n][0] * rstd * g.x / (1.f + __expf(-o0)), acc[n][1] * rstd * g.y / (1.f + __expf(-o1)));
                        w.y = pk2(acc[n][2] * rstd * g.z / (1.f + __expf(-o2)), acc[n][3] * rstd * g.w / (1.f + __expf(-o3)));
                        *(u32x2*)(mrow + 16 * n) = w; __builtin_amdgcn_sched_barrier(0); }
                }
            }
            __syncthreads();
        }
#undef STEP_DEC
#undef STEP_LOAD
#undef STEP_STORE
    }
}

DI void phase_act(const Args& a, int tid) {
    bf16_t* UG = (bf16_t*)(a.ws + OFF_UG);
    constexpr int NV = DFF / 8, RUN = 16, NRUN = MTOK / RUN;
    const int gt = blockIdx.x * 512 + tid, NT = gridDim.x * 512;
    for (int it = gt; it < NRUN * NV; it += NT) {
        const int vv = it % NV, run = it / NV, f0 = vv * 8, t0 = run * RUN;
        float w0[8], w1[8], w2[8], cb[8];
#pragma unroll
        for (int i = 0; i < 8; ++i) { w0[i] = a.conv_w[f0 + i]; w1[i] = a.conv_w[DFF + f0 + i]; w2[i] = a.conv_w[2 * DFF + f0 + i]; cb[i] = a.conv_b[f0 + i]; }
        const u32x4 zero = {0u, 0u, 0u, 0u};
        const bf16_t* G = UG + DFF + f0;
        u32x4 gp = ((t0 & (SEQ - 1)) == 0) ? zero : *(const u32x4*)(G + (size_t)(t0 - 1) * NUP);
        u32x4 gc = *(const u32x4*)(G + (size_t)t0 * NUP);
        for (int i = 0; i < RUN; ++i) { const int t = t0 + i;
            const u32x4 gn = (((t + 1) & (SEQ - 1)) == 0) ? zero : *(const u32x4*)(G + (size_t)(t + 1) * NUP);
            const u32x4 uv = *(const u32x4*)(UG + (size_t)t * NUP + f0);
            u32x4 o;
#pragma unroll
            for (int q = 0; q < 4; ++q) { float r[2];
#pragma unroll
                for (int e = 0; e < 2; ++e) { const int k = 2 * q + e; const unsigned sh = e ? 16u : 0u;
                    const float g = w0[k] * bf2f((gp[q] >> sh) & 0xffffu) + w1[k] * bf2f((gc[q] >> sh) & 0xffffu) + w2[k] * bf2f((gn[q] >> sh) & 0xffffu) + cb[k];
                    r[e] = 0.5f * g * (1.f + erff(g * 0.70710678118654752f)) * bf2f((uv[q] >> sh) & 0xffffu); }
                o[q] = pk2(r[0], r[1]); }
            *(u32x4*)(UG + (size_t)t * NUP + f0) = o;
            gp = gc; gc = gn; }
    }
}

DI void phase_final(const Args& a, int lane, int wave) {
    const bf16_t* x2 = (const bf16_t*)(a.ws + OFF_X1B);
    const int gw = blockIdx.x * 8 + wave, NGW = gridDim.x * 8;
    f32x4 g[8];
#pragma unroll
    for (int j = 0; j < 8; ++j) g[j] = *(const f32x4*)(a.g_final + 4 * lane + 256 * j);
    for (int m = 2 * gw; m < MTOK; m += 2 * NGW) {
        f32x4 v0[8], v1[8]; float ss0 = 0.f, ss1 = 0.f;
#pragma unroll
        for (int j = 0; j < 8; ++j) { const u32x2 p0 = *(const u32x2*)(x2 + (size_t)m * DM + 4 * lane + 256 * j), p1 = *(const u32x2*)(x2 + (size_t)(m + 1) * DM + 4 * lane + 256 * j);
            v0[j] = (f32x4){bf2f(p0.x & 0xffffu), bf2f(p0.x >> 16), bf2f(p0.y & 0xffffu), bf2f(p0.y >> 16)}; v1[j] = (f32x4){bf2f(p1.x & 0xffffu), bf2f(p1.x >> 16), bf2f(p1.y & 0xffffu), bf2f(p1.y >> 16)}; }
#pragma unroll
        for (int j = 0; j < 8; ++j) { ss0 += (v0[j].x * v0[j].x + v0[j].y * v0[j].y) + (v0[j].z * v0[j].z + v0[j].w * v0[j].w); ss1 += (v1[j].x * v1[j].x + v1[j].y * v1[j].y) + (v1[j].z * v1[j].z + v1[j].w * v1[j].w); }
        const float rstd0 = rsqrtf(wave_sum(ss0) * (1.f / DM) + EPSN), rstd1 = rsqrtf(wave_sum(ss1) * (1.f / DM) + EPSN);
#pragma unroll
        for (int j = 0; j < 8; ++j) { *(f32x4*)(a.out + (size_t)m * DM + 4 * lane + 256 * j) = v0[j] * rstd0 * g[j]; *(f32x4*)(a.out + (size_t)(m + 1) * DM + 4 * lane + 256 * j) = v1[j] * rstd1 * g[j]; }
    }
}

#define XB_TMO      128
#define XB_XCNT(j)  (256  + 64 * (j))
#define XB_XSUB(j)  (1280 + 64 * (j))
#define XB_XGEN(j)  (2304 + 64 * (j))
#define XB_TOP      3328
#define XB_TOPGEN   3392
#define XCD_BAR_WORDS 3456
#define XB_SPIN_CAP (1u << 18)

__device__ __forceinline__ unsigned xb_ld(unsigned* p)              { return __hip_atomic_load(p, __ATOMIC_RELAXED, __HIP_MEMORY_SCOPE_AGENT); }
__device__ __forceinline__ unsigned xb_add(unsigned* p, unsigned v) { return __hip_atomic_fetch_add(p, v, __ATOMIC_RELAXED, __HIP_MEMORY_SCOPE_AGENT); }
__device__ __forceinline__ unsigned xb_xcc_id() { return (unsigned)__builtin_amdgcn_s_getreg((3 << 11) | 20) & 0xFu; }
#define XB_SPIN(cond, bar) do { unsigned _sp = 0; while (cond) { __builtin_amdgcn_s_sleep(1); \
    if ((++_sp & 255u) == 0u) { if (xb_ld(&(bar)[XB_TMO])) break; if (_sp > XB_SPIN_CAP) { atomicAdd(&(bar)[XB_TMO], 1u); break; } } } } while (0)

struct XcdBarrier {
    unsigned* bar; unsigned x;
    volatile LAS unsigned* st;
};

__device__ __forceinline__ XcdBarrier xcd_barrier_post(unsigned* bar, volatile LAS unsigned* st) {
    XcdBarrier b; b.bar = bar; b.x = xb_xcc_id(); b.st = st;
    if (threadIdx.x == 0) (void)xb_add(&bar[XB_XCNT(b.x)], 1u);
    return b;
}
__device__ __forceinline__ void xcd_barrier_complete(unsigned* bar, unsigned x, unsigned& nloc, unsigned& nx) {
    const unsigned G = gridDim.x * gridDim.y * gridDim.z;
    unsigned sum, cnt, mine, sp = 0u;
    for (;;) {
        sum = 0u; cnt = 0u; mine = 0u;
#pragma unroll
        for (unsigned j = 0; j < 16; ++j) { const unsigned c = xb_ld(&bar[XB_XCNT(j)]); sum += c; cnt += (c > 0u) ? 1u : 0u; mine = (j == x) ? c : mine; }
        if (sum == G) break;
        __builtin_amdgcn_s_sleep(1);
        if ((++sp & 255u) == 0u) { if (xb_ld(&bar[XB_TMO])) break; if (sp > XB_SPIN_CAP) { atomicAdd(&bar[XB_TMO], 1u); break; } }
    }
    nloc = mine > 0u ? mine : 1u; nx = cnt > 0u ? cnt : 1u;
}

__device__ __forceinline__ void xcd_barrier(const XcdBarrier& b) {
    asm volatile("s_waitcnt vmcnt(0)" ::: "memory");
    __syncthreads();
    if (threadIdx.x == 0) {
        unsigned* bar = b.bar;
        __builtin_amdgcn_s_waitcnt(0);
        unsigned nloc = b.st[0], nx = b.st[1];
        if (nloc == 0u) { xcd_barrier_complete(bar, b.x, nloc, nx); b.st[0] = nloc; b.st[1] = nx; }
        const unsigned old = xb_add(&bar[XB_XSUB(b.x)], 1u);
        const unsigned gen = old / nloc;
        if (old + 1u == (gen + 1u) * nloc) {
            __builtin_amdgcn_fence(__ATOMIC_RELEASE, "agent");
            asm volatile("s_waitcnt vmcnt(0)" ::: "memory");
            const unsigned og = xb_add(&bar[XB_TOP], 1u);
            const unsigned tg = og / nx;
            if (og + 1u == (tg + 1u) * nx) xb_add(&bar[XB_TOPGEN], 1u);
            else XB_SPIN(xb_ld(&bar[XB_TOPGEN]) == tg, bar);
            __builtin_amdgcn_fence(__ATOMIC_ACQUIRE, "agent");
            xb_add(&bar[XB_XGEN(b.x)], 1u);
            asm volatile("s_waitcnt vmcnt(0)" ::: "memory");
        } else {
            XB_SPIN(xb_ld(&bar[XB_XGEN(b.x)]) == gen, bar);
            __builtin_amdgcn_fence(__ATOMIC_ACQUIRE, "agent");
            asm volatile("s_waitcnt vmcnt(0)" ::: "memory");
        }
    }
    __syncthreads();
}


__global__ void __launch_bounds__(512, 2) mega(Args a) {
    extern __shared__ __attribute__((aligned(16))) unsigned char lds_raw[];
    LAS unsigned char* lds = (LAS unsigned char*)lds_raw;
    cg::grid_group grid = cg::this_grid();
    const int tid = threadIdx.x, lane = tid & 63, wave = __builtin_amdgcn_readfirstlane(tid >> 6);
    const int lo = a.ph_lo, hi = a.ph_hi;
    volatile LAS unsigned* xst = (volatile LAS unsigned*)(lds + LDS_BYTES - 16);
    if (tid == 0) { xst[0] = 0u; xst[1] = 0u; }
    __syncthreads();
    if (hi - lo > 1) (void)xcd_barrier_post((unsigned*)(a.ws + OFF_BAR), xst);
    const float* mod = (const float*)(a.ws + OFF_MOD);
#ifndef PHMASK
#define PHMASK 0xfff
#endif
#define PH(k) (((PHMASK >> (k)) & 1) && lo <= (k) && (k) < hi)
#ifndef PROBE_A
#define PROBE_A -1
#define PROBE_B -1
#endif
    unsigned long long* stamps = (unsigned long long*)(a.ws + WS_NEED);
#define STAMP(k) do { if (PROBE_A >= 0 && blockIdx.x == 0 && tid == 0) stamps[k] = __builtin_amdgcn_s_memrealtime(); } while (0)
#define SEAM(k) do { if (PH(k) && PH((k) + 1)) { XcdBarrier xb_; xb_.bar = (unsigned*)(a.ws + OFF_BAR); xb_.x = xb_xcc_id(); xb_.st = (volatile LAS unsigned*)(lds + LDS_BYTES - 16); xcd_barrier(xb_); } STAMP((k) + 1); } while (0)
#ifdef MK_GRID_SYNC_FIRST
    if (hi - lo > 1) grid.sync();
#endif
    STAMP(0);
    if (PH(0)) phase0(a, lds, tid, lane, wave);
#ifdef DUP_P0
    if (PH(0)) { __syncthreads(); phase0(a, lds, tid, lane, wave); }
#endif
    SEAM(0);
    if (PH(1)) phase_norm<true, false>(a, lds, a.x, a.g_norm1, 0, DM, tid, lane, wave);
    SEAM(1);
    if (PH(2)) {
        if (blockIdx.x < NCOMBO) gate_prep(a, lds, blockIdx.x, tid);
        pg8::Gemm g{(const bf16_t*)(a.ws + OFF_HB), (const bf16_t*)(a.ws + OFF_WIN), MTOK, NPC, DM, DM}; pg8::StaticOrder S; S.init(MTOK, NPC, gridDim.x, blockIdx.x);
        pg8::EpiBf16<0> E{(bf16_t*)(a.ws + OFF_P), NPC, nullptr, 0, 0, 1.f};
        pg8::gemm_phase<pg8::EpiBf16<0>, pg8::StaticOrder, GEMM_ALIGN, true>(lds, g, S, E);
#ifdef DUP_GEMM_IN
        pg8::gemm_phase<pg8::EpiBf16<0>, pg8::StaticOrder, true, true>(lds, g, S, E);
#endif
#ifdef DUP_GEMM_HALFK
        { pg8::Gemm g2{(const bf16_t*)(a.ws + OFF_HB), (const bf16_t*)(a.ws + OFF_WIN), MTOK, NPC, DUP_GEMM_HALFK, DM};
          pg8::EpiBf16<0> E2{(bf16_t*)(a.ws + OFF_CST), 0, nullptr, 0, 0, 1.f};
          pg8::gemm_phase<pg8::EpiBf16<0>, pg8::StaticOrder, true, true>(lds, g2, S, E2); }
#endif
    }
    SEAM(2);
    if (PH(3)) mlstm_delta(a, lds, tid, lane, wave);
#if defined(DUP_MIX) || defined(DUP_A1)
    if (PH(3)) { __syncthreads(); mlstm_delta(a, lds, tid, lane, wave); }
#endif
    SEAM(3);
    if (PH(4)) { mlstm_scan(a, tid); natten(a, lds, tid, lane, wave); }
#if defined(DUP_MIX) || defined(DUP_NAT)
    if (PH(4)) { __syncthreads(); natten(a, lds, tid, lane, wave); }
#endif
    SEAM(4);
    if (PH(5)) mlstm_out(a, lds, tid, lane, wave);
#ifdef DUP_MIX
    if (PH(5)) { __syncthreads(); mlstm_out(a, lds, tid, lane, wave); }
#endif
    SEAM(5);
    if (PH(6)) {
        __syncthreads();
        pg8::Gemm g{(const bf16_t*)(a.ws + OFF_HB), (const bf16_t*)(a.ws + OFF_WOUT), MTOK, DM, DM, DM}; pg8::StaticOrder S; S.init(MTOK, DM, gridDim.x, blockIdx.x);
        EpiResid16<false> E{a.x, (bf16_t*)(a.ws + OFF_X1B), mod + 2 * DM};
        pg8::gemm_phase<EpiResid16<false>, pg8::StaticOrder, GEMM_ALIGN, true>(lds, g, S, E);
    }
    SEAM(6);
    if (PH(7)) phase_norm<false, true>(a, lds, a.ws + OFF_X1B, a.g_norm2, 3 * DM, 4 * DM, tid, lane, wave);
    SEAM(7);
    if (PH(8)) {
        pg8::Gemm g{(const bf16_t*)(a.ws + OFF_HB), (const bf16_t*)(a.ws + OFF_WUP), MTOK, NUP, DM, DM}; pg8::StaticOrder S; S.init(MTOK, NUP, gridDim.x, blockIdx.x);
        EpiGlu E{(bf16_t*)(a.ws + OFF_ACT), a.conv_w, a.conv_b, (float*)(a.ws + OFF_EDGE), (LAS float*)(lds + 131072)};
        pg8::gemm_phase<EpiGlu, pg8::StaticOrder, true, true>(lds, g, S, E);
    }
    SEAM(8);
    if (PH(10)) {
        pg8::Gemm g{(const bf16_t*)(a.ws + OFF_ACT), (const bf16_t*)(a.ws + OFF_WDN), MTOK, DM, DFF, DFF}; pg8::StaticOrder S; S.init(MTOK, DM, gridDim.x, blockIdx.x);
        { pg8::Unit uu; int lastpm = -1; for (int i = 0; S.next(i, uu); ++i) if (uu.pm != lastpm) { glu_fixup(a, uu.pm, tid); lastpm = uu.pm; } }
        __threadfence(); __syncthreads();
        EpiResid16<true> E{a.ws + OFF_X1B, (bf16_t*)(a.ws + OFF_X1B), mod + 5 * DM};
        pg8::gemm_phase<EpiResid16<true>, pg8::StaticOrder, GEMM_ALIGN, true>(lds, g, S, E);
    }
    SEAM(10);
    if (PH(11)) phase_final(a, lane, wave);
    if (PROBE_A >= 0) { __syncthreads(); if (blockIdx.x == 0 && tid == 0) { stamps[12] = __builtin_amdgcn_s_memrealtime();
        const float Ta = (float)(stamps[PROBE_A + 1] - stamps[PROBE_A]) * 0.01f, Tb = (float)(stamps[PROBE_B + 1] - stamps[PROBE_B]) * 0.01f;
        a.out[0] += Ta + Tb; for (int i = 1; i <= 1000; ++i) a.out[i] += 0.5f * Tb; } }
#undef PH
#undef SEAM
}

extern "C" void kernel_launch(void* const* d_in, const int* in_sizes, int n_in, void* d_out, int out_size, void* d_ws, size_t ws_size, hipStream_t stream) {
    static int grid = 0;
    if (grid == 0) {
        if (n_in != 16 || out_size != MTOK * DM || ws_size < WS_NEED) { fprintf(stderr, "kernel_launch: unexpected problem (n_in %d out %d ws %zu need %zu)\n", n_in, out_size, ws_size, (size_t)WS_NEED); grid = -1; return; }
        int dev = 0, cus = 0, per_cu = 0;
        hipGetDevice(&dev); hipDeviceGetAttribute(&cus, hipDeviceAttributeMultiprocessorCount, dev);
        if (hipFuncSetAttribute((const void*)mega, hipFuncAttributeMaxDynamicSharedMemorySize, LDS_BYTES) != hipSuccess) { fprintf(stderr, "kernel_launch: hipFuncSetAttribute failed\n"); grid = -1; return; }
        if (hipOccupancyMaxActiveBlocksPerMultiprocessor(&per_cu, (const void*)mega, 512, LDS_BYTES) != hipSuccess || per_cu < 1) { fprintf(stderr, "kernel_launch: occupancy query failed (%d)\n", per_cu); (void)hipGetLastError(); per_cu = 1; }
        grid = cus * (per_cu > 1 ? 1 : per_cu);
        fprintf(stderr, "kernel_launch: grid %d (cus %d, per_cu %d)\n", grid, cus, per_cu);
        if (grid < 4 || (grid & 3) != 0) { fprintf(stderr, "kernel_launch: this kernel needs a workgroup count that is a multiple of 4 (neighbourhood-attention head pairs are fixed per workgroup); nothing launched\n"); grid = -1; return; }
    }
    if (grid < 0) return;
    Args a{};
    a.x = (const float*)d_in[0]; a.c = (const float*)d_in[1]; a.w_ada = (const float*)d_in[2]; a.b_ada = (const float*)d_in[3]; a.g_norm1 = (const float*)d_in[4];
    a.w_in = (const float*)d_in[5]; a.b_gates = (const float*)d_in[6]; a.g_head_a = (const float*)d_in[7]; a.rpb = (const float*)d_in[8]; a.w_out = (const float*)d_in[9];
    a.g_norm2 = (const float*)d_in[10]; a.w_up = (const float*)d_in[11]; a.conv_w = (const float*)d_in[12]; a.conv_b = (const float*)d_in[13]; a.w_down = (const float*)d_in[14];
    a.g_final = (const float*)d_in[15]; a.out = (float*)d_out; a.ws = (unsigned char*)d_ws;
#if MK_PER_PHASE
    for (int p = 0; p < NPH; ++p) { a.ph_lo = p; a.ph_hi = p + 1; hipLaunchKernelGGL(mega, dim3(grid), dim3(512), LDS_BYTES, stream, a); }
#else
    a.ph_lo = 0; a.ph_hi = NPH;
    if (hipMemsetAsync((char*)d_ws + OFF_BAR, 0, BAR_BYTES, stream) != hipSuccess) { fprintf(stderr, "kernel_launch: memset failed\n"); return; }
    void* args[] = {&a};
    hipError_t e = hipLaunchCooperativeKernel((const void*)mega, dim3(grid), dim3(512), args, LDS_BYTES, stream);
    if (e != hipSuccess) fprintf(stderr, "kernel_launch: cooperative launch failed: %s (grid %d)\n", hipGetErrorString(e), grid);
#endif
}
```

```cpp
#include <hip/hip_runtime.h>
#include <hip/hip_cooperative_groups.h>
#include <cstdio>
#include <cstdint>
namespace cg = cooperative_groups;
#define MK_PER_PHASE 0
namespace pg8 {
#define PG8_LAS __attribute__((address_space(3)))
typedef unsigned short bf16_t;
typedef short bf16x8 __attribute__((ext_vector_type(8)));
typedef float f32x4 __attribute__((ext_vector_type(4)));
typedef unsigned u32x4 __attribute__((ext_vector_type(4)));
constexpr int BM = 256, BK = 64, HALF = 128, HTB = HALF * BK * 2  , STAGE_BYTES = 8 * HTB, NXCD = 8, WGM = 8;

__host__ __device__ __forceinline__ int lds_byte(int r, int c) { const int st = (r >> 4) * 2 + (c >> 5), rr = r & 15, cc = c & 31, ob = rr * 64 + cc * 2; return st * 1024 + (ob ^ (((ob >> 9) & 1) << 5)); }
__host__ __device__ __forceinline__ void stage_rc(int b, int& R, int& C) { const int st = b / 1024, sb = b % 1024, swz = sb ^ (((sb >> 9) & 1) << 5); R = (st >> 1) * 16 + swz / 64; C = (st & 1) * 32 + (swz % 64) / 2; }
__host__ __device__ __forceinline__ int perm32(int rho) { const int n = rho >> 4, i = rho & 15; return 8 * (i >> 2) + 4 * n + (i & 3); }

struct Unit { int pm, pn; };
struct Gemm { const bf16_t* A; const bf16_t* Bt; int M, N, K, lda; };

struct StaticOrder {
    int nM, nN, nwg, G, c;
    __host__ __device__ void init(int M, int N, int G_, int c_) { nM = M / BM; nN = N / BM; nwg = nM * nN; G = G_; c = c_; }
    __host__ __device__ bool next(int i, Unit& u) const {
        const long L = (long)i * G + c; if (L >= nwg) return false;
        int wgid = (int)L; { const int q = nwg / NXCD, r = nwg % NXCD, xcd = wgid % NXCD, off = wgid / NXCD; wgid = (xcd < r ? xcd * (q + 1) : r * (q + 1) + (xcd - r) * q) + off; }
        const int nig = WGM * nN, gid = wgid / nig, fm = gid * WGM, gsz = (nM - fm) < WGM ? (nM - fm) : WGM;
        u.pm = fm + ((wgid % nig) % gsz); u.pn = (wgid % nig) / gsz; return true;
    }
    __device__ __forceinline__ void a_ready(const Unit&) const {}
    __device__ __forceinline__ void done(const Unit&) const {}
};

__device__ __forceinline__ unsigned cvt_pk_bf16(float lo, float hi) { unsigned r; asm volatile("v_cvt_pk_bf16_f32 %0, %1, %2" : "=v"(r) : "v"(lo), "v"(hi)); return r; }
typedef float f32x2 __attribute__((ext_vector_type(2)));
__device__ __forceinline__ f32x2 gelu_pk(f32x2 v) {
    const f32x2 av = __builtin_elementwise_abs(v), d = av * 0.2316418882f + 1.0f;
    f32x2 t; t.x = __builtin_amdgcn_rcpf(d.x); t.y = __builtin_amdgcn_rcpf(d.y);
    f32x2 q = t * 0.5307027145f + (-0.7265760135f); q = q * t + 0.7107068705f; q = q * t + (-0.142248368f); q = q * t + 0.127414796f; q = q * t;
    const f32x2 s = (v * v) * (-0.72134752044f);
    f32x2 e; e.x = __builtin_amdgcn_exp2f(s.x); e.y = __builtin_amdgcn_exp2f(s.y);
    const f32x2 m = v * (q * e), r = v - m;
    f32x2 o; o.x = v.x < 0.f ? m.x : r.x; o.y = v.y < 0.f ? m.y : r.y; return o;
}

template <int ACT  > struct EpiBf16 {
    static constexpr bool PERM = true, AFTER_DRAIN = false; static_assert(ACT == 0 || ACT == 1, "EpiBf16: ACT is 0 (none) or 1 (gelu_pk)");
    bf16_t* O; int ldc; const float* bias; int split_cols; size_t split_stride; float scale0;
    __device__ __forceinline__ void operator()(const f32x4 (&acc)[2][2][4][2], const Unit& u, int wr, int wc, int fr, int fq) const {
        const int row0 = u.pm * BM + wr * 64 + fr; int colt = u.pn * BM; bf16_t* base = O;
        float sc = 1.f; if (split_cols) { const int t = colt / split_cols; base += (size_t)t * split_stride; colt -= t * split_cols; if (t == 0) sc = scale0; }
        const int col0 = colt + wc * 32 + 8 * fq, bcol0 = u.pn * BM + wc * 32 + 8 * fq;
        f32x4 bv[2][2];
#pragma unroll
        for (int bj = 0; bj < 2; ++bj)
#pragma unroll
            for (int n = 0; n < 2; ++n) bv[bj][n] = bias ? *(const f32x4*)(bias + bcol0 + bj * HALF + 4 * n) : (f32x4){0.f, 0.f, 0.f, 0.f};
#pragma unroll
        for (int ai = 0; ai < 2; ++ai)
#pragma unroll
            for (int m = 0; m < 4; ++m) { bf16_t* rowp = base + (size_t)(row0 + ai * HALF + m * 16) * ldc + col0;
#pragma unroll
                for (int bj = 0; bj < 2; ++bj) { f32x4 v0 = acc[ai][bj][m][0] + bv[bj][0], v1 = acc[ai][bj][m][1] + bv[bj][1];
                    if (ACT == 1) { f32x2 a = gelu_pk((f32x2){v0[0], v0[1]}), b = gelu_pk((f32x2){v0[2], v0[3]}), c = gelu_pk((f32x2){v1[0], v1[1]}), d = gelu_pk((f32x2){v1[2], v1[3]});
                        v0 = (f32x4){a.x, a.y, b.x, b.y}; v1 = (f32x4){c.x, c.y, d.x, d.y}; }
                    v0 = v0 * sc; v1 = v1 * sc; u32x4 w; w.x = cvt_pk_bf16(v0[0], v0[1]); w.y = cvt_pk_bf16(v0[2], v0[3]); w.z = cvt_pk_bf16(v1[0], v1[1]); w.w = cvt_pk_bf16(v1[2], v1[3]);
                    *(u32x4*)(rowp + bj * HALF) = w; } }
    }
};

template <class Epi, class Sched, bool ALIGN_EPI = false, bool SP2 = false>
__device__ __forceinline__ void gemm_phase(PG8_LAS unsigned char* lds, const Gemm g, const Sched& S, const Epi& E) {
    const int tid = threadIdx.x, wid = __builtin_amdgcn_readfirstlane(tid >> 6), lane = tid & 63, wr = wid >> 2, wc = wid & 3, fr = lane & 15, fq = lane >> 4;
    const int K = g.K, nt = K / BK;
    unsigned voffA[2], voffB[2];
#pragma unroll
    for (int i = 0; i < 2; ++i) { int R, C; stage_rc(tid * 16 + i * 8192, R, C); const int Rb = Epi::PERM ? ((R & ~31) + perm32(R & 31)) : R;
        voffA[i] = (unsigned)(R * g.lda + C) * 2u; voffB[i] = (unsigned)(Rb * K + C) * 2u; }
    const size_t kstep = (size_t)(BK * 2);
    const size_t hstep = (size_t)HALF * K * 2;
    const size_t tstep = 2 * hstep; const size_t hstepA = (size_t)HALF * g.lda * 2, tstepA = 2 * hstepA;
    const unsigned ldsw = (unsigned)wid * 1024u;
    const int aoff = lds_byte(wr * 64 + fr, fq * 8), boff = lds_byte(wc * 32 + fr, fq * 8);
#define PG8_SA(b, h) (((b) * 2 + (h)) * HTB)
#define PG8_SB(b, h) ((4 + (b) * 2 + (h)) * HTB)
#define PG8_STAGE(bufoff, gbase, voff) do { _Pragma("unroll") for (int _i = 0; _i < 2; ++_i) \
        __builtin_amdgcn_global_load_lds((const unsigned*)((const char*)(gbase) + (voff)[_i]), (PG8_LAS unsigned*)(lds + (bufoff) + ldsw + _i * 8192), 16, 0, 0); } while (0)
#define PG8_LDA(dst, b, h) do { _Pragma("unroll") for (int m = 0; m < 4; ++m) _Pragma("unroll") for (int k = 0; k < 2; ++k) dst[m][k] = *(const PG8_LAS bf16x8*)(lds + PG8_SA(b, h) + aoff + m * 2048 + k * 1024); } while (0)
#define PG8_LDB(dst, b, h) do { _Pragma("unroll") for (int n = 0; n < 2; ++n) _Pragma("unroll") for (int k = 0; k < 2; ++k) dst[n][k] = *(const PG8_LAS bf16x8*)(lds + PG8_SB(b, h) + boff + n * 2048 + k * 1024); } while (0)
#define PG8_MMA(ai, bj, At, Bt) do { __builtin_amdgcn_s_setprio(1); _Pragma("unroll") for (int m = 0; m < 4; ++m) _Pragma("unroll") for (int n = 0; n < 2; ++n) _Pragma("unroll") for (int k = 0; k < 2; ++k) \
        acc[ai][bj][m][n] = __builtin_amdgcn_mfma_f32_16x16x32_bf16(Bt[n][k], At[m][k], acc[ai][bj][m][n], 0, 0, 0); __builtin_amdgcn_s_setprio(0); } while (0)
#define PG8_WAIT_V(n) asm volatile("s_waitcnt vmcnt(" #n ")" ::: "memory")
#define PG8_WAIT_L(n) asm volatile("s_waitcnt lgkmcnt(" #n ")" ::: "memory")
#define PG8_BAR __builtin_amdgcn_s_barrier()
#define PG8_SCHED __builtin_amdgcn_sched_barrier(0)
    Unit cur, nxt; int ui = 0;
    if (!S.next(0, cur)) return;
    f32x4 acc[2][2][4][2];
#pragma unroll
    for (int a = 0; a < 2; ++a)
#pragma unroll
        for (int b = 0; b < 2; ++b)
#pragma unroll
            for (int m = 0; m < 4; ++m)
#pragma unroll
                for (int n = 0; n < 2; ++n) acc[a][b][m][n] = (f32x4){0.f, 0.f, 0.f, 0.f};
    bf16x8 At[4][2], B0[2][2], B1[2][2];
    const char* cA = (const char*)g.A + (size_t)cur.pm * tstepA; const char* cB = (const char*)g.Bt + (size_t)cur.pn * tstep;
    S.a_ready(cur);
    if constexpr (SP2) {
        PG8_STAGE(PG8_SB(0, 0), cB, voffB); PG8_STAGE(PG8_SB(0, 1), cB + hstep, voffB); PG8_STAGE(PG8_SA(0, 0), cA, voffA); PG8_STAGE(PG8_SA(0, 1), cA + hstepA, voffA);
        if (wr == 1) PG8_BAR;
        PG8_WAIT_V(2); PG8_BAR;
        PG8_STAGE(PG8_SB(1, 0), cB + kstep, voffB); PG8_STAGE(PG8_SA(1, 0), cA + kstep, voffA); PG8_STAGE(PG8_SB(1, 1), cB + hstep + kstep, voffB);
        PG8_WAIT_V(6); PG8_BAR;
    } else {
        PG8_STAGE(PG8_SB(0, 0), cB, voffB); PG8_STAGE(PG8_SA(0, 0), cA, voffA); PG8_STAGE(PG8_SB(0, 1), cB + hstep, voffB); PG8_STAGE(PG8_SA(0, 1), cA + hstepA, voffA);
        if (wr == 1) PG8_BAR;
        PG8_WAIT_V(4); PG8_BAR;
        PG8_STAGE(PG8_SB(1, 0), cB + kstep, voffB); PG8_STAGE(PG8_SA(1, 0), cA + kstep, voffA); PG8_STAGE(PG8_SB(1, 1), cB + hstep + kstep, voffB);
        PG8_WAIT_V(6); PG8_BAR;
    }
    for (;;) {
        const bool has_next = S.next(ui + 1, nxt);
        const char* nA = has_next ? (const char*)g.A + (size_t)nxt.pm * tstepA : cA; const char* nB = has_next ? (const char*)g.Bt + (size_t)nxt.pn * tstep : cB;
        for (int t = 0; t < nt; t += 2) {
            const bool last = (t == nt - 2);
            const char* a1 = cA + (size_t)(t + 1) * kstep;
            const char* a2 = last ? nA : cA + (size_t)(t + 2) * kstep; const char* b2 = last ? nB : cB + (size_t)(t + 2) * kstep;
            const char* a3 = a2 + kstep; const char* b3 = b2 + kstep;
            if (last && has_next) S.a_ready(nxt);
            if constexpr (SP2) {
            PG8_LDB(B0, 0, 0); PG8_LDB(B1, 0, 1); PG8_SCHED; PG8_LDA(At, 0, 0); PG8_STAGE(PG8_SA(1, 1), a1 + hstepA, voffA);
            PG8_WAIT_V(8); PG8_WAIT_L(0); PG8_BAR; PG8_MMA(0, 0, At, B0); PG8_MMA(0, 1, At, B1); PG8_BAR; PG8_SCHED;
            PG8_LDA(At, 0, 1); PG8_STAGE(PG8_SB(0, 0), b2, voffB); PG8_STAGE(PG8_SB(0, 1), b2 + hstep, voffB); PG8_STAGE(PG8_SA(0, 0), a2, voffA);
            PG8_WAIT_V(8); PG8_WAIT_L(0); PG8_BAR; PG8_MMA(1, 0, At, B0); PG8_MMA(1, 1, At, B1); PG8_BAR; PG8_SCHED;
            PG8_LDB(B0, 1, 0); PG8_LDB(B1, 1, 1); PG8_SCHED; PG8_LDA(At, 1, 0); PG8_STAGE(PG8_SA(0, 1), a2 + hstepA, voffA);
            PG8_WAIT_V(8); PG8_WAIT_L(0); PG8_BAR; PG8_MMA(0, 0, At, B0); PG8_MMA(0, 1, At, B1); PG8_BAR; PG8_SCHED;
            PG8_LDA(At, 1, 1); PG8_STAGE(PG8_SB(1, 0), b3, voffB); PG8_STAGE(PG8_SB(1, 1), b3 + hstep, voffB); PG8_STAGE(PG8_SA(1, 0), a3, voffA);
            PG8_WAIT_V(8); PG8_WAIT_L(0); PG8_BAR; PG8_MMA(1, 0, At, B0); PG8_MMA(1, 1, At, B1); PG8_BAR; PG8_SCHED;
            } else {
            PG8_LDB(B0, 0, 0); PG8_SCHED; PG8_LDA(At, 0, 0); PG8_STAGE(PG8_SA(1, 1), a1 + hstepA, voffA);
            PG8_WAIT_L(8); PG8_BAR; PG8_WAIT_L(0); PG8_MMA(0, 0, At, B0); PG8_BAR; PG8_SCHED;
            PG8_LDB(B1, 0, 1); PG8_STAGE(PG8_SB(0, 0), b2, voffB);
            PG8_BAR; PG8_WAIT_L(0); PG8_MMA(0, 1, At, B1); PG8_BAR;
            PG8_LDA(At, 0, 1); PG8_STAGE(PG8_SA(0, 0), a2, voffA);
            PG8_BAR; PG8_WAIT_L(0); PG8_MMA(1, 0, At, B0); PG8_BAR; PG8_SCHED;
            PG8_STAGE(PG8_SB(0, 1), b2 + hstep, voffB);
            PG8_WAIT_V(6); PG8_BAR; PG8_MMA(1, 1, At, B1); PG8_BAR;
            PG8_LDB(B0, 1, 0); PG8_SCHED; PG8_LDA(At, 1, 0); PG8_STAGE(PG8_SA(0, 1), a2 + hstepA, voffA);
            PG8_WAIT_L(8); PG8_BAR; PG8_WAIT_L(0); PG8_MMA(0, 0, At, B0); PG8_BAR; PG8_SCHED;
            PG8_LDB(B1, 1, 1); PG8_STAGE(PG8_SB(1, 0), b3, voffB);
            PG8_BAR; PG8_WAIT_L(0); PG8_MMA(0, 1, At, B1); PG8_BAR;
            PG8_LDA(At, 1, 1); PG8_STAGE(PG8_SA(1, 0), a3, voffA);
            PG8_BAR; PG8_WAIT_L(0); PG8_MMA(1, 0, At, B0); PG8_BAR; PG8_SCHED;
            PG8_STAGE(PG8_SB(1, 1), b3 + hstep, voffB);
            PG8_WAIT_V(6); PG8_BAR; PG8_MMA(1, 1, At, B1); PG8_BAR;
            }
        }
        if constexpr (ALIGN_EPI) { if (wr == 0) PG8_BAR; }
        if constexpr (!Epi::AFTER_DRAIN) { E(acc, cur, wr, wc, fr, fq); S.done(cur); }
        if (!has_next) break;
#pragma unroll
        for (int a = 0; a < 2; ++a)
#pragma unroll
            for (int b = 0; b < 2; ++b)
#pragma unroll
                for (int m = 0; m < 4; ++m)
#pragma unroll
                    for (int n = 0; n < 2; ++n) acc[a][b][m][n] = (f32x4){0.f, 0.f, 0.f, 0.f};
        cur = nxt; cA = nA; cB = nB; ++ui;
        if constexpr (ALIGN_EPI) { if (wr == 1) PG8_BAR; }
    }
    PG8_WAIT_V(0);
    if constexpr (!ALIGN_EPI) { if (wr == 0) PG8_BAR; }
    PG8_BAR;
    if constexpr (Epi::AFTER_DRAIN) { E.fused(acc, cur, wr, wc, fr, fq, lds, wid, lane); S.done(cur); }
#undef PG8_SA
#undef PG8_SB
#undef PG8_STAGE
#undef PG8_LDA
#undef PG8_LDB
#undef PG8_MMA
#undef PG8_WAIT_V
#undef PG8_WAIT_L
#undef PG8_BAR
#undef PG8_SCHED
}
}

#define DI __device__ __forceinline__
#define LAS __attribute__((address_space(3)))
typedef unsigned short bf16_t;
typedef short bf16x8 __attribute__((ext_vector_type(8)));
typedef short s16x4 __attribute__((ext_vector_type(4)));
typedef short v4i16_t __attribute__((ext_vector_type(4)));
typedef float f32x4 __attribute__((ext_vector_type(4)));
typedef unsigned u32x4 __attribute__((ext_vector_type(4)));
typedef unsigned u32x2 __attribute__((ext_vector_type(2)));

constexpr int NB = 2, SEQ = 8192, DM = 2048, MTOK = NB * SEQ, NPC = 7168, WIN_LD = 7184, DFF = 5632, NUP = 2 * DFF, NMOD = 6 * DM;
constexpr int LCH = 256, NCH = SEQ / LCH, EEXT = 272, ST_ELEMS = EEXT * 256, NCOMBO = 16;
constexpr float EPSN = 1e-6f;
#ifndef MK_PER_PHASE
#define MK_PER_PHASE 0
#endif
#ifndef GEMM_ALIGN
#define GEMM_ALIGN true
#endif
constexpr int NPH = 12;
constexpr int LDS_BYTES = 147456;

constexpr size_t OFF_P = 0;
constexpr size_t OFF_CST = OFF_P + (size_t)MTOK * NPC * 2;
constexpr size_t OFF_WIN = OFF_CST + (size_t)NCOMBO * NCH * ST_ELEMS * 2;
constexpr size_t OFF_WOUT = OFF_WIN + (size_t)NPC * DM * 2;
constexpr size_t OFF_R0END = OFF_WOUT + (size_t)DM * DM * 2;
constexpr size_t OFF_UG = 0;
constexpr size_t OFF_ACT = 0;
constexpr size_t OFF_EDGE = OFF_ACT + (size_t)MTOK * DFF * 2;
constexpr size_t OFF_X1B = OFF_EDGE + (size_t)3 * 64 * 2 * DFF * 4;
static_assert(OFF_X1B + (size_t)MTOK * DM * 2 <= OFF_CST + (size_t)NCOMBO * NCH * ST_ELEMS * 2, "x1b must stay below the weight copies that are still live in phase 6");
constexpr size_t OFF_WUP = OFF_UG + (size_t)MTOK * NUP * 2;
constexpr size_t OFF_WDN = OFF_WUP + (size_t)NUP * DM * 2;
constexpr size_t OFF_HB = OFF_WDN + (size_t)DM * DFF * 2;
constexpr size_t OFF_MOD = OFF_HB + (size_t)MTOK * DM * 2;
constexpr size_t OFF_GATES = OFF_MOD + 131072;
constexpr size_t OFF_UL = OFF_GATES + (size_t)MTOK * 16 * 4;
constexpr size_t OFF_ML = OFF_UL + (size_t)NCOMBO * SEQ * 4;
constexpr size_t OFF_EMT = OFF_ML + (size_t)NCOMBO * SEQ * 4;
constexpr size_t OFF_MPREV = OFF_EMT + (size_t)NCOMBO * SEQ * 4;
constexpr size_t OFF_MEND = OFF_MPREV + 4096;
constexpr size_t WS_NEED = OFF_MEND + 4096;
constexpr size_t OFF_BAR = WS_NEED + 4096;
constexpr size_t BAR_BYTES = 16384;
static_assert(OFF_R0END <= OFF_WUP, "overlay region");
static_assert(OFF_BAR + BAR_BYTES <= 536870912ull, "workspace budget");

struct Args {
    const float *x, *c, *w_ada, *b_ada, *g_norm1, *w_in, *b_gates, *g_head_a, *rpb, *w_out, *g_norm2, *w_up, *conv_w, *conv_b, *w_down, *g_final;
    float* out; unsigned char* ws; int ph_lo, ph_hi;
};

DI float bf2f(unsigned v) { return __uint_as_float(v << 16); }
DI unsigned f2bf(float f) { unsigned u = __float_as_uint(f); return (u + 0x7fffu + ((u >> 16) & 1u)) >> 16; }
DI unsigned pk2(float lo, float hi) { return f2bf(lo) | (f2bf(hi) << 16); }
DI float wave_sum(float v) {
#pragma unroll
    for (int o = 1; o < 64; o <<= 1) v += __shfl_xor(v, o);
    return v;
}
DI s16x4 tr_read(const LAS unsigned char* p) { return __builtin_bit_cast(s16x4, __builtin_amdgcn_ds_read_tr16_b64_v4i16((LAS v4i16_t*)p)); }
DI bf16x8 tr_frag(const LAS unsigned char* base, int pitch, int rowA, int rowB, int col, int qin, int pin) {
    const s16x4 lo = tr_read(base + (rowA + qin) * pitch + (col + 4 * pin) * 2);
    const s16x4 hi = tr_read(base + (rowB + qin) * pitch + (col + 4 * pin) * 2);
    return (bf16x8){lo[0], lo[1], lo[2], lo[3], hi[0], hi[1], hi[2], hi[3]};
}
DI bf16x8 ld_frag(const LAS unsigned char* p) { return *(const LAS bf16x8*)p; }
#define MFMA16(a, b, c) __builtin_amdgcn_mfma_f32_16x16x32_bf16((a), (b), (c), 0, 0, 0)
DI bf16x8 pack8(const f32x4& a, const f32x4& b) {
    u32x4 w; w.x = pk2(a[0], a[1]); w.y = pk2(a[2], a[3]); w.z = pk2(b[0], b[1]); w.w = pk2(b[2], b[3]);
    return __builtin_bit_cast(bf16x8, w);
}
DI bf16x8 scale8(const bf16x8& q, float s) {
    const u32x4 u = __builtin_bit_cast(u32x4, q); u32x4 w;
#pragma unroll
    for (int i = 0; i < 4; ++i) w[i] = pk2(bf2f(u[i] & 0xffffu) * s, bf2f(u[i] >> 16) * s);
    return __builtin_bit_cast(bf16x8, w);
}
template <int ROWS, int COLS> DI void stage_tile(LAS unsigned char* dst, int lp, const bf16_t* src, int gp, int tid, int nthr) {
    constexpr int VPR = COLS / 8, NV = ROWS * VPR;
    int t0 = tid; asm volatile("" : "+v"(t0));
#pragma unroll 2
    for (int v = t0; v < NV; v += nthr) { const int r = v / VPR, cv = v % VPR;
        const u32x4 d = *(const u32x4*)(src + (r * gp + cv * 8)); *(LAS u32x4*)(dst + r * lp + cv * 16) = d; }
}

struct EpiResid {
    static constexpr bool PERM = false, AFTER_DRAIN = false;
    const float* res; float* out; const float* gate;
    __device__ __forceinline__ void operator()(const pg8::f32x4 (&acc)[2][2][4][2], const pg8::Unit& u, int wr, int wc, int fr, int fq) const {
        const int row0 = u.pm * 256 + wr * 64 + fr, col0 = u.pn * 256 + wc * 32 + 4 * fq, bb = u.pm >> 5;
        f32x4 gv[2][2];
#pragma unroll
        for (int bj = 0; bj < 2; ++bj)
#pragma unroll
            for (int n = 0; n < 2; ++n) gv[bj][n] = *(const f32x4*)(gate + (size_t)bb * NMOD + col0 + bj * 128 + n * 16);
#pragma unroll
        for (int ai = 0; ai < 2; ++ai)
#pragma unroll
            for (int m = 0; m < 4; ++m) { const size_t ro = (size_t)(row0 + ai * 128 + m * 16) * DM + col0;
#pragma unroll
                for (int bj = 0; bj < 2; ++bj)
#pragma unroll
                    for (int n = 0; n < 2; ++n) { const size_t o = ro + bj * 128 + n * 16; const f32x4 r = *(const f32x4*)(res + o); *(f32x4*)(out + o) = r + gv[bj][n] * acc[ai][bj][m][n]; } }
    }
};

template <bool RES_BF16> struct EpiResid16 {
    static constexpr bool PERM = true, AFTER_DRAIN = false;
    const void* res; bf16_t* out; const float* gate;
    __device__ __forceinline__ void operator()(const pg8::f32x4 (&acc)[2][2][4][2], const pg8::Unit& u, int wr, int wc, int fr, int fq) const {
        const int row0 = u.pm * 256 + wr * 64 + fr, col0 = u.pn * 256 + wc * 32 + 8 * fq, bb = u.pm >> 5;
        f32x4 gv[2][2];
#pragma unroll
        for (int bj = 0; bj < 2; ++bj)
#pragma unroll
            for (int n = 0; n < 2; ++n) gv[bj][n] = *(const f32x4*)(gate + (size_t)bb * NMOD + col0 + bj * 128 + 4 * n);
#pragma unroll
        for (int ai = 0; ai < 2; ++ai)
#pragma unroll
            for (int m = 0; m < 4; ++m) { const size_t ro = (size_t)(row0 + ai * 128 + m * 16) * DM + col0;
#pragma unroll
                for (int bj = 0; bj < 2; ++bj) { const size_t o = ro + bj * 128; f32x4 r0, r1;
                    if (RES_BF16) { const u32x4 rv = *(const u32x4*)((const bf16_t*)res + o);
                        r0 = (f32x4){bf2f(rv.x & 0xffffu), bf2f(rv.x >> 16), bf2f(rv.y & 0xffffu), bf2f(rv.y >> 16)}; r1 = (f32x4){bf2f(rv.z & 0xffffu), bf2f(rv.z >> 16), bf2f(rv.w & 0xffffu), bf2f(rv.w >> 16)}; }
                    else { r0 = *(const f32x4*)((const float*)res + o); r1 = *(const f32x4*)((const float*)res + o + 4); }
                    r0 = r0 + gv[bj][0] * acc[ai][bj][m][0]; r1 = r1 + gv[bj][1] * acc[ai][bj][m][1];
                    u32x4 w; w.x = pg8::cvt_pk_bf16(r0[0], r0[1]); w.y = pg8::cvt_pk_bf16(r0[2], r0[3]); w.z = pg8::cvt_pk_bf16(r1[0], r1[1]); w.w = pg8::cvt_pk_bf16(r1[2], r1[3]);
                    *(u32x4*)(out + o) = w; } }
    }
};

constexpr size_t EDGE_STRIDE = (size_t)64 * 2 * DFF;
struct EpiGlu {
    static constexpr bool PERM = true, AFTER_DRAIN = false;
    bf16_t* ACT; const float* cw; const float* cb; float* edge; LAS float* xg;
    __device__ __forceinline__ void operator()(const pg8::f32x4 (&acc)[2][2][4][2], const pg8::Unit& u, int wr, int wc, int fr, int fq) const {
        const int lane = threadIdx.x & 63, fl = wc * 32 + 8 * fq, f0 = u.pn * 128 + fl;
        float w0[8], w1[8], w2[8], bb[8];
#pragma unroll
        for (int k = 0; k < 8; k += 4) { const f32x4 a0 = *(const f32x4*)(cw + f0 + k), a1 = *(const f32x4*)(cw + DFF + f0 + k), a2 = *(const f32x4*)(cw + 2 * DFF + f0 + k), a3 = *(const f32x4*)(cb + f0 + k);
#pragma unroll
            for (int i = 0; i < 4; ++i) { w0[k + i] = a0[i]; w1[k + i] = a1[i]; w2[k + i] = a2[i]; bb[k + i] = a3[i]; } }
#pragma unroll
        for (int ai = 0; ai < 2; ++ai) { const int bi = 2 * ai + wr;
            if (fr == 0) { *(LAS f32x4*)(xg + bi * 128 + fl) = acc[ai][1][0][0]; *(LAS f32x4*)(xg + bi * 128 + fl + 4) = acc[ai][1][0][1]; }
            if (fr == 15) { *(LAS f32x4*)(xg + (4 + bi) * 128 + fl) = acc[ai][1][3][0]; *(LAS f32x4*)(xg + (4 + bi) * 128 + fl + 4) = acc[ai][1][3][1]; } }
        asm volatile("s_waitcnt lgkmcnt(0)" ::: "memory"); __builtin_amdgcn_s_barrier(); asm volatile("" ::: "memory");
#pragma unroll
        for (int ai = 0; ai < 2; ++ai) { const int bi = 2 * ai + wr;
            f32x4 xp[2], xn[2];
#pragma unroll
            for (int n = 0; n < 2; ++n) { xp[n] = (f32x4){0.f, 0.f, 0.f, 0.f}; xn[n] = (f32x4){0.f, 0.f, 0.f, 0.f};
                if (fr == 0 && bi > 0) xp[n] = *(const LAS f32x4*)(xg + (4 + bi - 1) * 128 + fl + 4 * n);
                if (fr == 15 && bi < 3) xn[n] = *(const LAS f32x4*)(xg + (bi + 1) * 128 + fl + 4 * n); }
            unsigned o[4][4];
#pragma unroll
            for (int n = 0; n < 2; ++n)
#pragma unroll
                for (int i = 0; i < 4; i += 2) {
                    float r[4][2];
#pragma unroll
                    for (int e = 0; e < 2; ++e) { const int k = 4 * n + i + e;
                        float g[4], up[4], dn[4];
#pragma unroll
                        for (int m = 0; m < 4; ++m) { g[m] = acc[ai][1][m][n][i + e];
                            up[m] = __int_as_float(__builtin_amdgcn_update_dpp(0, __float_as_int(g[m]), 0x121, 0xf, 0xf, false));
                            dn[m] = __int_as_float(__builtin_amdgcn_update_dpp(0, __float_as_int(g[m]), 0x12F, 0xf, 0xf, false)); }
#pragma unroll
                        for (int m = 0; m < 4; ++m) { const float pv = (fr == 0) ? (m > 0 ? up[m > 0 ? m - 1 : 0] : xp[n][i + e]) : up[m];
                            const float nv = (fr == 15) ? (m < 3 ? dn[m < 3 ? m + 1 : 3] : xn[n][i + e]) : dn[m];
                            r[m][e] = w0[k] * pv + w1[k] * g[m] + w2[k] * nv + bb[k]; } }
#pragma unroll
                    for (int m = 0; m < 4; ++m) { const pg8::f32x2 gl = pg8::gelu_pk((pg8::f32x2){r[m][0], r[m][1]});
                        const bool e0 = (bi == 0 && m == 0 && fr == 0), e1 = (bi == 3 && m == 3 && fr == 15);
                        if (e0 || e1) { float* ep = edge + ((size_t)(u.pm * 2 + (e1 ? 1 : 0)) * DFF + f0 + 4 * n + i);
                            ep[0] = r[m][0]; ep[1] = r[m][1]; ep[EDGE_STRIDE] = acc[ai][1][m][n][i]; ep[EDGE_STRIDE + 1] = acc[ai][1][m][n][i + 1];
                            ep[2 * EDGE_STRIDE] = acc[ai][0][m][n][i]; ep[2 * EDGE_STRIDE + 1] = acc[ai][0][m][n][i + 1]; }
                        o[m][2 * n + (i >> 1)] = pg8::cvt_pk_bf16(gl.x * acc[ai][0][m][n][i], gl.y * acc[ai][0][m][n][i + 1]); }
                }
#pragma unroll
            for (int m = 0; m < 4; ++m) { const int row = u.pm * 256 + ai * 128 + wr * 64 + m * 16 + fr;
                u32x4 w; w.x = o[m][0]; w.y = o[m][1]; w.z = o[m][2]; w.w = o[m][3];
                *(u32x4*)(ACT + (size_t)row * DFF + f0) = w; }
        }
    }
};
DI void glu_fixup(const Args& a, int pm, int tid) {
    const float* edge = (const float*)(a.ws + OFF_EDGE); bf16_t* ACT = (bf16_t*)(a.ws + OFF_ACT);
    for (int idx = tid; idx < 2 * DFF; idx += 512) { const int e = idx / DFF, f = idx % DFF, t = pm * 256 + 255 * e;
        const float part = edge[(size_t)(pm * 2 + e) * DFF + f], uu = edge[2 * EDGE_STRIDE + (size_t)(pm * 2 + e) * DFF + f];
        float miss = 0.f;
        if (e == 0) { if ((t & (SEQ - 1)) != 0) miss = a.conv_w[f] * edge[EDGE_STRIDE + (size_t)((pm - 1) * 2 + 1) * DFF + f]; }
        else { if (((t + 1) & (SEQ - 1)) != 0) miss = a.conv_w[2 * DFF + f] * edge[EDGE_STRIDE + (size_t)((pm + 1) * 2) * DFF + f]; }
        const float g = part + miss;
        ACT[(size_t)t * DFF + f] = (bf16_t)f2bf(0.5f * g * (1.f + erff(g * 0.70710678118654752f)) * uu); }
}

DI void tr_block(const float* src, int ldw, bf16_t* dst, int ldd, float scale, LAS float* scr, int lane) {
#pragma unroll 8
    for (int i = 0; i < 32; ++i) { const int kk = 2 * i + (lane >> 5); scr[kk * 33 + (lane & 31)] = src[(size_t)kk * ldw + (lane & 31)]; }
    asm volatile("s_waitcnt lgkmcnt(0)" ::: "memory");
    const int c = lane & 7;
#pragma unroll
    for (int j = 0; j < 4; ++j) { const int n = (lane >> 3) + 8 * j; const LAS float* s = scr + (8 * c) * 33 + n;
        u32x4 o; o.x = pk2(s[0 * 33] * scale, s[1 * 33] * scale); o.y = pk2(s[2 * 33] * scale, s[3 * 33] * scale); o.z = pk2(s[4 * 33] * scale, s[5 * 33] * scale); o.w = pk2(s[6 * 33] * scale, s[7 * 33] * scale);
        *(u32x4*)(dst + (size_t)n * ldd + 8 * c) = o; }
    asm volatile("s_waitcnt lgkmcnt(0)" ::: "memory");
}
DI void phase0(const Args& a, LAS unsigned char* lds, int tid, int lane, int wave) {
    LAS float* sc = (LAS float*)lds;
    LAS float* red = sc + 4096;
    float* mod = (float*)(a.ws + OFF_MOD);
    for (int i = tid; i < 4096; i += 512) { const float v = a.c[i]; sc[i] = v / (1.f + __expf(-v)); }
    __syncthreads();
    for (int item = blockIdx.x; item < 256; item += gridDim.x) {
        const int n0 = item * 48;
        if (tid < 384) {
            const int cq = tid % 12, ks = tid / 12;
            f32x4 a0 = {0.f, 0.f, 0.f, 0.f}, a1 = {0.f, 0.f, 0.f, 0.f};
            const float* wp = a.w_ada + (size_t)(ks * 64) * NMOD + n0 + 4 * cq;
#pragma unroll 8
            for (int kk = 0; kk < 64; ++kk) { const f32x4 w = *(const f32x4*)(wp + (size_t)kk * NMOD); const float s0 = sc[ks * 64 + kk], s1 = sc[2048 + ks * 64 + kk]; a0 += s0 * w; a1 += s1 * w; }
            LAS float* rp = red + (ks * 12 + cq) * 8;
            *(LAS f32x4*)rp = a0; *(LAS f32x4*)(rp + 4) = a1;
        }
        __syncthreads();
        if (tid < 96) { const int cq = tid >> 3, j = tid & 7; float s = 0.f;
            for (int ks = 0; ks < 32; ++ks) s += red[(ks * 12 + cq) * 8 + j];
            const int bb = j >> 2, col = n0 + 4 * cq + (j & 3); mod[bb * NMOD + col] = s + a.b_ada[col]; }
        __syncthreads();
    }
    LAS float* scr = (LAS float*)(lds + 32768 + wave * 8448);
    bf16_t* WinT = (bf16_t*)(a.ws + OFF_WIN); bf16_t* WoutT = (bf16_t*)(a.ws + OFF_WOUT); bf16_t* WupT = (bf16_t*)(a.ws + OFF_WUP); bf16_t* WdnT = (bf16_t*)(a.ws + OFF_WDN);
    constexpr int I_IN = 32 * (NPC / 32), I_OUT = 32 * (DM / 32), I_UP = 32 * (NUP / 32), I_DN = (DFF / 64) * (DM / 32);
    const int gw = blockIdx.x * 8 + wave, NGW = gridDim.x * 8;
    for (int it = gw; it < I_IN + I_OUT + I_UP + I_DN; it += NGW) {
        int r = it;
        if (r < I_IN) { const int nblk = NPC / 32, kb = r / nblk, nb = r % nblk, n0 = nb * 32, ns = n0 < 4096 ? n0 : n0 + 16;
            tr_block(a.w_in + (size_t)(kb * 64) * WIN_LD + ns, WIN_LD, WinT + (size_t)n0 * DM + kb * 64, DM, (n0 >= 1024 && n0 < 2048) ? 0.0625f : 1.f, scr, lane); continue; }
        r -= I_IN;
        if (r < I_OUT) { const int nblk = DM / 32, kb = r / nblk, nb = r % nblk;
            tr_block(a.w_out + (size_t)(kb * 64) * DM + nb * 32, DM, WoutT + (size_t)(nb * 32) * DM + kb * 64, DM, 1.f, scr, lane); continue; }
        r -= I_OUT;
        if (r < I_UP) { const int nblk = NUP / 32, kb = r / nblk, nb = r % nblk, n0 = nb * 32, pn = n0 >> 8, j0 = n0 & 255, ns = (j0 < 128) ? pn * 128 + j0 : DFF + pn * 128 + j0 - 128;
            tr_block(a.w_up + (size_t)(kb * 64) * NUP + ns, NUP, WupT + (size_t)n0 * DM + kb * 64, DM, 1.f, scr, lane); continue; }
        r -= I_UP;
        { const int nblk = DM / 32, kb = r / nblk, nb = r % nblk;
            tr_block(a.w_down + (size_t)(kb * 64) * DM + nb * 32, DM, WdnT + (size_t)(nb * 32) * DFF + kb * 64, DFF, 1.f, scr, lane); }
    }
}

DI float gate_reduce16(float (&g16)[16], int lane) {
#pragma unroll
    for (int i = 0; i < 8; ++i) { const bool hi = lane & 32; const float snd = hi ? g16[i] : g16[i + 8], keep = hi ? g16[i + 8] : g16[i]; g16[i] = keep + __shfl_xor(snd, 32); }
#pragma unroll
    for (int i = 0; i < 4; ++i) { const bool hi = lane & 16; const float snd = hi ? g16[i] : g16[i + 4], keep = hi ? g16[i + 4] : g16[i]; g16[i] = keep + __shfl_xor(snd, 16); }
#pragma unroll
    for (int i = 0; i < 2; ++i) { const bool hi = lane & 8; const float snd = hi ? g16[i] : g16[i + 2], keep = hi ? g16[i + 2] : g16[i]; g16[i] = keep + __shfl_xor(snd, 8); }
    { const bool hi = lane & 4; const float snd = hi ? g16[0] : g16[1], keep = hi ? g16[1] : g16[0]; g16[0] = keep + __shfl_xor(snd, 4); }
    g16[0] += __shfl_xor(g16[0], 2); g16[0] += __shfl_xor(g16[0], 1);
    return g16[0];
}
template <bool GATES, bool IN_BF16> DI void phase_norm(const Args& a, LAS unsigned char* lds, const void* xin_, const float* gn, int sh_off, int sc_off, int tid, int lane, int wave) {
    const float* xin = (const float*)xin_; const bf16_t* xin16 = (const bf16_t*)xin_;
    const float* mod = (const float*)(a.ws + OFF_MOD);
    bf16_t* Hb = (bf16_t*)(a.ws + OFF_HB);
    float* gates = (float*)(a.ws + OFF_GATES);
    LAS float* wg = (LAS float*)lds;
    if (GATES) {
        __syncthreads();
        for (int idx = tid; idx < 2048 * 16; idx += 512) { const int k = idx >> 4, i = idx & 15; wg[i * 2052 + k] = a.w_in[(size_t)k * WIN_LD + 4096 + i]; }
        __syncthreads();
    }
    const int gw = blockIdx.x * 8 + wave, NGW = gridDim.x * 8;
    int curb = -1; f32x4 gs[8], sh[8];
    for (int m = 2 * gw; m < MTOK; m += 2 * NGW) {
        const int bb = m >> 13;
        if (bb != curb) { curb = bb;
#pragma unroll
            for (int j = 0; j < 8; ++j) { const int k = 4 * lane + 256 * j; const f32x4 g = *(const f32x4*)(gn + k), s = *(const f32x4*)(mod + bb * NMOD + sc_off + k);
                gs[j] = g * (1.f + s); sh[j] = *(const f32x4*)(mod + bb * NMOD + sh_off + k); } }
        f32x4 v0[8], v1[8]; float ss0 = 0.f, ss1 = 0.f;
#pragma unroll
        for (int j = 0; j < 8; ++j) {
            if (IN_BF16) { const u32x2 p0 = *(const u32x2*)(xin16 + (size_t)m * DM + 4 * lane + 256 * j), p1 = *(const u32x2*)(xin16 + (size_t)(m + 1) * DM + 4 * lane + 256 * j);
                v0[j] = (f32x4){bf2f(p0.x & 0xffffu), bf2f(p0.x >> 16), bf2f(p0.y & 0xffffu), bf2f(p0.y >> 16)}; v1[j] = (f32x4){bf2f(p1.x & 0xffffu), bf2f(p1.x >> 16), bf2f(p1.y & 0xffffu), bf2f(p1.y >> 16)}; }
            else { v0[j] = *(const f32x4*)(xin + (size_t)m * DM + 4 * lane + 256 * j); v1[j] = *(const f32x4*)(xin + (size_t)(m + 1) * DM + 4 * lane + 256 * j); } }
#pragma unroll
        for (int j = 0; j < 8; ++j) { ss0 += (v0[j].x * v0[j].x + v0[j].y * v0[j].y) + (v0[j].z * v0[j].z + v0[j].w * v0[j].w); ss1 += (v1[j].x * v1[j].x + v1[j].y * v1[j].y) + (v1[j].z * v1[j].z + v1[j].w * v1[j].w); }
        const float rstd0 = rsqrtf(wave_sum(ss0) * (1.f / DM) + EPSN), rstd1 = rsqrtf(wave_sum(ss1) * (1.f / DM) + EPSN);
#pragma unroll
        for (int j = 0; j < 8; ++j) { v0[j] = v0[j] * rstd0 * gs[j] + sh[j]; v1[j] = v1[j] * rstd1 * gs[j] + sh[j];
            u32x2 o; o.x = pk2(v0[j].x, v0[j].y); o.y = pk2(v0[j].z, v0[j].w); *(u32x2*)(Hb + (size_t)m * DM + 4 * lane + 256 * j) = o;
            o.x = pk2(v1[j].x, v1[j].y); o.y = pk2(v1[j].z, v1[j].w); *(u32x2*)(Hb + (size_t)(m + 1) * DM + 4 * lane + 256 * j) = o; }
        if (GATES) {
            float ga[16], gb[16];
#pragma unroll
            for (int i = 0; i < 16; ++i) { float s0 = 0.f, s1 = 0.f;
#pragma unroll
                for (int j = 0; j < 8; ++j) { const f32x4 w = *(const LAS f32x4*)(wg + i * 2052 + 4 * lane + 256 * j);
                    s0 += (v0[j].x * w.x + v0[j].y * w.y) + (v0[j].z * w.z + v0[j].w * w.w); s1 += (v1[j].x * w.x + v1[j].y * w.y) + (v1[j].z * w.z + v1[j].w * w.w); }
                ga[i] = s0; gb[i] = s1; __builtin_amdgcn_sched_barrier(0); }
            const float r0 = gate_reduce16(ga, lane), r1 = gate_reduce16(gb, lane);
            if ((lane & 3) == 0) { const int gi = ((lane >> 5) & 1) * 8 + ((lane >> 4) & 1) * 4 + ((lane >> 3) & 1) * 2 + ((lane >> 2) & 1); const float bg = a.b_gates[gi];
                gates[(size_t)m * 16 + gi] = r0 + bg; gates[(size_t)(m + 1) * 16 + gi] = r1 + bg; }
        }
    }
}

DI void gate_prep(const Args& a, LAS unsigned char* lds, int combo, int tid) {
    const float* gates = (const float*)(a.ws + OFF_GATES);
    float* ulA = (float*)(a.ws + OFF_UL); float* MlA = (float*)(a.ws + OFF_ML); float* emtA = (float*)(a.ws + OFF_EMT);
    float* mprevA = (float*)(a.ws + OFF_MPREV); float* mendA = (float*)(a.ws + OFF_MEND);
    LAS float* sT = (LAS float*)lds; LAS float* sM = sT + 512; LAS float* sG = sM + 512; LAS float* sX = sG + 32; LAS float* sMp = sX + 32; LAS float* sMe = sMp + 32;
    const int b = combo >> 3, dir = (combo >> 2) & 1, h = combo & 3;
    const int ci = dir * 8 + h, cf = dir * 8 + 4 + h, cs = tid >> 4;
    float li[16], bl[16], cm[16];
    float run = 0.f;
#pragma unroll
    for (int i = 0; i < 16; ++i) { const int tau = tid * 16 + i, t = dir ? SEQ - 1 - tau : tau; const float* gp = gates + (size_t)(b * SEQ + t) * 16;
        li[i] = gp[ci]; const float f = gp[cf]; const float lf = fminf(f, 0.f) - log1pf(__expf(-fabsf(f))); run += lf; bl[i] = run; }
    sT[tid] = run; __syncthreads();
    float base = 0.f; for (int j = cs * 16; j < tid; ++j) base += sT[j];
    float mx = -3.0e38f;
#pragma unroll
    for (int i = 0; i < 16; ++i) { bl[i] += base; li[i] -= bl[i]; mx = fmaxf(mx, li[i]); cm[i] = mx; }
    sM[tid] = mx; __syncthreads();
    float mbase = -3.0e38f; for (int j = cs * 16; j < tid; ++j) mbase = fmaxf(mbase, sM[j]);
    if (tid < 32) { float g = 0.f, xm = -3.0e38f; for (int j = 0; j < 16; ++j) { g += sT[tid * 16 + j]; xm = fmaxf(xm, sM[tid * 16 + j]); } sG[tid] = g; sX[tid] = xm; }
    __syncthreads();
    if (tid == 0) { float m = -1e30f; for (int c = 0; c < 32; ++c) { sMp[c] = m; const float me = fmaxf(m, sX[c]); sMe[c] = me; m = sG[c] + me; } }
    __syncthreads();
    const float mp = sMp[cs];
#pragma unroll
    for (int i = 0; i < 16; ++i) { const int tau = tid * 16 + i, t = dir ? SEQ - 1 - tau : tau; const float Ml = fmaxf(mp, fmaxf(cm[i], mbase));
        ulA[combo * SEQ + t] = li[i]; MlA[combo * SEQ + t] = Ml; emtA[combo * SEQ + t] = __expf(-(bl[i] + Ml)); }
    if ((tid & 15) == 0) { const int c = dir ? NCH - 1 - cs : cs; mprevA[combo * NCH + c] = mp; mendA[combo * NCH + c] = sMe[cs]; }
    __syncthreads();
}

DI void mlstm_delta(const Args& a, LAS unsigned char* lds, int tid, int lane, int wave) {
    const bf16_t* P = (const bf16_t*)(a.ws + OFF_P); bf16_t* cst = (bf16_t*)(a.ws + OFF_CST);
    const float* ulA = (const float*)(a.ws + OFF_UL); const float* mendA = (const float*)(a.ws + OFF_MEND);
    const int l15 = lane & 15, quad = lane >> 4, qin = l15 >> 2, pin = l15 & 3;
    constexpr int BUFB = 2 * 34816;
    LAS float* wS = (LAS float*)(lds + 2 * BUFB);
    const short one = (l15 == 0) ? (short)0x3F80 : (short)0;
    const bf16x8 ones = {one, one, one, one, one, one, one, one};
    for (int item = blockIdx.x; item < NCOMBO * NCH; item += gridDim.x) {
        const int combo = item / NCH, c = item % NCH, b = combo >> 3, h = combo & 3;
        const float mend = mendA[combo * NCH + c];
        __syncthreads();
        if (tid < 256) wS[tid] = __expf(ulA[combo * SEQ + c * LCH + tid] - mend);
        f32x4 acc[17][2];
#pragma unroll
        for (int m = 0; m < 17; ++m) { acc[m][0] = (f32x4){0.f, 0.f, 0.f, 0.f}; acc[m][1] = (f32x4){0.f, 0.f, 0.f, 0.f}; }
        const bf16_t* Pk = P + (size_t)(b * SEQ + c * LCH) * NPC + 1024 + h * 256;
        u32x4 pre[8];
#define DL_LOAD(sb_) do { int t0_ = tid; asm volatile("" : "+v"(t0_)); const bf16_t* src_ = Pk + (unsigned)(((sb_) * 64 + (t0_ >> 5)) * NPC + (t0_ & 31) * 8); \
        _Pragma("unroll") for (int i_ = 0; i_ < 4; ++i_) { pre[i_] = *(const u32x4*)(src_ + i_ * 16 * NPC); pre[4 + i_] = *(const u32x4*)(src_ + i_ * 16 * NPC + 1024); } } while (0)
#define DL_STORE(sb_) do { int t0_ = tid; asm volatile("" : "+v"(t0_)); LAS unsigned char* d_ = lds + ((sb_) & 1) * BUFB + (t0_ >> 5) * 544 + (t0_ & 31) * 16; \
        _Pragma("unroll") for (int i_ = 0; i_ < 4; ++i_) { const float w_ = wS[(sb_) * 64 + (t0_ >> 5) + 16 * i_]; \
            *(LAS bf16x8*)(d_ + i_ * 16 * 544) = scale8(__builtin_bit_cast(bf16x8, pre[i_]), w_); *(LAS u32x4*)(d_ + 34816 + i_ * 16 * 544) = pre[4 + i_]; } } while (0)
        DL_LOAD(0);
        __syncthreads();
        DL_STORE(0);
        __syncthreads();
#pragma unroll 1
        for (int sb = 0; sb < 4; ++sb) {
            const LAS unsigned char* Kt = lds + (sb & 1) * BUFB; const LAS unsigned char* Vt = Kt + 34816;
            if (sb + 1 < 4) DL_LOAD(sb + 1);
#pragma unroll 1
            for (int kk = 0; kk < 2; ++kk) {
                bf16x8 bfr[2];
#pragma unroll
                for (int n = 0; n < 2; ++n) bfr[n] = tr_frag(Kt, 544, kk * 32 + 4 * quad, kk * 32 + 16 + 4 * quad, wave * 32 + n * 16, qin, pin);
#pragma unroll
                for (int m = 0; m < 16; ++m) { const bf16x8 afr = tr_frag(Vt, 544, kk * 32 + 4 * quad, kk * 32 + 16 + 4 * quad, m * 16, qin, pin);
                    acc[m][0] = MFMA16(afr, bfr[0], acc[m][0]); acc[m][1] = MFMA16(afr, bfr[1], acc[m][1]); if ((m & 3) == 3) __builtin_amdgcn_sched_barrier(0); }
                acc[16][0] = MFMA16(ones, bfr[0], acc[16][0]); acc[16][1] = MFMA16(ones, bfr[1], acc[16][1]);
            }
            if (sb + 1 < 4) DL_STORE(sb + 1);
            __syncthreads();
        }
#undef DL_LOAD
#undef DL_STORE
        int loff = 4 * quad * 256 + wave * 32 + l15; asm volatile("" : "+v"(loff));
        bf16_t* dst = cst + (size_t)item * ST_ELEMS + loff;
#pragma unroll
        for (int m = 0; m < 17; ++m)
#pragma unroll
            for (int n = 0; n < 2; ++n)
#pragma unroll
                for (int r = 0; r < 4; ++r) { dst[(16 * m + r) * 256 + 16 * n] = (bf16_t)f2bf(acc[m][n][r]); if (r == 3) __builtin_amdgcn_sched_barrier(0); }
    }
}

DI void mlstm_scan(const Args& a, int tid) {
    bf16_t* cst = (bf16_t*)(a.ws + OFF_CST);
    const float* mprevA = (const float*)(a.ws + OFF_MPREV); const float* mendA = (const float*)(a.ws + OFF_MEND);
    constexpr int VPS = ST_ELEMS / 8;
    const int gt = blockIdx.x * 512 + tid, NT = gridDim.x * 512;
    for (int v = gt; v < NCOMBO * VPS; v += NT) {
        const int combo = v / VPS, vi = v % VPS, dir = (combo >> 2) & 1;
        float st[8];
#pragma unroll
        for (int i = 0; i < 8; ++i) st[i] = 0.f;
        bf16_t* base = cst + (size_t)combo * NCH * ST_ELEMS + vi * 8;
        for (int cs0 = 0; cs0 < NCH; cs0 += 8) {
            u32x4 d[8]; float dec[8];
#pragma unroll
            for (int q = 0; q < 8; ++q) { const int c = dir ? NCH - 1 - (cs0 + q) : cs0 + q;
                d[q] = *(const u32x4*)(base + (size_t)c * ST_ELEMS); dec[q] = __expf(mprevA[combo * NCH + c] - mendA[combo * NCH + c]); }
#pragma unroll
            for (int q = 0; q < 8; ++q) { const int c = dir ? NCH - 1 - (cs0 + q) : cs0 + q;
                u32x4 o;
#pragma unroll
                for (int i = 0; i < 4; ++i) { o[i] = pk2(st[2 * i], st[2 * i + 1]); st[2 * i] = dec[q] * st[2 * i] + bf2f(d[q][i] & 0xffffu); st[2 * i + 1] = dec[q] * st[2 * i + 1] + bf2f(d[q][i] >> 16); }
                *(u32x4*)(base + (size_t)c * ST_ELEMS) = o; }
        }
    }
}

DI void nat_scores(f32x4 (&st)[4][2], const LAS unsigned char* T, const bf16x8 (&qf)[4], int kc0, int l15, int quad) {
#pragma unroll
    for (int k4 = 0; k4 < 4; ++k4)
#pragma unroll
        for (int mi = 0; mi < 2; ++mi) { f32x4 s = {0.f, 0.f, 0.f, 0.f};
#pragma unroll
            for (int ks = 0; ks < 4; ++ks) { s = MFMA16(ld_frag(T + (k4 * 64 + kc0 + 16 * mi + l15) * 272 + (ks * 32 + quad * 8) * 2), qf[ks], s); if (ks == 1) __builtin_amdgcn_sched_barrier(0); }
            st[k4][mi] = s; __builtin_amdgcn_sched_barrier(0); }
}
DI float nat_mask(f32x4 (&st)[4][2], const LAS float* rpbS, int kr0, int rs, int r, const bool (&sel)[4], const int (&dcb)[4], float scale) {
    float mx = -3.0e38f;
#pragma unroll
    for (int k4 = 0; k4 < 4; ++k4) { const int dr = rs + kr0 + k4 - r + 7;
#pragma unroll
        for (int rr = 0; rr < 4; ++rr) { const float sv = (sel[rr] ? st[k4][0][rr] : st[k4][1][rr]) * scale + rpbS[dr * 31 + dcb[rr]]; st[k4][0][rr] = sv; mx = fmaxf(mx, sv); } }
    mx = fmaxf(mx, __shfl_xor(mx, 16)); mx = fmaxf(mx, __shfl_xor(mx, 32));
    return mx;
}
DI float nat_exp(bf16x8 (&pf)[4], f32x4 (&st)[4][2], const bool (&sel)[4], float m) {
    float sum = 0.f;
#pragma unroll
    for (int k4 = 0; k4 < 4; ++k4) { f32x4 p0, p1;
#pragma unroll
        for (int rr = 0; rr < 4; ++rr) { const float p = __expf(st[k4][0][rr] - m); sum += p; p0[rr] = sel[rr] ? p : 0.f; p1[rr] = sel[rr] ? 0.f : p; }
        pf[k4] = pack8(p0, p1); }
    return sum;
}
DI void nat_pv(f32x4 (&o)[8], const bf16x8 (&pf)[4], const LAS unsigned char* T, int kc0, int quad, int qin, int pin) {
#pragma unroll
    for (int k4 = 0; k4 < 4; ++k4) {
#pragma unroll
        for (int n = 0; n < 8; ++n) { o[n] = MFMA16(tr_frag(T + k4 * 64 * 272, 272, kc0 + 4 * quad, kc0 + 16 + 4 * quad, 16 * n, qin, pin), pf[k4], o[n]); if ((n & 3) == 3) __builtin_amdgcn_sched_barrier(0); } }
}
DI void natten(const Args& a, LAS unsigned char* lds, int tid, int lane, int wave) {
    const bf16_t* P = (const bf16_t*)(a.ws + OFF_P); bf16_t* mixed = (bf16_t*)(a.ws + OFF_HB);
    const int l15 = lane & 15, quad = lane >> 4, qin = l15 >> 2, pin = l15 & 3;
    const int hw = wave >> 2, j = wave & 3, htid = tid & 255;
    LAS unsigned char* T = lds + hw * 69632;
    LAS float* rpbS = (LAS float*)(lds + 139264) + hw * 480;
    const int kc0 = (j == 0) ? 0 : (j == 1) ? 8 : (j == 2) ? 24 : 32;
    const float scale = 0.08838834764831845f;
    const int nit = (1024 - (int)blockIdx.x + (int)gridDim.x - 1) / (int)gridDim.x;
    if (nit <= 0) return;
    __syncthreads();
    { const int h0 = (blockIdx.x & 3) * 2 + hw; for (int i = htid; i < 465; i += 256) rpbS[i] = a.rpb[h0 * 465 + i]; }
    u32x4 pre[16];
    const bool xmap = (gridDim.x == 256);
#define NAT_ITEM(k_) (xmap ? ((((int)blockIdx.x & 7) >> 2) << 9) | ((32 * (k_) + ((int)blockIdx.x >> 3)) << 2) | ((int)blockIdx.x & 3) : (int)blockIdx.x + (k_) * (int)gridDim.x)
#define NAT_LOAD(g_) do { const int it_ = NAT_ITEM((g_) >> 2), sp_ = (g_) & 3; const int b_ = it_ >> 9, r_ = (it_ >> 2) & 127, h_ = (it_ & 3) * 2 + hw; \
        const int rs_ = min(max(r_ - 4, 0), 120); int t0_ = htid; asm volatile("" : "+v"(t0_)); \
        const bf16_t* src_ = P + (unsigned)((b_ * SEQ + (rs_ + 4 * (sp_ & 1)) * 64) * NPC + ((sp_ >> 1) ? 6144 : 5120) + h_ * 128 + ((t0_ >> 4) * NPC + (t0_ & 15) * 8)); \
        _Pragma("unroll") for (int i_ = 0; i_ < 16; ++i_) pre[i_] = *(const u32x4*)(src_ + i_ * 16 * NPC); } while (0)
#define NAT_STORE() do { int t0_ = htid; asm volatile("" : "+v"(t0_)); LAS unsigned char* d_ = T + (t0_ >> 4) * 272 + (t0_ & 15) * 16; \
        _Pragma("unroll") for (int i_ = 0; i_ < 16; ++i_) *(LAS u32x4*)(d_ + i_ * 16 * 272) = pre[i_]; } while (0)
    NAT_LOAD(0); NAT_STORE();
    __syncthreads();
#pragma unroll 1
    for (int k = 0; k < nit; ++k) {
        const int item = NAT_ITEM(k);
        const int b = item >> 9, r = (item >> 2) & 127, h = (item & 3) * 2 + hw;
        int l15g = l15; asm volatile("" : "+v"(l15g));
        const int rs = min(max(r - 4, 0), 120), qcol = 16 * j + l15g;
        const int tokq = b * SEQ + r * 64 + qcol;
        bf16x8 qf[4]; f32x4 st[4][2]; bf16x8 pf0[4], pf1[4];
#pragma unroll
        for (int ks = 0; ks < 4; ++ks) qf[ks] = *(const bf16x8*)(P + (unsigned)(tokq * NPC + 4096 + h * 128 + ks * 32 + quad * 8));
        const int cs = min(max(qcol - 8, 0), 48);
        bool sel[4]; int dcb[4];
#pragma unroll
        for (int rr = 0; rr < 4; ++rr) { sel[rr] = (4 * quad + rr >= cs - kc0); dcb[rr] = kc0 + 4 * quad + rr + (sel[rr] ? 0 : 16) - qcol + 15; }
        NAT_LOAD(4 * k + 1);
        nat_scores(st, T, qf, kc0, l15, quad);
        const float m0 = nat_mask(st, rpbS, 0, rs, r, sel, dcb, scale);
        float sum0 = nat_exp(pf0, st, sel, m0);
        __syncthreads(); NAT_STORE(); __syncthreads();
        NAT_LOAD(4 * k + 2);
        nat_scores(st, T, qf, kc0, l15, quad);
        const float m1 = nat_mask(st, rpbS, 4, rs, r, sel, dcb, scale);
        const float M = fmaxf(m0, m1), f0 = __expf(m0 - M);
        float sum1 = nat_exp(pf1, st, sel, M);
        float tot = sum0 * f0 + sum1;
        tot += __shfl_xor(tot, 16); tot += __shfl_xor(tot, 32);
        const float inv = 1.f / tot;
        __syncthreads(); NAT_STORE(); __syncthreads();
        f32x4 o[8];
#pragma unroll
        for (int n = 0; n < 8; ++n) o[n] = (f32x4){0.f, 0.f, 0.f, 0.f};
        NAT_LOAD(4 * k + 3);
        nat_pv(o, pf0, T, kc0, quad, qin, pin);
#pragma unroll
        for (int n = 0; n < 8; ++n) o[n] = o[n] * f0;
        __syncthreads(); NAT_STORE(); __syncthreads();
        if (k + 1 < nit) NAT_LOAD(4 * k + 4);
        nat_pv(o, pf1, T, kc0, quad, qin, pin);
#pragma unroll
        for (int n = 0; n < 8; ++n) { u32x2 w; w.x = pk2(o[n][0] * inv, o[n][1] * inv); w.y = pk2(o[n][2] * inv, o[n][3] * inv);
            *(u32x2*)(mixed + (unsigned)(tokq * DM + 1024 + h * 128 + 16 * n + 4 * quad)) = w; }
        __syncthreads();
        if (k + 1 < nit) NAT_STORE();
        __syncthreads();
    }
#undef NAT_LOAD
#undef NAT_ITEM
#undef NAT_STORE
}

DI void mlstm_out(const Args& a, LAS unsigned char* lds, int tid, int lane, int wave) {
    const bf16_t* P = (const bf16_t*)(a.ws + OFF_P); const bf16_t* cst = (const bf16_t*)(a.ws + OFF_CST); bf16_t* mixed = (bf16_t*)(a.ws + OFF_HB);
    const float* ulA = (const float*)(a.ws + OFF_UL); const float* MlA = (const float*)(a.ws + OFF_ML); const float* emtA = (const float*)(a.ws + OFF_EMT);
    const float* mprevA = (const float*)(a.ws + OFF_MPREV);
    const int l15 = lane & 15, quad = lane >> 4, qin = l15 >> 2, pin = l15 & 3;
    constexpr int BUFB = 33792 + 34816;
    LAS float* ulS2 = (LAS float*)(lds + 2 * BUFB);
    const short one = (l15 == 0) ? (short)0x3F80 : (short)0;
    const bf16x8 ones = {one, one, one, one, one, one, one, one};
    for (int item = blockIdx.x; item < 512; item += gridDim.x) {
        const int bh = item >> 6, c = (item >> 1) & 31, half = item & 1, b = bh >> 2, h = bh & 3;
        int l15i = l15, tt = tid; asm volatile("" : "+v"(l15i), "+v"(tt));
        const int t_loc = 128 * half + 16 * wave + l15i;
        const size_t tok = (size_t)b * SEQ + c * LCH + t_loc;
        const int n0 = 2 * half + 2;
        __syncthreads();
        { const int d = tt >> 8; ulS2[tt] = ulA[((b * 2 + d) * 4 + h) * SEQ + c * LCH + (tt & 255)]; }
        u32x4 pre[8];
#define STEP_DEC(s_, dir_, st_, idx_) do { int r_ = (s_); dir_ = 0; if (r_ >= n0 + 4) { r_ -= n0 + 4; dir_ = 1; } const int nk_ = dir_ ? 4 - 2 * half : n0; st_ = (r_ >= nk_); idx_ = st_ ? r_ - nk_ : (dir_ ? 2 * half + r_ : r_); } while (0)
#define STEP_LOAD(s_) do { int dir_, st_, idx_; STEP_DEC(s_, dir_, st_, idx_); int t0_ = tid; asm volatile("" : "+v"(t0_)); \
        if (!st_) { const bf16_t* src_ = P + ((size_t)b * SEQ + c * LCH + 64 * idx_) * NPC + 1024 + h * 256 + ((t0_ >> 5) * NPC + (t0_ & 31) * 8); \
            _Pragma("unroll") for (int i_ = 0; i_ < 4; ++i_) { pre[i_] = *(const u32x4*)(src_ + i_ * 16 * NPC); pre[4 + i_] = *(const u32x4*)(src_ + i_ * 16 * NPC + 1024); } } \
        else { const bf16_t* src_ = cst + (size_t)(((b * 2 + dir_) * 4 + h) * NCH + c) * ST_ELEMS + 64 * idx_ + ((t0_ >> 3) * 256 + (t0_ & 7) * 8); \
            _Pragma("unroll") for (int i_ = 0; i_ < 4; ++i_) pre[i_] = *(const u32x4*)(src_ + i_ * 64 * 256); \
            if (t0_ < 128) pre[4] = *(const u32x4*)(src_ + 4 * 64 * 256); } } while (0)
#define STEP_STORE(s_) do { int dir_, st_, idx_; STEP_DEC(s_, dir_, st_, idx_); LAS unsigned char* bp_ = lds + ((s_) & 1) * BUFB; int t0_ = tid; asm volatile("" : "+v"(t0_)); \
        if (!st_) { LAS unsigned char* d_ = bp_ + (t0_ >> 5) * 528 + (t0_ & 31) * 16; \
            _Pragma("unroll") for (int i_ = 0; i_ < 4; ++i_) { *(LAS u32x4*)(d_ + i_ * 16 * 528) = pre[i_]; *(LAS u32x4*)(bp_ + 33792 + ((t0_ >> 5) + 16 * i_) * 544 + (t0_ & 31) * 16) = pre[4 + i_]; } } \
        else { LAS unsigned char* d_ = bp_ + (t0_ >> 3) * 144 + (t0_ & 7) * 16; \
            _Pragma("unroll") for (int i_ = 0; i_ < 4; ++i_) *(LAS u32x4*)(d_ + i_ * 64 * 144) = pre[i_]; \
            if (t0_ < 128) *(LAS u32x4*)(d_ + 4 * 64 * 144) = pre[4]; } } while (0)
        bf16x8 qf[8];
        { int qo = h * 256 + quad * 8; asm volatile("" : "+v"(qo)); const bf16_t* qp = P + tok * NPC + qo;
#pragma unroll
          for (int ks = 0; ks < 8; ++ks) qf[ks] = *(const bf16x8*)(qp + ks * 32); }
        STEP_LOAD(0); STEP_STORE(0);
        __syncthreads();
        f32x4 acc[17]; float Ml = 0.f, emt = 1.f, aa = 0.f;
#pragma unroll 1
        for (int s = 0; s < 14; ++s) {
            int dir, st, idx; STEP_DEC(s, dir, st, idx);
            const LAS unsigned char* T0 = lds + (s & 1) * BUFB; const LAS unsigned char* T1 = T0 + 33792;
            const LAS float* ulS = ulS2 + dir * 256;
            if (s == 0 || s == n0 + 4) {
                const int combo = (b * 2 + dir) * 4 + h;
                Ml = MlA[combo * SEQ + c * LCH + t_loc]; emt = emtA[combo * SEQ + c * LCH + t_loc]; aa = __expf(mprevA[combo * NCH + c] - Ml);
#pragma unroll
                for (int m = 0; m < 17; ++m) acc[m] = (f32x4){0.f, 0.f, 0.f, 0.f};
            }
            if (s + 1 < 14) STEP_LOAD(s + 1);
            if (!st && (dir ? (64 * idx + 63 >= 128 * half + 16 * wave) : (64 * idx <= 128 * half + 16 * wave + 15))) {
                const int jb = idx;
                f32x4 sc[4];
#pragma unroll
                for (int mi = 0; mi < 4; ++mi) sc[mi] = (f32x4){0.f, 0.f, 0.f, 0.f};
#pragma unroll
                for (int mi = 0; mi < 4; ++mi) {
#pragma unroll
                    for (int ks = 0; ks < 8; ++ks) { sc[mi] = MFMA16(ld_frag(T0 + (16 * mi + l15) * 528 + (32 * ks + 8 * quad) * 2), qf[ks], sc[mi]); if (ks == 3) __builtin_amdgcn_sched_barrier(0); }
                    __builtin_amdgcn_sched_barrier(0); }
#pragma unroll
                for (int mi = 0; mi < 4; ++mi)
#pragma unroll
                    for (int rr = 0; rr < 4; ++rr) { const int s_loc = 64 * jb + 16 * mi + 4 * quad + rr; const bool valid = dir ? (s_loc >= t_loc) : (s_loc <= t_loc);
                        const float wgt = valid ? __expf(ulS[s_loc] - Ml) : 0.f; sc[mi][rr] *= wgt; }
#pragma unroll
                for (int kk = 0; kk < 2; ++kk) { const bf16x8 pf = pack8(sc[2 * kk], sc[2 * kk + 1]);
#pragma unroll
                    for (int n = 0; n < 16; ++n) { acc[n] = MFMA16(tr_frag(T1, 544, 32 * kk + 4 * quad, 32 * kk + 16 + 4 * quad, 16 * n, qin, pin), pf, acc[n]); if ((n & 1) == 1) __builtin_amdgcn_sched_barrier(0); }
                    acc[16] = MFMA16(ones, pf, acc[16]); }
            } else if (st) {
                const int db = idx;
                bf16x8 aq[2];
                aq[0] = (db == 0) ? qf[0] : (db == 1) ? qf[2] : (db == 2) ? qf[4] : qf[6];
                aq[1] = (db == 0) ? qf[1] : (db == 1) ? qf[3] : (db == 2) ? qf[5] : qf[7];
                aq[0] = scale8(aq[0], aa); aq[1] = scale8(aq[1], aa);
#pragma unroll
                for (int kk = 0; kk < 2; ++kk) {
#pragma unroll
                    for (int m = 0; m < 17; ++m) { acc[m] = MFMA16(ld_frag(T0 + (16 * m + l15) * 144 + (32 * kk + 8 * quad) * 2), aq[kk], acc[m]); if ((m & 1) == 1) __builtin_amdgcn_sched_barrier(0); } }
            }
            if (s + 1 < 14) STEP_STORE(s + 1);
            if (s == n0 + 3 || s == 13) {
                const float den = __shfl(acc[16][0], l15);
                const float dn = 1.f / fmaxf(fabsf(den), emt);
                int moff = h * 256 + 4 * quad; asm volatile("" : "+v"(moff));
                bf16_t* mrow = mixed + tok * DM + moff;
                if (dir == 0) {
#pragma unroll
                    for (int n = 0; n < 16; ++n) { u32x2 w; w.x = pk2(acc[n][0] * dn, acc[n][1] * dn); w.y = pk2(acc[n][2] * dn, acc[n][3] * dn); *(u32x2*)(mrow + 16 * n) = w; }
                } else {
                    float ss = 0.f;
#pragma unroll
                    for (int n = 0; n < 16; ++n) { const u32x2 hf = *(const u32x2*)(mrow + 16 * n);
                        acc[n][0] = acc[n][0] * dn + bf2f(hf.x & 0xffffu); acc[n][1] = acc[n][1] * dn + bf2f(hf.x >> 16);
                        acc[n][2] = acc[n][2] * dn + bf2f(hf.y & 0xffffu); acc[n][3] = acc[n][3] * dn + bf2f(hf.y >> 16);
                        ss += (acc[n][0] * acc[n][0] + acc[n][1] * acc[n][1]) + (acc[n][2] * acc[n][2] + acc[n][3] * acc[n][3]); if ((n & 3) == 3) __builtin_amdgcn_sched_barrier(0); }
                    ss += __shfl_xor(ss, 16); ss += __shfl_xor(ss, 32);
                    const float rstd = rsqrtf(ss * (1.f / 256.f) + EPSN);
                    __builtin_amdgcn_sched_barrier(0);
                    int eb = h * 256 + 4 * quad; asm volatile("" : "+v"(eb));
                    const float* gp = a.g_head_a + eb; const bf16_t* ovp = P + tok * NPC + 3072 + eb;
#pragma unroll
                    for (int n = 0; n < 16; ++n) { const f32x4 g = *(const f32x4*)(gp + 16 * n);
                        const u32x2 ov = *(const u32x2*)(ovp + 16 * n);
                        const float o0 = bf2f(ov.x & 0xffffu), o1 = bf2f(ov.x >> 16), o2 = bf2f(ov.y & 0xffffu), o3 = bf2f(ov.y >> 16);
                        u32x2 w; w.x = pk2(acc[n][0] * rstd * g.x / (1.f + __expf(-o0)), acc[n][1] * rstd * g.y / (1.f + __expf(-o1)));
                        w.y = pk2(acc[n][2] * rstd * g.z / (1.f + __expf(-o2)), acc[n][3] * rstd * g.w / (1.f + __expf(-o3)));
                        *(u32x2*)(mrow + 16 * n) = w; __builtin_amdgcn_sched_barrier(0); }
                }
            }
            __syncthreads();
        }
#undef STEP_DEC
#undef STEP_LOAD
#undef STEP_STORE
    }
}

DI void phase_act(const Args& a, int tid) {
    bf16_t* UG = (bf16_t*)(a.ws + OFF_UG);
    constexpr int NV = DFF / 8, RUN = 16, NRUN = MTOK / RUN;
    const int gt = blockIdx.x * 512 + tid, NT = gridDim.x * 512;
    for (int it = gt; it < NRUN * NV; it += NT) {
        const int vv = it % NV, run = it / NV, f0 = vv * 8, t0 = run * RUN;
        float w0[8], w1[8], w2[8], cb[8];
#pragma unroll
        for (int i = 0; i < 8; ++i) { w0[i] = a.conv_w[f0 + i]; w1[i] = a.conv_w[DFF + f0 + i]; w2[i] = a.conv_w[2 * DFF + f0 + i]; cb[i] = a.conv_b[f0 + i]; }
        const u32x4 zero = {0u, 0u, 0u, 0u};
        const bf16_t* G = UG + DFF + f0;
        u32x4 gp = ((t0 & (SEQ - 1)) == 0) ? zero : *(const u32x4*)(G + (size_t)(t0 - 1) * NUP);
        u32x4 gc = *(const u32x4*)(G + (size_t)t0 * NUP);
        for (int i = 0; i < RUN; ++i) { const int t = t0 + i;
            const u32x4 gn = (((t + 1) & (SEQ - 1)) == 0) ? zero : *(const u32x4*)(G + (size_t)(t + 1) * NUP);
            const u32x4 uv = *(const u32x4*)(UG + (size_t)t * NUP + f0);
            u32x4 o;
#pragma unroll
            for (int q = 0; q < 4; ++q) { float r[2];
#pragma unroll
                for (int e = 0; e < 2; ++e) { const int k = 2 * q + e; const unsigned sh = e ? 16u : 0u;
                    const float g = w0[k] * bf2f((gp[q] >> sh) & 0xffffu) + w1[k] * bf2f((gc[q] >> sh) & 0xffffu) + w2[k] * bf2f((gn[q] >> sh) & 0xffffu) + cb[k];
                    r[e] = 0.5f * g * (1.f + erff(g * 0.70710678118654752f)) * bf2f((uv[q] >> sh) & 0xffffu); }
                o[q] = pk2(r[0], r[1]); }
            *(u32x4*)(UG + (size_t)t * NUP + f0) = o;
            gp = gc; gc = gn; }
    }
}

DI void phase_final(const Args& a, int lane, int wave) {
    const bf16_t* x2 = (const bf16_t*)(a.ws + OFF_X1B);
    const int gw = blockIdx.x * 8 + wave, NGW = gridDim.x * 8;
    f32x4 g[8];
#pragma unroll
    for (int j = 0; j < 8; ++j) g[j] = *(const f32x4*)(a.g_final + 4 * lane + 256 * j);
    for (int m = 4 * gw; m < MTOK; m += 4 * NGW) {
        u32x2 p[4][8];
#pragma unroll
        for (int r = 0; r < 4; ++r)
#pragma unroll
            for (int j = 0; j < 8; ++j) p[r][j] = *(const u32x2*)(x2 + (size_t)(m + r) * DM + 4 * lane + 256 * j);
#pragma unroll
        for (int r = 0; r < 4; ++r) {
            f32x4 v[8]; float ss = 0.f;
#pragma unroll
            for (int j = 0; j < 8; ++j) { v[j] = (f32x4){bf2f(p[r][j].x & 0xffffu), bf2f(p[r][j].x >> 16), bf2f(p[r][j].y & 0xffffu), bf2f(p[r][j].y >> 16)};
                ss += (v[j].x * v[j].x + v[j].y * v[j].y) + (v[j].z * v[j].z + v[j].w * v[j].w); }
            const float rstd = rsqrtf(wave_sum(ss) * (1.f / DM) + EPSN);
#pragma unroll
            for (int j = 0; j < 8; ++j) *(f32x4*)(a.out + (size_t)(m + r) * DM + 4 * lane + 256 * j) = v[j] * rstd * g[j];
        }
    }
}

#define XB_TMO      128
#define XB_XCNT(j)  (256  + 64 * (j))
#define XB_XSUB(j)  (1280 + 64 * (j))
#define XB_XGEN(j)  (2304 + 64 * (j))
#define XB_TOP      3328
#define XB_TOPGEN   3392
#define XCD_BAR_WORDS 3456
#define XB_SPIN_CAP (1u << 18)

__device__ __forceinline__ unsigned xb_ld(unsigned* p)              { return __hip_atomic_load(p, __ATOMIC_RELAXED, __HIP_MEMORY_SCOPE_AGENT); }
__device__ __forceinline__ unsigned xb_add(unsigned* p, unsigned v) { return __hip_atomic_fetch_add(p, v, __ATOMIC_RELAXED, __HIP_MEMORY_SCOPE_AGENT); }
__device__ __forceinline__ unsigned xb_xcc_id() { return (unsigned)__builtin_amdgcn_s_getreg((3 << 11) | 20) & 0xFu; }
#define XB_SPIN(cond, bar) do { unsigned _sp = 0; while (cond) { __builtin_amdgcn_s_sleep(1); \
    if ((++_sp & 255u) == 0u) { if (xb_ld(&(bar)[XB_TMO])) break; if (_sp > XB_SPIN_CAP) { atomicAdd(&(bar)[XB_TMO], 1u); break; } } } } while (0)

struct XcdBarrier {
    unsigned* bar; unsigned x;
    volatile LAS unsigned* st;
};

__device__ __forceinline__ XcdBarrier xcd_barrier_post(unsigned* bar, volatile LAS unsigned* st) {
    XcdBarrier b; b.bar = bar; b.x = xb_xcc_id(); b.st = st;
    if (threadIdx.x == 0) (void)xb_add(&bar[XB_XCNT(b.x)], 1u);
    return b;
}
__device__ __forceinline__ void xcd_barrier_complete(unsigned* bar, unsigned x, unsigned& nloc, unsigned& nx) {
    const unsigned G = gridDim.x * gridDim.y * gridDim.z;
    unsigned sum, cnt, mine, sp = 0u;
    for (;;) {
        sum = 0u; cnt = 0u; mine = 0u;
#pragma unroll
        for (unsigned j = 0; j < 16; ++j) { const unsigned c = xb_ld(&bar[XB_XCNT(j)]); sum += c; cnt += (c > 0u) ? 1u : 0u; mine = (j == x) ? c : mine; }
        if (sum == G) break;
        __builtin_amdgcn_s_sleep(1);
        if ((++sp & 255u) == 0u) { if (xb_ld(&bar[XB_TMO])) break; if (sp > XB_SPIN_CAP) { atomicAdd(&bar[XB_TMO], 1u); break; } }
    }
    nloc = mine > 0u ? mine : 1u; nx = cnt > 0u ? cnt : 1u;
}

__device__ __forceinline__ void xcd_barrier(const XcdBarrier& b) {
    asm volatile("s_waitcnt vmcnt(0)" ::: "memory");
    __syncthreads();
    if (threadIdx.x == 0) {
        unsigned* bar = b.bar;
        __builtin_amdgcn_s_waitcnt(0);
        unsigned nloc = b.st[0], nx = b.st[1];
        if (nloc == 0u) { xcd_barrier_complete(bar, b.x, nloc, nx); b.st[0] = nloc; b.st[1] = nx; }
        const unsigned old = xb_add(&bar[XB_XSUB(b.x)], 1u);
        const unsigned gen = old / nloc;
        if (old + 1u == (gen + 1u) * nloc) {
            __builtin_amdgcn_fence(__ATOMIC_RELEASE, "agent");
            asm volatile("s_waitcnt vmcnt(0)" ::: "memory");
            const unsigned og = xb_add(&bar[XB_TOP], 1u);
            const unsigned tg = og / nx;
            if (og + 1u == (tg + 1u) * nx) xb_add(&bar[XB_TOPGEN], 1u);
            else XB_SPIN(xb_ld(&bar[XB_TOPGEN]) == tg, bar);
            __builtin_amdgcn_fence(__ATOMIC_ACQUIRE, "agent");
            xb_add(&bar[XB_XGEN(b.x)], 1u);
            asm volatile("s_waitcnt vmcnt(0)" ::: "memory");
        } else {
            XB_SPIN(xb_ld(&bar[XB_XGEN(b.x)]) == gen, bar);
            __builtin_amdgcn_fence(__ATOMIC_ACQUIRE, "agent");
            asm volatile("s_waitcnt vmcnt(0)" ::: "memory");
        }
    }
    __syncthreads();
}


__global__ void __launch_bounds__(512, 2) mega(Args a) {
    extern __shared__ __attribute__((aligned(16))) unsigned char lds_raw[];
    LAS unsigned char* lds = (LAS unsigned char*)lds_raw;
    cg::grid_group grid = cg::this_grid();
    const int tid = threadIdx.x, lane = tid & 63, wave = __builtin_amdgcn_readfirstlane(tid >> 6);
    const int lo = a.ph_lo, hi = a.ph_hi;
    volatile LAS unsigned* xst = (volatile LAS unsigned*)(lds + LDS_BYTES - 16);
    if (tid == 0) { xst[0] = 0u; xst[1] = 0u; }
    __syncthreads();
    if (hi - lo > 1) (void)xcd_barrier_post((unsigned*)(a.ws + OFF_BAR), xst);
    const float* mod = (const float*)(a.ws + OFF_MOD);
#ifndef PHMASK
#define PHMASK 0xfff
#endif
#define PH(k) (((PHMASK >> (k)) & 1) && lo <= (k) && (k) < hi)
#ifndef PROBE_A
#define PROBE_A -1
#define PROBE_B -1
#endif
    unsigned long long* stamps = (unsigned long long*)(a.ws + WS_NEED);
#define STAMP(k) do { if (PROBE_A >= 0 && blockIdx.x == 0 && tid == 0) stamps[k] = __builtin_amdgcn_s_memrealtime(); } while (0)
#define SEAM(k) do { if (PH(k) && PH((k) + 1)) { XcdBarrier xb_; xb_.bar = (unsigned*)(a.ws + OFF_BAR); xb_.x = xb_xcc_id(); xb_.st = (volatile LAS unsigned*)(lds + LDS_BYTES - 16); xcd_barrier(xb_); } STAMP((k) + 1); } while (0)
#ifdef MK_GRID_SYNC_FIRST
    if (hi - lo > 1) grid.sync();
#endif
    STAMP(0);
    if (PH(0)) phase0(a, lds, tid, lane, wave);
#ifdef DUP_P0
    if (PH(0)) { __syncthreads(); phase0(a, lds, tid, lane, wave); }
#endif
    SEAM(0);
    if (PH(1)) phase_norm<true, false>(a, lds, a.x, a.g_norm1, 0, DM, tid, lane, wave);
    SEAM(1);
    if (PH(2)) {
        if (blockIdx.x < NCOMBO) gate_prep(a, lds, blockIdx.x, tid);
        pg8::Gemm g{(const bf16_t*)(a.ws + OFF_HB), (const bf16_t*)(a.ws + OFF_WIN), MTOK, NPC, DM, DM}; pg8::StaticOrder S; S.init(MTOK, NPC, gridDim.x, blockIdx.x);
#ifdef SKEW_TICKS
        if ((blockIdx.x >> 3) & 1) { const unsigned long long t0 = __builtin_amdgcn_s_memrealtime(); while (__builtin_amdgcn_s_memrealtime() - t0 < SKEW_TICKS) __builtin_amdgcn_s_sleep(8); }
#endif
        pg8::EpiBf16<0> E{(bf16_t*)(a.ws + OFF_P), NPC, nullptr, 0, 0, 1.f};
        pg8::gemm_phase<pg8::EpiBf16<0>, pg8::StaticOrder, GEMM_ALIGN, true>(lds, g, S, E);
#ifdef DUP_GEMM_IN
        pg8::gemm_phase<pg8::EpiBf16<0>, pg8::StaticOrder, true, true>(lds, g, S, E);
#endif
#ifdef DUP_GEMM_HALFK
        { pg8::Gemm g2{(const bf16_t*)(a.ws + OFF_HB), (const bf16_t*)(a.ws + OFF_WIN), MTOK, NPC, DUP_GEMM_HALFK, DM};
          pg8::EpiBf16<0> E2{(bf16_t*)(a.ws + OFF_CST), 0, nullptr, 0, 0, 1.f};
          pg8::gemm_phase<pg8::EpiBf16<0>, pg8::StaticOrder, true, true>(lds, g2, S, E2); }
#endif
    }
    SEAM(2);
    if (PH(3)) mlstm_delta(a, lds, tid, lane, wave);
#if defined(DUP_MIX) || defined(DUP_A1)
    if (PH(3)) { __syncthreads(); mlstm_delta(a, lds, tid, lane, wave); }
#endif
    SEAM(3);
    if (PH(4)) { mlstm_scan(a, tid); natten(a, lds, tid, lane, wave); }
#if defined(DUP_MIX) || defined(DUP_NAT)
    if (PH(4)) { __syncthreads(); natten(a, lds, tid, lane, wave); }
#endif
    SEAM(4);
    if (PH(5)) mlstm_out(a, lds, tid, lane, wave);
#ifdef DUP_MIX
    if (PH(5)) { __syncthreads(); mlstm_out(a, lds, tid, lane, wave); }
#endif
    SEAM(5);
    if (PH(6)) {
        __syncthreads();
        pg8::Gemm g{(const bf16_t*)(a.ws + OFF_HB), (const bf16_t*)(a.ws + OFF_WOUT), MTOK, DM, DM, DM}; pg8::StaticOrder S; S.init(MTOK, DM, gridDim.x, blockIdx.x);
        EpiResid16<false> E{a.x, (bf16_t*)(a.ws + OFF_X1B), mod + 2 * DM};
        pg8::gemm_phase<EpiResid16<false>, pg8::StaticOrder, GEMM_ALIGN, true>(lds, g, S, E);
    }
    SEAM(6);
    if (PH(7)) phase_norm<false, true>(a, lds, a.ws + OFF_X1B, a.g_norm2, 3 * DM, 4 * DM, tid, lane, wave);
    SEAM(7);
    if (PH(8)) {
        pg8::Gemm g{(const bf16_t*)(a.ws + OFF_HB), (const bf16_t*)(a.ws + OFF_WUP), MTOK, NUP, DM, DM}; pg8::StaticOrder S; S.init(MTOK, NUP, gridDim.x, blockIdx.x);
#ifdef SKEW_TICKS
        if ((blockIdx.x >> 3) & 1) { const unsigned long long t0 = __builtin_amdgcn_s_memrealtime(); while (__builtin_amdgcn_s_memrealtime() - t0 < SKEW_TICKS) __builtin_amdgcn_s_sleep(8); }
#endif
        EpiGlu E{(bf16_t*)(a.ws + OFF_ACT), a.conv_w, a.conv_b, (float*)(a.ws + OFF_EDGE), (LAS float*)(lds + 131072)};
        pg8::gemm_phase<EpiGlu, pg8::StaticOrder, true, true>(lds, g, S, E);
    }
    SEAM(8);
    if (PH(10)) {
        pg8::Gemm g{(const bf16_t*)(a.ws + OFF_ACT), (const bf16_t*)(a.ws + OFF_WDN), MTOK, DM, DFF, DFF}; pg8::StaticOrder S; S.init(MTOK, DM, gridDim.x, blockIdx.x);
        { pg8::Unit uu; int lastpm = -1; for (int i = 0; S.next(i, uu); ++i) if (uu.pm != lastpm) { glu_fixup(a, uu.pm, tid); lastpm = uu.pm; } }
        __threadfence(); __syncthreads();
        EpiResid16<true> E{a.ws + OFF_X1B, (bf16_t*)(a.ws + OFF_X1B), mod + 5 * DM};
        pg8::gemm_phase<EpiResid16<true>, pg8::StaticOrder, GEMM_ALIGN, true>(lds, g, S, E);
    }
    SEAM(10);
    if (PH(11)) phase_final(a, lane, wave);
    if (PROBE_A >= 0) { __syncthreads(); if (blockIdx.x == 0 && tid == 0) { stamps[12] = __builtin_amdgcn_s_memrealtime();
        const float Ta = (float)(stamps[PROBE_A + 1] - stamps[PROBE_A]) * 0.01f, Tb = (float)(stamps[PROBE_B + 1] - stamps[PROBE_B]) * 0.01f;
        a.out[0] += Ta + Tb; for (int i = 1; i <= 1000; ++i) a.out[i] += 0.5f * Tb; } }
#undef PH
#undef SEAM
}

extern "C" void kernel_launch(void* const* d_in, const int* in_sizes, int n_in, void* d_out, int out_size, void* d_ws, size_t ws_size, hipStream_t stream) {
    static int grid = 0;
    if (grid == 0) {
        if (n_in != 16 || out_size != MTOK * DM || ws_size < WS_NEED) { fprintf(stderr, "kernel_launch: unexpected problem (n_in %d out %d ws %zu need %zu)\n", n_in, out_size, ws_size, (size_t)WS_NEED); grid = -1; return; }
        int dev = 0, cus = 0, per_cu = 0;
        hipGetDevice(&dev); hipDeviceGetAttribute(&cus, hipDeviceAttributeMultiprocessorCount, dev);
        if (hipFuncSetAttribute((const void*)mega, hipFuncAttributeMaxDynamicSharedMemorySize, LDS_BYTES) != hipSuccess) { fprintf(stderr, "kernel_launch: hipFuncSetAttribute failed\n"); grid = -1; return; }
        if (hipOccupancyMaxActiveBlocksPerMultiprocessor(&per_cu, (const void*)mega, 512, LDS_BYTES) != hipSuccess || per_cu < 1) { fprintf(stderr, "kernel_launch: occupancy query failed (%d)\n", per_cu); (void)hipGetLastError(); per_cu = 1; }
        grid = cus * (per_cu > 1 ? 1 : per_cu);
        fprintf(stderr, "kernel_launch: grid %d (cus %d, per_cu %d)\n", grid, cus, per_cu);
        if (grid < 4 || (grid & 3) != 0) { fprintf(stderr, "kernel_launch: this kernel needs a workgroup count that is a multiple of 4 (neighbourhood-attention head pairs are fixed per workgroup); nothing launched\n"); grid = -1; return; }
    }
    if (grid < 0) return;
    Args a{};
    a.x = (const float*)d_in[0]; a.c = (const float*)d_in[1]; a.w_ada = (const float*)d_in[2]; a.b_ada = (const float*)d_in[3]; a.g_norm1 = (const float*)d_in[4];
    a.w_in = (const float*)d_in[5]; a.b_gates = (const float*)d_in[6]; a.g_head_a = (const float*)d_in[7]; a.rpb = (const float*)d_in[8]; a.w_out = (const float*)d_in[9];
    a.g_norm2 = (const float*)d_in[10]; a.w_up = (const float*)d_in[11]; a.conv_w = (const float*)d_in[12]; a.conv_b = (const float*)d_in[13]; a.w_down = (const float*)d_in[14];
    a.g_final = (const float*)d_in[15]; a.out = (float*)d_out; a.ws = (unsigned char*)d_ws;
#if MK_PER_PHASE
    for (int p = 0; p < NPH; ++p) { a.ph_lo = p; a.ph_hi = p + 1; hipLaunchKernelGGL(mega, dim3(grid), dim3(512), LDS_BYTES, stream, a); }
#else
    a.ph_lo = 0; a.ph_hi = NPH;
    if (hipMemsetAsync((char*)d_ws + OFF_BAR, 0, BAR_BYTES, stream) != hipSuccess) { fprintf(stderr, "kernel_launch: memset failed\n"); return; }
    void* args[] = {&a};
    hipError_t e = hipLaunchCooperativeKernel((const void*)mega, dim3(grid), dim3(512), args, LDS_BYTES, stream);
    if (e != hipSuccess) fprintf(stderr, "kernel_launch: cooperative launch failed: %s (grid %d)\n", hipGetErrorString(e), grid);
#endif
}
```

```cpp
#include <hip/hip_runtime.h>
#include <hip/hip_cooperative_groups.h>
#include <cstdio>
#include <cstdint>
namespace cg = cooperative_groups;
#define MK_PER_PHASE 0
namespace pg8 {
#define PG8_LAS __attribute__((address_space(3)))
typedef unsigned short bf16_t;
typedef short bf16x8 __attribute__((ext_vector_type(8)));
typedef float f32x4 __attribute__((ext_vector_type(4)));
typedef unsigned u32x4 __attribute__((ext_vector_type(4)));
constexpr int BM = 256, BK = 64, HALF = 128, HTB = HALF * BK * 2  , STAGE_BYTES = 8 * HTB, NXCD = 8, WGM = 8;

__host__ __device__ __forceinline__ int lds_byte(int r, int c) { const int st = (r >> 4) * 2 + (c >> 5), rr = r & 15, cc = c & 31, ob = rr * 64 + cc * 2; return st * 1024 + (ob ^ (((ob >> 9) & 1) << 5)); }
__host__ __device__ __forceinline__ void stage_rc(int b, int& R, int& C) { const int st = b / 1024, sb = b % 1024, swz = sb ^ (((sb >> 9) & 1) << 5); R = (st >> 1) * 16 + swz / 64; C = (st & 1) * 32 + (swz % 64) / 2; }
__host__ __device__ __forceinline__ int perm32(int rho) { const int n = rho >> 4, i = rho & 15; return 8 * (i >> 2) + 4 * n + (i & 3); }

struct Unit { int pm, pn; };
struct Gemm { const bf16_t* A; const bf16_t* Bt; int M, N, K, lda; };

struct StaticOrder {
    int nM, nN, nwg, G, c;
    __host__ __device__ void init(int M, int N, int G_, int c_) { nM = M / BM; nN = N / BM; nwg = nM * nN; G = G_; c = c_; }
    __host__ __device__ bool next(int i, Unit& u) const {
        const long L = (long)i * G + c; if (L >= nwg) return false;
        int wgid = (int)L; { const int q = nwg / NXCD, r = nwg % NXCD, xcd = wgid % NXCD, off = wgid / NXCD; wgid = (xcd < r ? xcd * (q + 1) : r * (q + 1) + (xcd - r) * q) + off; }
        const int nig = WGM * nN, gid = wgid / nig, fm = gid * WGM, gsz = (nM - fm) < WGM ? (nM - fm) : WGM;
        u.pm = fm + ((wgid % nig) % gsz); u.pn = (wgid % nig) / gsz; return true;
    }
    __device__ __forceinline__ void a_ready(const Unit&) const {}
    __device__ __forceinline__ void done(const Unit&) const {}
};

__device__ __forceinline__ unsigned cvt_pk_bf16(float lo, float hi) { unsigned r; asm volatile("v_cvt_pk_bf16_f32 %0, %1, %2" : "=v"(r) : "v"(lo), "v"(hi)); return r; }
typedef float f32x2 __attribute__((ext_vector_type(2)));
__device__ __forceinline__ f32x2 gelu_pk(f32x2 v) {
    const f32x2 av = __builtin_elementwise_abs(v), d = av * 0.2316418882f + 1.0f;
    f32x2 t; t.x = __builtin_amdgcn_rcpf(d.x); t.y = __builtin_amdgcn_rcpf(d.y);
    f32x2 q = t * 0.5307027145f + (-0.7265760135f); q = q * t + 0.7107068705f; q = q * t + (-0.142248368f); q = q * t + 0.127414796f; q = q * t;
    const f32x2 s = (v * v) * (-0.72134752044f);
    f32x2 e; e.x = __builtin_amdgcn_exp2f(s.x); e.y = __builtin_amdgcn_exp2f(s.y);
    const f32x2 m = v * (q * e), r = v - m;
    f32x2 o; o.x = v.x < 0.f ? m.x : r.x; o.y = v.y < 0.f ? m.y : r.y; return o;
}

template <int ACT  > struct EpiBf16 {
    static constexpr bool PERM = true, AFTER_DRAIN = false; static_assert(ACT == 0 || ACT == 1, "EpiBf16: ACT is 0 (none) or 1 (gelu_pk)");
    bf16_t* O; int ldc; const float* bias; int split_cols; size_t split_stride; float scale0;
    __device__ __forceinline__ void operator()(const f32x4 (&acc)[2][2][4][2], const Unit& u, int wr, int wc, int fr, int fq) const {
        const int row0 = u.pm * BM + wr * 64 + fr; int colt = u.pn * BM; bf16_t* base = O;
        float sc = 1.f; if (split_cols) { const int t = colt / split_cols; base += (size_t)t * split_stride; colt -= t * split_cols; if (t == 0) sc = scale0; }
        const int col0 = colt + wc * 32 + 8 * fq, bcol0 = u.pn * BM + wc * 32 + 8 * fq;
        f32x4 bv[2][2];
#pragma unroll
        for (int bj = 0; bj < 2; ++bj)
#pragma unroll
            for (int n = 0; n < 2; ++n) bv[bj][n] = bias ? *(const f32x4*)(bias + bcol0 + bj * HALF + 4 * n) : (f32x4){0.f, 0.f, 0.f, 0.f};
#pragma unroll
        for (int ai = 0; ai < 2; ++ai)
#pragma unroll
            for (int m = 0; m < 4; ++m) { bf16_t* rowp = base + (size_t)(row0 + ai * HALF + m * 16) * ldc + col0;
#pragma unroll
                for (int bj = 0; bj < 2; ++bj) { f32x4 v0 = acc[ai][bj][m][0] + bv[bj][0], v1 = acc[ai][bj][m][1] + bv[bj][1];
                    if (ACT == 1) { f32x2 a = gelu_pk((f32x2){v0[0], v0[1]}), b = gelu_pk((f32x2){v0[2], v0[3]}), c = gelu_pk((f32x2){v1[0], v1[1]}), d = gelu_pk((f32x2){v1[2], v1[3]});
                        v0 = (f32x4){a.x, a.y, b.x, b.y}; v1 = (f32x4){c.x, c.y, d.x, d.y}; }
                    v0 = v0 * sc; v1 = v1 * sc; u32x4 w; w.x = cvt_pk_bf16(v0[0], v0[1]); w.y = cvt_pk_bf16(v0[2], v0[3]); w.z = cvt_pk_bf16(v1[0], v1[1]); w.w = cvt_pk_bf16(v1[2], v1[3]);
                    *(u32x4*)(rowp + bj * HALF) = w; } }
    }
};

template <class Epi, class Sched, bool ALIGN_EPI = false, bool SP2 = false>
__device__ __forceinline__ void gemm_phase(PG8_LAS unsigned char* lds, const Gemm g, const Sched& S, const Epi& E) {
    const int tid = threadIdx.x, wid = __builtin_amdgcn_readfirstlane(tid >> 6), lane = tid & 63, wr = wid >> 2, wc = wid & 3, fr = lane & 15, fq = lane >> 4;
    const int K = g.K, nt = K / BK;
    unsigned voffA[2], voffB[2];
#pragma unroll
    for (int i = 0; i < 2; ++i) { int R, C; stage_rc(tid * 16 + i * 8192, R, C); const int Rb = Epi::PERM ? ((R & ~31) + perm32(R & 31)) : R;
        voffA[i] = (unsigned)(R * g.lda + C) * 2u; voffB[i] = (unsigned)(Rb * K + C) * 2u; }
    const size_t kstep = (size_t)(BK * 2);
    const size_t hstep = (size_t)HALF * K * 2;
    const size_t tstep = 2 * hstep; const size_t hstepA = (size_t)HALF * g.lda * 2, tstepA = 2 * hstepA;
    const unsigned ldsw = (unsigned)wid * 1024u;
    const int aoff = lds_byte(wr * 64 + fr, fq * 8), boff = lds_byte(wc * 32 + fr, fq * 8);
#define PG8_SA(b, h) (((b) * 2 + (h)) * HTB)
#define PG8_SB(b, h) ((4 + (b) * 2 + (h)) * HTB)
#define PG8_STAGE(bufoff, gbase, voff) do { _Pragma("unroll") for (int _i = 0; _i < 2; ++_i) \
        __builtin_amdgcn_global_load_lds((const unsigned*)((const char*)(gbase) + (voff)[_i]), (PG8_LAS unsigned*)(lds + (bufoff) + ldsw + _i * 8192), 16, 0, 0); } while (0)
#define PG8_LDA(dst, b, h) do { _Pragma("unroll") for (int m = 0; m < 4; ++m) _Pragma("unroll") for (int k = 0; k < 2; ++k) dst[m][k] = *(const PG8_LAS bf16x8*)(lds + PG8_SA(b, h) + aoff + m * 2048 + k * 1024); } while (0)
#define PG8_LDB(dst, b, h) do { _Pragma("unroll") for (int n = 0; n < 2; ++n) _Pragma("unroll") for (int k = 0; k < 2; ++k) dst[n][k] = *(const PG8_LAS bf16x8*)(lds + PG8_SB(b, h) + boff + n * 2048 + k * 1024); } while (0)
#define PG8_MMA(ai, bj, At, Bt) do { __builtin_amdgcn_s_setprio(1); _Pragma("unroll") for (int m = 0; m < 4; ++m) _Pragma("unroll") for (int n = 0; n < 2; ++n) _Pragma("unroll") for (int k = 0; k < 2; ++k) \
        acc[ai][bj][m][n] = __builtin_amdgcn_mfma_f32_16x16x32_bf16(Bt[n][k], At[m][k], acc[ai][bj][m][n], 0, 0, 0); __builtin_amdgcn_s_setprio(0); } while (0)
#define PG8_WAIT_V(n) asm volatile("s_waitcnt vmcnt(" #n ")" ::: "memory")
#define PG8_WAIT_L(n) asm volatile("s_waitcnt lgkmcnt(" #n ")" ::: "memory")
#define PG8_BAR __builtin_amdgcn_s_barrier()
#define PG8_SCHED __builtin_amdgcn_sched_barrier(0)
    Unit cur, nxt; int ui = 0;
    if (!S.next(0, cur)) return;
    f32x4 acc[2][2][4][2];
#pragma unroll
    for (int a = 0; a < 2; ++a)
#pragma unroll
        for (int b = 0; b < 2; ++b)
#pragma unroll
            for (int m = 0; m < 4; ++m)
#pragma unroll
                for (int n = 0; n < 2; ++n) acc[a][b][m][n] = (f32x4){0.f, 0.f, 0.f, 0.f};
    bf16x8 At[4][2], B0[2][2], B1[2][2];
    const char* cA = (const char*)g.A + (size_t)cur.pm * tstepA; const char* cB = (const char*)g.Bt + (size_t)cur.pn * tstep;
    S.a_ready(cur);
    if constexpr (SP2) {
        PG8_STAGE(PG8_SB(0, 0), cB, voffB); PG8_STAGE(PG8_SB(0, 1), cB + hstep, voffB); PG8_STAGE(PG8_SA(0, 0), cA, voffA); PG8_STAGE(PG8_SA(0, 1), cA + hstepA, voffA);
        if (wr == 1) PG8_BAR;
        PG8_WAIT_V(2); PG8_BAR;
        PG8_STAGE(PG8_SB(1, 0), cB + kstep, voffB); PG8_STAGE(PG8_SA(1, 0), cA + kstep, voffA); PG8_STAGE(PG8_SB(1, 1), cB + hstep + kstep, voffB);
        PG8_WAIT_V(6); PG8_BAR;
    } else {
        PG8_STAGE(PG8_SB(0, 0), cB, voffB); PG8_STAGE(PG8_SA(0, 0), cA, voffA); PG8_STAGE(PG8_SB(0, 1), cB + hstep, voffB); PG8_STAGE(PG8_SA(0, 1), cA + hstepA, voffA);
        if (wr == 1) PG8_BAR;
        PG8_WAIT_V(4); PG8_BAR;
        PG8_STAGE(PG8_SB(1, 0), cB + kstep, voffB); PG8_STAGE(PG8_SA(1, 0), cA + kstep, voffA); PG8_STAGE(PG8_SB(1, 1), cB + hstep + kstep, voffB);
        PG8_WAIT_V(6); PG8_BAR;
    }
    for (;;) {
        const bool has_next = S.next(ui + 1, nxt);
        const char* nA = has_next ? (const char*)g.A + (size_t)nxt.pm * tstepA : cA; const char* nB = has_next ? (const char*)g.Bt + (size_t)nxt.pn * tstep : cB;
        for (int t = 0; t < nt; t += 2) {
            const bool last = (t == nt - 2);
            const char* a1 = cA + (size_t)(t + 1) * kstep;
            const char* a2 = last ? nA : cA + (size_t)(t + 2) * kstep; const char* b2 = last ? nB : cB + (size_t)(t + 2) * kstep;
            const char* a3 = a2 + kstep; const char* b3 = b2 + kstep;
            if (last && has_next) S.a_ready(nxt);
            if constexpr (SP2) {
            PG8_LDB(B0, 0, 0); PG8_LDB(B1, 0, 1); PG8_SCHED; PG8_LDA(At, 0, 0); PG8_STAGE(PG8_SA(1, 1), a1 + hstepA, voffA);
            PG8_WAIT_V(8); PG8_WAIT_L(0); PG8_BAR; PG8_MMA(0, 0, At, B0); PG8_MMA(0, 1, At, B1); PG8_BAR; PG8_SCHED;
            PG8_LDA(At, 0, 1); PG8_STAGE(PG8_SB(0, 0), b2, voffB); PG8_STAGE(PG8_SB(0, 1), b2 + hstep, voffB); PG8_STAGE(PG8_SA(0, 0), a2, voffA);
            PG8_WAIT_V(8); PG8_WAIT_L(0); PG8_BAR; PG8_MMA(1, 0, At, B0); PG8_MMA(1, 1, At, B1); PG8_BAR; PG8_SCHED;
            PG8_LDB(B0, 1, 0); PG8_LDB(B1, 1, 1); PG8_SCHED; PG8_LDA(At, 1, 0); PG8_STAGE(PG8_SA(0, 1), a2 + hstepA, voffA);
            PG8_WAIT_V(8); PG8_WAIT_L(0); PG8_BAR; PG8_MMA(0, 0, At, B0); PG8_MMA(0, 1, At, B1); PG8_BAR; PG8_SCHED;
            PG8_LDA(At, 1, 1); PG8_STAGE(PG8_SB(1, 0), b3, voffB); PG8_STAGE(PG8_SB(1, 1), b3 + hstep, voffB); PG8_STAGE(PG8_SA(1, 0), a3, voffA);
            PG8_WAIT_V(8); PG8_WAIT_L(0); PG8_BAR; PG8_MMA(1, 0, At, B0); PG8_MMA(1, 1, At, B1); PG8_BAR; PG8_SCHED;
            } else {
            PG8_LDB(B0, 0, 0); PG8_SCHED; PG8_LDA(At, 0, 0); PG8_STAGE(PG8_SA(1, 1), a1 + hstepA, voffA);
            PG8_WAIT_L(8); PG8_BAR; PG8_WAIT_L(0); PG8_MMA(0, 0, At, B0); PG8_BAR; PG8_SCHED;
            PG8_LDB(B1, 0, 1); PG8_STAGE(PG8_SB(0, 0), b2, voffB);
            PG8_BAR; PG8_WAIT_L(0); PG8_MMA(0, 1, At, B1); PG8_BAR;
            PG8_LDA(At, 0, 1); PG8_STAGE(PG8_SA(0, 0), a2, voffA);
            PG8_BAR; PG8_WAIT_L(0); PG8_MMA(1, 0, At, B0); PG8_BAR; PG8_SCHED;
            PG8_STAGE(PG8_SB(0, 1), b2 + hstep, voffB);
            PG8_WAIT_V(6); PG8_BAR; PG8_MMA(1, 1, At, B1); PG8_BAR;
            PG8_LDB(B0, 1, 0); PG8_SCHED; PG8_LDA(At, 1, 0); PG8_STAGE(PG8_SA(0, 1), a2 + hstepA, voffA);
            PG8_WAIT_L(8); PG8_BAR; PG8_WAIT_L(0); PG8_MMA(0, 0, At, B0); PG8_BAR; PG8_SCHED;
            PG8_LDB(B1, 1, 1); PG8_STAGE(PG8_SB(1, 0), b3, voffB);
            PG8_BAR; PG8_WAIT_L(0); PG8_MMA(0, 1, At, B1); PG8_BAR;
            PG8_LDA(At, 1, 1); PG8_STAGE(PG8_SA(1, 0), a3, voffA);
            PG8_BAR; PG8_WAIT_L(0); PG8_MMA(1, 0, At, B0); PG8_BAR; PG8_SCHED;
            PG8_STAGE(PG8_SB(1, 1), b3 + hstep, voffB);
            PG8_WAIT_V(6); PG8_BAR; PG8_MMA(1, 1, At, B1); PG8_BAR;
            }
        }
        if constexpr (ALIGN_EPI) { if (wr == 0) PG8_BAR; }
        if constexpr (!Epi::AFTER_DRAIN) { E(acc, cur, wr, wc, fr, fq); S.done(cur); }
        if (!has_next) break;
#pragma unroll
        for (int a = 0; a < 2; ++a)
#pragma unroll
            for (int b = 0; b < 2; ++b)
#pragma unroll
                for (int m = 0; m < 4; ++m)
#pragma unroll
                    for (int n = 0; n < 2; ++n) acc[a][b][m][n] = (f32x4){0.f, 0.f, 0.f, 0.f};
        cur = nxt; cA = nA; cB = nB; ++ui;
        if constexpr (ALIGN_EPI) { if (wr == 1) PG8_BAR; }
    }
    PG8_WAIT_V(0);
    if constexpr (!ALIGN_EPI) { if (wr == 0) PG8_BAR; }
    PG8_BAR;
    if constexpr (Epi::AFTER_DRAIN) { E.fused(acc, cur, wr, wc, fr, fq, lds, wid, lane); S.done(cur); }
#undef PG8_SA
#undef PG8_SB
#undef PG8_STAGE
#undef PG8_LDA
#undef PG8_LDB
#undef PG8_MMA
#undef PG8_WAIT_V
#undef PG8_WAIT_L
#undef PG8_BAR
#undef PG8_SCHED
}
}

#define DI __device__ __forceinline__
#define LAS __attribute__((address_space(3)))
typedef unsigned short bf16_t;
typedef short bf16x8 __attribute__((ext_vector_type(8)));
typedef short s16x4 __attribute__((ext_vector_type(4)));
typedef short v4i16_t __attribute__((ext_vector_type(4)));
typedef float f32x4 __attribute__((ext_vector_type(4)));
typedef unsigned u32x4 __attribute__((ext_vector_type(4)));
typedef unsigned u32x2 __attribute__((ext_vector_type(2)));

constexpr int NB = 2, SEQ = 8192, DM = 2048, MTOK = NB * SEQ, NPC = 7168, WIN_LD = 7184, DFF = 5632, NUP = 2 * DFF, NMOD = 6 * DM;
constexpr int LCH = 256, NCH = SEQ / LCH, EEXT = 272, ST_ELEMS = EEXT * 256, NCOMBO = 16;
constexpr float EPSN = 1e-6f;
#ifndef MK_PER_PHASE
#define MK_PER_PHASE 0
#endif
#ifndef GEMM_ALIGN
#define GEMM_ALIGN true
#endif
constexpr int NPH = 12;
constexpr int LDS_BYTES = 147456;

constexpr size_t OFF_P = 0;
constexpr size_t OFF_CST = OFF_P + (size_t)MTOK * NPC * 2;
constexpr size_t OFF_WIN = OFF_CST + (size_t)NCOMBO * NCH * ST_ELEMS * 2;
constexpr size_t OFF_WOUT = OFF_WIN + (size_t)NPC * DM * 2;
constexpr size_t OFF_R0END = OFF_WOUT + (size_t)DM * DM * 2;
constexpr size_t OFF_UG = 0;
constexpr size_t OFF_ACT = 0;
constexpr size_t OFF_EDGE = OFF_ACT + (size_t)MTOK * DFF * 2;
constexpr size_t OFF_X1B = OFF_EDGE + (size_t)3 * 64 * 2 * DFF * 4;
static_assert(OFF_X1B + (size_t)MTOK * DM * 2 <= OFF_CST + (size_t)NCOMBO * NCH * ST_ELEMS * 2, "x1b must stay below the weight copies that are still live in phase 6");
constexpr size_t OFF_WUP = OFF_UG + (size_t)MTOK * NUP * 2;
constexpr size_t OFF_WDN = OFF_WUP + (size_t)NUP * DM * 2;
constexpr size_t OFF_HB = OFF_WDN + (size_t)DM * DFF * 2;
constexpr size_t OFF_MOD = OFF_HB + (size_t)MTOK * DM * 2;
constexpr size_t OFF_GATES = OFF_MOD + 131072;
constexpr size_t OFF_UL = OFF_GATES + (size_t)MTOK * 16 * 4;
constexpr size_t OFF_ML = OFF_UL + (size_t)NCOMBO * SEQ * 4;
constexpr size_t OFF_EMT = OFF_ML + (size_t)NCOMBO * SEQ * 4;
constexpr size_t OFF_MPREV = OFF_EMT + (size_t)NCOMBO * SEQ * 4;
constexpr size_t OFF_MEND = OFF_MPREV + 4096;
constexpr size_t WS_NEED = OFF_MEND + 4096;
constexpr size_t OFF_BAR = WS_NEED + 4096;
constexpr size_t BAR_BYTES = 16384;
static_assert(OFF_R0END <= OFF_WUP, "overlay region");
static_assert(OFF_BAR + BAR_BYTES <= 536870912ull, "workspace budget");

struct Args {
    const float *x, *c, *w_ada, *b_ada, *g_norm1, *w_in, *b_gates, *g_head_a, *rpb, *w_out, *g_norm2, *w_up, *conv_w, *conv_b, *w_down, *g_final;
    float* out; unsigned char* ws; int ph_lo, ph_hi;
};

DI float bf2f(unsigned v) { return __uint_as_float(v << 16); }
DI unsigned f2bf(float f) { unsigned u = __float_as_uint(f); return (u + 0x7fffu + ((u >> 16) & 1u)) >> 16; }
typedef __bf16 bf16x2_hw __attribute__((ext_vector_type(2)));
typedef float f32x2_hw __attribute__((ext_vector_type(2)));
DI unsigned pk2(float lo, float hi) { const f32x2_hw v = {lo, hi}; const bf16x2_hw b = __builtin_convertvector(v, bf16x2_hw); return __builtin_bit_cast(unsigned, b); }
DI float wave_sum(float v) {
#pragma unroll
    for (int o = 1; o < 64; o <<= 1) v += __shfl_xor(v, o);
    return v;
}
DI s16x4 tr_read(const LAS unsigned char* p) { return __builtin_bit_cast(s16x4, __builtin_amdgcn_ds_read_tr16_b64_v4i16((LAS v4i16_t*)p)); }
DI bf16x8 tr_frag(const LAS unsigned char* base, int pitch, int rowA, int rowB, int col, int qin, int pin) {
    const s16x4 lo = tr_read(base + (rowA + qin) * pitch + (col + 4 * pin) * 2);
    const s16x4 hi = tr_read(base + (rowB + qin) * pitch + (col + 4 * pin) * 2);
    return (bf16x8){lo[0], lo[1], lo[2], lo[3], hi[0], hi[1], hi[2], hi[3]};
}
DI bf16x8 ld_frag(const LAS unsigned char* p) { return *(const LAS bf16x8*)p; }
#define MFMA16(a, b, c) __builtin_amdgcn_mfma_f32_16x16x32_bf16((a), (b), (c), 0, 0, 0)
DI bf16x8 pack8(const f32x4& a, const f32x4& b) {
    u32x4 w; w.x = pk2(a[0], a[1]); w.y = pk2(a[2], a[3]); w.z = pk2(b[0], b[1]); w.w = pk2(b[2], b[3]);
    return __builtin_bit_cast(bf16x8, w);
}
DI bf16x8 scale8(const bf16x8& q, float s) {
    const u32x4 u = __builtin_bit_cast(u32x4, q); u32x4 w;
#pragma unroll
    for (int i = 0; i < 4; ++i) w[i] = pk2(bf2f(u[i] & 0xffffu) * s, bf2f(u[i] >> 16) * s);
    return __builtin_bit_cast(bf16x8, w);
}
template <int ROWS, int COLS> DI void stage_tile(LAS unsigned char* dst, int lp, const bf16_t* src, int gp, int tid, int nthr) {
    constexpr int VPR = COLS / 8, NV = ROWS * VPR;
    int t0 = tid; asm volatile("" : "+v"(t0));
#pragma unroll 2
    for (int v = t0; v < NV; v += nthr) { const int r = v / VPR, cv = v % VPR;
        const u32x4 d = *(const u32x4*)(src + (r * gp + cv * 8)); *(LAS u32x4*)(dst + r * lp + cv * 16) = d; }
}

struct EpiResid {
    static constexpr bool PERM = false, AFTER_DRAIN = false;
    const float* res; float* out; const float* gate;
    __device__ __forceinline__ void operator()(const pg8::f32x4 (&acc)[2][2][4][2], const pg8::Unit& u, int wr, int wc, int fr, int fq) const {
        const int row0 = u.pm * 256 + wr * 64 + fr, col0 = u.pn * 256 + wc * 32 + 4 * fq, bb = u.pm >> 5;
        f32x4 gv[2][2];
#pragma unroll
        for (int bj = 0; bj < 2; ++bj)
#pragma unroll
            for (int n = 0; n < 2; ++n) gv[bj][n] = *(const f32x4*)(gate + (size_t)bb * NMOD + col0 + bj * 128 + n * 16);
#pragma unroll
        for (int ai = 0; ai < 2; ++ai)
#pragma unroll
            for (int m = 0; m < 4; ++m) { const size_t ro = (size_t)(row0 + ai * 128 + m * 16) * DM + col0;
#pragma unroll
                for (int bj = 0; bj < 2; ++bj)
#pragma unroll
                    for (int n = 0; n < 2; ++n) { const size_t o = ro + bj * 128 + n * 16; const f32x4 r = *(const f32x4*)(res + o); *(f32x4*)(out + o) = r + gv[bj][n] * acc[ai][bj][m][n]; } }
    }
};

template <bool RES_BF16> struct EpiResid16 {
    static constexpr bool PERM = true, AFTER_DRAIN = false;
    const void* res; bf16_t* out; const float* gate;
    __device__ __forceinline__ void operator()(const pg8::f32x4 (&acc)[2][2][4][2], const pg8::Unit& u, int wr, int wc, int fr, int fq) const {
        const int row0 = u.pm * 256 + wr * 64 + fr, col0 = u.pn * 256 + wc * 32 + 8 * fq, bb = u.pm >> 5;
        f32x4 gv[2][2];
#pragma unroll
        for (int bj = 0; bj < 2; ++bj)
#pragma unroll
            for (int n = 0; n < 2; ++n) gv[bj][n] = *(const f32x4*)(gate + (size_t)bb * NMOD + col0 + bj * 128 + 4 * n);
#pragma unroll
        for (int ai = 0; ai < 2; ++ai)
#pragma unroll
            for (int m = 0; m < 4; ++m) { const size_t ro = (size_t)(row0 + ai * 128 + m * 16) * DM + col0;
#pragma unroll
                for (int bj = 0; bj < 2; ++bj) { const size_t o = ro + bj * 128; f32x4 r0, r1;
                    if (RES_BF16) { const u32x4 rv = *(const u32x4*)((const bf16_t*)res + o);
                        r0 = (f32x4){bf2f(rv.x & 0xffffu), bf2f(rv.x >> 16), bf2f(rv.y & 0xffffu), bf2f(rv.y >> 16)}; r1 = (f32x4){bf2f(rv.z & 0xffffu), bf2f(rv.z >> 16), bf2f(rv.w & 0xffffu), bf2f(rv.w >> 16)}; }
                    else { r0 = *(const f32x4*)((const float*)res + o); r1 = *(const f32x4*)((const float*)res + o + 4); }
                    r0 = r0 + gv[bj][0] * acc[ai][bj][m][0]; r1 = r1 + gv[bj][1] * acc[ai][bj][m][1];
                    u32x4 w; w.x = pg8::cvt_pk_bf16(r0[0], r0[1]); w.y = pg8::cvt_pk_bf16(r0[2], r0[3]); w.z = pg8::cvt_pk_bf16(r1[0], r1[1]); w.w = pg8::cvt_pk_bf16(r1[2], r1[3]);
                    *(u32x4*)(out + o) = w; } }
    }
};

constexpr size_t EDGE_STRIDE = (size_t)64 * 2 * DFF;
struct EpiGlu {
    static constexpr bool PERM = true, AFTER_DRAIN = false;
    bf16_t* ACT; const float* cw; const float* cb; float* edge; LAS float* xg;
    __device__ __forceinline__ void operator()(const pg8::f32x4 (&acc)[2][2][4][2], const pg8::Unit& u, int wr, int wc, int fr, int fq) const {
        const int lane = threadIdx.x & 63, fl = wc * 32 + 8 * fq, f0 = u.pn * 128 + fl;
        float w0[8], w1[8], w2[8], bb[8];
#pragma unroll
        for (int k = 0; k < 8; k += 4) { const f32x4 a0 = *(const f32x4*)(cw + f0 + k), a1 = *(const f32x4*)(cw + DFF + f0 + k), a2 = *(const f32x4*)(cw + 2 * DFF + f0 + k), a3 = *(const f32x4*)(cb + f0 + k);
#pragma unroll
            for (int i = 0; i < 4; ++i) { w0[k + i] = a0[i]; w1[k + i] = a1[i]; w2[k + i] = a2[i]; bb[k + i] = a3[i]; } }
#pragma unroll
        for (int ai = 0; ai < 2; ++ai) { const int bi = 2 * ai + wr;
            if (fr == 0) { *(LAS f32x4*)(xg + bi * 128 + fl) = acc[ai][1][0][0]; *(LAS f32x4*)(xg + bi * 128 + fl + 4) = acc[ai][1][0][1]; }
            if (fr == 15) { *(LAS f32x4*)(xg + (4 + bi) * 128 + fl) = acc[ai][1][3][0]; *(LAS f32x4*)(xg + (4 + bi) * 128 + fl + 4) = acc[ai][1][3][1]; } }
        asm volatile("s_waitcnt lgkmcnt(0)" ::: "memory"); __builtin_amdgcn_s_barrier(); asm volatile("" ::: "memory");
#pragma unroll
        for (int ai = 0; ai < 2; ++ai) { const int bi = 2 * ai + wr;
            f32x4 xp[2], xn[2];
#pragma unroll
            for (int n = 0; n < 2; ++n) { xp[n] = (f32x4){0.f, 0.f, 0.f, 0.f}; xn[n] = (f32x4){0.f, 0.f, 0.f, 0.f};
                if (fr == 0 && bi > 0) xp[n] = *(const LAS f32x4*)(xg + (4 + bi - 1) * 128 + fl + 4 * n);
                if (fr == 15 && bi < 3) xn[n] = *(const LAS f32x4*)(xg + (bi + 1) * 128 + fl + 4 * n); }
            unsigned o[4][4];
#pragma unroll
            for (int n = 0; n < 2; ++n)
#pragma unroll
                for (int i = 0; i < 4; i += 2) {
                    float r[4][2];
#pragma unroll
                    for (int e = 0; e < 2; ++e) { const int k = 4 * n + i + e;
                        float g[4], up[4], dn[4];
#pragma unroll
                        for (int m = 0; m < 4; ++m) { g[m] = acc[ai][1][m][n][i + e];
                            up[m] = __int_as_float(__builtin_amdgcn_update_dpp(0, __float_as_int(g[m]), 0x121, 0xf, 0xf, false));
                            dn[m] = __int_as_float(__builtin_amdgcn_update_dpp(0, __float_as_int(g[m]), 0x12F, 0xf, 0xf, false)); }
#pragma unroll
                        for (int m = 0; m < 4; ++m) { const float pv = (fr == 0) ? (m > 0 ? up[m > 0 ? m - 1 : 0] : xp[n][i + e]) : up[m];
                            const float nv = (fr == 15) ? (m < 3 ? dn[m < 3 ? m + 1 : 3] : xn[n][i + e]) : dn[m];
                            r[m][e] = w0[k] * pv + w1[k] * g[m] + w2[k] * nv + bb[k]; } }
#pragma unroll
                    for (int m = 0; m < 4; ++m) { const pg8::f32x2 gl = pg8::gelu_pk((pg8::f32x2){r[m][0], r[m][1]});
                        const bool e0 = (bi == 0 && m == 0 && fr == 0), e1 = (bi == 3 && m == 3 && fr == 15);
                        if (e0 || e1) { float* ep = edge + ((size_t)(u.pm * 2 + (e1 ? 1 : 0)) * DFF + f0 + 4 * n + i);
                            ep[0] = r[m][0]; ep[1] = r[m][1]; ep[EDGE_STRIDE] = acc[ai][1][m][n][i]; ep[EDGE_STRIDE + 1] = acc[ai][1][m][n][i + 1];
                            ep[2 * EDGE_STRIDE] = acc[ai][0][m][n][i]; ep[2 * EDGE_STRIDE + 1] = acc[ai][0][m][n][i + 1]; }
                        o[m][2 * n + (i >> 1)] = pg8::cvt_pk_bf16(gl.x * acc[ai][0][m][n][i], gl.y * acc[ai][0][m][n][i + 1]); }
                }
#pragma unroll
            for (int m = 0; m < 4; ++m) { const int row = u.pm * 256 + ai * 128 + wr * 64 + m * 16 + fr;
                u32x4 w; w.x = o[m][0]; w.y = o[m][1]; w.z = o[m][2]; w.w = o[m][3];
                *(u32x4*)(ACT + (size_t)row * DFF + f0) = w; }
        }
    }
};
DI void glu_fixup(const Args& a, int pm, int tid) {
    const float* edge = (const float*)(a.ws + OFF_EDGE); bf16_t* ACT = (bf16_t*)(a.ws + OFF_ACT);
    for (int idx = tid; idx < 2 * DFF; idx += 512) { const int e = idx / DFF, f = idx % DFF, t = pm * 256 + 255 * e;
        const float part = edge[(size_t)(pm * 2 + e) * DFF + f], uu = edge[2 * EDGE_STRIDE + (size_t)(pm * 2 + e) * DFF + f];
        float miss = 0.f;
        if (e == 0) { if ((t & (SEQ - 1)) != 0) miss = a.conv_w[f] * edge[EDGE_STRIDE + (size_t)((pm - 1) * 2 + 1) * DFF + f]; }
        else { if (((t + 1) & (SEQ - 1)) != 0) miss = a.conv_w[2 * DFF + f] * edge[EDGE_STRIDE + (size_t)((pm + 1) * 2) * DFF + f]; }
        const float g = part + miss;
        ACT[(size_t)t * DFF + f] = (bf16_t)f2bf(0.5f * g * (1.f + erff(g * 0.70710678118654752f)) * uu); }
}

DI void tr_block(const float* src, int ldw, bf16_t* dst, int ldd, float scale, LAS float* scr, int lane) {
#pragma unroll 8
    for (int i = 0; i < 32; ++i) { const int kk = 2 * i + (lane >> 5); scr[kk * 33 + (lane & 31)] = src[(size_t)kk * ldw + (lane & 31)]; }
    asm volatile("s_waitcnt lgkmcnt(0)" ::: "memory");
    const int c = lane & 7;
#pragma unroll
    for (int j = 0; j < 4; ++j) { const int n = (lane >> 3) + 8 * j; const LAS float* s = scr + (8 * c) * 33 + n;
        u32x4 o; o.x = pk2(s[0 * 33] * scale, s[1 * 33] * scale); o.y = pk2(s[2 * 33] * scale, s[3 * 33] * scale); o.z = pk2(s[4 * 33] * scale, s[5 * 33] * scale); o.w = pk2(s[6 * 33] * scale, s[7 * 33] * scale);
        *(u32x4*)(dst + (size_t)n * ldd + 8 * c) = o; }
    asm volatile("s_waitcnt lgkmcnt(0)" ::: "memory");
}
DI void phase0(const Args& a, LAS unsigned char* lds, int tid, int lane, int wave) {
    LAS float* sc = (LAS float*)lds;
    LAS float* red = sc + 4096;
    float* mod = (float*)(a.ws + OFF_MOD);
    for (int i = tid; i < 4096; i += 512) { const float v = a.c[i]; sc[i] = v / (1.f + __expf(-v)); }
    __syncthreads();
    for (int item = blockIdx.x; item < 256; item += gridDim.x) {
        const int n0 = item * 48;
        if (tid < 384) {
            const int cq = tid % 12, ks = tid / 12;
            f32x4 a0 = {0.f, 0.f, 0.f, 0.f}, a1 = {0.f, 0.f, 0.f, 0.f};
            const float* wp = a.w_ada + (size_t)(ks * 64) * NMOD + n0 + 4 * cq;
#pragma unroll 8
            for (int kk = 0; kk < 64; ++kk) { const f32x4 w = *(const f32x4*)(wp + (size_t)kk * NMOD); const float s0 = sc[ks * 64 + kk], s1 = sc[2048 + ks * 64 + kk]; a0 += s0 * w; a1 += s1 * w; }
            LAS float* rp = red + (ks * 12 + cq) * 8;
            *(LAS f32x4*)rp = a0; *(LAS f32x4*)(rp + 4) = a1;
        }
        __syncthreads();
        if (tid < 96) { const int cq = tid >> 3, j = tid & 7; float s = 0.f;
            for (int ks = 0; ks < 32; ++ks) s += red[(ks * 12 + cq) * 8 + j];
            const int bb = j >> 2, col = n0 + 4 * cq + (j & 3); mod[bb * NMOD + col] = s + a.b_ada[col]; }
        __syncthreads();
    }
    LAS float* scr = (LAS float*)(lds + 32768 + wave * 8448);
    bf16_t* WinT = (bf16_t*)(a.ws + OFF_WIN); bf16_t* WoutT = (bf16_t*)(a.ws + OFF_WOUT); bf16_t* WupT = (bf16_t*)(a.ws + OFF_WUP); bf16_t* WdnT = (bf16_t*)(a.ws + OFF_WDN);
    constexpr int I_IN = 32 * (NPC / 32), I_OUT = 32 * (DM / 32), I_UP = 32 * (NUP / 32), I_DN = (DFF / 64) * (DM / 32);
    const int gw = blockIdx.x * 8 + wave, NGW = gridDim.x * 8;
    for (int it = gw; it < I_IN + I_OUT + I_UP + I_DN; it += NGW) {
        int r = it;
        if (r < I_IN) { const int nblk = NPC / 32, kb = r / nblk, nb = r % nblk, n0 = nb * 32, ns = n0 < 4096 ? n0 : n0 + 16;
            tr_block(a.w_in + (size_t)(kb * 64) * WIN_LD + ns, WIN_LD, WinT + (size_t)n0 * DM + kb * 64, DM, (n0 >= 1024 && n0 < 2048) ? 0.0625f : 1.f, scr, lane); continue; }
        r -= I_IN;
        if (r < I_OUT) { const int nblk = DM / 32, kb = r / nblk, nb = r % nblk;
            tr_block(a.w_out + (size_t)(kb * 64) * DM + nb * 32, DM, WoutT + (size_t)(nb * 32) * DM + kb * 64, DM, 1.f, scr, lane); continue; }
        r -= I_OUT;
        if (r < I_UP) { const int nblk = NUP / 32, kb = r / nblk, nb = r % nblk, n0 = nb * 32, pn = n0 >> 8, j0 = n0 & 255, ns = (j0 < 128) ? pn * 128 + j0 : DFF + pn * 128 + j0 - 128;
            tr_block(a.w_up + (size_t)(kb * 64) * NUP + ns, NUP, WupT + (size_t)n0 * DM + kb * 64, DM, 1.f, scr, lane); continue; }
        r -= I_UP;
        { const int nblk = DM / 32, kb = r / nblk, nb = r % nblk;
            tr_block(a.w_down + (size_t)(kb * 64) * DM + nb * 32, DM, WdnT + (size_t)(nb * 32) * DFF + kb * 64, DFF, 1.f, scr, lane); }
    }
}

DI float gate_reduce16(float (&g16)[16], int lane) {
#pragma unroll
    for (int i = 0; i < 8; ++i) { const bool hi = lane & 32; const float snd = hi ? g16[i] : g16[i + 8], keep = hi ? g16[i + 8] : g16[i]; g16[i] = keep + __shfl_xor(snd, 32); }
#pragma unroll
    for (int i = 0; i < 4; ++i) { const bool hi = lane & 16; const float snd = hi ? g16[i] : g16[i + 4], keep = hi ? g16[i + 4] : g16[i]; g16[i] = keep + __shfl_xor(snd, 16); }
#pragma unroll
    for (int i = 0; i < 2; ++i) { const bool hi = lane & 8; const float snd = hi ? g16[i] : g16[i + 2], keep = hi ? g16[i + 2] : g16[i]; g16[i] = keep + __shfl_xor(snd, 8); }
    { const bool hi = lane & 4; const float snd = hi ? g16[0] : g16[1], keep = hi ? g16[1] : g16[0]; g16[0] = keep + __shfl_xor(snd, 4); }
    g16[0] += __shfl_xor(g16[0], 2); g16[0] += __shfl_xor(g16[0], 1);
    return g16[0];
}
template <bool GATES, bool IN_BF16> DI void phase_norm(const Args& a, LAS unsigned char* lds, const void* xin_, const float* gn, int sh_off, int sc_off, int tid, int lane, int wave) {
    const float* xin = (const float*)xin_; const bf16_t* xin16 = (const bf16_t*)xin_;
    const float* mod = (const float*)(a.ws + OFF_MOD);
    bf16_t* Hb = (bf16_t*)(a.ws + OFF_HB);
    float* gates = (float*)(a.ws + OFF_GATES);
    LAS float* wg = (LAS float*)lds;
    if (GATES) {
        __syncthreads();
        for (int idx = tid; idx < 2048 * 16; idx += 512) { const int k = idx >> 4, i = idx & 15; wg[i * 2052 + k] = a.w_in[(size_t)k * WIN_LD + 4096 + i]; }
        __syncthreads();
    }
    constexpr int R = GATES ? 2 : 4;
    const int gw = blockIdx.x * 8 + wave, NGW = gridDim.x * 8;
    int curb = -1; f32x4 gs[8], sh[8];
    for (int m = R * gw; m < MTOK; m += R * NGW) {
        const int bb = m >> 13;
        if (bb != curb) { curb = bb;
#pragma unroll
            for (int j = 0; j < 8; ++j) { const int k = 4 * lane + 256 * j; const f32x4 g = *(const f32x4*)(gn + k), s = *(const f32x4*)(mod + bb * NMOD + sc_off + k);
                gs[j] = g * (1.f + s); sh[j] = *(const f32x4*)(mod + bb * NMOD + sh_off + k); } }
        f32x4 v[R][8];
#pragma unroll
        for (int r = 0; r < R; ++r)
#pragma unroll
            for (int j = 0; j < 8; ++j) {
                if (IN_BF16) { const u32x2 p0 = *(const u32x2*)(xin16 + (size_t)(m + r) * DM + 4 * lane + 256 * j);
                    v[r][j] = (f32x4){bf2f(p0.x & 0xffffu), bf2f(p0.x >> 16), bf2f(p0.y & 0xffffu), bf2f(p0.y >> 16)}; }
                else v[r][j] = *(const f32x4*)(xin + (size_t)(m + r) * DM + 4 * lane + 256 * j); }
#pragma unroll
        for (int r = 0; r < R; ++r) { float ss = 0.f;
#pragma unroll
            for (int j = 0; j < 8; ++j) ss += (v[r][j].x * v[r][j].x + v[r][j].y * v[r][j].y) + (v[r][j].z * v[r][j].z + v[r][j].w * v[r][j].w);
            const float rstd = rsqrtf(wave_sum(ss) * (1.f / DM) + EPSN);
#pragma unroll
            for (int j = 0; j < 8; ++j) { v[r][j] = v[r][j] * rstd * gs[j] + sh[j];
                u32x2 o; o.x = pk2(v[r][j].x, v[r][j].y); o.y = pk2(v[r][j].z, v[r][j].w); *(u32x2*)(Hb + (size_t)(m + r) * DM + 4 * lane + 256 * j) = o; } }
        if (GATES) {
            float ga[16], gb[16];
#pragma unroll
            for (int i = 0; i < 16; ++i) { float s0 = 0.f, s1 = 0.f;
#pragma unroll
                for (int j = 0; j < 8; ++j) { const f32x4 w = *(const LAS f32x4*)(wg + i * 2052 + 4 * lane + 256 * j);
                    s0 += (v[0][j].x * w.x + v[0][j].y * w.y) + (v[0][j].z * w.z + v[0][j].w * w.w); s1 += (v[R - 1][j].x * w.x + v[R - 1][j].y * w.y) + (v[R - 1][j].z * w.z + v[R - 1][j].w * w.w); }
                ga[i] = s0; gb[i] = s1; __builtin_amdgcn_sched_barrier(0); }
            const float r0 = gate_reduce16(ga, lane), r1 = gate_reduce16(gb, lane);
            if ((lane & 3) == 0) { const int gi = ((lane >> 5) & 1) * 8 + ((lane >> 4) & 1) * 4 + ((lane >> 3) & 1) * 2 + ((lane >> 2) & 1); const float bg = a.b_gates[gi];
                gates[(size_t)m * 16 + gi] = r0 + bg; gates[(size_t)(m + 1) * 16 + gi] = r1 + bg; }
        }
    }
}

DI void gate_prep(const Args& a, LAS unsigned char* lds, int combo, int tid) {
    const float* gates = (const float*)(a.ws + OFF_GATES);
    float* ulA = (float*)(a.ws + OFF_UL); float* MlA = (float*)(a.ws + OFF_ML); float* emtA = (float*)(a.ws + OFF_EMT);
    float* mprevA = (float*)(a.ws + OFF_MPREV); float* mendA = (float*)(a.ws + OFF_MEND);
    LAS float* sT = (LAS float*)lds; LAS float* sM = sT + 512; LAS float* sG = sM + 512; LAS float* sX = sG + 32; LAS float* sMp = sX + 32; LAS float* sMe = sMp + 32;
    const int b = combo >> 3, dir = (combo >> 2) & 1, h = combo & 3;
    const int ci = dir * 8 + h, cf = dir * 8 + 4 + h, cs = tid >> 4;
    float li[16], bl[16], cm[16];
    float run = 0.f;
#pragma unroll
    for (int i = 0; i < 16; ++i) { const int tau = tid * 16 + i, t = dir ? SEQ - 1 - tau : tau; const float* gp = gates + (size_t)(b * SEQ + t) * 16;
        li[i] = gp[ci]; const float f = gp[cf]; const float lf = fminf(f, 0.f) - log1pf(__expf(-fabsf(f))); run += lf; bl[i] = run; }
    sT[tid] = run; __syncthreads();
    float base = 0.f; for (int j = cs * 16; j < tid; ++j) base += sT[j];
    float mx = -3.0e38f;
#pragma unroll
    for (int i = 0; i < 16; ++i) { bl[i] += base; li[i] -= bl[i]; mx = fmaxf(mx, li[i]); cm[i] = mx; }
    sM[tid] = mx; __syncthreads();
    float mbase = -3.0e38f; for (int j = cs * 16; j < tid; ++j) mbase = fmaxf(mbase, sM[j]);
    if (tid < 32) { float g = 0.f, xm = -3.0e38f; for (int j = 0; j < 16; ++j) { g += sT[tid * 16 + j]; xm = fmaxf(xm, sM[tid * 16 + j]); } sG[tid] = g; sX[tid] = xm; }
    __syncthreads();
    if (tid == 0) { float m = -1e30f; for (int c = 0; c < 32; ++c) { sMp[c] = m; const float me = fmaxf(m, sX[c]); sMe[c] = me; m = sG[c] + me; } }
    __syncthreads();
    const float mp = sMp[cs];
#pragma unroll
    for (int i = 0; i < 16; ++i) { const int tau = tid * 16 + i, t = dir ? SEQ - 1 - tau : tau; const float Ml = fmaxf(mp, fmaxf(cm[i], mbase));
        ulA[combo * SEQ + t] = li[i]; MlA[combo * SEQ + t] = Ml; emtA[combo * SEQ + t] = __expf(-(bl[i] + Ml)); }
    if ((tid & 15) == 0) { const int c = dir ? NCH - 1 - cs : cs; mprevA[combo * NCH + c] = mp; mendA[combo * NCH + c] = sMe[cs]; }
    __syncthreads();
}

DI void mlstm_delta(const Args& a, LAS unsigned char* lds, int tid, int lane, int wave) {
    const bf16_t* P = (const bf16_t*)(a.ws + OFF_P); bf16_t* cst = (bf16_t*)(a.ws + OFF_CST);
    const float* ulA = (const float*)(a.ws + OFF_UL); const float* mendA = (const float*)(a.ws + OFF_MEND);
    const int l15 = lane & 15, quad = lane >> 4, qin = l15 >> 2, pin = l15 & 3;
    constexpr int BUFB = 2 * 34816;
    LAS float* wS = (LAS float*)(lds + 2 * BUFB);
    const short one = (l15 == 0) ? (short)0x3F80 : (short)0;
    const bf16x8 ones = {one, one, one, one, one, one, one, one};
    for (int item = blockIdx.x; item < NCOMBO * NCH; item += gridDim.x) {
        const int combo = item / NCH, c = item % NCH, b = combo >> 3, h = combo & 3;
        const float mend = mendA[combo * NCH + c];
        __syncthreads();
        if (tid < 256) wS[tid] = __expf(ulA[combo * SEQ + c * LCH + tid] - mend);
        f32x4 acc[17][2];
#pragma unroll
        for (int m = 0; m < 17; ++m) { acc[m][0] = (f32x4){0.f, 0.f, 0.f, 0.f}; acc[m][1] = (f32x4){0.f, 0.f, 0.f, 0.f}; }
        const bf16_t* Pk = P + (size_t)(b * SEQ + c * LCH) * NPC + 1024 + h * 256;
        u32x4 pre[8];
#define DL_LOAD(sb_) do { int t0_ = tid; asm volatile("" : "+v"(t0_)); const bf16_t* src_ = Pk + (unsigned)(((sb_) * 64 + (t0_ >> 5)) * NPC + (t0_ & 31) * 8); \
        _Pragma("unroll") for (int i_ = 0; i_ < 4; ++i_) { pre[i_] = *(const u32x4*)(src_ + i_ * 16 * NPC); pre[4 + i_] = *(const u32x4*)(src_ + i_ * 16 * NPC + 1024); } } while (0)
#define DL_STORE(sb_) do { int t0_ = tid; asm volatile("" : "+v"(t0_)); LAS unsigned char* d_ = lds + ((sb_) & 1) * BUFB + (t0_ >> 5) * 544 + (t0_ & 31) * 16; \
        _Pragma("unroll") for (int i_ = 0; i_ < 4; ++i_) { const float w_ = wS[(sb_) * 64 + (t0_ >> 5) + 16 * i_]; \
            *(LAS bf16x8*)(d_ + i_ * 16 * 544) = scale8(__builtin_bit_cast(bf16x8, pre[i_]), w_); *(LAS u32x4*)(d_ + 34816 + i_ * 16 * 544) = pre[4 + i_]; } } while (0)
        DL_LOAD(0);
        __syncthreads();
        DL_STORE(0);
        __syncthreads();
#pragma unroll 1
        for (int sb = 0; sb < 4; ++sb) {
            const LAS unsigned char* Kt = lds + (sb & 1) * BUFB; const LAS unsigned char* Vt = Kt + 34816;
            if (sb + 1 < 4) DL_LOAD(sb + 1);
#pragma unroll 1
            for (int kk = 0; kk < 2; ++kk) {
                bf16x8 bfr[2];
#pragma unroll
                for (int n = 0; n < 2; ++n) bfr[n] = tr_frag(Kt, 544, kk * 32 + 4 * quad, kk * 32 + 16 + 4 * quad, wave * 32 + n * 16, qin, pin);
#pragma unroll
                for (int m = 0; m < 16; ++m) { const bf16x8 afr = tr_frag(Vt, 544, kk * 32 + 4 * quad, kk * 32 + 16 + 4 * quad, m * 16, qin, pin);
                    acc[m][0] = MFMA16(bfr[0], afr, acc[m][0]); acc[m][1] = MFMA16(bfr[1], afr, acc[m][1]); if ((m & 3) == 3) __builtin_amdgcn_sched_barrier(0); }
                acc[16][0] = MFMA16(bfr[0], ones, acc[16][0]); acc[16][1] = MFMA16(bfr[1], ones, acc[16][1]);
            }
            if (sb + 1 < 4) DL_STORE(sb + 1);
            __syncthreads();
        }
#undef DL_LOAD
#undef DL_STORE
        int loff = l15 * 256 + wave * 32 + 4 * quad; asm volatile("" : "+v"(loff));
        bf16_t* dst = cst + (size_t)item * ST_ELEMS + loff;
#pragma unroll
        for (int m = 0; m < 17; ++m) {
#pragma unroll
            for (int n = 0; n < 2; ++n) { u32x2 w; w.x = pk2(acc[m][n][0], acc[m][n][1]); w.y = pk2(acc[m][n][2], acc[m][n][3]); *(u32x2*)(dst + (16 * m) * 256 + 16 * n) = w; }
            __builtin_amdgcn_sched_barrier(0); }
    }
}

DI void mlstm_scan(const Args& a, int tid) {
    bf16_t* cst = (bf16_t*)(a.ws + OFF_CST);
    const float* mprevA = (const float*)(a.ws + OFF_MPREV); const float* mendA = (const float*)(a.ws + OFF_MEND);
    constexpr int VPS = ST_ELEMS / 8;
    const int gt = blockIdx.x * 512 + tid, NT = gridDim.x * 512;
    for (int v = gt; v < NCOMBO * VPS; v += NT) {
        const int combo = v / VPS, vi = v % VPS, dir = (combo >> 2) & 1;
        float st[8];
#pragma unroll
        for (int i = 0; i < 8; ++i) st[i] = 0.f;
        bf16_t* base = cst + (size_t)combo * NCH * ST_ELEMS + vi * 8;
        for (int cs0 = 0; cs0 < NCH; cs0 += 8) {
            u32x4 d[8]; float dec[8];
#pragma unroll
            for (int q = 0; q < 8; ++q) { const int c = dir ? NCH - 1 - (cs0 + q) : cs0 + q;
                d[q] = *(const u32x4*)(base + (size_t)c * ST_ELEMS); dec[q] = __expf(mprevA[combo * NCH + c] - mendA[combo * NCH + c]); }
#pragma unroll
            for (int q = 0; q < 8; ++q) { const int c = dir ? NCH - 1 - (cs0 + q) : cs0 + q;
                u32x4 o;
#pragma unroll
                for (int i = 0; i < 4; ++i) { o[i] = pk2(st[2 * i], st[2 * i + 1]); st[2 * i] = dec[q] * st[2 * i] + bf2f(d[q][i] & 0xffffu); st[2 * i + 1] = dec[q] * st[2 * i + 1] + bf2f(d[q][i] >> 16); }
                *(u32x4*)(base + (size_t)c * ST_ELEMS) = o; }
        }
    }
}

DI void nat_scores(f32x4 (&st)[4][2], const LAS unsigned char* T, const bf16x8 (&qf)[4], int kc0, int l15, int quad) {
#pragma unroll
    for (int k4 = 0; k4 < 4; ++k4)
#pragma unroll
        for (int mi = 0; mi < 2; ++mi) { f32x4 s = {0.f, 0.f, 0.f, 0.f};
#pragma unroll
            for (int ks = 0; ks < 4; ++ks) { s = MFMA16(ld_frag(T + (k4 * 64 + kc0 + 16 * mi + l15) * 272 + (ks * 32 + quad * 8) * 2), qf[ks], s); if (ks == 1) __builtin_amdgcn_sched_barrier(0); }
            st[k4][mi] = s; __builtin_amdgcn_sched_barrier(0); }
}
DI float nat_mask(f32x4 (&st)[4][2], const LAS float* rpbS, int kr0, int rs, int r, const bool (&sel)[4], const int (&dcb)[4], float scale) {
    float mx = -3.0e38f;
#pragma unroll
    for (int k4 = 0; k4 < 4; ++k4) { const int dr = rs + kr0 + k4 - r + 7;
#pragma unroll
        for (int rr = 0; rr < 4; ++rr) { const float sv = (sel[rr] ? st[k4][0][rr] : st[k4][1][rr]) * scale + rpbS[dr * 31 + dcb[rr]]; st[k4][0][rr] = sv; mx = fmaxf(mx, sv); } }
    mx = fmaxf(mx, __shfl_xor(mx, 16)); mx = fmaxf(mx, __shfl_xor(mx, 32));
    return mx;
}
DI float nat_exp(bf16x8 (&pf)[4], f32x4 (&st)[4][2], const bool (&sel)[4], float m) {
    float sum = 0.f;
#pragma unroll
    for (int k4 = 0; k4 < 4; ++k4) { f32x4 p0, p1;
#pragma unroll
        for (int rr = 0; rr < 4; ++rr) { const float p = __expf(st[k4][0][rr] - m); sum += p; p0[rr] = sel[rr] ? p : 0.f; p1[rr] = sel[rr] ? 0.f : p; }
        pf[k4] = pack8(p0, p1); }
    return sum;
}
DI void nat_pv(f32x4 (&o)[8], const bf16x8 (&pf)[4], const LAS unsigned char* T, int kc0, int quad, int qin, int pin) {
#pragma unroll
    for (int k4 = 0; k4 < 4; ++k4) {
#pragma unroll
        for (int n = 0; n < 8; ++n) { o[n] = MFMA16(tr_frag(T + k4 * 64 * 272, 272, kc0 + 4 * quad, kc0 + 16 + 4 * quad, 16 * n, qin, pin), pf[k4], o[n]); if ((n & 3) == 3) __builtin_amdgcn_sched_barrier(0); } }
}
DI void natten(const Args& a, LAS unsigned char* lds, int tid, int lane, int wave) {
    const bf16_t* P = (const bf16_t*)(a.ws + OFF_P); bf16_t* mixed = (bf16_t*)(a.ws + OFF_HB);
    const int l15 = lane & 15, quad = lane >> 4, qin = l15 >> 2, pin = l15 & 3;
    const int hw = wave >> 2, j = wave & 3, htid = tid & 255;
    LAS unsigned char* T = lds + hw * 69632;
    LAS float* rpbS = (LAS float*)(lds + 139264) + hw * 480;
    const int kc0 = (j == 0) ? 0 : (j == 1) ? 8 : (j == 2) ? 24 : 32;
    const float scale = 0.08838834764831845f;
    const int nit = (1024 - (int)blockIdx.x + (int)gridDim.x - 1) / (int)gridDim.x;
    if (nit <= 0) return;
    __syncthreads();
    { const int h0 = (blockIdx.x & 3) * 2 + hw; for (int i = htid; i < 465; i += 256) rpbS[i] = a.rpb[h0 * 465 + i]; }
    u32x4 pre[16];
    const bool xmap = (gridDim.x == 256);
#define NAT_ITEM(k_) (xmap ? ((((int)blockIdx.x & 7) >> 2) << 9) | ((32 * (k_) + ((int)blockIdx.x >> 3)) << 2) | ((int)blockIdx.x & 3) : (int)blockIdx.x + (k_) * (int)gridDim.x)
#define NAT_LOAD(g_) do { const int it_ = NAT_ITEM((g_) >> 2), sp_ = (g_) & 3; const int b_ = it_ >> 9, r_ = (it_ >> 2) & 127, h_ = (it_ & 3) * 2 + hw; \
        const int rs_ = min(max(r_ - 4, 0), 120); int t0_ = htid; asm volatile("" : "+v"(t0_)); \
        const bf16_t* src_ = P + (unsigned)((b_ * SEQ + (rs_ + 4 * (sp_ & 1)) * 64) * NPC + ((sp_ >> 1) ? 6144 : 5120) + h_ * 128 + ((t0_ >> 4) * NPC + (t0_ & 15) * 8)); \
        _Pragma("unroll") for (int i_ = 0; i_ < 16; ++i_) pre[i_] = *(const u32x4*)(src_ + i_ * 16 * NPC); } while (0)
#define NAT_STORE() do { int t0_ = htid; asm volatile("" : "+v"(t0_)); LAS unsigned char* d_ = T + (t0_ >> 4) * 272 + (t0_ & 15) * 16; \
        _Pragma("unroll") for (int i_ = 0; i_ < 16; ++i_) *(LAS u32x4*)(d_ + i_ * 16 * 272) = pre[i_]; } while (0)
    NAT_LOAD(0); NAT_STORE();
    __syncthreads();
#pragma unroll 1
    for (int k = 0; k < nit; ++k) {
        const int item = NAT_ITEM(k);
        const int b = item >> 9, r = (item >> 2) & 127, h = (item & 3) * 2 + hw;
        int l15g = l15; asm volatile("" : "+v"(l15g));
        const int rs = min(max(r - 4, 0), 120), qcol = 16 * j + l15g;
        const int tokq = b * SEQ + r * 64 + qcol;
        bf16x8 qf[4]; f32x4 st[4][2]; bf16x8 pf0[4], pf1[4];
#pragma unroll
        for (int ks = 0; ks < 4; ++ks) qf[ks] = *(const bf16x8*)(P + (unsigned)(tokq * NPC + 4096 + h * 128 + ks * 32 + quad * 8));
        const int cs = min(max(qcol - 8, 0), 48);
        bool sel[4]; int dcb[4];
#pragma unroll
        for (int rr = 0; rr < 4; ++rr) { sel[rr] = (4 * quad + rr >= cs - kc0); dcb[rr] = kc0 + 4 * quad + rr + (sel[rr] ? 0 : 16) - qcol + 15; }
        NAT_LOAD(4 * k + 1);
        nat_scores(st, T, qf, kc0, l15, quad);
        const float m0 = nat_mask(st, rpbS, 0, rs, r, sel, dcb, scale);
        float sum0 = nat_exp(pf0, st, sel, m0);
        __syncthreads(); NAT_STORE(); __syncthreads();
        NAT_LOAD(4 * k + 2);
        nat_scores(st, T, qf, kc0, l15, quad);
        const float m1 = nat_mask(st, rpbS, 4, rs, r, sel, dcb, scale);
        const float M = fmaxf(m0, m1), f0 = __expf(m0 - M);
        float sum1 = nat_exp(pf1, st, sel, M);
        float tot = sum0 * f0 + sum1;
        tot += __shfl_xor(tot, 16); tot += __shfl_xor(tot, 32);
        const float inv = 1.f / tot;
        __syncthreads(); NAT_STORE(); __syncthreads();
        f32x4 o[8];
#pragma unroll
        for (int n = 0; n < 8; ++n) o[n] = (f32x4){0.f, 0.f, 0.f, 0.f};
        NAT_LOAD(4 * k + 3);
        nat_pv(o, pf0, T, kc0, quad, qin, pin);
#pragma unroll
        for (int n = 0; n < 8; ++n) o[n] = o[n] * f0;
        __syncthreads(); NAT_STORE(); __syncthreads();
        if (k + 1 < nit) NAT_LOAD(4 * k + 4);
        nat_pv(o, pf1, T, kc0, quad, qin, pin);
#pragma unroll
        for (int n = 0; n < 8; ++n) { u32x2 w; w.x = pk2(o[n][0] * inv, o[n][1] * inv); w.y = pk2(o[n][2] * inv, o[n][3] * inv);
            *(u32x2*)(mixed + (unsigned)(tokq * DM + 1024 + h * 128 + 16 * n + 4 * quad)) = w; }
        __syncthreads();
        if (k + 1 < nit) NAT_STORE();
        __syncthreads();
    }
#undef NAT_LOAD
#undef NAT_ITEM
#undef NAT_STORE
}

DI void mlstm_out(const Args& a, LAS unsigned char* lds, int tid, int lane, int wave) {
    const bf16_t* P = (const bf16_t*)(a.ws + OFF_P); const bf16_t* cst = (const bf16_t*)(a.ws + OFF_CST); bf16_t* mixed = (bf16_t*)(a.ws + OFF_HB);
    const float* ulA = (const float*)(a.ws + OFF_UL); const float* MlA = (const float*)(a.ws + OFF_ML); const float* emtA = (const float*)(a.ws + OFF_EMT);
    const float* mprevA = (const float*)(a.ws + OFF_MPREV);
    const int l15 = lane & 15, quad = lane >> 4, qin = l15 >> 2, pin = l15 & 3;
    constexpr int BUFB = 33792 + 34816;
    LAS float* ulS2 = (LAS float*)(lds + 2 * BUFB);
    const short one = (l15 == 0) ? (short)0x3F80 : (short)0;
    const bf16x8 ones = {one, one, one, one, one, one, one, one};
    for (int item = blockIdx.x; item < 512; item += gridDim.x) {
        const int bh = item >> 6, c = (item >> 1) & 31, half = item & 1, b = bh >> 2, h = bh & 3;
        int l15i = l15, tt = tid; asm volatile("" : "+v"(l15i), "+v"(tt));
        const int t_loc = 128 * half + 16 * wave + l15i;
        const size_t tok = (size_t)b * SEQ + c * LCH + t_loc;
        const int n0 = 2 * half + 2;
        __syncthreads();
        { const int d = tt >> 8; ulS2[tt] = ulA[((b * 2 + d) * 4 + h) * SEQ + c * LCH + (tt & 255)]; }
        u32x4 pre[8];
#define STEP_DEC(s_, dir_, st_, idx_) do { int r_ = (s_); dir_ = 0; if (r_ >= n0 + 4) { r_ -= n0 + 4; dir_ = 1; } const int nk_ = dir_ ? 4 - 2 * half : n0; st_ = (r_ >= nk_); idx_ = st_ ? r_ - nk_ : (dir_ ? 2 * half + r_ : r_); } while (0)
#define STEP_LOAD(s_) do { int dir_, st_, idx_; STEP_DEC(s_, dir_, st_, idx_); int t0_ = tid; asm volatile("" : "+v"(t0_)); \
        if (!st_) { const bf16_t* src_ = P + ((size_t)b * SEQ + c * LCH + 64 * idx_) * NPC + 1024 + h * 256 + ((t0_ >> 5) * NPC + (t0_ & 31) * 8); \
            _Pragma("unroll") for (int i_ = 0; i_ < 4; ++i_) { pre[i_] = *(const u32x4*)(src_ + i_ * 16 * NPC); pre[4 + i_] = *(const u32x4*)(src_ + i_ * 16 * NPC + 1024); } } \
        else { const bf16_t* src_ = cst + (size_t)(((b * 2 + dir_) * 4 + h) * NCH + c) * ST_ELEMS + 64 * idx_ + ((t0_ >> 3) * 256 + (t0_ & 7) * 8); \
            _Pragma("unroll") for (int i_ = 0; i_ < 4; ++i_) pre[i_] = *(const u32x4*)(src_ + i_ * 64 * 256); \
            if (t0_ < 128) pre[4] = *(const u32x4*)(src_ + 4 * 64 * 256); } } while (0)
#define STEP_STORE(s_) do { int dir_, st_, idx_; STEP_DEC(s_, dir_, st_, idx_); LAS unsigned char* bp_ = lds + ((s_) & 1) * BUFB; int t0_ = tid; asm volatile("" : "+v"(t0_)); \
        if (!st_) { LAS unsigned char* d_ = bp_ + (t0_ >> 5) * 528 + (t0_ & 31) * 16; \
            _Pragma("unroll") for (int i_ = 0; i_ < 4; ++i_) { *(LAS u32x4*)(d_ + i_ * 16 * 528) = pre[i_]; *(LAS u32x4*)(bp_ + 33792 + ((t0_ >> 5) + 16 * i_) * 544 + (t0_ & 31) * 16) = pre[4 + i_]; } } \
        else { LAS unsigned char* d_ = bp_ + (t0_ >> 3) * 144 + (t0_ & 7) * 16; \
            _Pragma("unroll") for (int i_ = 0; i_ < 4; ++i_) *(LAS u32x4*)(d_ + i_ * 64 * 144) = pre[i_]; \
            if (t0_ < 128) *(LAS u32x4*)(d_ + 4 * 64 * 144) = pre[4]; } } while (0)
        bf16x8 qf[8];
        { int qo = h * 256 + quad * 8; asm volatile("" : "+v"(qo)); const bf16_t* qp = P + tok * NPC + qo;
#pragma unroll
          for (int ks = 0; ks < 8; ++ks) qf[ks] = *(const bf16x8*)(qp + ks * 32); }
        STEP_LOAD(0); STEP_STORE(0);
        __syncthreads();
        f32x4 acc[17]; float Ml = 0.f, emt = 1.f, aa = 0.f;
#pragma unroll 1
        for (int s = 0; s < 14; ++s) {
            int dir, st, idx; STEP_DEC(s, dir, st, idx);
            const LAS unsigned char* T0 = lds + (s & 1) * BUFB; const LAS unsigned char* T1 = T0 + 33792;
            const LAS float* ulS = ulS2 + dir * 256;
            if (s == 0 || s == n0 + 4) {
                const int combo = (b * 2 + dir) * 4 + h;
                Ml = MlA[combo * SEQ + c * LCH + t_loc]; emt = emtA[combo * SEQ + c * LCH + t_loc]; aa = __expf(mprevA[combo * NCH + c] - Ml);
#pragma unroll
                for (int m = 0; m < 17; ++m) acc[m] = (f32x4){0.f, 0.f, 0.f, 0.f};
            }
            if (s + 1 < 14) STEP_LOAD(s + 1);
            if (!st && (dir ? (64 * idx + 63 >= 128 * half + 16 * wave) : (64 * idx <= 128 * half + 16 * wave + 15))) {
                const int jb = idx;
                f32x4 sc[4];
#pragma unroll
                for (int mi = 0; mi < 4; ++mi) sc[mi] = (f32x4){0.f, 0.f, 0.f, 0.f};
#pragma unroll
                for (int mi = 0; mi < 4; ++mi) {
#pragma unroll
                    for (int ks = 0; ks < 8; ++ks) { sc[mi] = MFMA16(ld_frag(T0 + (16 * mi + l15) * 528 + (32 * ks + 8 * quad) * 2), qf[ks], sc[mi]); if (ks == 3) __builtin_amdgcn_sched_barrier(0); }
                    __builtin_amdgcn_sched_barrier(0); }
#pragma unroll
                for (int mi = 0; mi < 4; ++mi)
#pragma unroll
                    for (int rr = 0; rr < 4; ++rr) { const int s_loc = 64 * jb + 16 * mi + 4 * quad + rr; const bool valid = dir ? (s_loc >= t_loc) : (s_loc <= t_loc);
                        const float wgt = valid ? __expf(ulS[s_loc] - Ml) : 0.f; sc[mi][rr] *= wgt; }
#pragma unroll
                for (int kk = 0; kk < 2; ++kk) { const bf16x8 pf = pack8(sc[2 * kk], sc[2 * kk + 1]);
                    bf16x8 f0 = tr_frag(T1, 544, 32 * kk + 4 * quad, 32 * kk + 16 + 4 * quad, 0, qin, pin), f1 = tr_frag(T1, 544, 32 * kk + 4 * quad, 32 * kk + 16 + 4 * quad, 16, qin, pin);
#pragma unroll
                    for (int n = 0; n < 16; n += 2) {
                        bf16x8 g0 = f0, g1 = f1;
                        if (n + 2 < 16) { g0 = tr_frag(T1, 544, 32 * kk + 4 * quad, 32 * kk + 16 + 4 * quad, 16 * (n + 2), qin, pin); g1 = tr_frag(T1, 544, 32 * kk + 4 * quad, 32 * kk + 16 + 4 * quad, 16 * (n + 3), qin, pin); }
                        acc[n] = MFMA16(f0, pf, acc[n]); acc[n + 1] = MFMA16(f1, pf, acc[n + 1]);
                        f0 = g0; f1 = g1; __builtin_amdgcn_sched_barrier(0); }
                    acc[16] = MFMA16(ones, pf, acc[16]); }
            } else if (st) {
                const int db = idx;
                bf16x8 aq[2];
                aq[0] = (db == 0) ? qf[0] : (db == 1) ? qf[2] : (db == 2) ? qf[4] : qf[6];
                aq[1] = (db == 0) ? qf[1] : (db == 1) ? qf[3] : (db == 2) ? qf[5] : qf[7];
                aq[0] = scale8(aq[0], aa); aq[1] = scale8(aq[1], aa);
#pragma unroll
                for (int kk = 0; kk < 2; ++kk) {
                    const LAS unsigned char* sp = T0 + l15 * 144 + (32 * kk + 8 * quad) * 2;
                    bf16x8 f0 = ld_frag(sp), f1 = ld_frag(sp + 16 * 144);
#pragma unroll
                    for (int m = 0; m < 16; m += 2) {
                        bf16x8 g0 = f0, g1 = f1;
                        if (m + 2 < 17) g0 = ld_frag(sp + 16 * (m + 2) * 144);
                        if (m + 3 < 17) g1 = ld_frag(sp + 16 * (m + 3) * 144);
                        acc[m] = MFMA16(f0, aq[kk], acc[m]); acc[m + 1] = MFMA16(f1, aq[kk], acc[m + 1]);
                        f0 = g0; f1 = g1; __builtin_amdgcn_sched_barrier(0); }
                    acc[16] = MFMA16(f0, aq[kk], acc[16]); }
            }
            if (s + 1 < 14) STEP_STORE(s + 1);
            if (s == n0 + 3 || s == 13) {
                const float den = __shfl(acc[16][0], l15);
                const float dn = 1.f / fmaxf(fabsf(den), emt);
                int moff = h * 256 + 4 * quad; asm volatile("" : "+v"(moff));
                bf16_t* mrow = mixed + tok * DM + moff;
                if (dir == 0) {
#pragma unroll
                    for (int n = 0; n < 16; ++n) { u32x2 w; w.x = pk2(acc[n][0] * dn, acc[n][1] * dn); w.y = pk2(acc[n][2] * dn, acc[n][3] * dn); *(u32x2*)(mrow + 16 * n) = w; }
                } else {
                    float ss = 0.f;
#pragma unroll
                    for (int n = 0; n < 16; ++n) { const u32x2 hf = *(const u32x2*)(mrow + 16 * n);
                        acc[n][0] = acc[n][0] * dn + bf2f(hf.x & 0xffffu); acc[n][1] = acc[n][1] * dn + bf2f(hf.x >> 16);
                        acc[n][2] = acc[n][2] * dn + bf2f(hf.y & 0xffffu); acc[n][3] = acc[n][3] * dn + bf2f(hf.y >> 16);
                        ss += (acc[n][0] * acc[n][0] + acc[n][1] * acc[n][1]) + (acc[n][2] * acc[n][2] + acc[n][3] * acc[n][3]); if ((n & 3) == 3) __builtin_amdgcn_sched_barrier(0); }
                    ss += __shfl_xor(ss, 16); ss += __shfl_xor(ss, 32);
                    const float rstd = rsqrtf(ss * (1.f / 256.f) + EPSN);
                    __builtin_amdgcn_sched_barrier(0);
                    int eb = h * 256 + 4 * quad; asm volatile("" : "+v"(eb));
                    const float* gp = a.g_head_a + eb; const bf16_t* ovp = P + tok * NPC + 3072 + eb;
#pragma unroll
                    for (int n = 0; n < 16; ++n) { const f32x4 g = *(const f32x4*)(gp + 16 * n);
                        const u32x2 ov = *(const u32x2*)(ovp + 16 * n);
                        const float o0 = bf2f(ov.x & 0xffffu), o1 = bf2f(ov.x >> 16), o2 = bf2f(ov.y & 0xffffu), o3 = bf2f(ov.y >> 16);
                        u32x2 w; w.x = pk2(acc[n][0] * rstd * g.x * __builtin_amdgcn_rcpf(1.f + __expf(-o0)), acc[n][1] * rstd * g.y * __builtin_amdgcn_rcpf(1.f + __expf(-o1)));
                        w.y = pk2(acc[n][2] * rstd * g.z * __builtin_amdgcn_rcpf(1.f + __expf(-o2)), acc[n][3] * rstd * g.w * __builtin_amdgcn_rcpf(1.f + __expf(-o3)));
                        *(u32x2*)(mrow + 16 * n) = w; __builtin_amdgcn_sched_barrier(0); }
                }
            }
            __syncthreads();
        }
#undef STEP_DEC
#undef STEP_LOAD
#undef STEP_STORE
    }
}

DI void phase_act(const Args& a, int tid) {
    bf16_t* UG = (bf16_t*)(a.ws + OFF_UG);
    constexpr int NV = DFF / 8, RUN = 16, NRUN = MTOK / RUN;
    const int gt = blockIdx.x * 512 + tid, NT = gridDim.x * 512;
    for (int it = gt; it < NRUN * NV; it += NT) {
        const int vv = it % NV, run = it / NV, f0 = vv * 8, t0 = run * RUN;
        float w0[8], w1[8], w2[8], cb[8];
#pragma unroll
        for (int i = 0; i < 8; ++i) { w0[i] = a.conv_w[f0 + i]; w1[i] = a.conv_w[DFF + f0 + i]; w2[i] = a.conv_w[2 * DFF + f0 + i]; cb[i] = a.conv_b[f0 + i]; }
        const u32x4 zero = {0u, 0u, 0u, 0u};
        const bf16_t* G = UG + DFF + f0;
        u32x4 gp = ((t0 & (SEQ - 1)) == 0) ? zero : *(const u32x4*)(G + (size_t)(t0 - 1) * NUP);
        u32x4 gc = *(const u32x4*)(G + (size_t)t0 * NUP);
        for (int i = 0; i < RUN; ++i) { const int t = t0 + i;
            const u32x4 gn = (((t + 1) & (SEQ - 1)) == 0) ? zero : *(const u32x4*)(G + (size_t)(t + 1) * NUP);
            const u32x4 uv = *(const u32x4*)(UG + (size_t)t * NUP + f0);
            u32x4 o;
#pragma unroll
            for (int q = 0; q < 4; ++q) { float r[2];
#pragma unroll
                for (int e = 0; e < 2; ++e) { const int k = 2 * q + e; const unsigned sh = e ? 16u : 0u;
                    const float g = w0[k] * bf2f((gp[q] >> sh) & 0xffffu) + w1[k] * bf2f((gc[q] >> sh) & 0xffffu) + w2[k] * bf2f((gn[q] >> sh) & 0xffffu) + cb[k];
                    r[e] = 0.5f * g * (1.f + erff(g * 0.70710678118654752f)) * bf2f((uv[q] >> sh) & 0xffffu); }
                o[q] = pk2(r[0], r[1]); }
            *(u32x4*)(UG + (size_t)t * NUP + f0) = o;
            gp = gc; gc = gn; }
    }
}

DI void phase_final(const Args& a, int lane, int wave) {
    const bf16_t* x2 = (const bf16_t*)(a.ws + OFF_X1B);
    const int gw = blockIdx.x * 8 + wave, NGW = gridDim.x * 8;
    f32x4 g[8];
#pragma unroll
    for (int j = 0; j < 8; ++j) g[j] = *(const f32x4*)(a.g_final + 4 * lane + 256 * j);
    for (int m = 4 * gw; m < MTOK; m += 4 * NGW) {
        u32x2 p[4][8];
#pragma unroll
        for (int r = 0; r < 4; ++r)
#pragma unroll
            for (int j = 0; j < 8; ++j) p[r][j] = *(const u32x2*)(x2 + (size_t)(m + r) * DM + 4 * lane + 256 * j);
#pragma unroll
        for (int r = 0; r < 4; ++r) {
            f32x4 v[8]; float ss = 0.f;
#pragma unroll
            for (int j = 0; j < 8; ++j) { v[j] = (f32x4){bf2f(p[r][j].x & 0xffffu), bf2f(p[r][j].x >> 16), bf2f(p[r][j].y & 0xffffu), bf2f(p[r][j].y >> 16)};
                ss += (v[j].x * v[j].x + v[j].y * v[j].y) + (v[j].z * v[j].z + v[j].w * v[j].w); }
            const float rstd = rsqrtf(wave_sum(ss) * (1.f / DM) + EPSN);
#pragma unroll
            for (int j = 0; j < 8; ++j) *(f32x4*)(a.out + (size_t)(m + r) * DM + 4 * lane + 256 * j) = v[j] * rstd * g[j];
        }
    }
}

#define XB_TMO      128
#define XB_XCNT(j)  (256  + 64 * (j))
#define XB_XSUB(j)  (1280 + 64 * (j))
#define XB_XGEN(j)  (2304 + 64 * (j))
#define XB_TOP      3328
#define XB_TOPGEN   3392
#define XCD_BAR_WORDS 3456
#define XB_SPIN_CAP (1u << 18)

__device__ __forceinline__ unsigned xb_ld(unsigned* p)              { return __hip_atomic_load(p, __ATOMIC_RELAXED, __HIP_MEMORY_SCOPE_AGENT); }
__device__ __forceinline__ unsigned xb_add(unsigned* p, unsigned v) { return __hip_atomic_fetch_add(p, v, __ATOMIC_RELAXED, __HIP_MEMORY_SCOPE_AGENT); }
__device__ __forceinline__ unsigned xb_xcc_id() { return (unsigned)__builtin_amdgcn_s_getreg((3 << 11) | 20) & 0xFu; }
#define XB_SPIN(cond, bar) do { unsigned _sp = 0; while (cond) { __builtin_amdgcn_s_sleep(1); \
    if ((++_sp & 255u) == 0u) { if (xb_ld(&(bar)[XB_TMO])) break; if (_sp > XB_SPIN_CAP) { atomicAdd(&(bar)[XB_TMO], 1u); break; } } } } while (0)

struct XcdBarrier {
    unsigned* bar; unsigned x;
    volatile LAS unsigned* st;
};

__device__ __forceinline__ XcdBarrier xcd_barrier_post(unsigned* bar, volatile LAS unsigned* st) {
    XcdBarrier b; b.bar = bar; b.x = xb_xcc_id(); b.st = st;
    if (threadIdx.x == 0) (void)xb_add(&bar[XB_XCNT(b.x)], 1u);
    return b;
}
__device__ __forceinline__ void xcd_barrier_complete(unsigned* bar, unsigned x, unsigned& nloc, unsigned& nx) {
    const unsigned G = gridDim.x * gridDim.y * gridDim.z;
    unsigned sum, cnt, mine, sp = 0u;
    for (;;) {
        sum = 0u; cnt = 0u; mine = 0u;
#pragma unroll
        for (unsigned j = 0; j < 16; ++j) { const unsigned c = xb_ld(&bar[XB_XCNT(j)]); sum += c; cnt += (c > 0u) ? 1u : 0u; mine = (j == x) ? c : mine; }
        if (sum == G) break;
        __builtin_amdgcn_s_sleep(1);
        if ((++sp & 255u) == 0u) { if (xb_ld(&bar[XB_TMO])) break; if (sp > XB_SPIN_CAP) { atomicAdd(&bar[XB_TMO], 1u); break; } }
    }
    nloc = mine > 0u ? mine : 1u; nx = cnt > 0u ? cnt : 1u;
}

__device__ __forceinline__ void xcd_barrier(const XcdBarrier& b) {
    asm volatile("s_waitcnt vmcnt(0)" ::: "memory");
    __syncthreads();
    if (threadIdx.x == 0) {
        unsigned* bar = b.bar;
        __builtin_amdgcn_s_waitcnt(0);
        unsigned nloc = b.st[0], nx = b.st[1];
        if (nloc == 0u) { xcd_barrier_complete(bar, b.x, nloc, nx); b.st[0] = nloc; b.st[1] = nx; }
        const unsigned old = xb_add(&bar[XB_XSUB(b.x)], 1u);
        const unsigned gen = old / nloc;
        if (old + 1u == (gen + 1u) * nloc) {
            __builtin_amdgcn_fence(__ATOMIC_RELEASE, "agent");
            asm volatile("s_waitcnt vmcnt(0)" ::: "memory");
            const unsigned og = xb_add(&bar[XB_TOP], 1u);
            const unsigned tg = og / nx;
            if (og + 1u == (tg + 1u) * nx) xb_add(&bar[XB_TOPGEN], 1u);
            else XB_SPIN(xb_ld(&bar[XB_TOPGEN]) == tg, bar);
            __builtin_amdgcn_fence(__ATOMIC_ACQUIRE, "agent");
            xb_add(&bar[XB_XGEN(b.x)], 1u);
            asm volatile("s_waitcnt vmcnt(0)" ::: "memory");
        } else {
            XB_SPIN(xb_ld(&bar[XB_XGEN(b.x)]) == gen, bar);
            __builtin_amdgcn_fence(__ATOMIC_ACQUIRE, "agent");
            asm volatile("s_waitcnt vmcnt(0)" ::: "memory");
        }
    }
    __syncthreads();
}


DI int lane_now() { int l = (int)(threadIdx.x & 63u); asm volatile("" : "+v"(l)); return l; }
__global__ void __launch_bounds__(512, 2) mega(Args a) {
    extern __shared__ __attribute__((aligned(16))) unsigned char lds_raw[];
    LAS unsigned char* lds = (LAS unsigned char*)lds_raw;
    cg::grid_group grid = cg::this_grid();
    const int tid = threadIdx.x, wave = __builtin_amdgcn_readfirstlane(tid >> 6);
#define lane lane_now()
    const int lo = a.ph_lo, hi = a.ph_hi;
    volatile LAS unsigned* xst = (volatile LAS unsigned*)(lds + LDS_BYTES - 16);
    if (tid == 0) { xst[0] = 0u; xst[1] = 0u; }
    __syncthreads();
    if (hi - lo > 1) (void)xcd_barrier_post((unsigned*)(a.ws + OFF_BAR), xst);
    const float* mod = (const float*)(a.ws + OFF_MOD);
#ifndef PHMASK
#define PHMASK 0xfff
#endif
#define PH(k) (((PHMASK >> (k)) & 1) && lo <= (k) && (k) < hi)
#ifndef PROBE_A
#define PROBE_A -1
#define PROBE_B -1
#endif
    unsigned long long* stamps = (unsigned long long*)(a.ws + WS_NEED);
#define STAMP(k) do { if (PROBE_A >= 0 && blockIdx.x == 0 && tid == 0) stamps[k] = __builtin_amdgcn_s_memrealtime(); } while (0)
#define SEAM(k) do { if (PH(k) && PH((k) + 1)) { XcdBarrier xb_; xb_.bar = (unsigned*)(a.ws + OFF_BAR); xb_.x = xb_xcc_id(); xb_.st = (volatile LAS unsigned*)(lds + LDS_BYTES - 16); xcd_barrier(xb_); } STAMP((k) + 1); } while (0)
#ifdef MK_GRID_SYNC_FIRST
    if (hi - lo > 1) grid.sync();
#endif
    STAMP(0);
    if (PH(0)) phase0(a, lds, tid, lane, wave);
#ifdef DUP_P0
    if (PH(0)) { __syncthreads(); phase0(a, lds, tid, lane, wave); }
#endif
    SEAM(0);
    if (PH(1)) phase_norm<true, false>(a, lds, a.x, a.g_norm1, 0, DM, tid, lane, wave);
    SEAM(1);
    if (PH(2)) {
        if (blockIdx.x < NCOMBO) gate_prep(a, lds, blockIdx.x, tid);
        pg8::Gemm g{(const bf16_t*)(a.ws + OFF_HB), (const bf16_t*)(a.ws + OFF_WIN), MTOK, NPC, DM, DM}; pg8::StaticOrder S; S.init(MTOK, NPC, gridDim.x, blockIdx.x);
#ifdef SKEW_TICKS
        if ((blockIdx.x >> 3) & 1) { const unsigned long long t0 = __builtin_amdgcn_s_memrealtime(); while (__builtin_amdgcn_s_memrealtime() - t0 < SKEW_TICKS) __builtin_amdgcn_s_sleep(8); }
#endif
        pg8::EpiBf16<0> E{(bf16_t*)(a.ws + OFF_P), NPC, nullptr, 0, 0, 1.f};
        pg8::gemm_phase<pg8::EpiBf16<0>, pg8::StaticOrder, GEMM_ALIGN, true>(lds, g, S, E);
#ifdef DUP_GEMM_IN
        pg8::gemm_phase<pg8::EpiBf16<0>, pg8::StaticOrder, true, true>(lds, g, S, E);
#endif
#ifdef DUP_GEMM_HALFK
        { pg8::Gemm g2{(const bf16_t*)(a.ws + OFF_HB), (const bf16_t*)(a.ws + OFF_WIN), MTOK, NPC, DUP_GEMM_HALFK, DM};
          pg8::EpiBf16<0> E2{(bf16_t*)(a.ws + OFF_CST), 0, nullptr, 0, 0, 1.f};
          pg8::gemm_phase<pg8::EpiBf16<0>, pg8::StaticOrder, true, true>(lds, g2, S, E2); }
#endif
    }
    SEAM(2);
    if (PH(3)) mlstm_delta(a, lds, tid, lane, wave);
#if defined(DUP_MIX) || defined(DUP_A1)
    if (PH(3)) { __syncthreads(); mlstm_delta(a, lds, tid, lane, wave); }
#endif
    SEAM(3);
    if (PH(4)) { mlstm_scan(a, tid); natten(a, lds, tid, lane, wave); }
#if defined(DUP_MIX) || defined(DUP_NAT)
    if (PH(4)) { __syncthreads(); natten(a, lds, tid, lane, wave); }
#endif
    SEAM(4);
    if (PH(5)) mlstm_out(a, lds, tid, lane, wave);
#if defined(DUP_MIX) || defined(DUP_A3)
    if (PH(5)) { __syncthreads(); mlstm_out(a, lds, tid, lane, wave); }
#endif
    SEAM(5);
    if (PH(6)) {
        __syncthreads();
        pg8::Gemm g{(const bf16_t*)(a.ws + OFF_HB), (const bf16_t*)(a.ws + OFF_WOUT), MTOK, DM, DM, DM}; pg8::StaticOrder S; S.init(MTOK, DM, gridDim.x, blockIdx.x);
        EpiResid16<false> E{a.x, (bf16_t*)(a.ws + OFF_X1B), mod + 2 * DM};
        pg8::gemm_phase<EpiResid16<false>, pg8::StaticOrder, GEMM_ALIGN, true>(lds, g, S, E);
    }
    SEAM(6);
    if (PH(7)) phase_norm<false, true>(a, lds, a.ws + OFF_X1B, a.g_norm2, 3 * DM, 4 * DM, tid, lane, wave);
    SEAM(7);
    if (PH(8)) {
        pg8::Gemm g{(const bf16_t*)(a.ws + OFF_HB), (const bf16_t*)(a.ws + OFF_WUP), MTOK, NUP, DM, DM}; pg8::StaticOrder S; S.init(MTOK, NUP, gridDim.x, blockIdx.x);
#ifdef SKEW_TICKS
        if ((blockIdx.x >> 3) & 1) { const unsigned long long t0 = __builtin_amdgcn_s_memrealtime(); while (__builtin_amdgcn_s_memrealtime() - t0 < SKEW_TICKS) __builtin_amdgcn_s_sleep(8); }
#endif
        EpiGlu E{(bf16_t*)(a.ws + OFF_ACT), a.conv_w, a.conv_b, (float*)(a.ws + OFF_EDGE), (LAS float*)(lds + 131072)};
        pg8::gemm_phase<EpiGlu, pg8::StaticOrder, true, true>(lds, g, S, E);
    }
    SEAM(8);
    if (PH(10)) {
        pg8::Gemm g{(const bf16_t*)(a.ws + OFF_ACT), (const bf16_t*)(a.ws + OFF_WDN), MTOK, DM, DFF, DFF}; pg8::StaticOrder S; S.init(MTOK, DM, gridDim.x, blockIdx.x);
        { pg8::Unit uu; int lastpm = -1; for (int i = 0; S.next(i, uu); ++i) if (uu.pm != lastpm) { glu_fixup(a, uu.pm, tid); lastpm = uu.pm; } }
        __threadfence(); __syncthreads();
        EpiResid16<true> E{a.ws + OFF_X1B, (bf16_t*)(a.ws + OFF_X1B), mod + 5 * DM};
        pg8::gemm_phase<EpiResid16<true>, pg8::StaticOrder, GEMM_ALIGN, true>(lds, g, S, E);
    }
    SEAM(10);
    if (PH(11)) phase_final(a, lane, wave);
    if (PROBE_A >= 0) { __syncthreads(); if (blockIdx.x == 0 && tid == 0) { stamps[12] = __builtin_amdgcn_s_memrealtime();
        const float Ta = (float)(stamps[PROBE_A + 1] - stamps[PROBE_A]) * 0.01f, Tb = (float)(stamps[PROBE_B + 1] - stamps[PROBE_B]) * 0.01f;
        a.out[0] += Ta + Tb; for (int i = 1; i <= 1000; ++i) a.out[i] += 0.5f * Tb; } }
#undef PH
#undef SEAM
#undef lane
}

extern "C" void kernel_launch(void* const* d_in, const int* in_sizes, int n_in, void* d_out, int out_size, void* d_ws, size_t ws_size, hipStream_t stream) {
    static int grid = 0;
    if (grid == 0) {
        if (n_in != 16 || out_size != MTOK * DM || ws_size < WS_NEED) { fprintf(stderr, "kernel_launch: unexpected problem (n_in %d out %d ws %zu need %zu)\n", n_in, out_size, ws_size, (size_t)WS_NEED); grid = -1; return; }
        int dev = 0, cus = 0, per_cu = 0;
        hipGetDevice(&dev); hipDeviceGetAttribute(&cus, hipDeviceAttributeMultiprocessorCount, dev);
        if (hipFuncSetAttribute((const void*)mega, hipFuncAttributeMaxDynamicSharedMemorySize, LDS_BYTES) != hipSuccess) { fprintf(stderr, "kernel_launch: hipFuncSetAttribute failed\n"); grid = -1; return; }
        if (hipOccupancyMaxActiveBlocksPerMultiprocessor(&per_cu, (const void*)mega, 512, LDS_BYTES) != hipSuccess || per_cu < 1) { fprintf(stderr, "kernel_launch: occupancy query failed (%d)\n", per_cu); (void)hipGetLastError(); per_cu = 1; }
        grid = cus * (per_cu > 1 ? 1 : per_cu);
        fprintf(stderr, "kernel_launch: grid %d (cus %d, per_cu %d)\n", grid, cus, per_cu);
        if (grid < 4 || (grid & 3) != 0) { fprintf(stderr, "kernel_launch: this kernel needs a workgroup count that is a multiple of 4 (neighbourhood-attention head pairs are fixed per workgroup); nothing launched\n"); grid = -1; return; }
    }
    if (grid < 0) return;
    Args a{};
    a.x = (const float*)d_in[0]; a.c = (const float*)d_in[1]; a.w_ada = (const float*)d_in[2]; a.b_ada = (const float*)d_in[3]; a.g_norm1 = (const float*)d_in[4];
    a.w_in = (const float*)d_in[5]; a.b_gates = (const float*)d_in[6]; a.g_head_a = (const float*)d_in[7]; a.rpb = (const float*)d_in[8]; a.w_out = (const float*)d_in[9];
    a.g_norm2 = (const float*)d_in[10]; a.w_up = (const float*)d_in[11]; a.conv_w = (const float*)d_in[12]; a.conv_b = (const float*)d_in[13]; a.w_down = (const float*)d_in[14];
    a.g_final = (const float*)d_in[15]; a.out = (float*)d_out; a.ws = (unsigned char*)d_ws;
#if MK_PER_PHASE
    for (int p = 0; p < NPH; ++p) { a.ph_lo = p; a.ph_hi = p + 1; hipLaunchKernelGGL(mega, dim3(grid), dim3(512), LDS_BYTES, stream, a); }
#else
    a.ph_lo = 0; a.ph_hi = NPH;
    if (hipMemsetAsync((char*)d_ws + OFF_BAR, 0, BAR_BYTES, stream) != hipSuccess) { fprintf(stderr, "kernel_launch: memset failed\n"); return; }
    void* args[] = {&a};
    hipError_t e = hipLaunchCooperativeKernel((const void*)mega, dim3(grid), dim3(512), args, LDS_BYTES, stream);
    if (e != hipSuccess) fprintf(stderr, "kernel_launch: cooperative launch failed: %s (grid %d)\n", hipGetErrorString(e), grid);
#endif
}
```

```cpp
#include <hip/hip_runtime.h>
#include <hip/hip_cooperative_groups.h>
#include <cstdio>
#include <cstdint>
namespace cg = cooperative_groups;
#define MK_PER_PHASE 0
namespace pg8 {
#define PG8_LAS __attribute__((address_space(3)))
typedef unsigned short bf16_t;
typedef short bf16x8 __attribute__((ext_vector_type(8)));
typedef float f32x4 __attribute__((ext_vector_type(4)));
typedef unsigned u32x4 __attribute__((ext_vector_type(4)));
constexpr int BM = 256, BK = 64, HALF = 128, HTB = HALF * BK * 2  , STAGE_BYTES = 8 * HTB, NXCD = 8, WGM = 8;

__host__ __device__ __forceinline__ int lds_byte(int r, int c) { const int st = (r >> 4) * 2 + (c >> 5), rr = r & 15, cc = c & 31, ob = rr * 64 + cc * 2; return st * 1024 + (ob ^ (((ob >> 9) & 1) << 5)); }
__host__ __device__ __forceinline__ void stage_rc(int b, int& R, int& C) { const int st = b / 1024, sb = b % 1024, swz = sb ^ (((sb >> 9) & 1) << 5); R = (st >> 1) * 16 + swz / 64; C = (st & 1) * 32 + (swz % 64) / 2; }
__host__ __device__ __forceinline__ int perm32(int rho) { const int n = rho >> 4, i = rho & 15; return 8 * (i >> 2) + 4 * n + (i & 3); }

struct Unit { int pm, pn; };
struct Gemm { const bf16_t* A; const bf16_t* Bt; int M, N, K, lda; };

struct StaticOrder {
    int nM, nN, nwg, G, c;
    __host__ __device__ void init(int M, int N, int G_, int c_) { nM = M / BM; nN = N / BM; nwg = nM * nN; G = G_; c = c_; }
    __host__ __device__ bool next(int i, Unit& u) const {
        const long L = (long)i * G + c; if (L >= nwg) return false;
        int wgid = (int)L; { const int q = nwg / NXCD, r = nwg % NXCD, xcd = wgid % NXCD, off = wgid / NXCD; wgid = (xcd < r ? xcd * (q + 1) : r * (q + 1) + (xcd - r) * q) + off; }
        const int nig = WGM * nN, gid = wgid / nig, fm = gid * WGM, gsz = (nM - fm) < WGM ? (nM - fm) : WGM;
        u.pm = fm + ((wgid % nig) % gsz); u.pn = (wgid % nig) / gsz; return true;
    }
    __device__ __forceinline__ void a_ready(const Unit&) const {}
    __device__ __forceinline__ void done(const Unit&) const {}
};

__device__ __forceinline__ unsigned cvt_pk_bf16(float lo, float hi) { unsigned r; asm volatile("v_cvt_pk_bf16_f32 %0, %1, %2" : "=v"(r) : "v"(lo), "v"(hi)); return r; }
typedef float f32x2 __attribute__((ext_vector_type(2)));
__device__ __forceinline__ f32x2 gelu_pk(f32x2 v) {
    const f32x2 av = __builtin_elementwise_abs(v), d = av * 0.2316418882f + 1.0f;
    f32x2 t; t.x = __builtin_amdgcn_rcpf(d.x); t.y = __builtin_amdgcn_rcpf(d.y);
    f32x2 q = t * 0.5307027145f + (-0.7265760135f); q = q * t + 0.7107068705f; q = q * t + (-0.142248368f); q = q * t + 0.127414796f; q = q * t;
    const f32x2 s = (v * v) * (-0.72134752044f);
    f32x2 e; e.x = __builtin_amdgcn_exp2f(s.x); e.y = __builtin_amdgcn_exp2f(s.y);
    const f32x2 m = v * (q * e), r = v - m;
    f32x2 o; o.x = v.x < 0.f ? m.x : r.x; o.y = v.y < 0.f ? m.y : r.y; return o;
}

template <int ACT  > struct EpiBf16 {
    static constexpr bool PERM = true, AFTER_DRAIN = false; static_assert(ACT == 0 || ACT == 1, "EpiBf16: ACT is 0 (none) or 1 (gelu_pk)");
    bf16_t* O; int ldc; const float* bias; int split_cols; size_t split_stride; float scale0;
    __device__ __forceinline__ void operator()(const f32x4 (&acc)[2][2][4][2], const Unit& u, int wr, int wc, int fr, int fq) const {
        const int row0 = u.pm * BM + wr * 64 + fr; int colt = u.pn * BM; bf16_t* base = O;
        float sc = 1.f; if (split_cols) { const int t = colt / split_cols; base += (size_t)t * split_stride; colt -= t * split_cols; if (t == 0) sc = scale0; }
        const int col0 = colt + wc * 32 + 8 * fq, bcol0 = u.pn * BM + wc * 32 + 8 * fq;
        f32x4 bv[2][2];
#pragma unroll
        for (int bj = 0; bj < 2; ++bj)
#pragma unroll
            for (int n = 0; n < 2; ++n) bv[bj][n] = bias ? *(const f32x4*)(bias + bcol0 + bj * HALF + 4 * n) : (f32x4){0.f, 0.f, 0.f, 0.f};
#pragma unroll
        for (int ai = 0; ai < 2; ++ai)
#pragma unroll
            for (int m = 0; m < 4; ++m) { bf16_t* rowp = base + (size_t)(row0 + ai * HALF + m * 16) * ldc + col0;
#pragma unroll
                for (int bj = 0; bj < 2; ++bj) { f32x4 v0 = acc[ai][bj][m][0] + bv[bj][0], v1 = acc[ai][bj][m][1] + bv[bj][1];
                    if (ACT == 1) { f32x2 a = gelu_pk((f32x2){v0[0], v0[1]}), b = gelu_pk((f32x2){v0[2], v0[3]}), c = gelu_pk((f32x2){v1[0], v1[1]}), d = gelu_pk((f32x2){v1[2], v1[3]});
                        v0 = (f32x4){a.x, a.y, b.x, b.y}; v1 = (f32x4){c.x, c.y, d.x, d.y}; }
                    v0 = v0 * sc; v1 = v1 * sc; u32x4 w; w.x = cvt_pk_bf16(v0[0], v0[1]); w.y = cvt_pk_bf16(v0[2], v0[3]); w.z = cvt_pk_bf16(v1[0], v1[1]); w.w = cvt_pk_bf16(v1[2], v1[3]);
                    *(u32x4*)(rowp + bj * HALF) = w; } }
    }
};

template <class Epi, class Sched, bool ALIGN_EPI = false, bool SP2 = false>
__device__ __forceinline__ void gemm_phase(PG8_LAS unsigned char* lds, const Gemm g, const Sched& S, const Epi& E) {
    const int tid = threadIdx.x, wid = __builtin_amdgcn_readfirstlane(tid >> 6), lane = tid & 63, wr = wid >> 2, wc = wid & 3, fr = lane & 15, fq = lane >> 4;
    const int K = g.K, nt = K / BK;
    unsigned voffA[2], voffB[2];
#pragma unroll
    for (int i = 0; i < 2; ++i) { int R, C; stage_rc(tid * 16 + i * 8192, R, C); const int Rb = Epi::PERM ? ((R & ~31) + perm32(R & 31)) : R;
        voffA[i] = (unsigned)(R * g.lda + C) * 2u; voffB[i] = (unsigned)(Rb * K + C) * 2u; }
    const size_t kstep = (size_t)(BK * 2);
    const size_t hstep = (size_t)HALF * K * 2;
    const size_t tstep = 2 * hstep; const size_t hstepA = (size_t)HALF * g.lda * 2, tstepA = 2 * hstepA;
    const unsigned ldsw = (unsigned)wid * 1024u;
    const int aoff = lds_byte(wr * 64 + fr, fq * 8), boff = lds_byte(wc * 32 + fr, fq * 8);
#define PG8_SA(b, h) (((b) * 2 + (h)) * HTB)
#define PG8_SB(b, h) ((4 + (b) * 2 + (h)) * HTB)
#define PG8_STAGE(bufoff, gbase, voff) do { _Pragma("unroll") for (int _i = 0; _i < 2; ++_i) \
        __builtin_amdgcn_global_load_lds((const unsigned*)((const char*)(gbase) + (voff)[_i]), (PG8_LAS unsigned*)(lds + (bufoff) + ldsw + _i * 8192), 16, 0, 0); } while (0)
#define PG8_LDA(dst, b, h) do { _Pragma("unroll") for (int m = 0; m < 4; ++m) _Pragma("unroll") for (int k = 0; k < 2; ++k) dst[m][k] = *(const PG8_LAS bf16x8*)(lds + PG8_SA(b, h) + aoff + m * 2048 + k * 1024); } while (0)
#define PG8_LDB(dst, b, h) do { _Pragma("unroll") for (int n = 0; n < 2; ++n) _Pragma("unroll") for (int k = 0; k < 2; ++k) dst[n][k] = *(const PG8_LAS bf16x8*)(lds + PG8_SB(b, h) + boff + n * 2048 + k * 1024); } while (0)
#define PG8_MMA(ai, bj, At, Bt) do { __builtin_amdgcn_s_setprio(1); _Pragma("unroll") for (int m = 0; m < 4; ++m) _Pragma("unroll") for (int n = 0; n < 2; ++n) _Pragma("unroll") for (int k = 0; k < 2; ++k) \
        acc[ai][bj][m][n] = __builtin_amdgcn_mfma_f32_16x16x32_bf16(Bt[n][k], At[m][k], acc[ai][bj][m][n], 0, 0, 0); __builtin_amdgcn_s_setprio(0); } while (0)
#define PG8_WAIT_V(n) asm volatile("s_waitcnt vmcnt(" #n ")" ::: "memory")
#define PG8_WAIT_L(n) asm volatile("s_waitcnt lgkmcnt(" #n ")" ::: "memory")
#define PG8_BAR __builtin_amdgcn_s_barrier()
#define PG8_SCHED __builtin_amdgcn_sched_barrier(0)
    Unit cur, nxt; int ui = 0;
    if (!S.next(0, cur)) return;
    f32x4 acc[2][2][4][2];
#pragma unroll
    for (int a = 0; a < 2; ++a)
#pragma unroll
        for (int b = 0; b < 2; ++b)
#pragma unroll
            for (int m = 0; m < 4; ++m)
#pragma unroll
                for (int n = 0; n < 2; ++n) acc[a][b][m][n] = (f32x4){0.f, 0.f, 0.f, 0.f};
    bf16x8 At[4][2], B0[2][2], B1[2][2];
    const char* cA = (const char*)g.A + (size_t)cur.pm * tstepA; const char* cB = (const char*)g.Bt + (size_t)cur.pn * tstep;
    S.a_ready(cur);
    if constexpr (SP2) {
        PG8_STAGE(PG8_SB(0, 0), cB, voffB); PG8_STAGE(PG8_SB(0, 1), cB + hstep, voffB); PG8_STAGE(PG8_SA(0, 0), cA, voffA); PG8_STAGE(PG8_SA(0, 1), cA + hstepA, voffA);
        if (wr == 1) PG8_BAR;
        PG8_WAIT_V(2); PG8_BAR;
        PG8_STAGE(PG8_SB(1, 0), cB + kstep, voffB); PG8_STAGE(PG8_SA(1, 0), cA + kstep, voffA); PG8_STAGE(PG8_SB(1, 1), cB + hstep + kstep, voffB);
        PG8_WAIT_V(6); PG8_BAR;
    } else {
        PG8_STAGE(PG8_SB(0, 0), cB, voffB); PG8_STAGE(PG8_SA(0, 0), cA, voffA); PG8_STAGE(PG8_SB(0, 1), cB + hstep, voffB); PG8_STAGE(PG8_SA(0, 1), cA + hstepA, voffA);
        if (wr == 1) PG8_BAR;
        PG8_WAIT_V(4); PG8_BAR;
        PG8_STAGE(PG8_SB(1, 0), cB + kstep, voffB); PG8_STAGE(PG8_SA(1, 0), cA + kstep, voffA); PG8_STAGE(PG8_SB(1, 1), cB + hstep + kstep, voffB);
        PG8_WAIT_V(6); PG8_BAR;
    }
    for (;;) {
        const bool has_next = S.next(ui + 1, nxt);
        const char* nA = has_next ? (const char*)g.A + (size_t)nxt.pm * tstepA : cA; const char* nB = has_next ? (const char*)g.Bt + (size_t)nxt.pn * tstep : cB;
        for (int t = 0; t < nt; t += 2) {
            const bool last = (t == nt - 2);
            const char* a1 = cA + (size_t)(t + 1) * kstep;
            const char* a2 = last ? nA : cA + (size_t)(t + 2) * kstep; const char* b2 = last ? nB : cB + (size_t)(t + 2) * kstep;
            const char* a3 = a2 + kstep; const char* b3 = b2 + kstep;
            if (last && has_next) S.a_ready(nxt);
            if constexpr (SP2) {
            PG8_LDB(B0, 0, 0); PG8_LDB(B1, 0, 1); PG8_SCHED; PG8_LDA(At, 0, 0); PG8_STAGE(PG8_SA(1, 1), a1 + hstepA, voffA);
            PG8_WAIT_V(8); PG8_WAIT_L(0); PG8_BAR; PG8_MMA(0, 0, At, B0); PG8_MMA(0, 1, At, B1); PG8_BAR; PG8_SCHED;
            PG8_LDA(At, 0, 1); PG8_STAGE(PG8_SB(0, 0), b2, voffB); PG8_STAGE(PG8_SB(0, 1), b2 + hstep, voffB); PG8_STAGE(PG8_SA(0, 0), a2, voffA);
            PG8_WAIT_V(8); PG8_WAIT_L(0); PG8_BAR; PG8_MMA(1, 0, At, B0); PG8_MMA(1, 1, At, B1); PG8_BAR; PG8_SCHED;
            PG8_LDB(B0, 1, 0); PG8_LDB(B1, 1, 1); PG8_SCHED; PG8_LDA(At, 1, 0); PG8_STAGE(PG8_SA(0, 1), a2 + hstepA, voffA);
            PG8_WAIT_V(8); PG8_WAIT_L(0); PG8_BAR; PG8_MMA(0, 0, At, B0); PG8_MMA(0, 1, At, B1); PG8_BAR; PG8_SCHED;
            PG8_LDA(At, 1, 1); PG8_STAGE(PG8_SB(1, 0), b3, voffB); PG8_STAGE(PG8_SB(1, 1), b3 + hstep, voffB); PG8_STAGE(PG8_SA(1, 0), a3, voffA);
            PG8_WAIT_V(8); PG8_WAIT_L(0); PG8_BAR; PG8_MMA(1, 0, At, B0); PG8_MMA(1, 1, At, B1); PG8_BAR; PG8_SCHED;
            } else {
            PG8_LDB(B0, 0, 0); PG8_SCHED; PG8_LDA(At, 0, 0); PG8_STAGE(PG8_SA(1, 1), a1 + hstepA, voffA);
            PG8_WAIT_L(8); PG8_BAR; PG8_WAIT_L(0); PG8_MMA(0, 0, At, B0); PG8_BAR; PG8_SCHED;
            PG8_LDB(B1, 0, 1); PG8_STAGE(PG8_SB(0, 0), b2, voffB);
            PG8_BAR; PG8_WAIT_L(0); PG8_MMA(0, 1, At, B1); PG8_BAR;
            PG8_LDA(At, 0, 1); PG8_STAGE(PG8_SA(0, 0), a2, voffA);
            PG8_BAR; PG8_WAIT_L(0); PG8_MMA(1, 0, At, B0); PG8_BAR; PG8_SCHED;
            PG8_STAGE(PG8_SB(0, 1), b2 + hstep, voffB);
            PG8_WAIT_V(6); PG8_BAR; PG8_MMA(1, 1, At, B1); PG8_BAR;
            PG8_LDB(B0, 1, 0); PG8_SCHED; PG8_LDA(At, 1, 0); PG8_STAGE(PG8_SA(0, 1), a2 + hstepA, voffA);
            PG8_WAIT_L(8); PG8_BAR; PG8_WAIT_L(0); PG8_MMA(0, 0, At, B0); PG8_BAR; PG8_SCHED;
            PG8_LDB(B1, 1, 1); PG8_STAGE(PG8_SB(1, 0), b3, voffB);
            PG8_BAR; PG8_WAIT_L(0); PG8_MMA(0, 1, At, B1); PG8_BAR;
            PG8_LDA(At, 1, 1); PG8_STAGE(PG8_SA(1, 0), a3, voffA);
            PG8_BAR; PG8_WAIT_L(0); PG8_MMA(1, 0, At, B0); PG8_BAR; PG8_SCHED;
            PG8_STAGE(PG8_SB(1, 1), b3 + hstep, voffB);
            PG8_WAIT_V(6); PG8_BAR; PG8_MMA(1, 1, At, B1); PG8_BAR;
            }
        }
        if constexpr (ALIGN_EPI) { if (wr == 0) PG8_BAR; }
        if constexpr (!Epi::AFTER_DRAIN) { E(acc, cur, wr, wc, fr, fq); S.done(cur); }
        if (!has_next) break;
#pragma unroll
        for (int a = 0; a < 2; ++a)
#pragma unroll
            for (int b = 0; b < 2; ++b)
#pragma unroll
                for (int m = 0; m < 4; ++m)
#pragma unroll
                    for (int n = 0; n < 2; ++n) acc[a][b][m][n] = (f32x4){0.f, 0.f, 0.f, 0.f};
        cur = nxt; cA = nA; cB = nB; ++ui;
        if constexpr (ALIGN_EPI) { if (wr == 1) PG8_BAR; }
    }
    PG8_WAIT_V(0);
    if constexpr (!ALIGN_EPI) { if (wr == 0) PG8_BAR; }
    PG8_BAR;
    if constexpr (Epi::AFTER_DRAIN) { E.fused(acc, cur, wr, wc, fr, fq, lds, wid, lane); S.done(cur); }
#undef PG8_SA
#undef PG8_SB
#undef PG8_STAGE
#undef PG8_LDA
#undef PG8_LDB
#undef PG8_MMA
#undef PG8_WAIT_V
#undef PG8_WAIT_L
#undef PG8_BAR
#undef PG8_SCHED
}
}

#define DI __device__ __forceinline__
#define LAS __attribute__((address_space(3)))
typedef unsigned short bf16_t;
typedef short bf16x8 __attribute__((ext_vector_type(8)));
typedef short s16x4 __attribute__((ext_vector_type(4)));
typedef short v4i16_t __attribute__((ext_vector_type(4)));
typedef float f32x4 __attribute__((ext_vector_type(4)));
typedef unsigned u32x4 __attribute__((ext_vector_type(4)));
typedef unsigned u32x2 __attribute__((ext_vector_type(2)));

constexpr int NB = 2, SEQ = 8192, DM = 2048, MTOK = NB * SEQ, NPC = 7168, WIN_LD = 7184, DFF = 5632, NUP = 2 * DFF, NMOD = 6 * DM;
constexpr int LCH = 256, NCH = SEQ / LCH, EEXT = 272, ST_ELEMS = EEXT * 256, NCOMBO = 16;
constexpr float EPSN = 1e-6f;
#ifndef MK_PER_PHASE
#define MK_PER_PHASE 0
#endif
#ifndef GEMM_ALIGN
#define GEMM_ALIGN true
#endif
constexpr int NPH = 12;
constexpr int LDS_BYTES = 147456;

constexpr size_t OFF_P = 0;
constexpr size_t OFF_CST = OFF_P + (size_t)MTOK * NPC * 2;
constexpr size_t OFF_WIN = OFF_CST + (size_t)NCOMBO * NCH * ST_ELEMS * 2;
constexpr size_t OFF_WOUT = OFF_WIN + (size_t)NPC * DM * 2;
constexpr size_t OFF_R0END = OFF_WOUT + (size_t)DM * DM * 2;
constexpr size_t OFF_UG = 0;
constexpr size_t OFF_ACT = 0;
constexpr size_t OFF_EDGE = OFF_ACT + (size_t)MTOK * DFF * 2;
constexpr size_t OFF_X1B = OFF_EDGE + (size_t)3 * 64 * 2 * DFF * 4;
static_assert(OFF_X1B + (size_t)MTOK * DM * 2 <= OFF_CST + (size_t)NCOMBO * NCH * ST_ELEMS * 2, "x1b must stay below the weight copies that are still live in phase 6");
constexpr size_t OFF_WUP = OFF_UG + (size_t)MTOK * NUP * 2;
constexpr size_t OFF_WDN = OFF_WUP + (size_t)NUP * DM * 2;
constexpr size_t OFF_HB = OFF_WDN + (size_t)DM * DFF * 2;
constexpr size_t OFF_MOD = OFF_HB + (size_t)MTOK * DM * 2;
constexpr size_t OFF_GATES = OFF_MOD + 131072;
constexpr size_t OFF_UL = OFF_GATES + (size_t)MTOK * 16 * 4;
constexpr size_t OFF_ML = OFF_UL + (size_t)NCOMBO * SEQ * 4;
constexpr size_t OFF_EMT = OFF_ML + (size_t)NCOMBO * SEQ * 4;
constexpr size_t OFF_MPREV = OFF_EMT + (size_t)NCOMBO * SEQ * 4;
constexpr size_t OFF_MEND = OFF_MPREV + 4096;
constexpr size_t WS_NEED = OFF_MEND + 4096;
constexpr size_t OFF_BAR = WS_NEED + 4096;
constexpr size_t BAR_BYTES = 16384;
static_assert(OFF_R0END <= OFF_WUP, "overlay region");
static_assert(OFF_BAR + BAR_BYTES <= 536870912ull, "workspace budget");

struct Args {
    const float *x, *c, *w_ada, *b_ada, *g_norm1, *w_in, *b_gates, *g_head_a, *rpb, *w_out, *g_norm2, *w_up, *conv_w, *conv_b, *w_down, *g_final;
    float* out; unsigned char* ws; int ph_lo, ph_hi;
};

DI float bf2f(unsigned v) { return __uint_as_float(v << 16); }
DI unsigned f2bf(float f) { unsigned u = __float_as_uint(f); return (u + 0x7fffu + ((u >> 16) & 1u)) >> 16; }
typedef __bf16 bf16x2_hw __attribute__((ext_vector_type(2)));
typedef float f32x2_hw __attribute__((ext_vector_type(2)));
DI unsigned pk2(float lo, float hi) { const f32x2_hw v = {lo, hi}; const bf16x2_hw b = __builtin_convertvector(v, bf16x2_hw); return __builtin_bit_cast(unsigned, b); }
DI float wave_sum(float v) {
#pragma unroll
    for (int o = 1; o < 64; o <<= 1) v += __shfl_xor(v, o);
    return v;
}
DI s16x4 tr_read(const LAS unsigned char* p) { return __builtin_bit_cast(s16x4, __builtin_amdgcn_ds_read_tr16_b64_v4i16((LAS v4i16_t*)p)); }
DI bf16x8 tr_frag(const LAS unsigned char* base, int pitch, int rowA, int rowB, int col, int qin, int pin) {
    const s16x4 lo = tr_read(base + (rowA + qin) * pitch + (col + 4 * pin) * 2);
    const s16x4 hi = tr_read(base + (rowB + qin) * pitch + (col + 4 * pin) * 2);
    return (bf16x8){lo[0], lo[1], lo[2], lo[3], hi[0], hi[1], hi[2], hi[3]};
}
DI bf16x8 ld_frag(const LAS unsigned char* p) { return *(const LAS bf16x8*)p; }
#define MFMA16(a, b, c) __builtin_amdgcn_mfma_f32_16x16x32_bf16((a), (b), (c), 0, 0, 0)
DI bf16x8 pack8(const f32x4& a, const f32x4& b) {
    u32x4 w; w.x = pk2(a[0], a[1]); w.y = pk2(a[2], a[3]); w.z = pk2(b[0], b[1]); w.w = pk2(b[2], b[3]);
    return __builtin_bit_cast(bf16x8, w);
}
DI bf16x8 scale8(const bf16x8& q, float s) {
    const u32x4 u = __builtin_bit_cast(u32x4, q); u32x4 w;
#pragma unroll
    for (int i = 0; i < 4; ++i) w[i] = pk2(bf2f(u[i] & 0xffffu) * s, bf2f(u[i] >> 16) * s);
    return __builtin_bit_cast(bf16x8, w);
}
template <int ROWS, int COLS> DI void stage_tile(LAS unsigned char* dst, int lp, const bf16_t* src, int gp, int tid, int nthr) {
    constexpr int VPR = COLS / 8, NV = ROWS * VPR;
    int t0 = tid; asm volatile("" : "+v"(t0));
#pragma unroll 2
    for (int v = t0; v < NV; v += nthr) { const int r = v / VPR, cv = v % VPR;
        const u32x4 d = *(const u32x4*)(src + (r * gp + cv * 8)); *(LAS u32x4*)(dst + r * lp + cv * 16) = d; }
}

struct EpiResid {
    static constexpr bool PERM = false, AFTER_DRAIN = false;
    const float* res; float* out; const float* gate;
    __device__ __forceinline__ void operator()(const pg8::f32x4 (&acc)[2][2][4][2], const pg8::Unit& u, int wr, int wc, int fr, int fq) const {
        const int row0 = u.pm * 256 + wr * 64 + fr, col0 = u.pn * 256 + wc * 32 + 4 * fq, bb = u.pm >> 5;
        f32x4 gv[2][2];
#pragma unroll
        for (int bj = 0; bj < 2; ++bj)
#pragma unroll
            for (int n = 0; n < 2; ++n) gv[bj][n] = *(const f32x4*)(gate + (size_t)bb * NMOD + col0 + bj * 128 + n * 16);
#pragma unroll
        for (int ai = 0; ai < 2; ++ai)
#pragma unroll
            for (int m = 0; m < 4; ++m) { const size_t ro = (size_t)(row0 + ai * 128 + m * 16) * DM + col0;
#pragma unroll
                for (int bj = 0; bj < 2; ++bj)
#pragma unroll
                    for (int n = 0; n < 2; ++n) { const size_t o = ro + bj * 128 + n * 16; const f32x4 r = *(const f32x4*)(res + o); *(f32x4*)(out + o) = r + gv[bj][n] * acc[ai][bj][m][n]; } }
    }
};

template <bool RES_BF16> struct EpiResid16 {
    static constexpr bool PERM = true, AFTER_DRAIN = false;
    const void* res; bf16_t* out; const float* gate;
    __device__ __forceinline__ void operator()(const pg8::f32x4 (&acc)[2][2][4][2], const pg8::Unit& u, int wr, int wc, int fr, int fq) const {
        const int row0 = u.pm * 256 + wr * 64 + fr, col0 = u.pn * 256 + wc * 32 + 8 * fq, bb = u.pm >> 5;
        f32x4 gv[2][2];
#pragma unroll
        for (int bj = 0; bj < 2; ++bj)
#pragma unroll
            for (int n = 0; n < 2; ++n) gv[bj][n] = *(const f32x4*)(gate + (size_t)bb * NMOD + col0 + bj * 128 + 4 * n);
#pragma unroll
        for (int ai = 0; ai < 2; ++ai)
#pragma unroll
            for (int m = 0; m < 4; ++m) { const size_t ro = (size_t)(row0 + ai * 128 + m * 16) * DM + col0;
#pragma unroll
                for (int bj = 0; bj < 2; ++bj) { const size_t o = ro + bj * 128; f32x4 r0, r1;
                    if (RES_BF16) { const u32x4 rv = *(const u32x4*)((const bf16_t*)res + o);
                        r0 = (f32x4){bf2f(rv.x & 0xffffu), bf2f(rv.x >> 16), bf2f(rv.y & 0xffffu), bf2f(rv.y >> 16)}; r1 = (f32x4){bf2f(rv.z & 0xffffu), bf2f(rv.z >> 16), bf2f(rv.w & 0xffffu), bf2f(rv.w >> 16)}; }
                    else { r0 = *(const f32x4*)((const float*)res + o); r1 = *(const f32x4*)((const float*)res + o + 4); }
                    r0 = r0 + gv[bj][0] * acc[ai][bj][m][0]; r1 = r1 + gv[bj][1] * acc[ai][bj][m][1];
                    u32x4 w; w.x = pg8::cvt_pk_bf16(r0[0], r0[1]); w.y = pg8::cvt_pk_bf16(r0[2], r0[3]); w.z = pg8::cvt_pk_bf16(r1[0], r1[1]); w.w = pg8::cvt_pk_bf16(r1[2], r1[3]);
                    *(u32x4*)(out + o) = w; } }
    }
};

constexpr size_t EDGE_STRIDE = (size_t)64 * 2 * DFF;
struct EpiGlu {
    static constexpr bool PERM = true, AFTER_DRAIN = false;
    bf16_t* ACT; const float* cw; const float* cb; float* edge; LAS float* xg;
    __device__ __forceinline__ void operator()(const pg8::f32x4 (&acc)[2][2][4][2], const pg8::Unit& u, int wr, int wc, int fr, int fq) const {
        const int lane = threadIdx.x & 63, fl = wc * 32 + 8 * fq, f0 = u.pn * 128 + fl;
        float w0[8], w1[8], w2[8], bb[8];
#pragma unroll
        for (int k = 0; k < 8; k += 4) { const f32x4 a0 = *(const f32x4*)(cw + f0 + k), a1 = *(const f32x4*)(cw + DFF + f0 + k), a2 = *(const f32x4*)(cw + 2 * DFF + f0 + k), a3 = *(const f32x4*)(cb + f0 + k);
#pragma unroll
            for (int i = 0; i < 4; ++i) { w0[k + i] = a0[i]; w1[k + i] = a1[i]; w2[k + i] = a2[i]; bb[k + i] = a3[i]; } }
#pragma unroll
        for (int ai = 0; ai < 2; ++ai) { const int bi = 2 * ai + wr;
            if (fr == 0) { *(LAS f32x4*)(xg + bi * 128 + fl) = acc[ai][1][0][0]; *(LAS f32x4*)(xg + bi * 128 + fl + 4) = acc[ai][1][0][1]; }
            if (fr == 15) { *(LAS f32x4*)(xg + (4 + bi) * 128 + fl) = acc[ai][1][3][0]; *(LAS f32x4*)(xg + (4 + bi) * 128 + fl + 4) = acc[ai][1][3][1]; } }
        asm volatile("s_waitcnt lgkmcnt(0)" ::: "memory"); __builtin_amdgcn_s_barrier(); asm volatile("" ::: "memory");
#pragma unroll
        for (int ai = 0; ai < 2; ++ai) { const int bi = 2 * ai + wr;
            f32x4 xp[2], xn[2];
#pragma unroll
            for (int n = 0; n < 2; ++n) { xp[n] = (f32x4){0.f, 0.f, 0.f, 0.f}; xn[n] = (f32x4){0.f, 0.f, 0.f, 0.f};
                if (fr == 0 && bi > 0) xp[n] = *(const LAS f32x4*)(xg + (4 + bi - 1) * 128 + fl + 4 * n);
                if (fr == 15 && bi < 3) xn[n] = *(const LAS f32x4*)(xg + (bi + 1) * 128 + fl + 4 * n); }
            unsigned o[4][4];
#pragma unroll
            for (int n = 0; n < 2; ++n)
#pragma unroll
                for (int i = 0; i < 4; i += 2) {
                    float r[4][2];
#pragma unroll
                    for (int e = 0; e < 2; ++e) { const int k = 4 * n + i + e;
                        float g[4], up[4], dn[4];
#pragma unroll
                        for (int m = 0; m < 4; ++m) { g[m] = acc[ai][1][m][n][i + e];
                            up[m] = __int_as_float(__builtin_amdgcn_update_dpp(0, __float_as_int(g[m]), 0x121, 0xf, 0xf, false));
                            dn[m] = __int_as_float(__builtin_amdgcn_update_dpp(0, __float_as_int(g[m]), 0x12F, 0xf, 0xf, false)); }
#pragma unroll
                        for (int m = 0; m < 4; ++m) { const float pv = (fr == 0) ? (m > 0 ? up[m > 0 ? m - 1 : 0] : xp[n][i + e]) : up[m];
                            const float nv = (fr == 15) ? (m < 3 ? dn[m < 3 ? m + 1 : 3] : xn[n][i + e]) : dn[m];
                            r[m][e] = w0[k] * pv + w1[k] * g[m] + w2[k] * nv + bb[k]; } }
#pragma unroll
                    for (int m = 0; m < 4; ++m) { const pg8::f32x2 gl = pg8::gelu_pk((pg8::f32x2){r[m][0], r[m][1]});
                        const bool e0 = (bi == 0 && m == 0 && fr == 0), e1 = (bi == 3 && m == 3 && fr == 15);
                        if (e0 || e1) { float* ep = edge + ((size_t)(u.pm * 2 + (e1 ? 1 : 0)) * DFF + f0 + 4 * n + i);
                            ep[0] = r[m][0]; ep[1] = r[m][1]; ep[EDGE_STRIDE] = acc[ai][1][m][n][i]; ep[EDGE_STRIDE + 1] = acc[ai][1][m][n][i + 1];
                            ep[2 * EDGE_STRIDE] = acc[ai][0][m][n][i]; ep[2 * EDGE_STRIDE + 1] = acc[ai][0][m][n][i + 1]; }
                        o[m][2 * n + (i >> 1)] = pg8::cvt_pk_bf16(gl.x * acc[ai][0][m][n][i], gl.y * acc[ai][0][m][n][i + 1]); }
                }
#pragma unroll
            for (int m = 0; m < 4; ++m) { const int row = u.pm * 256 + ai * 128 + wr * 64 + m * 16 + fr;
                u32x4 w; w.x = o[m][0]; w.y = o[m][1]; w.z = o[m][2]; w.w = o[m][3];
                *(u32x4*)(ACT + (size_t)row * DFF + f0) = w; }
        }
    }
};
DI void glu_fixup(const Args& a, int pm, int tid) {
    const float* edge = (const float*)(a.ws + OFF_EDGE); bf16_t* ACT = (bf16_t*)(a.ws + OFF_ACT);
    for (int idx = tid; idx < 2 * DFF; idx += 512) { const int e = idx / DFF, f = idx % DFF, t = pm * 256 + 255 * e;
        const float part = edge[(size_t)(pm * 2 + e) * DFF + f], uu = edge[2 * EDGE_STRIDE + (size_t)(pm * 2 + e) * DFF + f];
        float miss = 0.f;
        if (e == 0) { if ((t & (SEQ - 1)) != 0) miss = a.conv_w[f] * edge[EDGE_STRIDE + (size_t)((pm - 1) * 2 + 1) * DFF + f]; }
        else { if (((t + 1) & (SEQ - 1)) != 0) miss = a.conv_w[2 * DFF + f] * edge[EDGE_STRIDE + (size_t)((pm + 1) * 2) * DFF + f]; }
        const float g = part + miss;
        ACT[(size_t)t * DFF + f] = (bf16_t)f2bf(0.5f * g * (1.f + erff(g * 0.70710678118654752f)) * uu); }
}

DI void tr_block(const float* src, int ldw, bf16_t* dst, int ldd, float scale, LAS float* scr, int lane) {
#pragma unroll 8
    for (int i = 0; i < 32; ++i) { const int kk = 2 * i + (lane >> 5); scr[kk * 33 + (lane & 31)] = src[(size_t)kk * ldw + (lane & 31)]; }
    asm volatile("s_waitcnt lgkmcnt(0)" ::: "memory");
    const int c = lane & 7;
#pragma unroll
    for (int j = 0; j < 4; ++j) { const int n = (lane >> 3) + 8 * j; const LAS float* s = scr + (8 * c) * 33 + n;
        u32x4 o; o.x = pk2(s[0 * 33] * scale, s[1 * 33] * scale); o.y = pk2(s[2 * 33] * scale, s[3 * 33] * scale); o.z = pk2(s[4 * 33] * scale, s[5 * 33] * scale); o.w = pk2(s[6 * 33] * scale, s[7 * 33] * scale);
        *(u32x4*)(dst + (size_t)n * ldd + 8 * c) = o; }
    asm volatile("s_waitcnt lgkmcnt(0)" ::: "memory");
}
DI void phase0(const Args& a, LAS unsigned char* lds, int tid, int lane, int wave) {
    LAS float* sc = (LAS float*)lds;
    LAS float* red = sc + 4096;
    float* mod = (float*)(a.ws + OFF_MOD);
    for (int i = tid; i < 4096; i += 512) { const float v = a.c[i]; sc[i] = v / (1.f + __expf(-v)); }
    __syncthreads();
    for (int item = blockIdx.x; item < 256; item += gridDim.x) {
        const int n0 = item * 48;
        if (tid < 384) {
            const int cq = tid % 12, ks = tid / 12;
            f32x4 a0 = {0.f, 0.f, 0.f, 0.f}, a1 = {0.f, 0.f, 0.f, 0.f};
            const float* wp = a.w_ada + (size_t)(ks * 64) * NMOD + n0 + 4 * cq;
#pragma unroll 8
            for (int kk = 0; kk < 64; ++kk) { const f32x4 w = *(const f32x4*)(wp + (size_t)kk * NMOD); const float s0 = sc[ks * 64 + kk], s1 = sc[2048 + ks * 64 + kk]; a0 += s0 * w; a1 += s1 * w; }
            LAS float* rp = red + (ks * 12 + cq) * 8;
            *(LAS f32x4*)rp = a0; *(LAS f32x4*)(rp + 4) = a1;
        }
        __syncthreads();
        if (tid < 96) { const int cq = tid >> 3, j = tid & 7; float s = 0.f;
            for (int ks = 0; ks < 32; ++ks) s += red[(ks * 12 + cq) * 8 + j];
            const int bb = j >> 2, col = n0 + 4 * cq + (j & 3); mod[bb * NMOD + col] = s + a.b_ada[col]; }
        __syncthreads();
    }
    LAS float* scr = (LAS float*)(lds + 32768 + wave * 8448);
    bf16_t* WinT = (bf16_t*)(a.ws + OFF_WIN); bf16_t* WoutT = (bf16_t*)(a.ws + OFF_WOUT); bf16_t* WupT = (bf16_t*)(a.ws + OFF_WUP); bf16_t* WdnT = (bf16_t*)(a.ws + OFF_WDN);
    constexpr int I_IN = 32 * (NPC / 32), I_OUT = 32 * (DM / 32), I_UP = 32 * (NUP / 32), I_DN = (DFF / 64) * (DM / 32);
    const int gw = blockIdx.x * 8 + wave, NGW = gridDim.x * 8;
    for (int it = gw; it < I_IN + I_OUT + I_UP + I_DN; it += NGW) {
        int r = it;
        if (r < I_IN) { const int nblk = NPC / 32, kb = r / nblk, nb = r % nblk, n0 = nb * 32, ns = n0 < 4096 ? n0 : n0 + 16;
            tr_block(a.w_in + (size_t)(kb * 64) * WIN_LD + ns, WIN_LD, WinT + (size_t)n0 * DM + kb * 64, DM, (n0 >= 1024 && n0 < 2048) ? 0.0625f : 1.f, scr, lane); continue; }
        r -= I_IN;
        if (r < I_OUT) { const int nblk = DM / 32, kb = r / nblk, nb = r % nblk;
            tr_block(a.w_out + (size_t)(kb * 64) * DM + nb * 32, DM, WoutT + (size_t)(nb * 32) * DM + kb * 64, DM, 1.f, scr, lane); continue; }
        r -= I_OUT;
        if (r < I_UP) { const int nblk = NUP / 32, kb = r / nblk, nb = r % nblk, n0 = nb * 32, pn = n0 >> 8, j0 = n0 & 255, ns = (j0 < 128) ? pn * 128 + j0 : DFF + pn * 128 + j0 - 128;
            tr_block(a.w_up + (size_t)(kb * 64) * NUP + ns, NUP, WupT + (size_t)n0 * DM + kb * 64, DM, 1.f, scr, lane); continue; }
        r -= I_UP;
        { const int nblk = DM / 32, kb = r / nblk, nb = r % nblk;
            tr_block(a.w_down + (size_t)(kb * 64) * DM + nb * 32, DM, WdnT + (size_t)(nb * 32) * DFF + kb * 64, DFF, 1.f, scr, lane); }
    }
}

DI float gate_reduce16(float (&g16)[16], int lane) {
#pragma unroll
    for (int i = 0; i < 8; ++i) { const bool hi = lane & 32; const float snd = hi ? g16[i] : g16[i + 8], keep = hi ? g16[i + 8] : g16[i]; g16[i] = keep + __shfl_xor(snd, 32); }
#pragma unroll
    for (int i = 0; i < 4; ++i) { const bool hi = lane & 16; const float snd = hi ? g16[i] : g16[i + 4], keep = hi ? g16[i + 4] : g16[i]; g16[i] = keep + __shfl_xor(snd, 16); }
#pragma unroll
    for (int i = 0; i < 2; ++i) { const bool hi = lane & 8; const float snd = hi ? g16[i] : g16[i + 2], keep = hi ? g16[i + 2] : g16[i]; g16[i] = keep + __shfl_xor(snd, 8); }
    { const bool hi = lane & 4; const float snd = hi ? g16[0] : g16[1], keep = hi ? g16[1] : g16[0]; g16[0] = keep + __shfl_xor(snd, 4); }
    g16[0] += __shfl_xor(g16[0], 2); g16[0] += __shfl_xor(g16[0], 1);
    return g16[0];
}
template <bool GATES, bool IN_BF16> DI void phase_norm(const Args& a, LAS unsigned char* lds, const void* xin_, const float* gn, int sh_off, int sc_off, int tid, int lane, int wave) {
    const float* xin = (const float*)xin_; const bf16_t* xin16 = (const bf16_t*)xin_;
    const float* mod = (const float*)(a.ws + OFF_MOD);
    bf16_t* Hb = (bf16_t*)(a.ws + OFF_HB);
    float* gates = (float*)(a.ws + OFF_GATES);
    LAS float* wg = (LAS float*)lds;
    if (GATES) {
        __syncthreads();
        for (int idx = tid; idx < 2048 * 16; idx += 512) { const int k = idx >> 4, i = idx & 15; wg[i * 2052 + k] = a.w_in[(size_t)k * WIN_LD + 4096 + i]; }
        __syncthreads();
    }
    constexpr int R = GATES ? 2 : 4;
    const int gw = blockIdx.x * 8 + wave, NGW = gridDim.x * 8;
    int curb = -1; f32x4 gs[8], sh[8];
    for (int m = R * gw; m < MTOK; m += R * NGW) {
        const int bb = m >> 13;
        if (bb != curb) { curb = bb;
#pragma unroll
            for (int j = 0; j < 8; ++j) { const int k = 4 * lane + 256 * j; const f32x4 g = *(const f32x4*)(gn + k), s = *(const f32x4*)(mod + bb * NMOD + sc_off + k);
                gs[j] = g * (1.f + s); sh[j] = *(const f32x4*)(mod + bb * NMOD + sh_off + k); } }
        f32x4 v[R][8];
#pragma unroll
        for (int r = 0; r < R; ++r)
#pragma unroll
            for (int j = 0; j < 8; ++j) {
                if (IN_BF16) { const u32x2 p0 = *(const u32x2*)(xin16 + (size_t)(m + r) * DM + 4 * lane + 256 * j);
                    v[r][j] = (f32x4){bf2f(p0.x & 0xffffu), bf2f(p0.x >> 16), bf2f(p0.y & 0xffffu), bf2f(p0.y >> 16)}; }
                else v[r][j] = *(const f32x4*)(xin + (size_t)(m + r) * DM + 4 * lane + 256 * j); }
#pragma unroll
        for (int r = 0; r < R; ++r) { float ss = 0.f;
#pragma unroll
            for (int j = 0; j < 8; ++j) ss += (v[r][j].x * v[r][j].x + v[r][j].y * v[r][j].y) + (v[r][j].z * v[r][j].z + v[r][j].w * v[r][j].w);
            const float rstd = rsqrtf(wave_sum(ss) * (1.f / DM) + EPSN);
#pragma unroll
            for (int j = 0; j < 8; ++j) { v[r][j] = v[r][j] * rstd * gs[j] + sh[j];
                u32x2 o; o.x = pk2(v[r][j].x, v[r][j].y); o.y = pk2(v[r][j].z, v[r][j].w); *(u32x2*)(Hb + (size_t)(m + r) * DM + 4 * lane + 256 * j) = o; } }
        if (GATES) {
            float ga[16], gb[16];
#pragma unroll
            for (int i = 0; i < 16; ++i) { float s0 = 0.f, s1 = 0.f;
#pragma unroll
                for (int j = 0; j < 8; ++j) { const f32x4 w = *(const LAS f32x4*)(wg + i * 2052 + 4 * lane + 256 * j);
                    s0 += (v[0][j].x * w.x + v[0][j].y * w.y) + (v[0][j].z * w.z + v[0][j].w * w.w); s1 += (v[R - 1][j].x * w.x + v[R - 1][j].y * w.y) + (v[R - 1][j].z * w.z + v[R - 1][j].w * w.w); }
                ga[i] = s0; gb[i] = s1; __builtin_amdgcn_sched_barrier(0); }
            const float r0 = gate_reduce16(ga, lane), r1 = gate_reduce16(gb, lane);
            if ((lane & 3) == 0) { const int gi = ((lane >> 5) & 1) * 8 + ((lane >> 4) & 1) * 4 + ((lane >> 3) & 1) * 2 + ((lane >> 2) & 1); const float bg = a.b_gates[gi];
                gates[(size_t)m * 16 + gi] = r0 + bg; gates[(size_t)(m + 1) * 16 + gi] = r1 + bg; }
        }
    }
}

DI void gate_prep(const Args& a, LAS unsigned char* lds, int combo, int tid) {
    const float* gates = (const float*)(a.ws + OFF_GATES);
    float* ulA = (float*)(a.ws + OFF_UL); float* MlA = (float*)(a.ws + OFF_ML); float* emtA = (float*)(a.ws + OFF_EMT);
    float* mprevA = (float*)(a.ws + OFF_MPREV); float* mendA = (float*)(a.ws + OFF_MEND);
    LAS float* sT = (LAS float*)lds; LAS float* sM = sT + 512; LAS float* sG = sM + 512; LAS float* sX = sG + 32; LAS float* sMp = sX + 32; LAS float* sMe = sMp + 32;
    const int b = combo >> 3, dir = (combo >> 2) & 1, h = combo & 3;
    const int ci = dir * 8 + h, cf = dir * 8 + 4 + h, cs = tid >> 4;
    float li[16], bl[16], cm[16];
    float run = 0.f;
#pragma unroll
    for (int i = 0; i < 16; ++i) { const int tau = tid * 16 + i, t = dir ? SEQ - 1 - tau : tau; const float* gp = gates + (size_t)(b * SEQ + t) * 16;
        li[i] = gp[ci]; const float f = gp[cf]; const float lf = fminf(f, 0.f) - log1pf(__expf(-fabsf(f))); run += lf; bl[i] = run; }
    sT[tid] = run; __syncthreads();
    float base = 0.f; for (int j = cs * 16; j < tid; ++j) base += sT[j];
    float mx = -3.0e38f;
#pragma unroll
    for (int i = 0; i < 16; ++i) { bl[i] += base; li[i] -= bl[i]; mx = fmaxf(mx, li[i]); cm[i] = mx; }
    sM[tid] = mx; __syncthreads();
    float mbase = -3.0e38f; for (int j = cs * 16; j < tid; ++j) mbase = fmaxf(mbase, sM[j]);
    if (tid < 32) { float g = 0.f, xm = -3.0e38f; for (int j = 0; j < 16; ++j) { g += sT[tid * 16 + j]; xm = fmaxf(xm, sM[tid * 16 + j]); } sG[tid] = g; sX[tid] = xm; }
    __syncthreads();
    if (tid == 0) { float m = -1e30f; for (int c = 0; c < 32; ++c) { sMp[c] = m; const float me = fmaxf(m, sX[c]); sMe[c] = me; m = sG[c] + me; } }
    __syncthreads();
    const float mp = sMp[cs];
#pragma unroll
    for (int i = 0; i < 16; ++i) { const int tau = tid * 16 + i, t = dir ? SEQ - 1 - tau : tau; const float Ml = fmaxf(mp, fmaxf(cm[i], mbase));
        ulA[combo * SEQ + t] = li[i]; MlA[combo * SEQ + t] = Ml; emtA[combo * SEQ + t] = __expf(-(bl[i] + Ml)); }
    if ((tid & 15) == 0) { const int c = dir ? NCH - 1 - cs : cs; mprevA[combo * NCH + c] = mp; mendA[combo * NCH + c] = sMe[cs]; }
    __syncthreads();
}

DI void mlstm_delta(const Args& a, LAS unsigned char* lds, int tid, int lane, int wave) {
    const bf16_t* P = (const bf16_t*)(a.ws + OFF_P); bf16_t* cst = (bf16_t*)(a.ws + OFF_CST);
    const float* ulA = (const float*)(a.ws + OFF_UL); const float* mendA = (const float*)(a.ws + OFF_MEND);
    const int l15 = lane & 15, quad = lane >> 4, qin = l15 >> 2, pin = l15 & 3;
    constexpr int BUFB = 2 * 34816;
    LAS float* wS = (LAS float*)(lds + 2 * BUFB);
    const short one = (l15 == 0) ? (short)0x3F80 : (short)0;
    const bf16x8 ones = {one, one, one, one, one, one, one, one};
    for (int item = blockIdx.x; item < NCOMBO * NCH; item += gridDim.x) {
        const int combo = item / NCH, c = item % NCH, b = combo >> 3, h = combo & 3;
        const float mend = mendA[combo * NCH + c];
        __syncthreads();
        if (tid < 256) wS[tid] = __expf(ulA[combo * SEQ + c * LCH + tid] - mend);
        f32x4 acc[17][2];
#pragma unroll
        for (int m = 0; m < 17; ++m) { acc[m][0] = (f32x4){0.f, 0.f, 0.f, 0.f}; acc[m][1] = (f32x4){0.f, 0.f, 0.f, 0.f}; }
        const bf16_t* Pk = P + (size_t)(b * SEQ + c * LCH) * NPC + 1024 + h * 256;
        u32x4 pre[8];
#define DL_LOAD(sb_) do { int t0_ = tid; asm volatile("" : "+v"(t0_)); const bf16_t* src_ = Pk + (unsigned)(((sb_) * 64 + (t0_ >> 5)) * NPC + (t0_ & 31) * 8); \
        _Pragma("unroll") for (int i_ = 0; i_ < 4; ++i_) { pre[i_] = *(const u32x4*)(src_ + i_ * 16 * NPC); pre[4 + i_] = *(const u32x4*)(src_ + i_ * 16 * NPC + 1024); } } while (0)
#define DL_STORE(sb_) do { int t0_ = tid; asm volatile("" : "+v"(t0_)); LAS unsigned char* d_ = lds + ((sb_) & 1) * BUFB + (t0_ >> 5) * 544 + (t0_ & 31) * 16; \
        _Pragma("unroll") for (int i_ = 0; i_ < 4; ++i_) { const float w_ = wS[(sb_) * 64 + (t0_ >> 5) + 16 * i_]; \
            *(LAS bf16x8*)(d_ + i_ * 16 * 544) = scale8(__builtin_bit_cast(bf16x8, pre[i_]), w_); *(LAS u32x4*)(d_ + 34816 + i_ * 16 * 544) = pre[4 + i_]; } } while (0)
        DL_LOAD(0);
        __syncthreads();
        DL_STORE(0);
        __syncthreads();
#pragma unroll 1
        for (int sb = 0; sb < 4; ++sb) {
            const LAS unsigned char* Kt = lds + (sb & 1) * BUFB; const LAS unsigned char* Vt = Kt + 34816;
            if (sb + 1 < 4) DL_LOAD(sb + 1);
#pragma unroll 1
            for (int kk = 0; kk < 2; ++kk) {
                bf16x8 bfr[2];
#pragma unroll
                for (int n = 0; n < 2; ++n) bfr[n] = tr_frag(Kt, 544, kk * 32 + 4 * quad, kk * 32 + 16 + 4 * quad, wave * 32 + n * 16, qin, pin);
#pragma unroll
                for (int m = 0; m < 16; ++m) { const bf16x8 afr = tr_frag(Vt, 544, kk * 32 + 4 * quad, kk * 32 + 16 + 4 * quad, m * 16, qin, pin);
                    acc[m][0] = MFMA16(bfr[0], afr, acc[m][0]); acc[m][1] = MFMA16(bfr[1], afr, acc[m][1]); if ((m & 3) == 3) __builtin_amdgcn_sched_barrier(0); }
                acc[16][0] = MFMA16(bfr[0], ones, acc[16][0]); acc[16][1] = MFMA16(bfr[1], ones, acc[16][1]);
            }
            if (sb + 1 < 4) DL_STORE(sb + 1);
            __syncthreads();
        }
#undef DL_LOAD
#undef DL_STORE
        int loff = l15 * 256 + wave * 32 + 4 * quad; asm volatile("" : "+v"(loff));
        bf16_t* dst = cst + (size_t)item * ST_ELEMS + loff;
#pragma unroll
        for (int m = 0; m < 17; ++m) {
#pragma unroll
            for (int n = 0; n < 2; ++n) { u32x2 w; w.x = pk2(acc[m][n][0], acc[m][n][1]); w.y = pk2(acc[m][n][2], acc[m][n][3]); *(u32x2*)(dst + (16 * m) * 256 + 16 * n) = w; }
            __builtin_amdgcn_sched_barrier(0); }
    }
}

DI void mlstm_scan(const Args& a, int tid) {
    bf16_t* cst = (bf16_t*)(a.ws + OFF_CST);
    const float* mprevA = (const float*)(a.ws + OFF_MPREV); const float* mendA = (const float*)(a.ws + OFF_MEND);
    constexpr int VPS = ST_ELEMS / 8;
    const int gt = blockIdx.x * 512 + tid, NT = gridDim.x * 512;
    for (int v = gt; v < NCOMBO * VPS; v += NT) {
        const int combo = v / VPS, vi = v % VPS, dir = (combo >> 2) & 1;
        float st[8];
#pragma unroll
        for (int i = 0; i < 8; ++i) st[i] = 0.f;
        bf16_t* base = cst + (size_t)combo * NCH * ST_ELEMS + vi * 8;
        for (int cs0 = 0; cs0 < NCH; cs0 += 8) {
            u32x4 d[8]; float dec[8];
#pragma unroll
            for (int q = 0; q < 8; ++q) { const int c = dir ? NCH - 1 - (cs0 + q) : cs0 + q;
                d[q] = *(const u32x4*)(base + (size_t)c * ST_ELEMS); dec[q] = __expf(mprevA[combo * NCH + c] - mendA[combo * NCH + c]); }
#pragma unroll
            for (int q = 0; q < 8; ++q) { const int c = dir ? NCH - 1 - (cs0 + q) : cs0 + q;
                u32x4 o;
#pragma unroll
                for (int i = 0; i < 4; ++i) { o[i] = pk2(st[2 * i], st[2 * i + 1]); st[2 * i] = dec[q] * st[2 * i] + bf2f(d[q][i] & 0xffffu); st[2 * i + 1] = dec[q] * st[2 * i + 1] + bf2f(d[q][i] >> 16); }
                *(u32x4*)(base + (size_t)c * ST_ELEMS) = o; }
        }
    }
}

DI void nat_scores(f32x4 (&st)[4][2], const LAS unsigned char* T, const bf16x8 (&qf)[4], int kc0, int l15, int quad) {
#pragma unroll
    for (int k4 = 0; k4 < 4; ++k4)
#pragma unroll
        for (int mi = 0; mi < 2; ++mi) { f32x4 s = {0.f, 0.f, 0.f, 0.f};
#pragma unroll
            for (int ks = 0; ks < 4; ++ks) { s = MFMA16(ld_frag(T + (k4 * 64 + kc0 + 16 * mi + l15) * 272 + (ks * 32 + quad * 8) * 2), qf[ks], s); if (ks == 1) __builtin_amdgcn_sched_barrier(0); }
            st[k4][mi] = s; __builtin_amdgcn_sched_barrier(0); }
}
DI float nat_mask(f32x4 (&st)[4][2], const LAS float* rpbS, int kr0, int rs, int r, const bool (&sel)[4], const int (&dcb)[4], float scale) {
    float mx = -3.0e38f;
#pragma unroll
    for (int k4 = 0; k4 < 4; ++k4) { const int dr = rs + kr0 + k4 - r + 7;
#pragma unroll
        for (int rr = 0; rr < 4; ++rr) { const float sv = (sel[rr] ? st[k4][0][rr] : st[k4][1][rr]) * scale + rpbS[dr * 31 + dcb[rr]]; st[k4][0][rr] = sv; mx = fmaxf(mx, sv); } }
    mx = fmaxf(mx, __shfl_xor(mx, 16)); mx = fmaxf(mx, __shfl_xor(mx, 32));
    return mx;
}
DI float nat_exp(bf16x8 (&pf)[4], f32x4 (&st)[4][2], const bool (&sel)[4], float m) {
    float sum = 0.f;
#pragma unroll
    for (int k4 = 0; k4 < 4; ++k4) { f32x4 p0, p1;
#pragma unroll
        for (int rr = 0; rr < 4; ++rr) { const float p = __expf(st[k4][0][rr] - m); sum += p; p0[rr] = sel[rr] ? p : 0.f; p1[rr] = sel[rr] ? 0.f : p; }
        pf[k4] = pack8(p0, p1); }
    return sum;
}
DI void nat_pv(f32x4 (&o)[8], const bf16x8 (&pf)[4], const LAS unsigned char* T, int kc0, int quad, int qin, int pin) {
#pragma unroll
    for (int k4 = 0; k4 < 4; ++k4) {
#pragma unroll
        for (int n = 0; n < 8; ++n) { o[n] = MFMA16(tr_frag(T + k4 * 64 * 272, 272, kc0 + 4 * quad, kc0 + 16 + 4 * quad, 16 * n, qin, pin), pf[k4], o[n]); if ((n & 3) == 3) __builtin_amdgcn_sched_barrier(0); } }
}
DI void natten(const Args& a, LAS unsigned char* lds, int tid, int lane, int wave) {
    const bf16_t* P = (const bf16_t*)(a.ws + OFF_P); bf16_t* mixed = (bf16_t*)(a.ws + OFF_HB);
    const int l15 = lane & 15, quad = lane >> 4, qin = l15 >> 2, pin = l15 & 3;
    const int hw = wave >> 2, j = wave & 3, htid = tid & 255;
    LAS unsigned char* T = lds + hw * 69632;
    LAS float* rpbS = (LAS float*)(lds + 139264) + hw * 480;
    const int kc0 = (j == 0) ? 0 : (j == 1) ? 8 : (j == 2) ? 24 : 32;
    const float scale = 0.08838834764831845f;
    const int nit = (1024 - (int)blockIdx.x + (int)gridDim.x - 1) / (int)gridDim.x;
    if (nit <= 0) return;
    __syncthreads();
    { const int h0 = (blockIdx.x & 3) * 2 + hw; for (int i = htid; i < 465; i += 256) rpbS[i] = a.rpb[h0 * 465 + i]; }
    u32x4 pre[16];
    const bool xmap = (gridDim.x == 256);
#define NAT_ITEM(k_) (xmap ? ((((int)blockIdx.x & 7) >> 2) << 9) | ((32 * (k_) + ((int)blockIdx.x >> 3)) << 2) | ((int)blockIdx.x & 3) : (int)blockIdx.x + (k_) * (int)gridDim.x)
#define NAT_LOAD(g_) do { const int it_ = NAT_ITEM((g_) >> 2), sp_ = (g_) & 3; const int b_ = it_ >> 9, r_ = (it_ >> 2) & 127, h_ = (it_ & 3) * 2 + hw; \
        const int rs_ = min(max(r_ - 4, 0), 120); int t0_ = htid; asm volatile("" : "+v"(t0_)); \
        const bf16_t* src_ = P + (unsigned)((b_ * SEQ + (rs_ + 4 * (sp_ & 1)) * 64) * NPC + ((sp_ >> 1) ? 6144 : 5120) + h_ * 128 + ((t0_ >> 4) * NPC + (t0_ & 15) * 8)); \
        _Pragma("unroll") for (int i_ = 0; i_ < 16; ++i_) pre[i_] = *(const u32x4*)(src_ + i_ * 16 * NPC); } while (0)
#define NAT_STORE() do { int t0_ = htid; asm volatile("" : "+v"(t0_)); LAS unsigned char* d_ = T + (t0_ >> 4) * 272 + (t0_ & 15) * 16; \
        _Pragma("unroll") for (int i_ = 0; i_ < 16; ++i_) *(LAS u32x4*)(d_ + i_ * 16 * 272) = pre[i_]; } while (0)
    NAT_LOAD(0); NAT_STORE();
    __syncthreads();
#pragma unroll 1
    for (int k = 0; k < nit; ++k) {
        const int item = NAT_ITEM(k);
        const int b = item >> 9, r = (item >> 2) & 127, h = (item & 3) * 2 + hw;
        int l15g = l15; asm volatile("" : "+v"(l15g));
        const int rs = min(max(r - 4, 0), 120), qcol = 16 * j + l15g;
        const int tokq = b * SEQ + r * 64 + qcol;
        bf16x8 qf[4]; f32x4 st[4][2]; bf16x8 pf0[4], pf1[4];
#pragma unroll
        for (int ks = 0; ks < 4; ++ks) qf[ks] = *(const bf16x8*)(P + (unsigned)(tokq * NPC + 4096 + h * 128 + ks * 32 + quad * 8));
        const int cs = min(max(qcol - 8, 0), 48);
        bool sel[4]; int dcb[4];
#pragma unroll
        for (int rr = 0; rr < 4; ++rr) { sel[rr] = (4 * quad + rr >= cs - kc0); dcb[rr] = kc0 + 4 * quad + rr + (sel[rr] ? 0 : 16) - qcol + 15; }
        NAT_LOAD(4 * k + 1);
        nat_scores(st, T, qf, kc0, l15, quad);
        const float m0 = nat_mask(st, rpbS, 0, rs, r, sel, dcb, scale);
        float sum0 = nat_exp(pf0, st, sel, m0);
        __syncthreads(); NAT_STORE(); __syncthreads();
        NAT_LOAD(4 * k + 2);
        nat_scores(st, T, qf, kc0, l15, quad);
        const float m1 = nat_mask(st, rpbS, 4, rs, r, sel, dcb, scale);
        const float M = fmaxf(m0, m1), f0 = __expf(m0 - M);
        float sum1 = nat_exp(pf1, st, sel, M);
        float tot = sum0 * f0 + sum1;
        tot += __shfl_xor(tot, 16); tot += __shfl_xor(tot, 32);
        const float inv = 1.f / tot;
        __syncthreads(); NAT_STORE(); __syncthreads();
        f32x4 o[8];
#pragma unroll
        for (int n = 0; n < 8; ++n) o[n] = (f32x4){0.f, 0.f, 0.f, 0.f};
        NAT_LOAD(4 * k + 3);
        nat_pv(o, pf0, T, kc0, quad, qin, pin);
#pragma unroll
        for (int n = 0; n < 8; ++n) o[n] = o[n] * f0;
        __syncthreads(); NAT_STORE(); __syncthreads();
        if (k + 1 < nit) NAT_LOAD(4 * k + 4);
        nat_pv(o, pf1, T, kc0, quad, qin, pin);
#pragma unroll
        for (int n = 0; n < 8; ++n) { u32x2 w; w.x = pk2(o[n][0] * inv, o[n][1] * inv); w.y = pk2(o[n][2] * inv, o[n][3] * inv);
            *(u32x2*)(mixed + (unsigned)(tokq * DM + 1024 + h * 128 + 16 * n + 4 * quad)) = w; }
        __syncthreads();
        if (k + 1 < nit) NAT_STORE();
        __syncthreads();
    }
#undef NAT_LOAD
#undef NAT_ITEM
#undef NAT_STORE
}

DI void mlstm_out(const Args& a, LAS unsigned char* lds, int tid, int lane, int wave) {
    const bf16_t* P = (const bf16_t*)(a.ws + OFF_P); const bf16_t* cst = (const bf16_t*)(a.ws + OFF_CST); bf16_t* mixed = (bf16_t*)(a.ws + OFF_HB);
    const float* ulA = (const float*)(a.ws + OFF_UL); const float* MlA = (const float*)(a.ws + OFF_ML); const float* emtA = (const float*)(a.ws + OFF_EMT);
    const float* mprevA = (const float*)(a.ws + OFF_MPREV);
    const int l15 = lane & 15, quad = lane >> 4, qin = l15 >> 2, pin = l15 & 3;
    constexpr int BUFB = 33792 + 34816;
    LAS float* ulS2 = (LAS float*)(lds + 2 * BUFB);
    const short one = (l15 == 0) ? (short)0x3F80 : (short)0;
    const bf16x8 ones = {one, one, one, one, one, one, one, one};
    for (int item = blockIdx.x; item < 512; item += gridDim.x) {
        const int bh = item >> 6, c = (item >> 1) & 31, half = item & 1, b = bh >> 2, h = bh & 3;
        int l15i = l15, tt = tid; asm volatile("" : "+v"(l15i), "+v"(tt));
        const int t_loc = 128 * half + 16 * wave + l15i;
        const size_t tok = (size_t)b * SEQ + c * LCH + t_loc;
        const int n0 = 2 * half + 2;
        __syncthreads();
        { const int d = tt >> 8; ulS2[tt] = ulA[((b * 2 + d) * 4 + h) * SEQ + c * LCH + (tt & 255)]; }
        u32x4 pre[8];
#define STEP_DEC(s_, dir_, st_, idx_) do { int r_ = (s_); dir_ = 0; if (r_ >= n0 + 4) { r_ -= n0 + 4; dir_ = 1; } const int nk_ = dir_ ? 4 - 2 * half : n0; st_ = (r_ >= nk_); idx_ = st_ ? r_ - nk_ : (dir_ ? 2 * half + r_ : r_); } while (0)
#define STEP_LOAD(s_) do { int dir_, st_, idx_; STEP_DEC(s_, dir_, st_, idx_); int t0_ = tid; asm volatile("" : "+v"(t0_)); \
        if (!st_) { const bf16_t* src_ = P + ((size_t)b * SEQ + c * LCH + 64 * idx_) * NPC + 1024 + h * 256 + ((t0_ >> 5) * NPC + (t0_ & 31) * 8); \
            _Pragma("unroll") for (int i_ = 0; i_ < 4; ++i_) { pre[i_] = *(const u32x4*)(src_ + i_ * 16 * NPC); pre[4 + i_] = *(const u32x4*)(src_ + i_ * 16 * NPC + 1024); } } \
        else { const bf16_t* src_ = cst + (size_t)(((b * 2 + dir_) * 4 + h) * NCH + c) * ST_ELEMS + 64 * idx_ + ((t0_ >> 3) * 256 + (t0_ & 7) * 8); \
            _Pragma("unroll") for (int i_ = 0; i_ < 4; ++i_) pre[i_] = *(const u32x4*)(src_ + i_ * 64 * 256); \
            if (t0_ < 128) pre[4] = *(const u32x4*)(src_ + 4 * 64 * 256); } } while (0)
#define STEP_STORE(s_) do { int dir_, st_, idx_; STEP_DEC(s_, dir_, st_, idx_); LAS unsigned char* bp_ = lds + ((s_) & 1) * BUFB; int t0_ = tid; asm volatile("" : "+v"(t0_)); \
        if (!st_) { LAS unsigned char* d_ = bp_ + (t0_ >> 5) * 528 + (t0_ & 31) * 16; \
            _Pragma("unroll") for (int i_ = 0; i_ < 4; ++i_) { *(LAS u32x4*)(d_ + i_ * 16 * 528) = pre[i_]; *(LAS u32x4*)(bp_ + 33792 + ((t0_ >> 5) + 16 * i_) * 544 + (t0_ & 31) * 16) = pre[4 + i_]; } } \
        else { LAS unsigned char* d_ = bp_ + (t0_ >> 3) * 144 + (t0_ & 7) * 16; \
            _Pragma("unroll") for (int i_ = 0; i_ < 4; ++i_) *(LAS u32x4*)(d_ + i_ * 64 * 144) = pre[i_]; \
            if (t0_ < 128) *(LAS u32x4*)(d_ + 4 * 64 * 144) = pre[4]; } } while (0)
        bf16x8 qf[8];
        { int qo = h * 256 + quad * 8; asm volatile("" : "+v"(qo)); const bf16_t* qp = P + tok * NPC + qo;
#pragma unroll
          for (int ks = 0; ks < 8; ++ks) qf[ks] = *(const bf16x8*)(qp + ks * 32); }
        STEP_LOAD(0); STEP_STORE(0);
        __syncthreads();
        f32x4 acc[17]; float Ml = 0.f, emt = 1.f, aa = 0.f;
#pragma unroll 1
        for (int s = 0; s < 14; ++s) {
            int dir, st, idx; STEP_DEC(s, dir, st, idx);
            const LAS unsigned char* T0 = lds + (s & 1) * BUFB; const LAS unsigned char* T1 = T0 + 33792;
            const LAS float* ulS = ulS2 + dir * 256;
            if (s == 0 || s == n0 + 4) {
                const int combo = (b * 2 + dir) * 4 + h;
                Ml = MlA[combo * SEQ + c * LCH + t_loc]; emt = emtA[combo * SEQ + c * LCH + t_loc]; aa = __expf(mprevA[combo * NCH + c] - Ml);
#pragma unroll
                for (int m = 0; m < 17; ++m) acc[m] = (f32x4){0.f, 0.f, 0.f, 0.f};
            }
            if (s + 1 < 14) STEP_LOAD(s + 1);
            if (!st && (dir ? (64 * idx + 63 >= 128 * half + 16 * wave) : (64 * idx <= 128 * half + 16 * wave + 15))) {
                const int jb = idx;
                f32x4 sc[4];
#pragma unroll
                for (int mi = 0; mi < 4; ++mi) sc[mi] = (f32x4){0.f, 0.f, 0.f, 0.f};
#pragma unroll
                for (int mi = 0; mi < 4; ++mi) {
#pragma unroll
                    for (int ks = 0; ks < 8; ++ks) { sc[mi] = MFMA16(ld_frag(T0 + (16 * mi + l15) * 528 + (32 * ks + 8 * quad) * 2), qf[ks], sc[mi]); if (ks == 3) __builtin_amdgcn_sched_barrier(0); }
                    __builtin_amdgcn_sched_barrier(0); }
#pragma unroll
                for (int mi = 0; mi < 4; ++mi) { const int s0 = 64 * jb + 16 * mi + 4 * quad; const f32x4 uv = *(const LAS f32x4*)(ulS + s0);
#pragma unroll
                    for (int rr = 0; rr < 4; ++rr) { const int s_loc = s0 + rr; const bool valid = dir ? (s_loc >= t_loc) : (s_loc <= t_loc);
                        const float e = __expf(fminf(uv[rr] - Ml, 0.f)); sc[mi][rr] *= valid ? e : 0.f; } }
#pragma unroll
                for (int kk = 0; kk < 2; ++kk) { const bf16x8 pf = pack8(sc[2 * kk], sc[2 * kk + 1]);
                    bf16x8 f0 = tr_frag(T1, 544, 32 * kk + 4 * quad, 32 * kk + 16 + 4 * quad, 0, qin, pin), f1 = tr_frag(T1, 544, 32 * kk + 4 * quad, 32 * kk + 16 + 4 * quad, 16, qin, pin);
#pragma unroll
                    for (int n = 0; n < 16; n += 2) {
                        bf16x8 g0 = f0, g1 = f1;
                        if (n + 2 < 16) { g0 = tr_frag(T1, 544, 32 * kk + 4 * quad, 32 * kk + 16 + 4 * quad, 16 * (n + 2), qin, pin); g1 = tr_frag(T1, 544, 32 * kk + 4 * quad, 32 * kk + 16 + 4 * quad, 16 * (n + 3), qin, pin); }
                        acc[n] = MFMA16(f0, pf, acc[n]); acc[n + 1] = MFMA16(f1, pf, acc[n + 1]);
                        f0 = g0; f1 = g1; __builtin_amdgcn_sched_barrier(0); }
                    acc[16] = MFMA16(ones, pf, acc[16]); }
            } else if (st) {
                const int db = idx;
                bf16x8 aq[2];
                aq[0] = (db == 0) ? qf[0] : (db == 1) ? qf[2] : (db == 2) ? qf[4] : qf[6];
                aq[1] = (db == 0) ? qf[1] : (db == 1) ? qf[3] : (db == 2) ? qf[5] : qf[7];
                aq[0] = scale8(aq[0], aa); aq[1] = scale8(aq[1], aa);
#pragma unroll
                for (int kk = 0; kk < 2; ++kk) {
                    const LAS unsigned char* sp = T0 + l15 * 144 + (32 * kk + 8 * quad) * 2;
                    bf16x8 f0 = ld_frag(sp), f1 = ld_frag(sp + 16 * 144);
#pragma unroll
                    for (int m = 0; m < 16; m += 2) {
                        bf16x8 g0 = f0, g1 = f1;
                        if (m + 2 < 17) g0 = ld_frag(sp + 16 * (m + 2) * 144);
                        if (m + 3 < 17) g1 = ld_frag(sp + 16 * (m + 3) * 144);
                        acc[m] = MFMA16(f0, aq[kk], acc[m]); acc[m + 1] = MFMA16(f1, aq[kk], acc[m + 1]);
                        f0 = g0; f1 = g1; __builtin_amdgcn_sched_barrier(0); }
                    acc[16] = MFMA16(f0, aq[kk], acc[16]); }
            }
            if (s + 1 < 14) STEP_STORE(s + 1);
            if (s == n0 + 3 || s == 13) {
                const float den = __shfl(acc[16][0], l15);
                const float dn = 1.f / fmaxf(fabsf(den), emt);
                int moff = h * 256 + 4 * quad; asm volatile("" : "+v"(moff));
                bf16_t* mrow = mixed + tok * DM + moff;
                if (dir == 0) {
#pragma unroll
                    for (int n = 0; n < 16; ++n) { u32x2 w; w.x = pk2(acc[n][0] * dn, acc[n][1] * dn); w.y = pk2(acc[n][2] * dn, acc[n][3] * dn); *(u32x2*)(mrow + 16 * n) = w; }
                } else {
                    float ss = 0.f;
#pragma unroll
                    for (int n = 0; n < 16; ++n) { const u32x2 hf = *(const u32x2*)(mrow + 16 * n);
                        acc[n][0] = acc[n][0] * dn + bf2f(hf.x & 0xffffu); acc[n][1] = acc[n][1] * dn + bf2f(hf.x >> 16);
                        acc[n][2] = acc[n][2] * dn + bf2f(hf.y & 0xffffu); acc[n][3] = acc[n][3] * dn + bf2f(hf.y >> 16);
                        ss += (acc[n][0] * acc[n][0] + acc[n][1] * acc[n][1]) + (acc[n][2] * acc[n][2] + acc[n][3] * acc[n][3]); if ((n & 3) == 3) __builtin_amdgcn_sched_barrier(0); }
                    ss += __shfl_xor(ss, 16); ss += __shfl_xor(ss, 32);
                    const float rstd = rsqrtf(ss * (1.f / 256.f) + EPSN);
                    __builtin_amdgcn_sched_barrier(0);
                    int eb = h * 256 + 4 * quad; asm volatile("" : "+v"(eb));
                    const float* gp = a.g_head_a + eb; const bf16_t* ovp = P + tok * NPC + 3072 + eb;
#pragma unroll
                    for (int n = 0; n < 16; ++n) { const f32x4 g = *(const f32x4*)(gp + 16 * n);
                        const u32x2 ov = *(const u32x2*)(ovp + 16 * n);
                        const float o0 = bf2f(ov.x & 0xffffu), o1 = bf2f(ov.x >> 16), o2 = bf2f(ov.y & 0xffffu), o3 = bf2f(ov.y >> 16);
                        u32x2 w; w.x = pk2(acc[n][0] * rstd * g.x * __builtin_amdgcn_rcpf(1.f + __expf(-o0)), acc[n][1] * rstd * g.y * __builtin_amdgcn_rcpf(1.f + __expf(-o1)));
                        w.y = pk2(acc[n][2] * rstd * g.z * __builtin_amdgcn_rcpf(1.f + __expf(-o2)), acc[n][3] * rstd * g.w * __builtin_amdgcn_rcpf(1.f + __expf(-o3)));
                        *(u32x2*)(mrow + 16 * n) = w; __builtin_amdgcn_sched_barrier(0); }
                }
            }
            __syncthreads();
        }
#undef STEP_DEC
#undef STEP_LOAD
#undef STEP_STORE
    }
}

DI void phase_act(const Args& a, int tid) {
    bf16_t* UG = (bf16_t*)(a.ws + OFF_UG);
    constexpr int NV = DFF / 8, RUN = 16, NRUN = MTOK / RUN;
    const int gt = blockIdx.x * 512 + tid, NT = gridDim.x * 512;
    for (int it = gt; it < NRUN * NV; it += NT) {
        const int vv = it % NV, run = it / NV, f0 = vv * 8, t0 = run * RUN;
        float w0[8], w1[8], w2[8], cb[8];
#pragma unroll
        for (int i = 0; i < 8; ++i) { w0[i] = a.conv_w[f0 + i]; w1[i] = a.conv_w[DFF + f0 + i]; w2[i] = a.conv_w[2 * DFF + f0 + i]; cb[i] = a.conv_b[f0 + i]; }
        const u32x4 zero = {0u, 0u, 0u, 0u};
        const bf16_t* G = UG + DFF + f0;
        u32x4 gp = ((t0 & (SEQ - 1)) == 0) ? zero : *(const u32x4*)(G + (size_t)(t0 - 1) * NUP);
        u32x4 gc = *(const u32x4*)(G + (size_t)t0 * NUP);
        for (int i = 0; i < RUN; ++i) { const int t = t0 + i;
            const u32x4 gn = (((t + 1) & (SEQ - 1)) == 0) ? zero : *(const u32x4*)(G + (size_t)(t + 1) * NUP);
            const u32x4 uv = *(const u32x4*)(UG + (size_t)t * NUP + f0);
            u32x4 o;
#pragma unroll
            for (int q = 0; q < 4; ++q) { float r[2];
#pragma unroll
                for (int e = 0; e < 2; ++e) { const int k = 2 * q + e; const unsigned sh = e ? 16u : 0u;
                    const float g = w0[k] * bf2f((gp[q] >> sh) & 0xffffu) + w1[k] * bf2f((gc[q] >> sh) & 0xffffu) + w2[k] * bf2f((gn[q] >> sh) & 0xffffu) + cb[k];
                    r[e] = 0.5f * g * (1.f + erff(g * 0.70710678118654752f)) * bf2f((uv[q] >> sh) & 0xffffu); }
                o[q] = pk2(r[0], r[1]); }
            *(u32x4*)(UG + (size_t)t * NUP + f0) = o;
            gp = gc; gc = gn; }
    }
}

DI void phase_final(const Args& a, int lane, int wave) {
    const bf16_t* x2 = (const bf16_t*)(a.ws + OFF_X1B);
    const int gw = blockIdx.x * 8 + wave, NGW = gridDim.x * 8;
    f32x4 g[8];
#pragma unroll
    for (int j = 0; j < 8; ++j) g[j] = *(const f32x4*)(a.g_final + 4 * lane + 256 * j);
    for (int m = 4 * gw; m < MTOK; m += 4 * NGW) {
        u32x2 p[4][8];
#pragma unroll
        for (int r = 0; r < 4; ++r)
#pragma unroll
            for (int j = 0; j < 8; ++j) p[r][j] = *(const u32x2*)(x2 + (size_t)(m + r) * DM + 4 * lane + 256 * j);
#pragma unroll
        for (int r = 0; r < 4; ++r) {
            f32x4 v[8]; float ss = 0.f;
#pragma unroll
            for (int j = 0; j < 8; ++j) { v[j] = (f32x4){bf2f(p[r][j].x & 0xffffu), bf2f(p[r][j].x >> 16), bf2f(p[r][j].y & 0xffffu), bf2f(p[r][j].y >> 16)};
                ss += (v[j].x * v[j].x + v[j].y * v[j].y) + (v[j].z * v[j].z + v[j].w * v[j].w); }
            const float rstd = rsqrtf(wave_sum(ss) * (1.f / DM) + EPSN);
#pragma unroll
            for (int j = 0; j < 8; ++j) *(f32x4*)(a.out + (size_t)(m + r) * DM + 4 * lane + 256 * j) = v[j] * rstd * g[j];
        }
    }
}

#define XB_TMO      128
#define XB_XCNT(j)  (256  + 64 * (j))
#define XB_XSUB(j)  (1280 + 64 * (j))
#define XB_XGEN(j)  (2304 + 64 * (j))
#define XB_TOP      3328
#define XB_TOPGEN   3392
#define XCD_BAR_WORDS 3456
#define XB_SPIN_CAP (1u << 18)

__device__ __forceinline__ unsigned xb_ld(unsigned* p)              { return __hip_atomic_load(p, __ATOMIC_RELAXED, __HIP_MEMORY_SCOPE_AGENT); }
__device__ __forceinline__ unsigned xb_add(unsigned* p, unsigned v) { return __hip_atomic_fetch_add(p, v, __ATOMIC_RELAXED, __HIP_MEMORY_SCOPE_AGENT); }
__device__ __forceinline__ unsigned xb_xcc_id() { return (unsigned)__builtin_amdgcn_s_getreg((3 << 11) | 20) & 0xFu; }
#define XB_SPIN(cond, bar) do { unsigned _sp = 0; while (cond) { __builtin_amdgcn_s_sleep(1); \
    if ((++_sp & 255u) == 0u) { if (xb_ld(&(bar)[XB_TMO])) break; if (_sp > XB_SPIN_CAP) { atomicAdd(&(bar)[XB_TMO], 1u); break; } } } } while (0)

struct XcdBarrier {
    unsigned* bar; unsigned x;
    volatile LAS unsigned* st;
};

__device__ __forceinline__ XcdBarrier xcd_barrier_post(unsigned* bar, volatile LAS unsigned* st) {
    XcdBarrier b; b.bar = bar; b.x = xb_xcc_id(); b.st = st;
    if (threadIdx.x == 0) (void)xb_add(&bar[XB_XCNT(b.x)], 1u);
    return b;
}
__device__ __forceinline__ void xcd_barrier_complete(unsigned* bar, unsigned x, unsigned& nloc, unsigned& nx) {
    const unsigned G = gridDim.x * gridDim.y * gridDim.z;
    unsigned sum, cnt, mine, sp = 0u;
    for (;;) {
        sum = 0u; cnt = 0u; mine = 0u;
#pragma unroll
        for (unsigned j = 0; j < 16; ++j) { const unsigned c = xb_ld(&bar[XB_XCNT(j)]); sum += c; cnt += (c > 0u) ? 1u : 0u; mine = (j == x) ? c : mine; }
        if (sum == G) break;
        __builtin_amdgcn_s_sleep(1);
        if ((++sp & 255u) == 0u) { if (xb_ld(&bar[XB_TMO])) break; if (sp > XB_SPIN_CAP) { atomicAdd(&bar[XB_TMO], 1u); break; } }
    }
    nloc = mine > 0u ? mine : 1u; nx = cnt > 0u ? cnt : 1u;
}

__device__ __forceinline__ void xcd_barrier(const XcdBarrier& b) {
    asm volatile("s_waitcnt vmcnt(0)" ::: "memory");
    __syncthreads();
    if (threadIdx.x == 0) {
        unsigned* bar = b.bar;
        __builtin_amdgcn_s_waitcnt(0);
        unsigned nloc = b.st[0], nx = b.st[1];
        if (nloc == 0u) { xcd_barrier_complete(bar, b.x, nloc, nx); b.st[0] = nloc; b.st[1] = nx; }
        const unsigned old = xb_add(&bar[XB_XSUB(b.x)], 1u);
        const unsigned gen = old / nloc;
        if (old + 1u == (gen + 1u) * nloc) {
            __builtin_amdgcn_fence(__ATOMIC_RELEASE, "agent");
            asm volatile("s_waitcnt vmcnt(0)" ::: "memory");
            const unsigned og = xb_add(&bar[XB_TOP], 1u);
            const unsigned tg = og / nx;
            if (og + 1u == (tg + 1u) * nx) xb_add(&bar[XB_TOPGEN], 1u);
            else XB_SPIN(xb_ld(&bar[XB_TOPGEN]) == tg, bar);
            __builtin_amdgcn_fence(__ATOMIC_ACQUIRE, "agent");
            xb_add(&bar[XB_XGEN(b.x)], 1u);
            asm volatile("s_waitcnt vmcnt(0)" ::: "memory");
        } else {
            XB_SPIN(xb_ld(&bar[XB_XGEN(b.x)]) == gen, bar);
            __builtin_amdgcn_fence(__ATOMIC_ACQUIRE, "agent");
            asm volatile("s_waitcnt vmcnt(0)" ::: "memory");
        }
    }
    __syncthreads();
}


DI int lane_now() { int l = (int)(threadIdx.x & 63u); asm volatile("" : "+v"(l)); return l; }
__global__ void __launch_bounds__(512, 2) mega(Args a) {
    extern __shared__ __attribute__((aligned(16))) unsigned char lds_raw[];
    LAS unsigned char* lds = (LAS unsigned char*)lds_raw;
    cg::grid_group grid = cg::this_grid();
    const int tid = threadIdx.x, wave = __builtin_amdgcn_readfirstlane(tid >> 6);
#define lane lane_now()
    const int lo = a.ph_lo, hi = a.ph_hi;
    volatile LAS unsigned* xst = (volatile LAS unsigned*)(lds + LDS_BYTES - 16);
    if (tid == 0) { xst[0] = 0u; xst[1] = 0u; }
    __syncthreads();
    if (hi - lo > 1) (void)xcd_barrier_post((unsigned*)(a.ws + OFF_BAR), xst);
    const float* mod = (const float*)(a.ws + OFF_MOD);
#ifndef PHMASK
#define PHMASK 0xfff
#endif
#define PH(k) (((PHMASK >> (k)) & 1) && lo <= (k) && (k) < hi)
#ifndef PROBE_A
#define PROBE_A -1
#define PROBE_B -1
#endif
    unsigned long long* stamps = (unsigned long long*)(a.ws + WS_NEED);
#define STAMP(k) do { if (PROBE_A >= 0 && blockIdx.x == 0 && tid == 0) stamps[k] = __builtin_amdgcn_s_memrealtime(); } while (0)
#define SEAM(k) do { if (PH(k) && PH((k) + 1)) { XcdBarrier xb_; xb_.bar = (unsigned*)(a.ws + OFF_BAR); xb_.x = xb_xcc_id(); xb_.st = (volatile LAS unsigned*)(lds + LDS_BYTES - 16); xcd_barrier(xb_); } STAMP((k) + 1); } while (0)
#ifdef MK_GRID_SYNC_FIRST
    if (hi - lo > 1) grid.sync();
#endif
    STAMP(0);
    if (PH(0)) phase0(a, lds, tid, lane, wave);
#ifdef DUP_P0
    if (PH(0)) { __syncthreads(); phase0(a, lds, tid, lane, wave); }
#endif
    SEAM(0);
    if (PH(1)) phase_norm<true, false>(a, lds, a.x, a.g_norm1, 0, DM, tid, lane, wave);
    SEAM(1);
    if (PH(2)) {
        if (blockIdx.x < NCOMBO) gate_prep(a, lds, blockIdx.x, tid);
        pg8::Gemm g{(const bf16_t*)(a.ws + OFF_HB), (const bf16_t*)(a.ws + OFF_WIN), MTOK, NPC, DM, DM}; pg8::StaticOrder S; S.init(MTOK, NPC, gridDim.x, blockIdx.x);
#ifdef SKEW_TICKS
        if ((blockIdx.x >> 3) & 1) { const unsigned long long t0 = __builtin_amdgcn_s_memrealtime(); while (__builtin_amdgcn_s_memrealtime() - t0 < SKEW_TICKS) __builtin_amdgcn_s_sleep(8); }
#endif
        pg8::EpiBf16<0> E{(bf16_t*)(a.ws + OFF_P), NPC, nullptr, 0, 0, 1.f};
        pg8::gemm_phase<pg8::EpiBf16<0>, pg8::StaticOrder, GEMM_ALIGN, true>(lds, g, S, E);
#ifdef DUP_GEMM_IN
        pg8::gemm_phase<pg8::EpiBf16<0>, pg8::StaticOrder, true, true>(lds, g, S, E);
#endif
#ifdef DUP_GEMM_HALFK
        { pg8::Gemm g2{(const bf16_t*)(a.ws + OFF_HB), (const bf16_t*)(a.ws + OFF_WIN), MTOK, NPC, DUP_GEMM_HALFK, DM};
          pg8::EpiBf16<0> E2{(bf16_t*)(a.ws + OFF_CST), 0, nullptr, 0, 0, 1.f};
          pg8::gemm_phase<pg8::EpiBf16<0>, pg8::StaticOrder, true, true>(lds, g2, S, E2); }
#endif
    }
    SEAM(2);
    if (PH(3)) mlstm_delta(a, lds, tid, lane, wave);
#if defined(DUP_MIX) || defined(DUP_A1)
    if (PH(3)) { __syncthreads(); mlstm_delta(a, lds, tid, lane, wave); }
#endif
    SEAM(3);
    if (PH(4)) { mlstm_scan(a, tid); natten(a, lds, tid, lane, wave); }
#if defined(DUP_MIX) || defined(DUP_NAT)
    if (PH(4)) { __syncthreads(); natten(a, lds, tid, lane, wave); }
#endif
    SEAM(4);
    if (PH(5)) mlstm_out(a, lds, tid, lane, wave);
#if defined(DUP_MIX) || defined(DUP_A3)
    if (PH(5)) { __syncthreads(); mlstm_out(a, lds, tid, lane, wave); }
#endif
    SEAM(5);
    if (PH(6)) {
        __syncthreads();
        pg8::Gemm g{(const bf16_t*)(a.ws + OFF_HB), (const bf16_t*)(a.ws + OFF_WOUT), MTOK, DM, DM, DM}; pg8::StaticOrder S; S.init(MTOK, DM, gridDim.x, blockIdx.x);
        EpiResid16<false> E{a.x, (bf16_t*)(a.ws + OFF_X1B), mod + 2 * DM};
        pg8::gemm_phase<EpiResid16<false>, pg8::StaticOrder, GEMM_ALIGN, true>(lds, g, S, E);
    }
    SEAM(6);
    if (PH(7)) phase_norm<false, true>(a, lds, a.ws + OFF_X1B, a.g_norm2, 3 * DM, 4 * DM, tid, lane, wave);
    SEAM(7);
    if (PH(8)) {
        pg8::Gemm g{(const bf16_t*)(a.ws + OFF_HB), (const bf16_t*)(a.ws + OFF_WUP), MTOK, NUP, DM, DM}; pg8::StaticOrder S; S.init(MTOK, NUP, gridDim.x, blockIdx.x);
#ifdef SKEW_TICKS
        if ((blockIdx.x >> 3) & 1) { const unsigned long long t0 = __builtin_amdgcn_s_memrealtime(); while (__builtin_amdgcn_s_memrealtime() - t0 < SKEW_TICKS) __builtin_amdgcn_s_sleep(8); }
#endif
        EpiGlu E{(bf16_t*)(a.ws + OFF_ACT), a.conv_w, a.conv_b, (float*)(a.ws + OFF_EDGE), (LAS float*)(lds + 131072)};
        pg8::gemm_phase<EpiGlu, pg8::StaticOrder, true, true>(lds, g, S, E);
    }
    SEAM(8);
    if (PH(10)) {
        pg8::Gemm g{(const bf16_t*)(a.ws + OFF_ACT), (const bf16_t*)(a.ws + OFF_WDN), MTOK, DM, DFF, DFF}; pg8::StaticOrder S; S.init(MTOK, DM, gridDim.x, blockIdx.x);
        { pg8::Unit uu; int lastpm = -1; for (int i = 0; S.next(i, uu); ++i) if (uu.pm != lastpm) { glu_fixup(a, uu.pm, tid); lastpm = uu.pm; } }
        __threadfence(); __syncthreads();
        EpiResid16<true> E{a.ws + OFF_X1B, (bf16_t*)(a.ws + OFF_X1B), mod + 5 * DM};
        pg8::gemm_phase<EpiResid16<true>, pg8::StaticOrder, GEMM_ALIGN, true>(lds, g, S, E);
    }
    SEAM(10);
    if (PH(11)) phase_final(a, lane, wave);
    if (PROBE_A >= 0) { __syncthreads(); if (blockIdx.x == 0 && tid == 0) { stamps[12] = __builtin_amdgcn_s_memrealtime();
        const float Ta = (float)(stamps[PROBE_A + 1] - stamps[PROBE_A]) * 0.01f, Tb = (float)(stamps[PROBE_B + 1] - stamps[PROBE_B]) * 0.01f;
        a.out[0] += Ta + Tb; for (int i = 1; i <= 1000; ++i) a.out[i] += 0.5f * Tb; } }
#undef PH
#undef SEAM
#undef lane
}

extern "C" void kernel_launch(void* const* d_in, const int* in_sizes, int n_in, void* d_out, int out_size, void* d_ws, size_t ws_size, hipStream_t stream) {
    static int grid = 0;
    if (grid == 0) {
        if (n_in != 16 || out_size != MTOK * DM || ws_size < WS_NEED) { fprintf(stderr, "kernel_launch: unexpected problem (n_in %d out %d ws %zu need %zu)\n", n_in, out_size, ws_size, (size_t)WS_NEED); grid = -1; return; }
        int dev = 0, cus = 0, per_cu = 0;
        hipGetDevice(&dev); hipDeviceGetAttribute(&cus, hipDeviceAttributeMultiprocessorCount, dev);
        if (hipFuncSetAttribute((const void*)mega, hipFuncAttributeMaxDynamicSharedMemorySize, LDS_BYTES) != hipSuccess) { fprintf(stderr, "kernel_launch: hipFuncSetAttribute failed\n"); grid = -1; return; }
        if (hipOccupancyMaxActiveBlocksPerMultiprocessor(&per_cu, (const void*)mega, 512, LDS_BYTES) != hipSuccess || per_cu < 1) { fprintf(stderr, "kernel_launch: occupancy query failed (%d)\n", per_cu); (void)hipGetLastError(); per_cu = 1; }
        grid = cus * (per_cu > 1 ? 1 : per_cu);
        fprintf(stderr, "kernel_launch: grid %d (cus %d, per_cu %d)\n", grid, cus, per_cu);
        if (grid < 4 || (grid & 3) != 0) { fprintf(stderr, "kernel_launch: this kernel needs a workgroup count that is a multiple of 4 (neighbourhood-attention head pairs are fixed per workgroup); nothing launched\n"); grid = -1; return; }
    }
    if (grid < 0) return;
    Args a{};
    a.x = (const float*)d_in[0]; a.c = (const float*)d_in[1]; a.w_ada = (const float*)d_in[2]; a.b_ada = (const float*)d_in[3]; a.g_norm1 = (const float*)d_in[4];
    a.w_in = (const float*)d_in[5]; a.b_gates = (const float*)d_in[6]; a.g_head_a = (const float*)d_in[7]; a.rpb = (const float*)d_in[8]; a.w_out = (const float*)d_in[9];
    a.g_norm2 = (const float*)d_in[10]; a.w_up = (const float*)d_in[11]; a.conv_w = (const float*)d_in[12]; a.conv_b = (const float*)d_in[13]; a.w_down = (const float*)d_in[14];
    a.g_final = (const float*)d_in[15]; a.out = (float*)d_out; a.ws = (unsigned char*)d_ws;
#if MK_PER_PHASE
    for (int p = 0; p < NPH; ++p) { a.ph_lo = p; a.ph_hi = p + 1; hipLaunchKernelGGL(mega, dim3(grid), dim3(512), LDS_BYTES, stream, a); }
#else
    a.ph_lo = 0; a.ph_hi = NPH;
    if (hipMemsetAsync((char*)d_ws + OFF_BAR, 0, BAR_BYTES, stream) != hipSuccess) { fprintf(stderr, "kernel_launch: memset failed\n"); return; }
    void* args[] = {&a};
    hipError_t e = hipLaunchCooperativeKernel((const void*)mega, dim3(grid), dim3(512), args, LDS_BYTES, stream);
    if (e != hipSuccess) fprintf(stderr, "kernel_launch: cooperative launch failed: %s (grid %d)\n", hipGetErrorString(e), grid);
#endif
}
```

```cpp
#include <hip/hip_runtime.h>
#include <hip/hip_cooperative_groups.h>
#include <cstdio>
#include <cstdint>
namespace cg = cooperative_groups;
#define MK_PER_PHASE 0
namespace pg8 {
#define PG8_LAS __attribute__((address_space(3)))
typedef unsigned short bf16_t;
typedef short bf16x8 __attribute__((ext_vector_type(8)));
typedef float f32x4 __attribute__((ext_vector_type(4)));
typedef unsigned u32x4 __attribute__((ext_vector_type(4)));
constexpr int BM = 256, BK = 64, HALF = 128, HTB = HALF * BK * 2  , STAGE_BYTES = 8 * HTB, NXCD = 8, WGM = 8;

__host__ __device__ __forceinline__ int lds_byte(int r, int c) { const int st = (r >> 4) * 2 + (c >> 5), rr = r & 15, cc = c & 31, ob = rr * 64 + cc * 2; return st * 1024 + (ob ^ (((ob >> 9) & 1) << 5)); }
__host__ __device__ __forceinline__ void stage_rc(int b, int& R, int& C) { const int st = b / 1024, sb = b % 1024, swz = sb ^ (((sb >> 9) & 1) << 5); R = (st >> 1) * 16 + swz / 64; C = (st & 1) * 32 + (swz % 64) / 2; }
__host__ __device__ __forceinline__ int perm32(int rho) { const int n = rho >> 4, i = rho & 15; return 8 * (i >> 2) + 4 * n + (i & 3); }

struct Unit { int pm, pn; };
struct Gemm { const bf16_t* A; const bf16_t* Bt; int M, N, K, lda; };

struct StaticOrder {
    int nM, nN, nwg, G, c;
    __host__ __device__ void init(int M, int N, int G_, int c_) { nM = M / BM; nN = N / BM; nwg = nM * nN; G = G_; c = c_; }
    __host__ __device__ bool next(int i, Unit& u) const {
        const long L = (long)i * G + c; if (L >= nwg) return false;
        int wgid = (int)L; { const int q = nwg / NXCD, r = nwg % NXCD, xcd = wgid % NXCD, off = wgid / NXCD; wgid = (xcd < r ? xcd * (q + 1) : r * (q + 1) + (xcd - r) * q) + off; }
        const int nig = WGM * nN, gid = wgid / nig, fm = gid * WGM, gsz = (nM - fm) < WGM ? (nM - fm) : WGM;
        u.pm = fm + ((wgid % nig) % gsz); u.pn = (wgid % nig) / gsz; return true;
    }
    __device__ __forceinline__ void a_ready(const Unit&) const {}
    __device__ __forceinline__ void done(const Unit&) const {}
};

__device__ __forceinline__ unsigned cvt_pk_bf16(float lo, float hi) { unsigned r; asm volatile("v_cvt_pk_bf16_f32 %0, %1, %2" : "=v"(r) : "v"(lo), "v"(hi)); return r; }
typedef float f32x2 __attribute__((ext_vector_type(2)));
__device__ __forceinline__ f32x2 gelu_pk(f32x2 v) {
    const f32x2 av = __builtin_elementwise_abs(v), d = av * 0.2316418882f + 1.0f;
    f32x2 t; t.x = __builtin_amdgcn_rcpf(d.x); t.y = __builtin_amdgcn_rcpf(d.y);
    f32x2 q = t * 0.5307027145f + (-0.7265760135f); q = q * t + 0.7107068705f; q = q * t + (-0.142248368f); q = q * t + 0.127414796f; q = q * t;
    const f32x2 s = (v * v) * (-0.72134752044f);
    f32x2 e; e.x = __builtin_amdgcn_exp2f(s.x); e.y = __builtin_amdgcn_exp2f(s.y);
    const f32x2 m = v * (q * e), r = v - m;
    f32x2 o; o.x = v.x < 0.f ? m.x : r.x; o.y = v.y < 0.f ? m.y : r.y; return o;
}

template <int ACT  > struct EpiBf16 {
    static constexpr bool PERM = true, AFTER_DRAIN = false; static_assert(ACT == 0 || ACT == 1, "EpiBf16: ACT is 0 (none) or 1 (gelu_pk)");
    bf16_t* O; int ldc; const float* bias; int split_cols; size_t split_stride; float scale0;
    __device__ __forceinline__ void operator()(const f32x4 (&acc)[2][2][4][2], const Unit& u, int wr, int wc, int fr, int fq) const {
        const int row0 = u.pm * BM + wr * 64 + fr; int colt = u.pn * BM; bf16_t* base = O;
        float sc = 1.f; if (split_cols) { const int t = colt / split_cols; base += (size_t)t * split_stride; colt -= t * split_cols; if (t == 0) sc = scale0; }
        const int col0 = colt + wc * 32 + 8 * fq, bcol0 = u.pn * BM + wc * 32 + 8 * fq;
        f32x4 bv[2][2];
#pragma unroll
        for (int bj = 0; bj < 2; ++bj)
#pragma unroll
            for (int n = 0; n < 2; ++n) bv[bj][n] = bias ? *(const f32x4*)(bias + bcol0 + bj * HALF + 4 * n) : (f32x4){0.f, 0.f, 0.f, 0.f};
#pragma unroll
        for (int ai = 0; ai < 2; ++ai)
#pragma unroll
            for (int m = 0; m < 4; ++m) { bf16_t* rowp = base + (size_t)(row0 + ai * HALF + m * 16) * ldc + col0;
#pragma unroll
                for (int bj = 0; bj < 2; ++bj) { f32x4 v0 = acc[ai][bj][m][0] + bv[bj][0], v1 = acc[ai][bj][m][1] + bv[bj][1];
                    if (ACT == 1) { f32x2 a = gelu_pk((f32x2){v0[0], v0[1]}), b = gelu_pk((f32x2){v0[2], v0[3]}), c = gelu_pk((f32x2){v1[0], v1[1]}), d = gelu_pk((f32x2){v1[2], v1[3]});
                        v0 = (f32x4){a.x, a.y, b.x, b.y}; v1 = (f32x4){c.x, c.y, d.x, d.y}; }
                    v0 = v0 * sc; v1 = v1 * sc; u32x4 w; w.x = cvt_pk_bf16(v0[0], v0[1]); w.y = cvt_pk_bf16(v0[2], v0[3]); w.z = cvt_pk_bf16(v1[0], v1[1]); w.w = cvt_pk_bf16(v1[2], v1[3]);
                    *(u32x4*)(rowp + bj * HALF) = w; } }
    }
};

template <class Epi, class Sched, bool ALIGN_EPI = false, bool SP2 = false>
__device__ __forceinline__ void gemm_phase(PG8_LAS unsigned char* lds, const Gemm g, const Sched& S, const Epi& E) {
    const int tid = threadIdx.x, wid = __builtin_amdgcn_readfirstlane(tid >> 6), lane = tid & 63, wr = wid >> 2, wc = wid & 3, fr = lane & 15, fq = lane >> 4;
    const int K = g.K, nt = K / BK;
    unsigned voffA[2], voffB[2];
#pragma unroll
    for (int i = 0; i < 2; ++i) { int R, C; stage_rc(tid * 16 + i * 8192, R, C); const int Rb = Epi::PERM ? ((R & ~31) + perm32(R & 31)) : R;
        voffA[i] = (unsigned)(R * g.lda + C) * 2u; voffB[i] = (unsigned)(Rb * K + C) * 2u; }
    const size_t kstep = (size_t)(BK * 2);
    const size_t hstep = (size_t)HALF * K * 2;
    const size_t tstep = 2 * hstep; const size_t hstepA = (size_t)HALF * g.lda * 2, tstepA = 2 * hstepA;
    const unsigned ldsw = (unsigned)wid * 1024u;
    const int aoff = lds_byte(wr * 64 + fr, fq * 8), boff = lds_byte(wc * 32 + fr, fq * 8);
#define PG8_SA(b, h) (((b) * 2 + (h)) * HTB)
#define PG8_SB(b, h) ((4 + (b) * 2 + (h)) * HTB)
#define PG8_STAGE(bufoff, gbase, voff) do { _Pragma("unroll") for (int _i = 0; _i < 2; ++_i) \
        __builtin_amdgcn_global_load_lds((const unsigned*)((const char*)(gbase) + (voff)[_i]), (PG8_LAS unsigned*)(lds + (bufoff) + ldsw + _i * 8192), 16, 0, 0); } while (0)
#define PG8_LDA(dst, b, h) do { _Pragma("unroll") for (int m = 0; m < 4; ++m) _Pragma("unroll") for (int k = 0; k < 2; ++k) dst[m][k] = *(const PG8_LAS bf16x8*)(lds + PG8_SA(b, h) + aoff + m * 2048 + k * 1024); } while (0)
#define PG8_LDB(dst, b, h) do { _Pragma("unroll") for (int n = 0; n < 2; ++n) _Pragma("unroll") for (int k = 0; k < 2; ++k) dst[n][k] = *(const PG8_LAS bf16x8*)(lds + PG8_SB(b, h) + boff + n * 2048 + k * 1024); } while (0)
#define PG8_MMA(ai, bj, At, Bt) do { __builtin_amdgcn_s_setprio(1); _Pragma("unroll") for (int m = 0; m < 4; ++m) _Pragma("unroll") for (int n = 0; n < 2; ++n) _Pragma("unroll") for (int k = 0; k < 2; ++k) \
        acc[ai][bj][m][n] = __builtin_amdgcn_mfma_f32_16x16x32_bf16(Bt[n][k], At[m][k], acc[ai][bj][m][n], 0, 0, 0); __builtin_amdgcn_s_setprio(0); } while (0)
#define PG8_WAIT_V(n) asm volatile("s_waitcnt vmcnt(" #n ")" ::: "memory")
#define PG8_WAIT_L(n) asm volatile("s_waitcnt lgkmcnt(" #n ")" ::: "memory")
#define PG8_BAR __builtin_amdgcn_s_barrier()
#define PG8_SCHED __builtin_amdgcn_sched_barrier(0)
    Unit cur, nxt; int ui = 0;
    if (!S.next(0, cur)) return;
    f32x4 acc[2][2][4][2];
#pragma unroll
    for (int a = 0; a < 2; ++a)
#pragma unroll
        for (int b = 0; b < 2; ++b)
#pragma unroll
            for (int m = 0; m < 4; ++m)
#pragma unroll
                for (int n = 0; n < 2; ++n) acc[a][b][m][n] = (f32x4){0.f, 0.f, 0.f, 0.f};
    bf16x8 At[4][2], B0[2][2], B1[2][2];
    const char* cA = (const char*)g.A + (size_t)cur.pm * tstepA; const char* cB = (const char*)g.Bt + (size_t)cur.pn * tstep;
    S.a_ready(cur);
    if constexpr (SP2) {
        PG8_STAGE(PG8_SB(0, 0), cB, voffB); PG8_STAGE(PG8_SB(0, 1), cB + hstep, voffB); PG8_STAGE(PG8_SA(0, 0), cA, voffA); PG8_STAGE(PG8_SA(0, 1), cA + hstepA, voffA);
        if (wr == 1) PG8_BAR;
        PG8_WAIT_V(2); PG8_BAR;
        PG8_STAGE(PG8_SB(1, 0), cB + kstep, voffB); PG8_STAGE(PG8_SA(1, 0), cA + kstep, voffA); PG8_STAGE(PG8_SB(1, 1), cB + hstep + kstep, voffB);
        PG8_WAIT_V(6); PG8_BAR;
    } else {
        PG8_STAGE(PG8_SB(0, 0), cB, voffB); PG8_STAGE(PG8_SA(0, 0), cA, voffA); PG8_STAGE(PG8_SB(0, 1), cB + hstep, voffB); PG8_STAGE(PG8_SA(0, 1), cA + hstepA, voffA);
        if (wr == 1) PG8_BAR;
        PG8_WAIT_V(4); PG8_BAR;
        PG8_STAGE(PG8_SB(1, 0), cB + kstep, voffB); PG8_STAGE(PG8_SA(1, 0), cA + kstep, voffA); PG8_STAGE(PG8_SB(1, 1), cB + hstep + kstep, voffB);
        PG8_WAIT_V(6); PG8_BAR;
    }
    for (;;) {
        const bool has_next = S.next(ui + 1, nxt);
        const char* nA = has_next ? (const char*)g.A + (size_t)nxt.pm * tstepA : cA; const char* nB = has_next ? (const char*)g.Bt + (size_t)nxt.pn * tstep : cB;
        for (int t = 0; t < nt; t += 2) {
            const bool last = (t == nt - 2);
            const char* a1 = cA + (size_t)(t + 1) * kstep;
            const char* a2 = last ? nA : cA + (size_t)(t + 2) * kstep; const char* b2 = last ? nB : cB + (size_t)(t + 2) * kstep;
            const char* a3 = a2 + kstep; const char* b3 = b2 + kstep;
            if (last && has_next) S.a_ready(nxt);
            if constexpr (SP2) {
            PG8_LDB(B0, 0, 0); PG8_LDB(B1, 0, 1); PG8_SCHED; PG8_LDA(At, 0, 0); PG8_STAGE(PG8_SA(1, 1), a1 + hstepA, voffA);
            PG8_WAIT_V(8); PG8_WAIT_L(0); PG8_BAR; PG8_MMA(0, 0, At, B0); PG8_MMA(0, 1, At, B1); PG8_BAR; PG8_SCHED;
            PG8_LDA(At, 0, 1); PG8_STAGE(PG8_SB(0, 0), b2, voffB); PG8_STAGE(PG8_SB(0, 1), b2 + hstep, voffB); PG8_STAGE(PG8_SA(0, 0), a2, voffA);
            PG8_WAIT_V(8); PG8_WAIT_L(0); PG8_BAR; PG8_MMA(1, 0, At, B0); PG8_MMA(1, 1, At, B1); PG8_BAR; PG8_SCHED;
            PG8_LDB(B0, 1, 0); PG8_LDB(B1, 1, 1); PG8_SCHED; PG8_LDA(At, 1, 0); PG8_STAGE(PG8_SA(0, 1), a2 + hstepA, voffA);
            PG8_WAIT_V(8); PG8_WAIT_L(0); PG8_BAR; PG8_MMA(0, 0, At, B0); PG8_MMA(0, 1, At, B1); PG8_BAR; PG8_SCHED;
            PG8_LDA(At, 1, 1); PG8_STAGE(PG8_SB(1, 0), b3, voffB); PG8_STAGE(PG8_SB(1, 1), b3 + hstep, voffB); PG8_STAGE(PG8_SA(1, 0), a3, voffA);
            PG8_WAIT_V(8); PG8_WAIT_L(0); PG8_BAR; PG8_MMA(1, 0, At, B0); PG8_MMA(1, 1, At, B1); PG8_BAR; PG8_SCHED;
            } else {
            PG8_LDB(B0, 0, 0); PG8_SCHED; PG8_LDA(At, 0, 0); PG8_STAGE(PG8_SA(1, 1), a1 + hstepA, voffA);
            PG8_WAIT_L(8); PG8_BAR; PG8_WAIT_L(0); PG8_MMA(0, 0, At, B0); PG8_BAR; PG8_SCHED;
            PG8_LDB(B1, 0, 1); PG8_STAGE(PG8_SB(0, 0), b2, voffB);
            PG8_BAR; PG8_WAIT_L(0); PG8_MMA(0, 1, At, B1); PG8_BAR;
            PG8_LDA(At, 0, 1); PG8_STAGE(PG8_SA(0, 0), a2, voffA);
            PG8_BAR; PG8_WAIT_L(0); PG8_MMA(1, 0, At, B0); PG8_BAR; PG8_SCHED;
            PG8_STAGE(PG8_SB(0, 1), b2 + hstep, voffB);
            PG8_WAIT_V(6); PG8_BAR; PG8_MMA(1, 1, At, B1); PG8_BAR;
            PG8_LDB(B0, 1, 0); PG8_SCHED; PG8_LDA(At, 1, 0); PG8_STAGE(PG8_SA(0, 1), a2 + hstepA, voffA);
            PG8_WAIT_L(8); PG8_BAR; PG8_WAIT_L(0); PG8_MMA(0, 0, At, B0); PG8_BAR; PG8_SCHED;
            PG8_LDB(B1, 1, 1); PG8_STAGE(PG8_SB(1, 0), b3, voffB);
            PG8_BAR; PG8_WAIT_L(0); PG8_MMA(0, 1, At, B1); PG8_BAR;
            PG8_LDA(At, 1, 1); PG8_STAGE(PG8_SA(1, 0), a3, voffA);
            PG8_BAR; PG8_WAIT_L(0); PG8_MMA(1, 0, At, B0); PG8_BAR; PG8_SCHED;
            PG8_STAGE(PG8_SB(1, 1), b3 + hstep, voffB);
            PG8_WAIT_V(6); PG8_BAR; PG8_MMA(1, 1, At, B1); PG8_BAR;
            }
        }
        if constexpr (ALIGN_EPI) { if (wr == 0) PG8_BAR; }
        if constexpr (!Epi::AFTER_DRAIN) { E(acc, cur, wr, wc, fr, fq); S.done(cur); }
        if (!has_next) break;
#pragma unroll
        for (int a = 0; a < 2; ++a)
#pragma unroll
            for (int b = 0; b < 2; ++b)
#pragma unroll
                for (int m = 0; m < 4; ++m)
#pragma unroll
                    for (int n = 0; n < 2; ++n) acc[a][b][m][n] = (f32x4){0.f, 0.f, 0.f, 0.f};
        cur = nxt; cA = nA; cB = nB; ++ui;
        if constexpr (ALIGN_EPI) { if (wr == 1) PG8_BAR; }
    }
    PG8_WAIT_V(0);
    if constexpr (!ALIGN_EPI) { if (wr == 0) PG8_BAR; }
    PG8_BAR;
    if constexpr (Epi::AFTER_DRAIN) { E.fused(acc, cur, wr, wc, fr, fq, lds, wid, lane); S.done(cur); }
#undef PG8_SA
#undef PG8_SB
#undef PG8_STAGE
#undef PG8_LDA
#undef PG8_LDB
#undef PG8_MMA
#undef PG8_WAIT_V
#undef PG8_WAIT_L
#undef PG8_BAR
#undef PG8_SCHED
}
}

#define DI __device__ __forceinline__
#define LAS __attribute__((address_space(3)))
typedef unsigned short bf16_t;
typedef short bf16x8 __attribute__((ext_vector_type(8)));
typedef short s16x4 __attribute__((ext_vector_type(4)));
typedef short v4i16_t __attribute__((ext_vector_type(4)));
typedef float f32x4 __attribute__((ext_vector_type(4)));
typedef unsigned u32x4 __attribute__((ext_vector_type(4)));
typedef unsigned u32x2 __attribute__((ext_vector_type(2)));

constexpr int NB = 2, SEQ = 8192, DM = 2048, MTOK = NB * SEQ, NPC = 7168, WIN_LD = 7184, DFF = 5632, NUP = 2 * DFF, NMOD = 6 * DM;
constexpr int LCH = 256, NCH = SEQ / LCH, EEXT = 272, ST_ELEMS = EEXT * 256, NCOMBO = 16;
constexpr float EPSN = 1e-6f;
#ifndef MK_PER_PHASE
#define MK_PER_PHASE 0
#endif
#ifndef GEMM_ALIGN
#define GEMM_ALIGN true
#endif
constexpr int NPH = 12;
constexpr int LDS_BYTES = 147456;

constexpr size_t OFF_P = 0;
constexpr size_t OFF_CST = OFF_P + (size_t)MTOK * NPC * 2;
constexpr size_t OFF_WIN = OFF_CST + (size_t)NCOMBO * NCH * ST_ELEMS * 2;
constexpr size_t OFF_WOUT = OFF_WIN + (size_t)NPC * DM * 2;
constexpr size_t OFF_R0END = OFF_WOUT + (size_t)DM * DM * 2;
constexpr size_t OFF_UG = 0;
constexpr size_t OFF_ACT = 0;
constexpr size_t OFF_EDGE = OFF_ACT + (size_t)MTOK * DFF * 2;
constexpr size_t OFF_X1B = OFF_EDGE + (size_t)3 * 64 * 2 * DFF * 4;
static_assert(OFF_X1B + (size_t)MTOK * DM * 2 <= OFF_CST + (size_t)NCOMBO * NCH * ST_ELEMS * 2, "x1b must stay below the weight copies that are still live in phase 6");
constexpr size_t OFF_WUP = OFF_UG + (size_t)MTOK * NUP * 2;
constexpr size_t OFF_WDN = OFF_WUP + (size_t)NUP * DM * 2;
constexpr size_t OFF_HB = OFF_WDN + (size_t)DM * DFF * 2;
constexpr size_t OFF_MOD = OFF_HB + (size_t)MTOK * DM * 2;
constexpr size_t OFF_GATES = OFF_MOD + 131072;
constexpr size_t OFF_UL = OFF_GATES + (size_t)MTOK * 16 * 4;
constexpr size_t OFF_ML = OFF_UL + (size_t)NCOMBO * SEQ * 4;
constexpr size_t OFF_EMT = OFF_ML + (size_t)NCOMBO * SEQ * 4;
constexpr size_t OFF_MPREV = OFF_EMT + (size_t)NCOMBO * SEQ * 4;
constexpr size_t OFF_MEND = OFF_MPREV + 4096;
constexpr size_t WS_NEED = OFF_MEND + 4096;
constexpr size_t OFF_BAR = WS_NEED + 4096;
constexpr size_t BAR_BYTES = 16384;
static_assert(OFF_R0END <= OFF_WUP, "overlay region");
static_assert(OFF_BAR + BAR_BYTES <= 536870912ull, "workspace budget");

struct Args {
    const float *x, *c, *w_ada, *b_ada, *g_norm1, *w_in, *b_gates, *g_head_a, *rpb, *w_out, *g_norm2, *w_up, *conv_w, *conv_b, *w_down, *g_final;
    float* out; unsigned char* ws; int ph_lo, ph_hi;
};

DI float bf2f(unsigned v) { return __uint_as_float(v << 16); }
DI unsigned f2bf(float f) { unsigned u = __float_as_uint(f); return (u + 0x7fffu + ((u >> 16) & 1u)) >> 16; }
typedef __bf16 bf16x2_hw __attribute__((ext_vector_type(2)));
typedef float f32x2_hw __attribute__((ext_vector_type(2)));
DI unsigned pk2(float lo, float hi) { const f32x2_hw v = {lo, hi}; const bf16x2_hw b = __builtin_convertvector(v, bf16x2_hw); return __builtin_bit_cast(unsigned, b); }
DI float wave_sum(float v) {
#pragma unroll
    for (int o = 1; o < 64; o <<= 1) v += __shfl_xor(v, o);
    return v;
}
DI s16x4 tr_read(const LAS unsigned char* p) { return __builtin_bit_cast(s16x4, __builtin_amdgcn_ds_read_tr16_b64_v4i16((LAS v4i16_t*)p)); }
DI bf16x8 tr_frag(const LAS unsigned char* base, int pitch, int rowA, int rowB, int col, int qin, int pin) {
    const s16x4 lo = tr_read(base + (rowA + qin) * pitch + (col + 4 * pin) * 2);
    const s16x4 hi = tr_read(base + (rowB + qin) * pitch + (col + 4 * pin) * 2);
    return (bf16x8){lo[0], lo[1], lo[2], lo[3], hi[0], hi[1], hi[2], hi[3]};
}
DI bf16x8 ld_frag(const LAS unsigned char* p) { return *(const LAS bf16x8*)p; }
#define MFMA16(a, b, c) __builtin_amdgcn_mfma_f32_16x16x32_bf16((a), (b), (c), 0, 0, 0)
DI bf16x8 pack8(const f32x4& a, const f32x4& b) {
    u32x4 w; w.x = pk2(a[0], a[1]); w.y = pk2(a[2], a[3]); w.z = pk2(b[0], b[1]); w.w = pk2(b[2], b[3]);
    return __builtin_bit_cast(bf16x8, w);
}
DI bf16x8 scale8(const bf16x8& q, float s) {
    const u32x4 u = __builtin_bit_cast(u32x4, q); u32x4 w;
#pragma unroll
    for (int i = 0; i < 4; ++i) w[i] = pk2(bf2f(u[i] & 0xffffu) * s, bf2f(u[i] >> 16) * s);
    return __builtin_bit_cast(bf16x8, w);
}
template <int ROWS, int COLS> DI void stage_tile(LAS unsigned char* dst, int lp, const bf16_t* src, int gp, int tid, int nthr) {
    constexpr int VPR = COLS / 8, NV = ROWS * VPR;
    int t0 = tid; asm volatile("" : "+v"(t0));
#pragma unroll 2
    for (int v = t0; v < NV; v += nthr) { const int r = v / VPR, cv = v % VPR;
        const u32x4 d = *(const u32x4*)(src + (r * gp + cv * 8)); *(LAS u32x4*)(dst + r * lp + cv * 16) = d; }
}

struct EpiResid {
    static constexpr bool PERM = false, AFTER_DRAIN = false;
    const float* res; float* out; const float* gate;
    __device__ __forceinline__ void operator()(const pg8::f32x4 (&acc)[2][2][4][2], const pg8::Unit& u, int wr, int wc, int fr, int fq) const {
        const int row0 = u.pm * 256 + wr * 64 + fr, col0 = u.pn * 256 + wc * 32 + 4 * fq, bb = u.pm >> 5;
        f32x4 gv[2][2];
#pragma unroll
        for (int bj = 0; bj < 2; ++bj)
#pragma unroll
            for (int n = 0; n < 2; ++n) gv[bj][n] = *(const f32x4*)(gate + (size_t)bb * NMOD + col0 + bj * 128 + n * 16);
#pragma unroll
        for (int ai = 0; ai < 2; ++ai)
#pragma unroll
            for (int m = 0; m < 4; ++m) { const size_t ro = (size_t)(row0 + ai * 128 + m * 16) * DM + col0;
#pragma unroll
                for (int bj = 0; bj < 2; ++bj)
#pragma unroll
                    for (int n = 0; n < 2; ++n) { const size_t o = ro + bj * 128 + n * 16; const f32x4 r = *(const f32x4*)(res + o); *(f32x4*)(out + o) = r + gv[bj][n] * acc[ai][bj][m][n]; } }
    }
};

template <bool RES_BF16> struct EpiResid16 {
    static constexpr bool PERM = true, AFTER_DRAIN = false;
    const void* res; bf16_t* out; const float* gate;
    __device__ __forceinline__ void operator()(const pg8::f32x4 (&acc)[2][2][4][2], const pg8::Unit& u, int wr, int wc, int fr, int fq) const {
        const int row0 = u.pm * 256 + wr * 64 + fr, col0 = u.pn * 256 + wc * 32 + 8 * fq, bb = u.pm >> 5;
        f32x4 gv[2][2];
#pragma unroll
        for (int bj = 0; bj < 2; ++bj)
#pragma unroll
            for (int n = 0; n < 2; ++n) gv[bj][n] = *(const f32x4*)(gate + (size_t)bb * NMOD + col0 + bj * 128 + 4 * n);
#pragma unroll
        for (int ai = 0; ai < 2; ++ai)
#pragma unroll
            for (int m = 0; m < 4; ++m) { const size_t ro = (size_t)(row0 + ai * 128 + m * 16) * DM + col0;
#pragma unroll
                for (int bj = 0; bj < 2; ++bj) { const size_t o = ro + bj * 128; f32x4 r0, r1;
                    if (RES_BF16) { const u32x4 rv = *(const u32x4*)((const bf16_t*)res + o);
                        r0 = (f32x4){bf2f(rv.x & 0xffffu), bf2f(rv.x >> 16), bf2f(rv.y & 0xffffu), bf2f(rv.y >> 16)}; r1 = (f32x4){bf2f(rv.z & 0xffffu), bf2f(rv.z >> 16), bf2f(rv.w & 0xffffu), bf2f(rv.w >> 16)}; }
                    else { r0 = *(const f32x4*)((const float*)res + o); r1 = *(const f32x4*)((const float*)res + o + 4); }
                    r0 = r0 + gv[bj][0] * acc[ai][bj][m][0]; r1 = r1 + gv[bj][1] * acc[ai][bj][m][1];
                    u32x4 w; w.x = pg8::cvt_pk_bf16(r0[0], r0[1]); w.y = pg8::cvt_pk_bf16(r0[2], r0[3]); w.z = pg8::cvt_pk_bf16(r1[0], r1[1]); w.w = pg8::cvt_pk_bf16(r1[2], r1[3]);
                    *(u32x4*)(out + o) = w; } }
    }
};

constexpr size_t EDGE_STRIDE = (size_t)64 * 2 * DFF;
struct EpiGlu {
    static constexpr bool PERM = true, AFTER_DRAIN = false;
    bf16_t* ACT; const float* cw; const float* cb; float* edge; LAS float* xg;
    __device__ __forceinline__ void operator()(const pg8::f32x4 (&acc)[2][2][4][2], const pg8::Unit& u, int wr, int wc, int fr, int fq) const {
        const int lane = threadIdx.x & 63, fl = wc * 32 + 8 * fq, f0 = u.pn * 128 + fl;
        float w0[8], w1[8], w2[8], bb[8];
#pragma unroll
        for (int k = 0; k < 8; k += 4) { const f32x4 a0 = *(const f32x4*)(cw + f0 + k), a1 = *(const f32x4*)(cw + DFF + f0 + k), a2 = *(const f32x4*)(cw + 2 * DFF + f0 + k), a3 = *(const f32x4*)(cb + f0 + k);
#pragma unroll
            for (int i = 0; i < 4; ++i) { w0[k + i] = a0[i]; w1[k + i] = a1[i]; w2[k + i] = a2[i]; bb[k + i] = a3[i]; } }
#pragma unroll
        for (int ai = 0; ai < 2; ++ai) { const int bi = 2 * ai + wr;
            if (fr == 0) { *(LAS f32x4*)(xg + bi * 128 + fl) = acc[ai][1][0][0]; *(LAS f32x4*)(xg + bi * 128 + fl + 4) = acc[ai][1][0][1]; }
            if (fr == 15) { *(LAS f32x4*)(xg + (4 + bi) * 128 + fl) = acc[ai][1][3][0]; *(LAS f32x4*)(xg + (4 + bi) * 128 + fl + 4) = acc[ai][1][3][1]; } }
        asm volatile("s_waitcnt lgkmcnt(0)" ::: "memory"); __builtin_amdgcn_s_barrier(); asm volatile("" ::: "memory");
#pragma unroll
        for (int ai = 0; ai < 2; ++ai) { const int bi = 2 * ai + wr;
            f32x4 xp[2], xn[2];
#pragma unroll
            for (int n = 0; n < 2; ++n) { xp[n] = (f32x4){0.f, 0.f, 0.f, 0.f}; xn[n] = (f32x4){0.f, 0.f, 0.f, 0.f};
                if (fr == 0 && bi > 0) xp[n] = *(const LAS f32x4*)(xg + (4 + bi - 1) * 128 + fl + 4 * n);
                if (fr == 15 && bi < 3) xn[n] = *(const LAS f32x4*)(xg + (bi + 1) * 128 + fl + 4 * n); }
            unsigned o[4][4];
#pragma unroll
            for (int n = 0; n < 2; ++n)
#pragma unroll
                for (int i = 0; i < 4; i += 2) {
                    float r[4][2];
#pragma unroll
                    for (int e = 0; e < 2; ++e) { const int k = 4 * n + i + e;
                        float g[4], up[4], dn[4];
#pragma unroll
                        for (int m = 0; m < 4; ++m) { g[m] = acc[ai][1][m][n][i + e];
                            up[m] = __int_as_float(__builtin_amdgcn_update_dpp(0, __float_as_int(g[m]), 0x121, 0xf, 0xf, false));
                            dn[m] = __int_as_float(__builtin_amdgcn_update_dpp(0, __float_as_int(g[m]), 0x12F, 0xf, 0xf, false)); }
#pragma unroll
                        for (int m = 0; m < 4; ++m) { const float pv = (fr == 0) ? (m > 0 ? up[m > 0 ? m - 1 : 0] : xp[n][i + e]) : up[m];
                            const float nv = (fr == 15) ? (m < 3 ? dn[m < 3 ? m + 1 : 3] : xn[n][i + e]) : dn[m];
                            r[m][e] = w0[k] * pv + w1[k] * g[m] + w2[k] * nv + bb[k]; } }
#pragma unroll
                    for (int m = 0; m < 4; ++m) { const pg8::f32x2 gl = pg8::gelu_pk((pg8::f32x2){r[m][0], r[m][1]});
                        const bool e0 = (bi == 0 && m == 0 && fr == 0), e1 = (bi == 3 && m == 3 && fr == 15);
                        if (e0 || e1) { float* ep = edge + ((size_t)(u.pm * 2 + (e1 ? 1 : 0)) * DFF + f0 + 4 * n + i);
                            ep[0] = r[m][0]; ep[1] = r[m][1]; ep[EDGE_STRIDE] = acc[ai][1][m][n][i]; ep[EDGE_STRIDE + 1] = acc[ai][1][m][n][i + 1];
                            ep[2 * EDGE_STRIDE] = acc[ai][0][m][n][i]; ep[2 * EDGE_STRIDE + 1] = acc[ai][0][m][n][i + 1]; }
                        o[m][2 * n + (i >> 1)] = pg8::cvt_pk_bf16(gl.x * acc[ai][0][m][n][i], gl.y * acc[ai][0][m][n][i + 1]); }
                }
#pragma unroll
            for (int m = 0; m < 4; ++m) { const int row = u.pm * 256 + ai * 128 + wr * 64 + m * 16 + fr;
                u32x4 w; w.x = o[m][0]; w.y = o[m][1]; w.z = o[m][2]; w.w = o[m][3];
                *(u32x4*)(ACT + (size_t)row * DFF + f0) = w; }
        }
    }
};
DI void glu_fixup(const Args& a, int pm, int tid) {
    const float* edge = (const float*)(a.ws + OFF_EDGE); bf16_t* ACT = (bf16_t*)(a.ws + OFF_ACT);
    for (int idx = tid; idx < 2 * DFF; idx += 512) { const int e = idx / DFF, f = idx % DFF, t = pm * 256 + 255 * e;
        const float part = edge[(size_t)(pm * 2 + e) * DFF + f], uu = edge[2 * EDGE_STRIDE + (size_t)(pm * 2 + e) * DFF + f];
        float miss = 0.f;
        if (e == 0) { if ((t & (SEQ - 1)) != 0) miss = a.conv_w[f] * edge[EDGE_STRIDE + (size_t)((pm - 1) * 2 + 1) * DFF + f]; }
        else { if (((t + 1) & (SEQ - 1)) != 0) miss = a.conv_w[2 * DFF + f] * edge[EDGE_STRIDE + (size_t)((pm + 1) * 2) * DFF + f]; }
        const float g = part + miss;
        ACT[(size_t)t * DFF + f] = (bf16_t)f2bf(0.5f * g * (1.f + erff(g * 0.70710678118654752f)) * uu); }
}

DI void tr_block(const float* src, int ldw, bf16_t* dst, int ldd, float scale, LAS float* scr, int lane) {
#pragma unroll 8
    for (int i = 0; i < 32; ++i) { const int kk = 2 * i + (lane >> 5); scr[kk * 33 + (lane & 31)] = src[(size_t)kk * ldw + (lane & 31)]; }
    asm volatile("s_waitcnt lgkmcnt(0)" ::: "memory");
    const int c = lane & 7;
#pragma unroll
    for (int j = 0; j < 4; ++j) { const int n = (lane >> 3) + 8 * j; const LAS float* s = scr + (8 * c) * 33 + n;
        u32x4 o; o.x = pk2(s[0 * 33] * scale, s[1 * 33] * scale); o.y = pk2(s[2 * 33] * scale, s[3 * 33] * scale); o.z = pk2(s[4 * 33] * scale, s[5 * 33] * scale); o.w = pk2(s[6 * 33] * scale, s[7 * 33] * scale);
        *(u32x4*)(dst + (size_t)n * ldd + 8 * c) = o; }
    asm volatile("s_waitcnt lgkmcnt(0)" ::: "memory");
}
DI void phase0(const Args& a, LAS unsigned char* lds, int tid, int lane, int wave) {
    LAS float* sc = (LAS float*)lds;
    LAS float* red = sc + 4096;
    float* mod = (float*)(a.ws + OFF_MOD);
    for (int i = tid; i < 4096; i += 512) { const float v = a.c[i]; sc[i] = v / (1.f + __expf(-v)); }
    __syncthreads();
    for (int item = blockIdx.x; item < 256; item += gridDim.x) {
        const int n0 = item * 48;
        if (tid < 384) {
            const int cq = tid % 12, ks = tid / 12;
            f32x4 a0 = {0.f, 0.f, 0.f, 0.f}, a1 = {0.f, 0.f, 0.f, 0.f};
            const float* wp = a.w_ada + (size_t)(ks * 64) * NMOD + n0 + 4 * cq;
#pragma unroll 8
            for (int kk = 0; kk < 64; ++kk) { const f32x4 w = *(const f32x4*)(wp + (size_t)kk * NMOD); const float s0 = sc[ks * 64 + kk], s1 = sc[2048 + ks * 64 + kk]; a0 += s0 * w; a1 += s1 * w; }
            LAS float* rp = red + (ks * 12 + cq) * 8;
            *(LAS f32x4*)rp = a0; *(LAS f32x4*)(rp + 4) = a1;
        }
        __syncthreads();
        if (tid < 96) { const int cq = tid >> 3, j = tid & 7; float s = 0.f;
            for (int ks = 0; ks < 32; ++ks) s += red[(ks * 12 + cq) * 8 + j];
            const int bb = j >> 2, col = n0 + 4 * cq + (j & 3); mod[bb * NMOD + col] = s + a.b_ada[col]; }
        __syncthreads();
    }
    LAS float* scr = (LAS float*)(lds + 32768 + wave * 8448);
    bf16_t* WinT = (bf16_t*)(a.ws + OFF_WIN); bf16_t* WoutT = (bf16_t*)(a.ws + OFF_WOUT); bf16_t* WupT = (bf16_t*)(a.ws + OFF_WUP); bf16_t* WdnT = (bf16_t*)(a.ws + OFF_WDN);
    constexpr int I_IN = 32 * (NPC / 32), I_OUT = 32 * (DM / 32), I_UP = 32 * (NUP / 32), I_DN = (DFF / 64) * (DM / 32);
    const int gw = blockIdx.x * 8 + wave, NGW = gridDim.x * 8;
    for (int it = gw; it < I_IN + I_OUT + I_UP + I_DN; it += NGW) {
        int r = it;
        if (r < I_IN) { const int nblk = NPC / 32, kb = r / nblk, nb = r % nblk, n0 = nb * 32, ns = n0 < 4096 ? n0 : n0 + 16;
            tr_block(a.w_in + (size_t)(kb * 64) * WIN_LD + ns, WIN_LD, WinT + (size_t)n0 * DM + kb * 64, DM, (n0 >= 1024 && n0 < 2048) ? 0.0625f : 1.f, scr, lane); continue; }
        r -= I_IN;
        if (r < I_OUT) { const int nblk = DM / 32, kb = r / nblk, nb = r % nblk;
            tr_block(a.w_out + (size_t)(kb * 64) * DM + nb * 32, DM, WoutT + (size_t)(nb * 32) * DM + kb * 64, DM, 1.f, scr, lane); continue; }
        r -= I_OUT;
        if (r < I_UP) { const int nblk = NUP / 32, kb = r / nblk, nb = r % nblk, n0 = nb * 32, pn = n0 >> 8, j0 = n0 & 255, ns = (j0 < 128) ? pn * 128 + j0 : DFF + pn * 128 + j0 - 128;
            tr_block(a.w_up + (size_t)(kb * 64) * NUP + ns, NUP, WupT + (size_t)n0 * DM + kb * 64, DM, 1.f, scr, lane); continue; }
        r -= I_UP;
        { const int nblk = DM / 32, kb = r / nblk, nb = r % nblk;
            tr_block(a.w_down + (size_t)(kb * 64) * DM + nb * 32, DM, WdnT + (size_t)(nb * 32) * DFF + kb * 64, DFF, 1.f, scr, lane); }
    }
}

DI float gate_reduce16(float (&g16)[16], int lane) {
#pragma unroll
    for (int i = 0; i < 8; ++i) { const bool hi = lane & 32; const float snd = hi ? g16[i] : g16[i + 8], keep = hi ? g16[i + 8] : g16[i]; g16[i] = keep + __shfl_xor(snd, 32); }
#pragma unroll
    for (int i = 0; i < 4; ++i) { const bool hi = lane & 16; const float snd = hi ? g16[i] : g16[i + 4], keep = hi ? g16[i + 4] : g16[i]; g16[i] = keep + __shfl_xor(snd, 16); }
#pragma unroll
    for (int i = 0; i < 2; ++i) { const bool hi = lane & 8; const float snd = hi ? g16[i] : g16[i + 2], keep = hi ? g16[i + 2] : g16[i]; g16[i] = keep + __shfl_xor(snd, 8); }
    { const bool hi = lane & 4; const float snd = hi ? g16[0] : g16[1], keep = hi ? g16[1] : g16[0]; g16[0] = keep + __shfl_xor(snd, 4); }
    g16[0] += __shfl_xor(g16[0], 2); g16[0] += __shfl_xor(g16[0], 1);
    return g16[0];
}
template <bool GATES, bool IN_BF16> DI void phase_norm(const Args& a, LAS unsigned char* lds, const void* xin_, const float* gn, int sh_off, int sc_off, int tid, int lane, int wave) {
    const float* xin = (const float*)xin_; const bf16_t* xin16 = (const bf16_t*)xin_;
    const float* mod = (const float*)(a.ws + OFF_MOD);
    bf16_t* Hb = (bf16_t*)(a.ws + OFF_HB);
    float* gates = (float*)(a.ws + OFF_GATES);
    LAS float* wg = (LAS float*)lds;
    if (GATES) {
        __syncthreads();
        for (int idx = tid; idx < 2048 * 16; idx += 512) { const int k = idx >> 4, i = idx & 15; wg[i * 2052 + k] = a.w_in[(size_t)k * WIN_LD + 4096 + i]; }
        __syncthreads();
    }
    constexpr int R = GATES ? 2 : 4;
    const int gw = blockIdx.x * 8 + wave, NGW = gridDim.x * 8;
    int curb = -1; f32x4 gs[8], sh[8];
    for (int m = R * gw; m < MTOK; m += R * NGW) {
        const int bb = m >> 13;
        if (bb != curb) { curb = bb;
#pragma unroll
            for (int j = 0; j < 8; ++j) { const int k = 4 * lane + 256 * j; const f32x4 g = *(const f32x4*)(gn + k), s = *(const f32x4*)(mod + bb * NMOD + sc_off + k);
                gs[j] = g * (1.f + s); sh[j] = *(const f32x4*)(mod + bb * NMOD + sh_off + k); } }
        f32x4 v[R][8];
#pragma unroll
        for (int r = 0; r < R; ++r)
#pragma unroll
            for (int j = 0; j < 8; ++j) {
                if (IN_BF16) { const u32x2 p0 = *(const u32x2*)(xin16 + (size_t)(m + r) * DM + 4 * lane + 256 * j);
                    v[r][j] = (f32x4){bf2f(p0.x & 0xffffu), bf2f(p0.x >> 16), bf2f(p0.y & 0xffffu), bf2f(p0.y >> 16)}; }
                else v[r][j] = *(const f32x4*)(xin + (size_t)(m + r) * DM + 4 * lane + 256 * j); }
#pragma unroll
        for (int r = 0; r < R; ++r) { float ss = 0.f;
#pragma unroll
            for (int j = 0; j < 8; ++j) ss += (v[r][j].x * v[r][j].x + v[r][j].y * v[r][j].y) + (v[r][j].z * v[r][j].z + v[r][j].w * v[r][j].w);
            const float rstd = rsqrtf(wave_sum(ss) * (1.f / DM) + EPSN);
#pragma unroll
            for (int j = 0; j < 8; ++j) { v[r][j] = v[r][j] * rstd * gs[j] + sh[j];
                u32x2 o; o.x = pk2(v[r][j].x, v[r][j].y); o.y = pk2(v[r][j].z, v[r][j].w); *(u32x2*)(Hb + (size_t)(m + r) * DM + 4 * lane + 256 * j) = o; } }
        if (GATES) {
            float ga[16], gb[16];
#pragma unroll
            for (int i = 0; i < 16; ++i) { float s0 = 0.f, s1 = 0.f;
#pragma unroll
                for (int j = 0; j < 8; ++j) { const f32x4 w = *(const LAS f32x4*)(wg + i * 2052 + 4 * lane + 256 * j);
                    s0 += (v[0][j].x * w.x + v[0][j].y * w.y) + (v[0][j].z * w.z + v[0][j].w * w.w); s1 += (v[R - 1][j].x * w.x + v[R - 1][j].y * w.y) + (v[R - 1][j].z * w.z + v[R - 1][j].w * w.w); }
                ga[i] = s0; gb[i] = s1; __builtin_amdgcn_sched_barrier(0); }
            const float r0 = gate_reduce16(ga, lane), r1 = gate_reduce16(gb, lane);
            if ((lane & 3) == 0) { const int gi = ((lane >> 5) & 1) * 8 + ((lane >> 4) & 1) * 4 + ((lane >> 3) & 1) * 2 + ((lane >> 2) & 1); const float bg = a.b_gates[gi];
                gates[(size_t)m * 16 + gi] = r0 + bg; gates[(size_t)(m + 1) * 16 + gi] = r1 + bg; }
        }
    }
}

DI void gate_prep(const Args& a, LAS unsigned char* lds, int combo, int tid) {
    const float* gates = (const float*)(a.ws + OFF_GATES);
    float* ulA = (float*)(a.ws + OFF_UL); float* MlA = (float*)(a.ws + OFF_ML); float* emtA = (float*)(a.ws + OFF_EMT);
    float* mprevA = (float*)(a.ws + OFF_MPREV); float* mendA = (float*)(a.ws + OFF_MEND);
    LAS float* sT = (LAS float*)lds; LAS float* sM = sT + 512; LAS float* sG = sM + 512; LAS float* sX = sG + 32; LAS float* sMp = sX + 32; LAS float* sMe = sMp + 32;
    const int b = combo >> 3, dir = (combo >> 2) & 1, h = combo & 3;
    const int ci = dir * 8 + h, cf = dir * 8 + 4 + h, cs = tid >> 4;
    float li[16], bl[16], cm[16];
    float run = 0.f;
#pragma unroll
    for (int i = 0; i < 16; ++i) { const int tau = tid * 16 + i, t = dir ? SEQ - 1 - tau : tau; const float* gp = gates + (size_t)(b * SEQ + t) * 16;
        li[i] = gp[ci]; const float f = gp[cf]; const float lf = fminf(f, 0.f) - log1pf(__expf(-fabsf(f))); run += lf; bl[i] = run; }
    sT[tid] = run; __syncthreads();
    float base = 0.f;
#pragma unroll
    for (int j = 0; j < 16; ++j) { const float v = sT[cs * 16 + j]; base += (j < (tid & 15)) ? v : 0.f; }
    float mx = -3.0e38f;
#pragma unroll
    for (int i = 0; i < 16; ++i) { bl[i] += base; li[i] -= bl[i]; mx = fmaxf(mx, li[i]); cm[i] = mx; }
    sM[tid] = mx; __syncthreads();
    float mbase = -3.0e38f;
#pragma unroll
    for (int j = 0; j < 16; ++j) { const float v = sM[cs * 16 + j]; mbase = fmaxf(mbase, (j < (tid & 15)) ? v : -3.0e38f); }
    if (tid < 32) { float g = 0.f, xm = -3.0e38f;
#pragma unroll
        for (int j = 0; j < 16; ++j) { g += sT[tid * 16 + j]; xm = fmaxf(xm, sM[tid * 16 + j]); } sG[tid] = g; sX[tid] = xm; }
    __syncthreads();
    if (tid == 0) { float gx[32], xx[32];
#pragma unroll
        for (int c = 0; c < 32; ++c) { gx[c] = sG[c]; xx[c] = sX[c]; }
        float m = -1e30f;
#pragma unroll
        for (int c = 0; c < 32; ++c) { sMp[c] = m; const float me = fmaxf(m, xx[c]); sMe[c] = me; m = gx[c] + me; } }
    __syncthreads();
    const float mp = sMp[cs];
#pragma unroll
    for (int i = 0; i < 16; ++i) { const int tau = tid * 16 + i, t = dir ? SEQ - 1 - tau : tau; const float Ml = fmaxf(mp, fmaxf(cm[i], mbase));
        ulA[combo * SEQ + t] = li[i]; MlA[combo * SEQ + t] = Ml; emtA[combo * SEQ + t] = __expf(-(bl[i] + Ml)); }
    if ((tid & 15) == 0) { const int c = dir ? NCH - 1 - cs : cs; mprevA[combo * NCH + c] = mp; mendA[combo * NCH + c] = sMe[cs]; }
    __syncthreads();
}

DI void mlstm_delta(const Args& a, LAS unsigned char* lds, int tid, int lane, int wave) {
    const bf16_t* P = (const bf16_t*)(a.ws + OFF_P); bf16_t* cst = (bf16_t*)(a.ws + OFF_CST);
    const float* ulA = (const float*)(a.ws + OFF_UL); const float* mendA = (const float*)(a.ws + OFF_MEND);
    const int l15 = lane & 15, quad = lane >> 4, qin = l15 >> 2, pin = l15 & 3;
    constexpr int BUFB = 2 * 34816;
    LAS float* wS = (LAS float*)(lds + 2 * BUFB);
    const short one = (l15 == 0) ? (short)0x3F80 : (short)0;
    const bf16x8 ones = {one, one, one, one, one, one, one, one};
    for (int item = blockIdx.x; item < NCOMBO * NCH; item += gridDim.x) {
        const int combo = item / NCH, c = item % NCH, b = combo >> 3, h = combo & 3;
        const float mend = mendA[combo * NCH + c];
        __syncthreads();
        if (tid < 256) wS[tid] = __expf(ulA[combo * SEQ + c * LCH + tid] - mend);
        f32x4 acc[17][2];
#pragma unroll
        for (int m = 0; m < 17; ++m) { acc[m][0] = (f32x4){0.f, 0.f, 0.f, 0.f}; acc[m][1] = (f32x4){0.f, 0.f, 0.f, 0.f}; }
        const bf16_t* Pk = P + (size_t)(b * SEQ + c * LCH) * NPC + 1024 + h * 256;
        u32x4 pre[8];
#define DL_LOAD(sb_) do { int t0_ = tid; asm volatile("" : "+v"(t0_)); const bf16_t* src_ = Pk + (unsigned)(((sb_) * 64 + (t0_ >> 5)) * NPC + (t0_ & 31) * 8); \
        _Pragma("unroll") for (int i_ = 0; i_ < 4; ++i_) { pre[i_] = *(const u32x4*)(src_ + i_ * 16 * NPC); pre[4 + i_] = *(const u32x4*)(src_ + i_ * 16 * NPC + 1024); } } while (0)
#define DL_STORE(sb_) do { int t0_ = tid; asm volatile("" : "+v"(t0_)); LAS unsigned char* d_ = lds + ((sb_) & 1) * BUFB + (t0_ >> 5) * 544 + (t0_ & 31) * 16; \
        _Pragma("unroll") for (int i_ = 0; i_ < 4; ++i_) { const float w_ = wS[(sb_) * 64 + (t0_ >> 5) + 16 * i_]; \
            *(LAS bf16x8*)(d_ + i_ * 16 * 544) = scale8(__builtin_bit_cast(bf16x8, pre[i_]), w_); *(LAS u32x4*)(d_ + 34816 + i_ * 16 * 544) = pre[4 + i_]; } } while (0)
        DL_LOAD(0);
        __syncthreads();
        DL_STORE(0);
        __syncthreads();
#pragma unroll 1
        for (int sb = 0; sb < 4; ++sb) {
            const LAS unsigned char* Kt = lds + (sb & 1) * BUFB; const LAS unsigned char* Vt = Kt + 34816;
            if (sb + 1 < 4) DL_LOAD(sb + 1);
#pragma unroll 1
            for (int kk = 0; kk < 2; ++kk) {
                bf16x8 bfr[2];
#pragma unroll
                for (int n = 0; n < 2; ++n) bfr[n] = tr_frag(Kt, 544, kk * 32 + 4 * quad, kk * 32 + 16 + 4 * quad, wave * 32 + n * 16, qin, pin);
#pragma unroll
                for (int m = 0; m < 16; ++m) { const bf16x8 afr = tr_frag(Vt, 544, kk * 32 + 4 * quad, kk * 32 + 16 + 4 * quad, m * 16, qin, pin);
                    acc[m][0] = MFMA16(bfr[0], afr, acc[m][0]); acc[m][1] = MFMA16(bfr[1], afr, acc[m][1]); if ((m & 3) == 3) __builtin_amdgcn_sched_barrier(0); }
                acc[16][0] = MFMA16(bfr[0], ones, acc[16][0]); acc[16][1] = MFMA16(bfr[1], ones, acc[16][1]);
            }
            if (sb + 1 < 4) DL_STORE(sb + 1);
            __syncthreads();
        }
#undef DL_LOAD
#undef DL_STORE
        int loff = l15 * 256 + wave * 32 + 4 * quad; asm volatile("" : "+v"(loff));
        bf16_t* dst = cst + (size_t)item * ST_ELEMS + loff;
#pragma unroll
        for (int m = 0; m < 17; ++m) {
#pragma unroll
            for (int n = 0; n < 2; ++n) { u32x2 w; w.x = pk2(acc[m][n][0], acc[m][n][1]); w.y = pk2(acc[m][n][2], acc[m][n][3]); *(u32x2*)(dst + (16 * m) * 256 + 16 * n) = w; }
            __builtin_amdgcn_sched_barrier(0); }
    }
}

DI void mlstm_scan(const Args& a, int tid) {
    bf16_t* cst = (bf16_t*)(a.ws + OFF_CST);
    const float* mprevA = (const float*)(a.ws + OFF_MPREV); const float* mendA = (const float*)(a.ws + OFF_MEND);
    constexpr int VPS = ST_ELEMS / 8;
    const int gt = blockIdx.x * 512 + tid, NT = gridDim.x * 512;
    for (int v = gt; v < NCOMBO * VPS; v += NT) {
        const int combo = v / VPS, vi = v % VPS, dir = (combo >> 2) & 1;
        float st[8];
#pragma unroll
        for (int i = 0; i < 8; ++i) st[i] = 0.f;
        bf16_t* base = cst + (size_t)combo * NCH * ST_ELEMS + vi * 8;
        for (int cs0 = 0; cs0 < NCH; cs0 += 8) {
            u32x4 d[8]; float dec[8];
#pragma unroll
            for (int q = 0; q < 8; ++q) { const int c = dir ? NCH - 1 - (cs0 + q) : cs0 + q;
                d[q] = *(const u32x4*)(base + (size_t)c * ST_ELEMS); dec[q] = __expf(mprevA[combo * NCH + c] - mendA[combo * NCH + c]); }
#pragma unroll
            for (int q = 0; q < 8; ++q) { const int c = dir ? NCH - 1 - (cs0 + q) : cs0 + q;
                u32x4 o;
#pragma unroll
                for (int i = 0; i < 4; ++i) { o[i] = pk2(st[2 * i], st[2 * i + 1]); st[2 * i] = dec[q] * st[2 * i] + bf2f(d[q][i] & 0xffffu); st[2 * i + 1] = dec[q] * st[2 * i + 1] + bf2f(d[q][i] >> 16); }
                *(u32x4*)(base + (size_t)c * ST_ELEMS) = o; }
        }
    }
}

DI void nat_scores(f32x4 (&st)[4][2], const LAS unsigned char* T, const bf16x8 (&qf)[4], int kc0, int l15, int quad) {
#pragma unroll
    for (int k4 = 0; k4 < 4; ++k4)
#pragma unroll
        for (int mi = 0; mi < 2; ++mi) { f32x4 s = {0.f, 0.f, 0.f, 0.f};
#pragma unroll
            for (int ks = 0; ks < 4; ++ks) { s = MFMA16(ld_frag(T + (k4 * 64 + kc0 + 16 * mi + l15) * 272 + (ks * 32 + quad * 8) * 2), qf[ks], s); if (ks == 1) __builtin_amdgcn_sched_barrier(0); }
            st[k4][mi] = s; __builtin_amdgcn_sched_barrier(0); }
}
DI float nat_mask(f32x4 (&st)[4][2], const LAS float* rpbS, int kr0, int rs, int r, const bool (&sel)[4], const int (&dcb)[4], float scale) {
    float mx = -3.0e38f;
#pragma unroll
    for (int k4 = 0; k4 < 4; ++k4) { const int dr = rs + kr0 + k4 - r + 7;
#pragma unroll
        for (int rr = 0; rr < 4; ++rr) { const float sv = (sel[rr] ? st[k4][0][rr] : st[k4][1][rr]) * scale + rpbS[dr * 31 + dcb[rr]]; st[k4][0][rr] = sv; mx = fmaxf(mx, sv); } }
    mx = fmaxf(mx, __shfl_xor(mx, 16)); mx = fmaxf(mx, __shfl_xor(mx, 32));
    return mx;
}
DI float nat_exp(bf16x8 (&pf)[4], f32x4 (&st)[4][2], const bool (&sel)[4], float m) {
    float sum = 0.f;
#pragma unroll
    for (int k4 = 0; k4 < 4; ++k4) { f32x4 p0, p1;
#pragma unroll
        for (int rr = 0; rr < 4; ++rr) { const float p = __expf(st[k4][0][rr] - m); sum += p; p0[rr] = sel[rr] ? p : 0.f; p1[rr] = sel[rr] ? 0.f : p; }
        pf[k4] = pack8(p0, p1); }
    return sum;
}
DI void nat_pv(f32x4 (&o)[8], const bf16x8 (&pf)[4], const LAS unsigned char* T, int kc0, int quad, int qin, int pin) {
#pragma unroll
    for (int k4 = 0; k4 < 4; ++k4) {
#pragma unroll
        for (int n = 0; n < 8; ++n) { o[n] = MFMA16(tr_frag(T + k4 * 64 * 272, 272, kc0 + 4 * quad, kc0 + 16 + 4 * quad, 16 * n, qin, pin), pf[k4], o[n]); if ((n & 3) == 3) __builtin_amdgcn_sched_barrier(0); } }
}
DI void natten(const Args& a, LAS unsigned char* lds, int tid, int lane, int wave) {
    const bf16_t* P = (const bf16_t*)(a.ws + OFF_P); bf16_t* mixed = (bf16_t*)(a.ws + OFF_HB);
    const int l15 = lane & 15, quad = lane >> 4, qin = l15 >> 2, pin = l15 & 3;
    const int hw = wave >> 2, j = wave & 3, htid = tid & 255;
    LAS unsigned char* T = lds + hw * 69632;
    LAS float* rpbS = (LAS float*)(lds + 139264) + hw * 480;
    const int kc0 = (j == 0) ? 0 : (j == 1) ? 8 : (j == 2) ? 24 : 32;
    const float scale = 0.08838834764831845f;
    const int nit = (1024 - (int)blockIdx.x + (int)gridDim.x - 1) / (int)gridDim.x;
    if (nit <= 0) return;
    __syncthreads();
    { const int h0 = (blockIdx.x & 3) * 2 + hw; for (int i = htid; i < 465; i += 256) rpbS[i] = a.rpb[h0 * 465 + i]; }
    u32x4 pre[16];
    const bool xmap = (gridDim.x == 256);
#define NAT_ITEM(k_) (xmap ? ((((int)blockIdx.x & 7) >> 2) << 9) | ((32 * (k_) + ((int)blockIdx.x >> 3)) << 2) | ((int)blockIdx.x & 3) : (int)blockIdx.x + (k_) * (int)gridDim.x)
#define NAT_LOAD(g_) do { const int it_ = NAT_ITEM((g_) >> 2), sp_ = (g_) & 3; const int b_ = it_ >> 9, r_ = (it_ >> 2) & 127, h_ = (it_ & 3) * 2 + hw; \
        const int rs_ = min(max(r_ - 4, 0), 120); int t0_ = htid; asm volatile("" : "+v"(t0_)); \
        const bf16_t* src_ = P + (unsigned)((b_ * SEQ + (rs_ + 4 * (sp_ & 1)) * 64) * NPC + ((sp_ >> 1) ? 6144 : 5120) + h_ * 128 + ((t0_ >> 4) * NPC + (t0_ & 15) * 8)); \
        _Pragma("unroll") for (int i_ = 0; i_ < 16; ++i_) pre[i_] = *(const u32x4*)(src_ + i_ * 16 * NPC); } while (0)
#define NAT_STORE() do { int t0_ = htid; asm volatile("" : "+v"(t0_)); LAS unsigned char* d_ = T + (t0_ >> 4) * 272 + (t0_ & 15) * 16; \
        _Pragma("unroll") for (int i_ = 0; i_ < 16; ++i_) *(LAS u32x4*)(d_ + i_ * 16 * 272) = pre[i_]; } while (0)
    NAT_LOAD(0); NAT_STORE();
    __syncthreads();
#pragma unroll 1
    for (int k = 0; k < nit; ++k) {
        const int item = NAT_ITEM(k);
        const int b = item >> 9, r = (item >> 2) & 127, h = (item & 3) * 2 + hw;
        int l15g = l15; asm volatile("" : "+v"(l15g));
        const int rs = min(max(r - 4, 0), 120), qcol = 16 * j + l15g;
        const int tokq = b * SEQ + r * 64 + qcol;
        bf16x8 qf[4]; f32x4 st[4][2]; bf16x8 pf0[4], pf1[4];
#pragma unroll
        for (int ks = 0; ks < 4; ++ks) qf[ks] = *(const bf16x8*)(P + (unsigned)(tokq * NPC + 4096 + h * 128 + ks * 32 + quad * 8));
        const int cs = min(max(qcol - 8, 0), 48);
        bool sel[4]; int dcb[4];
#pragma unroll
        for (int rr = 0; rr < 4; ++rr) { sel[rr] = (4 * quad + rr >= cs - kc0); dcb[rr] = kc0 + 4 * quad + rr + (sel[rr] ? 0 : 16) - qcol + 15; }
        NAT_LOAD(4 * k + 1);
        nat_scores(st, T, qf, kc0, l15, quad);
        const float m0 = nat_mask(st, rpbS, 0, rs, r, sel, dcb, scale);
        float sum0 = nat_exp(pf0, st, sel, m0);
        __syncthreads(); NAT_STORE(); __syncthreads();
        NAT_LOAD(4 * k + 2);
        nat_scores(st, T, qf, kc0, l15, quad);
        const float m1 = nat_mask(st, rpbS, 4, rs, r, sel, dcb, scale);
        const float M = fmaxf(m0, m1), f0 = __expf(m0 - M);
        float sum1 = nat_exp(pf1, st, sel, M);
        float tot = sum0 * f0 + sum1;
        tot += __shfl_xor(tot, 16); tot += __shfl_xor(tot, 32);
        const float inv = 1.f / tot;
        __syncthreads(); NAT_STORE(); __syncthreads();
        f32x4 o[8];
#pragma unroll
        for (int n = 0; n < 8; ++n) o[n] = (f32x4){0.f, 0.f, 0.f, 0.f};
        NAT_LOAD(4 * k + 3);
        nat_pv(o, pf0, T, kc0, quad, qin, pin);
#pragma unroll
        for (int n = 0; n < 8; ++n) o[n] = o[n] * f0;
        __syncthreads(); NAT_STORE(); __syncthreads();
        if (k + 1 < nit) NAT_LOAD(4 * k + 4);
        nat_pv(o, pf1, T, kc0, quad, qin, pin);
#pragma unroll
        for (int n = 0; n < 8; ++n) { u32x2 w; w.x = pk2(o[n][0] * inv, o[n][1] * inv); w.y = pk2(o[n][2] * inv, o[n][3] * inv);
            *(u32x2*)(mixed + (unsigned)(tokq * DM + 1024 + h * 128 + 16 * n + 4 * quad)) = w; }
        __syncthreads();
        if (k + 1 < nit) NAT_STORE();
        __syncthreads();
    }
#undef NAT_LOAD
#undef NAT_ITEM
#undef NAT_STORE
}

DI void mlstm_out(const Args& a, LAS unsigned char* lds, int tid, int lane, int wave) {
    const bf16_t* P = (const bf16_t*)(a.ws + OFF_P); const bf16_t* cst = (const bf16_t*)(a.ws + OFF_CST); bf16_t* mixed = (bf16_t*)(a.ws + OFF_HB);
    const float* ulA = (const float*)(a.ws + OFF_UL); const float* MlA = (const float*)(a.ws + OFF_ML); const float* emtA = (const float*)(a.ws + OFF_EMT);
    const float* mprevA = (const float*)(a.ws + OFF_MPREV);
    const int l15 = lane & 15, quad = lane >> 4, qin = l15 >> 2, pin = l15 & 3;
    constexpr int BUFB = 33792 + 34816;
    LAS float* ulS2 = (LAS float*)(lds + 2 * BUFB);
    const short one = (l15 == 0) ? (short)0x3F80 : (short)0;
    const bf16x8 ones = {one, one, one, one, one, one, one, one};
    for (int item = blockIdx.x; item < 512; item += gridDim.x) {
        const int bh = item >> 6, c = (item >> 1) & 31, half = item & 1, b = bh >> 2, h = bh & 3;
        int l15i = l15, tt = tid; asm volatile("" : "+v"(l15i), "+v"(tt));
        const int t_loc = 128 * half + 16 * wave + l15i;
        const size_t tok = (size_t)b * SEQ + c * LCH + t_loc;
        const int n0 = 2 * half + 2;
        __syncthreads();
        { const int d = tt >> 8; ulS2[tt] = ulA[((b * 2 + d) * 4 + h) * SEQ + c * LCH + (tt & 255)]; }
        u32x4 pre[8];
#define STEP_DEC(s_, dir_, st_, idx_) do { int r_ = (s_); dir_ = 0; if (r_ >= n0 + 4) { r_ -= n0 + 4; dir_ = 1; } const int nk_ = dir_ ? 4 - 2 * half : n0; st_ = (r_ >= nk_); idx_ = st_ ? r_ - nk_ : (dir_ ? 2 * half + r_ : r_); } while (0)
#define STEP_LOAD(s_) do { int dir_, st_, idx_; STEP_DEC(s_, dir_, st_, idx_); int t0_ = tid; asm volatile("" : "+v"(t0_)); \
        if (!st_) { const bf16_t* src_ = P + ((size_t)b * SEQ + c * LCH + 64 * idx_) * NPC + 1024 + h * 256 + ((t0_ >> 5) * NPC + (t0_ & 31) * 8); \
            _Pragma("unroll") for (int i_ = 0; i_ < 4; ++i_) { pre[i_] = *(const u32x4*)(src_ + i_ * 16 * NPC); pre[4 + i_] = *(const u32x4*)(src_ + i_ * 16 * NPC + 1024); } } \
        else { const bf16_t* src_ = cst + (size_t)(((b * 2 + dir_) * 4 + h) * NCH + c) * ST_ELEMS + 64 * idx_ + ((t0_ >> 3) * 256 + (t0_ & 7) * 8); \
            _Pragma("unroll") for (int i_ = 0; i_ < 4; ++i_) pre[i_] = *(const u32x4*)(src_ + i_ * 64 * 256); \
            if (t0_ < 128) pre[4] = *(const u32x4*)(src_ + 4 * 64 * 256); } } while (0)
#define STEP_STORE(s_) do { int dir_, st_, idx_; STEP_DEC(s_, dir_, st_, idx_); LAS unsigned char* bp_ = lds + ((s_) & 1) * BUFB; int t0_ = tid; asm volatile("" : "+v"(t0_)); \
        if (!st_) { LAS unsigned char* d_ = bp_ + (t0_ >> 5) * 528 + (t0_ & 31) * 16; \
            _Pragma("unroll") for (int i_ = 0; i_ < 4; ++i_) { *(LAS u32x4*)(d_ + i_ * 16 * 528) = pre[i_]; *(LAS u32x4*)(bp_ + 33792 + ((t0_ >> 5) + 16 * i_) * 544 + (t0_ & 31) * 16) = pre[4 + i_]; } } \
        else { LAS unsigned char* d_ = bp_ + (t0_ >> 3) * 144 + (t0_ & 7) * 16; \
            _Pragma("unroll") for (int i_ = 0; i_ < 4; ++i_) *(LAS u32x4*)(d_ + i_ * 64 * 144) = pre[i_]; \
            if (t0_ < 128) *(LAS u32x4*)(d_ + 4 * 64 * 144) = pre[4]; } } while (0)
        bf16x8 qf[8];
        { int qo = h * 256 + quad * 8; asm volatile("" : "+v"(qo)); const bf16_t* qp = P + tok * NPC + qo;
#pragma unroll
          for (int ks = 0; ks < 8; ++ks) qf[ks] = *(const bf16x8*)(qp + ks * 32); }
        STEP_LOAD(0); STEP_STORE(0);
        __syncthreads();
        f32x4 acc[17]; float Ml = 0.f, emt = 1.f, aa = 0.f;
#pragma unroll 1
        for (int s = 0; s < 14; ++s) {
            int dir, st, idx; STEP_DEC(s, dir, st, idx);
            const LAS unsigned char* T0 = lds + (s & 1) * BUFB; const LAS unsigned char* T1 = T0 + 33792;
            const LAS float* ulS = ulS2 + dir * 256;
            if (s == 0 || s == n0 + 4) {
                const int combo = (b * 2 + dir) * 4 + h;
                Ml = MlA[combo * SEQ + c * LCH + t_loc]; emt = emtA[combo * SEQ + c * LCH + t_loc]; aa = __expf(mprevA[combo * NCH + c] - Ml);
#pragma unroll
                for (int m = 0; m < 17; ++m) acc[m] = (f32x4){0.f, 0.f, 0.f, 0.f};
            }
            if (s + 1 < 14) STEP_LOAD(s + 1);
            if (!st && (dir ? (64 * idx + 63 >= 128 * half + 16 * wave) : (64 * idx <= 128 * half + 16 * wave + 15))) {
                const int jb = idx;
                f32x4 sc[4];
#pragma unroll
                for (int mi = 0; mi < 4; ++mi) sc[mi] = (f32x4){0.f, 0.f, 0.f, 0.f};
#pragma unroll
                for (int mi = 0; mi < 4; ++mi) {
#pragma unroll
                    for (int ks = 0; ks < 8; ++ks) { sc[mi] = MFMA16(ld_frag(T0 + (16 * mi + l15) * 528 + (32 * ks + 8 * quad) * 2), qf[ks], sc[mi]); if (ks == 3) __builtin_amdgcn_sched_barrier(0); }
                    __builtin_amdgcn_sched_barrier(0); }
#pragma unroll
                for (int mi = 0; mi < 4; ++mi) { const int s0 = 64 * jb + 16 * mi + 4 * quad; const f32x4 uv = *(const LAS f32x4*)(ulS + s0);
#pragma unroll
                    for (int rr = 0; rr < 4; ++rr) { const int s_loc = s0 + rr; const bool valid = dir ? (s_loc >= t_loc) : (s_loc <= t_loc);
                        const float e = __expf(fminf(uv[rr] - Ml, 0.f)); sc[mi][rr] *= valid ? e : 0.f; } }
#pragma unroll
                for (int kk = 0; kk < 2; ++kk) { const bf16x8 pf = pack8(sc[2 * kk], sc[2 * kk + 1]);
                    bf16x8 f0 = tr_frag(T1, 544, 32 * kk + 4 * quad, 32 * kk + 16 + 4 * quad, 0, qin, pin), f1 = tr_frag(T1, 544, 32 * kk + 4 * quad, 32 * kk + 16 + 4 * quad, 16, qin, pin);
#pragma unroll
                    for (int n = 0; n < 16; n += 2) {
                        bf16x8 g0 = f0, g1 = f1;
                        if (n + 2 < 16) { g0 = tr_frag(T1, 544, 32 * kk + 4 * quad, 32 * kk + 16 + 4 * quad, 16 * (n + 2), qin, pin); g1 = tr_frag(T1, 544, 32 * kk + 4 * quad, 32 * kk + 16 + 4 * quad, 16 * (n + 3), qin, pin); }
                        acc[n] = MFMA16(f0, pf, acc[n]); acc[n + 1] = MFMA16(f1, pf, acc[n + 1]);
                        f0 = g0; f1 = g1; __builtin_amdgcn_sched_barrier(0); }
                    acc[16] = MFMA16(ones, pf, acc[16]); }
            } else if (st) {
                const int db = idx;
                bf16x8 aq[2];
                aq[0] = (db == 0) ? qf[0] : (db == 1) ? qf[2] : (db == 2) ? qf[4] : qf[6];
                aq[1] = (db == 0) ? qf[1] : (db == 1) ? qf[3] : (db == 2) ? qf[5] : qf[7];
                aq[0] = scale8(aq[0], aa); aq[1] = scale8(aq[1], aa);
#pragma unroll
                for (int kk = 0; kk < 2; ++kk) {
                    const LAS unsigned char* sp = T0 + l15 * 144 + (32 * kk + 8 * quad) * 2;
                    bf16x8 f0 = ld_frag(sp), f1 = ld_frag(sp + 16 * 144);
#pragma unroll
                    for (int m = 0; m < 16; m += 2) {
                        bf16x8 g0 = f0, g1 = f1;
                        if (m + 2 < 17) g0 = ld_frag(sp + 16 * (m + 2) * 144);
                        if (m + 3 < 17) g1 = ld_frag(sp + 16 * (m + 3) * 144);
                        acc[m] = MFMA16(f0, aq[kk], acc[m]); acc[m + 1] = MFMA16(f1, aq[kk], acc[m + 1]);
                        f0 = g0; f1 = g1; __builtin_amdgcn_sched_barrier(0); }
                    acc[16] = MFMA16(f0, aq[kk], acc[16]); }
            }
            if (s + 1 < 14) STEP_STORE(s + 1);
            if (s == n0 + 3 || s == 13) {
                const float den = __shfl(acc[16][0], l15);
                const float dn = 1.f / fmaxf(fabsf(den), emt);
                int moff = h * 256 + 4 * quad; asm volatile("" : "+v"(moff));
                bf16_t* mrow = mixed + tok * DM + moff;
                if (dir == 0) {
#pragma unroll
                    for (int n = 0; n < 16; ++n) { u32x2 w; w.x = pk2(acc[n][0] * dn, acc[n][1] * dn); w.y = pk2(acc[n][2] * dn, acc[n][3] * dn); *(u32x2*)(mrow + 16 * n) = w; }
                } else {
                    float ss = 0.f;
#pragma unroll
                    for (int n = 0; n < 16; ++n) { const u32x2 hf = *(const u32x2*)(mrow + 16 * n);
                        acc[n][0] = acc[n][0] * dn + bf2f(hf.x & 0xffffu); acc[n][1] = acc[n][1] * dn + bf2f(hf.x >> 16);
                        acc[n][2] = acc[n][2] * dn + bf2f(hf.y & 0xffffu); acc[n][3] = acc[n][3] * dn + bf2f(hf.y >> 16);
                        ss += (acc[n][0] * acc[n][0] + acc[n][1] * acc[n][1]) + (acc[n][2] * acc[n][2] + acc[n][3] * acc[n][3]); if ((n & 3) == 3) __builtin_amdgcn_sched_barrier(0); }
                    ss += __shfl_xor(ss, 16); ss += __shfl_xor(ss, 32);
                    const float rstd = rsqrtf(ss * (1.f / 256.f) + EPSN);
                    __builtin_amdgcn_sched_barrier(0);
                    int eb = h * 256 + 4 * quad; asm volatile("" : "+v"(eb));
                    const float* gp = a.g_head_a + eb; const bf16_t* ovp = P + tok * NPC + 3072 + eb;
#pragma unroll
                    for (int n = 0; n < 16; ++n) { const f32x4 g = *(const f32x4*)(gp + 16 * n);
                        const u32x2 ov = *(const u32x2*)(ovp + 16 * n);
                        const float o0 = bf2f(ov.x & 0xffffu), o1 = bf2f(ov.x >> 16), o2 = bf2f(ov.y & 0xffffu), o3 = bf2f(ov.y >> 16);
                        u32x2 w; w.x = pk2(acc[n][0] * rstd * g.x * __builtin_amdgcn_rcpf(1.f + __expf(-o0)), acc[n][1] * rstd * g.y * __builtin_amdgcn_rcpf(1.f + __expf(-o1)));
                        w.y = pk2(acc[n][2] * rstd * g.z * __builtin_amdgcn_rcpf(1.f + __expf(-o2)), acc[n][3] * rstd * g.w * __builtin_amdgcn_rcpf(1.f + __expf(-o3)));
                        *(u32x2*)(mrow + 16 * n) = w; __builtin_amdgcn_sched_barrier(0); }
                }
            }
            __syncthreads();
        }
#undef STEP_DEC
#undef STEP_LOAD
#undef STEP_STORE
    }
}

DI void phase_act(const Args& a, int tid) {
    bf16_t* UG = (bf16_t*)(a.ws + OFF_UG);
    constexpr int NV = DFF / 8, RUN = 16, NRUN = MTOK / RUN;
    const int gt = blockIdx.x * 512 + tid, NT = gridDim.x * 512;
    for (int it = gt; it < NRUN * NV; it += NT) {
        const int vv = it % NV, run = it / NV, f0 = vv * 8, t0 = run * RUN;
        float w0[8], w1[8], w2[8], cb[8];
#pragma unroll
        for (int i = 0; i < 8; ++i) { w0[i] = a.conv_w[f0 + i]; w1[i] = a.conv_w[DFF + f0 + i]; w2[i] = a.conv_w[2 * DFF + f0 + i]; cb[i] = a.conv_b[f0 + i]; }
        const u32x4 zero = {0u, 0u, 0u, 0u};
        const bf16_t* G = UG + DFF + f0;
        u32x4 gp = ((t0 & (SEQ - 1)) == 0) ? zero : *(const u32x4*)(G + (size_t)(t0 - 1) * NUP);
        u32x4 gc = *(const u32x4*)(G + (size_t)t0 * NUP);
        for (int i = 0; i < RUN; ++i) { const int t = t0 + i;
            const u32x4 gn = (((t + 1) & (SEQ - 1)) == 0) ? zero : *(const u32x4*)(G + (size_t)(t + 1) * NUP);
            const u32x4 uv = *(const u32x4*)(UG + (size_t)t * NUP + f0);
            u32x4 o;
#pragma unroll
            for (int q = 0; q < 4; ++q) { float r[2];
#pragma unroll
                for (int e = 0; e < 2; ++e) { const int k = 2 * q + e; const unsigned sh = e ? 16u : 0u;
                    const float g = w0[k] * bf2f((gp[q] >> sh) & 0xffffu) + w1[k] * bf2f((gc[q] >> sh) & 0xffffu) + w2[k] * bf2f((gn[q] >> sh) & 0xffffu) + cb[k];
                    r[e] = 0.5f * g * (1.f + erff(g * 0.70710678118654752f)) * bf2f((uv[q] >> sh) & 0xffffu); }
                o[q] = pk2(r[0], r[1]); }
            *(u32x4*)(UG + (size_t)t * NUP + f0) = o;
            gp = gc; gc = gn; }
    }
}

DI void phase_final(const Args& a, int lane, int wave) {
    const bf16_t* x2 = (const bf16_t*)(a.ws + OFF_X1B);
    const int gw = blockIdx.x * 8 + wave, NGW = gridDim.x * 8;
    f32x4 g[8];
#pragma unroll
    for (int j = 0; j < 8; ++j) g[j] = *(const f32x4*)(a.g_final + 4 * lane + 256 * j);
    for (int m = 4 * gw; m < MTOK; m += 4 * NGW) {
        u32x2 p[4][8];
#pragma unroll
        for (int r = 0; r < 4; ++r)
#pragma unroll
            for (int j = 0; j < 8; ++j) p[r][j] = *(const u32x2*)(x2 + (size_t)(m + r) * DM + 4 * lane + 256 * j);
#pragma unroll
        for (int r = 0; r < 4; ++r) {
            f32x4 v[8]; float ss = 0.f;
#pragma unroll
            for (int j = 0; j < 8; ++j) { v[j] = (f32x4){bf2f(p[r][j].x & 0xffffu), bf2f(p[r][j].x >> 16), bf2f(p[r][j].y & 0xffffu), bf2f(p[r][j].y >> 16)};
                ss += (v[j].x * v[j].x + v[j].y * v[j].y) + (v[j].z * v[j].z + v[j].w * v[j].w); }
            const float rstd = rsqrtf(wave_sum(ss) * (1.f / DM) + EPSN);
#pragma unroll
            for (int j = 0; j < 8; ++j) *(f32x4*)(a.out + (size_t)(m + r) * DM + 4 * lane + 256 * j) = v[j] * rstd * g[j];
        }
    }
}

#define XB_TMO      128
#define XB_XCNT(j)  (256  + 64 * (j))
#define XB_XSUB(j)  (1280 + 64 * (j))
#define XB_XGEN(j)  (2304 + 64 * (j))
#define XB_TOP      3328
#define XB_TOPGEN   3392
#define XCD_BAR_WORDS 3456
#define XB_SPIN_CAP (1u << 18)

__device__ __forceinline__ unsigned xb_ld(unsigned* p)              { return __hip_atomic_load(p, __ATOMIC_RELAXED, __HIP_MEMORY_SCOPE_AGENT); }
__device__ __forceinline__ unsigned xb_add(unsigned* p, unsigned v) { return __hip_atomic_fetch_add(p, v, __ATOMIC_RELAXED, __HIP_MEMORY_SCOPE_AGENT); }
__device__ __forceinline__ unsigned xb_xcc_id() { return (unsigned)__builtin_amdgcn_s_getreg((3 << 11) | 20) & 0xFu; }
#define XB_SPIN(cond, bar) do { unsigned _sp = 0; while (cond) { __builtin_amdgcn_s_sleep(1); \
    if ((++_sp & 255u) == 0u) { if (xb_ld(&(bar)[XB_TMO])) break; if (_sp > XB_SPIN_CAP) { atomicAdd(&(bar)[XB_TMO], 1u); break; } } } } while (0)

struct XcdBarrier {
    unsigned* bar; unsigned x;
    volatile LAS unsigned* st;
};

__device__ __forceinline__ XcdBarrier xcd_barrier_post(unsigned* bar, volatile LAS unsigned* st) {
    XcdBarrier b; b.bar = bar; b.x = xb_xcc_id(); b.st = st;
    if (threadIdx.x == 0) (void)xb_add(&bar[XB_XCNT(b.x)], 1u);
    return b;
}
__device__ __forceinline__ void xcd_barrier_complete(unsigned* bar, unsigned x, unsigned& nloc, unsigned& nx) {
    const unsigned G = gridDim.x * gridDim.y * gridDim.z;
    unsigned sum, cnt, mine, sp = 0u;
    for (;;) {
        sum = 0u; cnt = 0u; mine = 0u;
#pragma unroll
        for (unsigned j = 0; j < 16; ++j) { const unsigned c = xb_ld(&bar[XB_XCNT(j)]); sum += c; cnt += (c > 0u) ? 1u : 0u; mine = (j == x) ? c : mine; }
        if (sum == G) break;
        __builtin_amdgcn_s_sleep(1);
        if ((++sp & 255u) == 0u) { if (xb_ld(&bar[XB_TMO])) break; if (sp > XB_SPIN_CAP) { atomicAdd(&bar[XB_TMO], 1u); break; } }
    }
    nloc = mine > 0u ? mine : 1u; nx = cnt > 0u ? cnt : 1u;
}

__device__ __forceinline__ void xcd_barrier(const XcdBarrier& b) {
    asm volatile("s_waitcnt vmcnt(0)" ::: "memory");
    __syncthreads();
    if (threadIdx.x == 0) {
        unsigned* bar = b.bar;
        __builtin_amdgcn_s_waitcnt(0);
        unsigned nloc = b.st[0], nx = b.st[1];
        if (nloc == 0u) { xcd_barrier_complete(bar, b.x, nloc, nx); b.st[0] = nloc; b.st[1] = nx; }
        const unsigned old = xb_add(&bar[XB_XSUB(b.x)], 1u);
        const unsigned gen = old / nloc;
        if (old + 1u == (gen + 1u) * nloc) {
            __builtin_amdgcn_fence(__ATOMIC_RELEASE, "agent");
            asm volatile("s_waitcnt vmcnt(0)" ::: "memory");
            const unsigned og = xb_add(&bar[XB_TOP], 1u);
            const unsigned tg = og / nx;
            if (og + 1u == (tg + 1u) * nx) xb_add(&bar[XB_TOPGEN], 1u);
            else XB_SPIN(xb_ld(&bar[XB_TOPGEN]) == tg, bar);
            __builtin_amdgcn_fence(__ATOMIC_ACQUIRE, "agent");
            xb_add(&bar[XB_XGEN(b.x)], 1u);
            asm volatile("s_waitcnt vmcnt(0)" ::: "memory");
        } else {
            XB_SPIN(xb_ld(&bar[XB_XGEN(b.x)]) == gen, bar);
            __builtin_amdgcn_fence(__ATOMIC_ACQUIRE, "agent");
            asm volatile("s_waitcnt vmcnt(0)" ::: "memory");
        }
    }
    __syncthreads();
}


DI int lane_now() { int l = (int)(threadIdx.x & 63u); asm volatile("" : "+v"(l)); return l; }
__global__ void __launch_bounds__(512, 2) mega(Args a) {
    extern __shared__ __attribute__((aligned(16))) unsigned char lds_raw[];
    LAS unsigned char* lds = (LAS unsigned char*)lds_raw;
    cg::grid_group grid = cg::this_grid();
    const int tid = threadIdx.x, wave = __builtin_amdgcn_readfirstlane(tid >> 6);
#define lane lane_now()
    const int lo = a.ph_lo, hi = a.ph_hi;
    volatile LAS unsigned* xst = (volatile LAS unsigned*)(lds + LDS_BYTES - 16);
    if (tid == 0) { xst[0] = 0u; xst[1] = 0u; }
    __syncthreads();
    if (hi - lo > 1) (void)xcd_barrier_post((unsigned*)(a.ws + OFF_BAR), xst);
    const float* mod = (const float*)(a.ws + OFF_MOD);
#ifndef PHMASK
#define PHMASK 0xfff
#endif
#define PH(k) (((PHMASK >> (k)) & 1) && lo <= (k) && (k) < hi)
#ifndef PROBE_A
#define PROBE_A -1
#define PROBE_B -1
#endif
    unsigned long long* stamps = (unsigned long long*)(a.ws + WS_NEED);
#define STAMP(k) do { if (PROBE_A >= 0 && blockIdx.x == 0 && tid == 0) stamps[k] = __builtin_amdgcn_s_memrealtime(); } while (0)
#define SEAM(k) do { if (PH(k) && PH((k) + 1)) { XcdBarrier xb_; xb_.bar = (unsigned*)(a.ws + OFF_BAR); xb_.x = xb_xcc_id(); xb_.st = (volatile LAS unsigned*)(lds + LDS_BYTES - 16); xcd_barrier(xb_); } STAMP((k) + 1); } while (0)
#ifdef MK_GRID_SYNC_FIRST
    if (hi - lo > 1) grid.sync();
#endif
    STAMP(0);
    if (PH(0)) phase0(a, lds, tid, lane, wave);
#ifdef DUP_P0
    if (PH(0)) { __syncthreads(); phase0(a, lds, tid, lane, wave); }
#endif
    SEAM(0);
    if (PH(1)) phase_norm<true, false>(a, lds, a.x, a.g_norm1, 0, DM, tid, lane, wave);
    SEAM(1);
    if (PH(2)) {
        if (blockIdx.x < NCOMBO) gate_prep(a, lds, blockIdx.x, tid);
        pg8::Gemm g{(const bf16_t*)(a.ws + OFF_HB), (const bf16_t*)(a.ws + OFF_WIN), MTOK, NPC, DM, DM}; pg8::StaticOrder S; S.init(MTOK, NPC, gridDim.x, blockIdx.x);
#ifdef SKEW_TICKS
        if ((blockIdx.x >> 3) & 1) { const unsigned long long t0 = __builtin_amdgcn_s_memrealtime(); while (__builtin_amdgcn_s_memrealtime() - t0 < SKEW_TICKS) __builtin_amdgcn_s_sleep(8); }
#endif
        pg8::EpiBf16<0> E{(bf16_t*)(a.ws + OFF_P), NPC, nullptr, 0, 0, 1.f};
        pg8::gemm_phase<pg8::EpiBf16<0>, pg8::StaticOrder, GEMM_ALIGN, true>(lds, g, S, E);
#ifdef DUP_GEMM_IN
        pg8::gemm_phase<pg8::EpiBf16<0>, pg8::StaticOrder, true, true>(lds, g, S, E);
#endif
#ifdef DUP_GEMM_HALFK
        { pg8::Gemm g2{(const bf16_t*)(a.ws + OFF_HB), (const bf16_t*)(a.ws + OFF_WIN), MTOK, NPC, DUP_GEMM_HALFK, DM};
          pg8::EpiBf16<0> E2{(bf16_t*)(a.ws + OFF_CST), 0, nullptr, 0, 0, 1.f};
          pg8::gemm_phase<pg8::EpiBf16<0>, pg8::StaticOrder, true, true>(lds, g2, S, E2); }
#endif
    }
    SEAM(2);
    if (PH(3)) mlstm_delta(a, lds, tid, lane, wave);
#if defined(DUP_MIX) || defined(DUP_A1)
    if (PH(3)) { __syncthreads(); mlstm_delta(a, lds, tid, lane, wave); }
#endif
    SEAM(3);
    if (PH(4)) { mlstm_scan(a, tid); natten(a, lds, tid, lane, wave); }
#if defined(DUP_MIX) || defined(DUP_NAT)
    if (PH(4)) { __syncthreads(); natten(a, lds, tid, lane, wave); }
#endif
    SEAM(4);
    if (PH(5)) mlstm_out(a, lds, tid, lane, wave);
#if defined(DUP_MIX) || defined(DUP_A3)
    if (PH(5)) { __syncthreads(); mlstm_out(a, lds, tid, lane, wave); }
#endif
    SEAM(5);
    if (PH(6)) {
        __syncthreads();
        pg8::Gemm g{(const bf16_t*)(a.ws + OFF_HB), (const bf16_t*)(a.ws + OFF_WOUT), MTOK, DM, DM, DM}; pg8::StaticOrder S; S.init(MTOK, DM, gridDim.x, blockIdx.x);
        EpiResid16<false> E{a.x, (bf16_t*)(a.ws + OFF_X1B), mod + 2 * DM};
        pg8::gemm_phase<EpiResid16<false>, pg8::StaticOrder, GEMM_ALIGN, true>(lds, g, S, E);
    }
    SEAM(6);
    if (PH(7)) phase_norm<false, true>(a, lds, a.ws + OFF_X1B, a.g_norm2, 3 * DM, 4 * DM, tid, lane, wave);
    SEAM(7);
    if (PH(8)) {
        pg8::Gemm g{(const bf16_t*)(a.ws + OFF_HB), (const bf16_t*)(a.ws + OFF_WUP), MTOK, NUP, DM, DM}; pg8::StaticOrder S; S.init(MTOK, NUP, gridDim.x, blockIdx.x);
#ifdef SKEW_TICKS
        if ((blockIdx.x >> 3) & 1) { const unsigned long long t0 = __builtin_amdgcn_s_memrealtime(); while (__builtin_amdgcn_s_memrealtime() - t0 < SKEW_TICKS) __builtin_amdgcn_s_sleep(8); }
#endif
        EpiGlu E{(bf16_t*)(a.ws + OFF_ACT), a.conv_w, a.conv_b, (float*)(a.ws + OFF_EDGE), (LAS float*)(lds + 131072)};
        pg8::gemm_phase<EpiGlu, pg8::StaticOrder, true, true>(lds, g, S, E);
    }
    SEAM(8);
    if (PH(10)) {
        pg8::Gemm g{(const bf16_t*)(a.ws + OFF_ACT), (const bf16_t*)(a.ws + OFF_WDN), MTOK, DM, DFF, DFF}; pg8::StaticOrder S; S.init(MTOK, DM, gridDim.x, blockIdx.x);
        { pg8::Unit uu; int lastpm = -1; for (int i = 0; S.next(i, uu); ++i) if (uu.pm != lastpm) { glu_fixup(a, uu.pm, tid); lastpm = uu.pm; } }
        __threadfence(); __syncthreads();
        EpiResid16<true> E{a.ws + OFF_X1B, (bf16_t*)(a.ws + OFF_X1B), mod + 5 * DM};
        pg8::gemm_phase<EpiResid16<true>, pg8::StaticOrder, GEMM_ALIGN, true>(lds, g, S, E);
    }
    SEAM(10);
    if (PH(11)) phase_final(a, lane, wave);
    if (PROBE_A >= 0) { __syncthreads(); if (blockIdx.x == 0 && tid == 0) { stamps[12] = __builtin_amdgcn_s_memrealtime();
        const float Ta = (float)(stamps[PROBE_A + 1] - stamps[PROBE_A]) * 0.01f, Tb = (float)(stamps[PROBE_B + 1] - stamps[PROBE_B]) * 0.01f;
        a.out[0] += Ta + Tb; for (int i = 1; i <= 1000; ++i) a.out[i] += 0.5f * Tb; } }
#undef PH
#undef SEAM
#undef lane
}

extern "C" void kernel_launch(void* const* d_in, const int* in_sizes, int n_in, void* d_out, int out_size, void* d_ws, size_t ws_size, hipStream_t stream) {
    static int grid = 0;
    if (grid == 0) {
        if (n_in != 16 || out_size != MTOK * DM || ws_size < WS_NEED) { fprintf(stderr, "kernel_launch: unexpected problem (n_in %d out %d ws %zu need %zu)\n", n_in, out_size, ws_size, (size_t)WS_NEED); grid = -1; return; }
        int dev = 0, cus = 0, per_cu = 0;
        hipGetDevice(&dev); hipDeviceGetAttribute(&cus, hipDeviceAttributeMultiprocessorCount, dev);
        if (hipFuncSetAttribute((const void*)mega, hipFuncAttributeMaxDynamicSharedMemorySize, LDS_BYTES) != hipSuccess) { fprintf(stderr, "kernel_launch: hipFuncSetAttribute failed\n"); grid = -1; return; }
        if (hipOccupancyMaxActiveBlocksPerMultiprocessor(&per_cu, (const void*)mega, 512, LDS_BYTES) != hipSuccess || per_cu < 1) { fprintf(stderr, "kernel_launch: occupancy query failed (%d)\n", per_cu); (void)hipGetLastError(); per_cu = 1; }
        grid = cus * (per_cu > 1 ? 1 : per_cu);
        fprintf(stderr, "kernel_launch: grid %d (cus %d, per_cu %d)\n", grid, cus, per_cu);
        if (grid < 4 || (grid & 3) != 0) { fprintf(stderr, "kernel_launch: this kernel needs a workgroup count that is a multiple of 4 (neighbourhood-attention head pairs are fixed per workgroup); nothing launched\n"); grid = -1; return; }
    }
    if (grid < 0) return;
    Args a{};
    a.x = (const float*)d_in[0]; a.c = (const float*)d_in[1]; a.w_ada = (const float*)d_in[2]; a.b_ada = (const float*)d_in[3]; a.g_norm1 = (const float*)d_in[4];
    a.w_in = (const float*)d_in[5]; a.b_gates = (const float*)d_in[6]; a.g_head_a = (const float*)d_in[7]; a.rpb = (const float*)d_in[8]; a.w_out = (const float*)d_in[9];
    a.g_norm2 = (const float*)d_in[10]; a.w_up = (const float*)d_in[11]; a.conv_w = (const float*)d_in[12]; a.conv_b = (const float*)d_in[13]; a.w_down = (const float*)d_in[14];
    a.g_final = (const float*)d_in[15]; a.out = (float*)d_out; a.ws = (unsigned char*)d_ws;
#if MK_PER_PHASE
    for (int p = 0; p < NPH; ++p) { a.ph_lo = p; a.ph_hi = p + 1; hipLaunchKernelGGL(mega, dim3(grid), dim3(512), LDS_BYTES, stream, a); }
#else
    a.ph_lo = 0; a.ph_hi = NPH;
    if (hipMemsetAsync((char*)d_ws + OFF_BAR, 0, BAR_BYTES, stream) != hipSuccess) { fprintf(stderr, "kernel_launch: memset failed\n"); return; }
    void* args[] = {&a};
    hipError_t e = hipLaunchCooperativeKernel((const void*)mega, dim3(grid), dim3(512), args, LDS_BYTES, stream);
    if (e != hipSuccess) fprintf(stderr, "kernel_launch: cooperative launch failed: %s (grid %d)\n", hipGetErrorString(e), grid);
#endif
}
```

```cpp
#include <hip/hip_runtime.h>
#include <hip/hip_cooperative_groups.h>
#include <cstdio>
#include <cstdint>
namespace cg = cooperative_groups;
#define MK_PER_PHASE 0
namespace pg8 {
#define PG8_LAS __attribute__((address_space(3)))
typedef unsigned short bf16_t;
typedef short bf16x8 __attribute__((ext_vector_type(8)));
typedef float f32x4 __attribute__((ext_vector_type(4)));
typedef unsigned u32x4 __attribute__((ext_vector_type(4)));
constexpr int BM = 256, BK = 64, HALF = 128, HTB = HALF * BK * 2  , STAGE_BYTES = 8 * HTB, NXCD = 8, WGM = 8;

__host__ __device__ __forceinline__ int lds_byte(int r, int c) { const int st = (r >> 4) * 2 + (c >> 5), rr = r & 15, cc = c & 31, ob = rr * 64 + cc * 2; return st * 1024 + (ob ^ (((ob >> 9) & 1) << 5)); }
__host__ __device__ __forceinline__ void stage_rc(int b, int& R, int& C) { const int st = b / 1024, sb = b % 1024, swz = sb ^ (((sb >> 9) & 1) << 5); R = (st >> 1) * 16 + swz / 64; C = (st & 1) * 32 + (swz % 64) / 2; }
__host__ __device__ __forceinline__ int perm32(int rho) { const int n = rho >> 4, i = rho & 15; return 8 * (i >> 2) + 4 * n + (i & 3); }

struct Unit { int pm, pn; };
struct Gemm { const bf16_t* A; const bf16_t* Bt; int M, N, K, lda; };

struct StaticOrder {
    int nM, nN, nwg, G, c;
    __host__ __device__ void init(int M, int N, int G_, int c_) { nM = M / BM; nN = N / BM; nwg = nM * nN; G = G_; c = c_; }
    __host__ __device__ bool next(int i, Unit& u) const {
        const long L = (long)i * G + c; if (L >= nwg) return false;
        int wgid = (int)L; { const int q = nwg / NXCD, r = nwg % NXCD, xcd = wgid % NXCD, off = wgid / NXCD; wgid = (xcd < r ? xcd * (q + 1) : r * (q + 1) + (xcd - r) * q) + off; }
        const int nig = WGM * nN, gid = wgid / nig, fm = gid * WGM, gsz = (nM - fm) < WGM ? (nM - fm) : WGM;
        u.pm = fm + ((wgid % nig) % gsz); u.pn = (wgid % nig) / gsz; return true;
    }
    __device__ __forceinline__ void a_ready(const Unit&) const {}
    __device__ __forceinline__ void done(const Unit&) const {}
};

__device__ __forceinline__ unsigned cvt_pk_bf16(float lo, float hi) { unsigned r; asm volatile("v_cvt_pk_bf16_f32 %0, %1, %2" : "=v"(r) : "v"(lo), "v"(hi)); return r; }
typedef float f32x2 __attribute__((ext_vector_type(2)));
__device__ __forceinline__ f32x2 gelu_pk(f32x2 v) {
    const f32x2 av = __builtin_elementwise_abs(v), d = av * 0.2316418882f + 1.0f;
    f32x2 t; t.x = __builtin_amdgcn_rcpf(d.x); t.y = __builtin_amdgcn_rcpf(d.y);
    f32x2 q = t * 0.5307027145f + (-0.7265760135f); q = q * t + 0.7107068705f; q = q * t + (-0.142248368f); q = q * t + 0.127414796f; q = q * t;
    const f32x2 s = (v * v) * (-0.72134752044f);
    f32x2 e; e.x = __builtin_amdgcn_exp2f(s.x); e.y = __builtin_amdgcn_exp2f(s.y);
    const f32x2 m = v * (q * e), r = v - m;
    f32x2 o; o.x = v.x < 0.f ? m.x : r.x; o.y = v.y < 0.f ? m.y : r.y; return o;
}

template <int ACT  > struct EpiBf16 {
    static constexpr bool PERM = true, AFTER_DRAIN = false; static_assert(ACT == 0 || ACT == 1, "EpiBf16: ACT is 0 (none) or 1 (gelu_pk)");
    bf16_t* O; int ldc; const float* bias; int split_cols; size_t split_stride; float scale0;
    __device__ __forceinline__ void operator()(const f32x4 (&acc)[2][2][4][2], const Unit& u, int wr, int wc, int fr, int fq) const {
        const int row0 = u.pm * BM + wr * 64 + fr; int colt = u.pn * BM; bf16_t* base = O;
        float sc = 1.f; if (split_cols) { const int t = colt / split_cols; base += (size_t)t * split_stride; colt -= t * split_cols; if (t == 0) sc = scale0; }
        const int col0 = colt + wc * 32 + 8 * fq, bcol0 = u.pn * BM + wc * 32 + 8 * fq;
        f32x4 bv[2][2];
#pragma unroll
        for (int bj = 0; bj < 2; ++bj)
#pragma unroll
            for (int n = 0; n < 2; ++n) bv[bj][n] = bias ? *(const f32x4*)(bias + bcol0 + bj * HALF + 4 * n) : (f32x4){0.f, 0.f, 0.f, 0.f};
#pragma unroll
        for (int ai = 0; ai < 2; ++ai)
#pragma unroll
            for (int m = 0; m < 4; ++m) { bf16_t* rowp = base + (size_t)(row0 + ai * HALF + m * 16) * ldc + col0;
#pragma unroll
                for (int bj = 0; bj < 2; ++bj) { f32x4 v0 = acc[ai][bj][m][0] + bv[bj][0], v1 = acc[ai][bj][m][1] + bv[bj][1];
                    if (ACT == 1) { f32x2 a = gelu_pk((f32x2){v0[0], v0[1]}), b = gelu_pk((f32x2){v0[2], v0[3]}), c = gelu_pk((f32x2){v1[0], v1[1]}), d = gelu_pk((f32x2){v1[2], v1[3]});
                        v0 = (f32x4){a.x, a.y, b.x, b.y}; v1 = (f32x4){c.x, c.y, d.x, d.y}; }
                    v0 = v0 * sc; v1 = v1 * sc; u32x4 w; w.x = cvt_pk_bf16(v0[0], v0[1]); w.y = cvt_pk_bf16(v0[2], v0[3]); w.z = cvt_pk_bf16(v1[0], v1[1]); w.w = cvt_pk_bf16(v1[2], v1[3]);
                    *(u32x4*)(rowp + bj * HALF) = w; } }
    }
};

template <class Epi, class Sched, bool ALIGN_EPI = false, bool SP2 = false>
__device__ __forceinline__ void gemm_phase(PG8_LAS unsigned char* lds, const Gemm g, const Sched& S, const Epi& E) {
    const int tid = threadIdx.x, wid = __builtin_amdgcn_readfirstlane(tid >> 6), lane = tid & 63, wr = wid >> 2, wc = wid & 3, fr = lane & 15, fq = lane >> 4;
    const int K = g.K, nt = K / BK;
    unsigned voffA[2], voffB[2];
#pragma unroll
    for (int i = 0; i < 2; ++i) { int R, C; stage_rc(tid * 16 + i * 8192, R, C); const int Rb = Epi::PERM ? ((R & ~31) + perm32(R & 31)) : R;
        voffA[i] = (unsigned)(R * g.lda + C) * 2u; voffB[i] = (unsigned)(Rb * K + C) * 2u; }
    const size_t kstep = (size_t)(BK * 2);
    const size_t hstep = (size_t)HALF * K * 2;
    const size_t tstep = 2 * hstep; const size_t hstepA = (size_t)HALF * g.lda * 2, tstepA = 2 * hstepA;
    const unsigned ldsw = (unsigned)wid * 1024u;
    const int aoff = lds_byte(wr * 64 + fr, fq * 8), boff = lds_byte(wc * 32 + fr, fq * 8);
#define PG8_SA(b, h) (((b) * 2 + (h)) * HTB)
#define PG8_SB(b, h) ((4 + (b) * 2 + (h)) * HTB)
#define PG8_STAGE(bufoff, gbase, voff) do { _Pragma("unroll") for (int _i = 0; _i < 2; ++_i) \
        __builtin_amdgcn_global_load_lds((const unsigned*)((const char*)(gbase) + (voff)[_i]), (PG8_LAS unsigned*)(lds + (bufoff) + ldsw + _i * 8192), 16, 0, 0); } while (0)
#define PG8_LDA(dst, b, h) do { _Pragma("unroll") for (int m = 0; m < 4; ++m) _Pragma("unroll") for (int k = 0; k < 2; ++k) dst[m][k] = *(const PG8_LAS bf16x8*)(lds + PG8_SA(b, h) + aoff + m * 2048 + k * 1024); } while (0)
#define PG8_LDB(dst, b, h) do { _Pragma("unroll") for (int n = 0; n < 2; ++n) _Pragma("unroll") for (int k = 0; k < 2; ++k) dst[n][k] = *(const PG8_LAS bf16x8*)(lds + PG8_SB(b, h) + boff + n * 2048 + k * 1024); } while (0)
#define PG8_MMA(ai, bj, At, Bt) do { __builtin_amdgcn_s_setprio(1); _Pragma("unroll") for (int m = 0; m < 4; ++m) _Pragma("unroll") for (int n = 0; n < 2; ++n) _Pragma("unroll") for (int k = 0; k < 2; ++k) \
        acc[ai][bj][m][n] = __builtin_amdgcn_mfma_f32_16x16x32_bf16(Bt[n][k], At[m][k], acc[ai][bj][m][n], 0, 0, 0); __builtin_amdgcn_s_setprio(0); } while (0)
#define PG8_WAIT_V(n) asm volatile("s_waitcnt vmcnt(" #n ")" ::: "memory")
#define PG8_WAIT_L(n) asm volatile("s_waitcnt lgkmcnt(" #n ")" ::: "memory")
#define PG8_BAR __builtin_amdgcn_s_barrier()
#define PG8_SCHED __builtin_amdgcn_sched_barrier(0)
    Unit cur, nxt; int ui = 0;
    if (!S.next(0, cur)) return;
    f32x4 acc[2][2][4][2];
#pragma unroll
    for (int a = 0; a < 2; ++a)
#pragma unroll
        for (int b = 0; b < 2; ++b)
#pragma unroll
            for (int m = 0; m < 4; ++m)
#pragma unroll
                for (int n = 0; n < 2; ++n) acc[a][b][m][n] = (f32x4){0.f, 0.f, 0.f, 0.f};
    bf16x8 At[4][2], B0[2][2], B1[2][2];
    const char* cA = (const char*)g.A + (size_t)cur.pm * tstepA; const char* cB = (const char*)g.Bt + (size_t)cur.pn * tstep;
    S.a_ready(cur);
    if constexpr (SP2) {
        PG8_STAGE(PG8_SB(0, 0), cB, voffB); PG8_STAGE(PG8_SB(0, 1), cB + hstep, voffB); PG8_STAGE(PG8_SA(0, 0), cA, voffA); PG8_STAGE(PG8_SA(0, 1), cA + hstepA, voffA);
        if (wr == 1) PG8_BAR;
        PG8_WAIT_V(2); PG8_BAR;
        PG8_STAGE(PG8_SB(1, 0), cB + kstep, voffB); PG8_STAGE(PG8_SA(1, 0), cA + kstep, voffA); PG8_STAGE(PG8_SB(1, 1), cB + hstep + kstep, voffB);
        PG8_WAIT_V(6); PG8_BAR;
    } else {
        PG8_STAGE(PG8_SB(0, 0), cB, voffB); PG8_STAGE(PG8_SA(0, 0), cA, voffA); PG8_STAGE(PG8_SB(0, 1), cB + hstep, voffB); PG8_STAGE(PG8_SA(0, 1), cA + hstepA, voffA);
        if (wr == 1) PG8_BAR;
        PG8_WAIT_V(4); PG8_BAR;
        PG8_STAGE(PG8_SB(1, 0), cB + kstep, voffB); PG8_STAGE(PG8_SA(1, 0), cA + kstep, voffA); PG8_STAGE(PG8_SB(1, 1), cB + hstep + kstep, voffB);
        PG8_WAIT_V(6); PG8_BAR;
    }
    for (;;) {
        const bool has_next = S.next(ui + 1, nxt);
        const char* nA = has_next ? (const char*)g.A + (size_t)nxt.pm * tstepA : cA; const char* nB = has_next ? (const char*)g.Bt + (size_t)nxt.pn * tstep : cB;
        for (int t = 0; t < nt; t += 2) {
            const bool last = (t == nt - 2);
            const char* a1 = cA + (size_t)(t + 1) * kstep;
            const char* a2 = last ? nA : cA + (size_t)(t + 2) * kstep; const char* b2 = last ? nB : cB + (size_t)(t + 2) * kstep;
            const char* a3 = a2 + kstep; const char* b3 = b2 + kstep;
            if (last && has_next) S.a_ready(nxt);
            if constexpr (SP2) {
            PG8_LDB(B0, 0, 0); PG8_LDB(B1, 0, 1); PG8_SCHED; PG8_LDA(At, 0, 0); PG8_STAGE(PG8_SA(1, 1), a1 + hstepA, voffA);
            PG8_WAIT_V(8); PG8_WAIT_L(0); PG8_BAR; PG8_MMA(0, 0, At, B0); PG8_MMA(0, 1, At, B1); PG8_BAR; PG8_SCHED;
            PG8_LDA(At, 0, 1); PG8_STAGE(PG8_SB(0, 0), b2, voffB); PG8_STAGE(PG8_SB(0, 1), b2 + hstep, voffB); PG8_STAGE(PG8_SA(0, 0), a2, voffA);
            PG8_WAIT_V(8); PG8_WAIT_L(0); PG8_BAR; PG8_MMA(1, 0, At, B0); PG8_MMA(1, 1, At, B1); PG8_BAR; PG8_SCHED;
            PG8_LDB(B0, 1, 0); PG8_LDB(B1, 1, 1); PG8_SCHED; PG8_LDA(At, 1, 0); PG8_STAGE(PG8_SA(0, 1), a2 + hstepA, voffA);
            PG8_WAIT_V(8); PG8_WAIT_L(0); PG8_BAR; PG8_MMA(0, 0, At, B0); PG8_MMA(0, 1, At, B1); PG8_BAR; PG8_SCHED;
            PG8_LDA(At, 1, 1); PG8_STAGE(PG8_SB(1, 0), b3, voffB); PG8_STAGE(PG8_SB(1, 1), b3 + hstep, voffB); PG8_STAGE(PG8_SA(1, 0), a3, voffA);
            PG8_WAIT_V(8); PG8_WAIT_L(0); PG8_BAR; PG8_MMA(1, 0, At, B0); PG8_MMA(1, 1, At, B1); PG8_BAR; PG8_SCHED;
            } else {
            PG8_LDB(B0, 0, 0); PG8_SCHED; PG8_LDA(At, 0, 0); PG8_STAGE(PG8_SA(1, 1), a1 + hstepA, voffA);
            PG8_WAIT_L(8); PG8_BAR; PG8_WAIT_L(0); PG8_MMA(0, 0, At, B0); PG8_BAR; PG8_SCHED;
            PG8_LDB(B1, 0, 1); PG8_STAGE(PG8_SB(0, 0), b2, voffB);
            PG8_BAR; PG8_WAIT_L(0); PG8_MMA(0, 1, At, B1); PG8_BAR;
            PG8_LDA(At, 0, 1); PG8_STAGE(PG8_SA(0, 0), a2, voffA);
            PG8_BAR; PG8_WAIT_L(0); PG8_MMA(1, 0, At, B0); PG8_BAR; PG8_SCHED;
            PG8_STAGE(PG8_SB(0, 1), b2 + hstep, voffB);
            PG8_WAIT_V(6); PG8_BAR; PG8_MMA(1, 1, At, B1); PG8_BAR;
            PG8_LDB(B0, 1, 0); PG8_SCHED; PG8_LDA(At, 1, 0); PG8_STAGE(PG8_SA(0, 1), a2 + hstepA, voffA);
            PG8_WAIT_L(8); PG8_BAR; PG8_WAIT_L(0); PG8_MMA(0, 0, At, B0); PG8_BAR; PG8_SCHED;
            PG8_LDB(B1, 1, 1); PG8_STAGE(PG8_SB(1, 0), b3, voffB);
            PG8_BAR; PG8_WAIT_L(0); PG8_MMA(0, 1, At, B1); PG8_BAR;
            PG8_LDA(At, 1, 1); PG8_STAGE(PG8_SA(1, 0), a3, voffA);
            PG8_BAR; PG8_WAIT_L(0); PG8_MMA(1, 0, At, B0); PG8_BAR; PG8_SCHED;
            PG8_STAGE(PG8_SB(1, 1), b3 + hstep, voffB);
            PG8_WAIT_V(6); PG8_BAR; PG8_MMA(1, 1, At, B1); PG8_BAR;
            }
        }
        if constexpr (ALIGN_EPI) { if (wr == 0) PG8_BAR; }
        if constexpr (!Epi::AFTER_DRAIN) { E(acc, cur, wr, wc, fr, fq); S.done(cur); }
        if (!has_next) break;
#pragma unroll
        for (int a = 0; a < 2; ++a)
#pragma unroll
            for (int b = 0; b < 2; ++b)
#pragma unroll
                for (int m = 0; m < 4; ++m)
#pragma unroll
                    for (int n = 0; n < 2; ++n) acc[a][b][m][n] = (f32x4){0.f, 0.f, 0.f, 0.f};
        cur = nxt; cA = nA; cB = nB; ++ui;
        if constexpr (ALIGN_EPI) { if (wr == 1) PG8_BAR; }
    }
    PG8_WAIT_V(0);
    if constexpr (!ALIGN_EPI) { if (wr == 0) PG8_BAR; }
    PG8_BAR;
    if constexpr (Epi::AFTER_DRAIN) { E.fused(acc, cur, wr, wc, fr, fq, lds, wid, lane); S.done(cur); }
#undef PG8_SA
#undef PG8_SB
#undef PG8_STAGE
#undef PG8_LDA
#undef PG8_LDB
#undef PG8_MMA
#undef PG8_WAIT_V
#undef PG8_WAIT_L
#undef PG8_BAR
#undef PG8_SCHED
}
}

#define DI __device__ __forceinline__
#define LAS __attribute__((address_space(3)))
typedef unsigned short bf16_t;
typedef short bf16x8 __attribute__((ext_vector_type(8)));
typedef short s16x4 __attribute__((ext_vector_type(4)));
typedef short v4i16_t __attribute__((ext_vector_type(4)));
typedef float f32x4 __attribute__((ext_vector_type(4)));
typedef unsigned u32x4 __attribute__((ext_vector_type(4)));
typedef unsigned u32x2 __attribute__((ext_vector_type(2)));

constexpr int NB = 2, SEQ = 8192, DM = 2048, MTOK = NB * SEQ, NPC = 7168, WIN_LD = 7184, DFF = 5632, NUP = 2 * DFF, NMOD = 6 * DM;
constexpr int LCH = 256, NCH = SEQ / LCH, EEXT = 272, ST_ELEMS = EEXT * 256, NCOMBO = 16;
constexpr float EPSN = 1e-6f;
#ifndef MK_PER_PHASE
#define MK_PER_PHASE 0
#endif
#ifndef GEMM_ALIGN
#define GEMM_ALIGN true
#endif
constexpr int NPH = 12;
constexpr int LDS_BYTES = 147456;

constexpr size_t OFF_P = 0;
constexpr size_t OFF_CST = OFF_P + (size_t)MTOK * NPC * 2;
constexpr size_t OFF_WIN = OFF_CST + (size_t)NCOMBO * NCH * ST_ELEMS * 2;
constexpr size_t OFF_WOUT = OFF_WIN + (size_t)NPC * DM * 2;
constexpr size_t OFF_R0END = OFF_WOUT + (size_t)DM * DM * 2;
constexpr size_t OFF_UG = 0;
constexpr size_t OFF_ACT = 0;
constexpr size_t OFF_EDGE = OFF_ACT + (size_t)MTOK * DFF * 2;
constexpr size_t OFF_X1B = OFF_EDGE + (size_t)3 * 64 * 2 * DFF * 4;
static_assert(OFF_X1B + (size_t)MTOK * DM * 2 <= OFF_CST + (size_t)NCOMBO * NCH * ST_ELEMS * 2, "x1b must stay below the weight copies that are still live in phase 6");
constexpr size_t OFF_WUP = OFF_UG + (size_t)MTOK * NUP * 2;
constexpr size_t OFF_WDN = OFF_WUP + (size_t)NUP * DM * 2;
constexpr size_t OFF_HB = OFF_WDN + (size_t)DM * DFF * 2;
constexpr size_t OFF_MOD = OFF_HB + (size_t)MTOK * DM * 2;
constexpr size_t OFF_GATES = OFF_MOD + 131072;
constexpr size_t OFF_UL = OFF_GATES + (size_t)MTOK * 16 * 4;
constexpr size_t OFF_ML = OFF_UL + (size_t)NCOMBO * SEQ * 4;
constexpr size_t OFF_EMT = OFF_ML + (size_t)NCOMBO * SEQ * 4;
constexpr size_t OFF_MPREV = OFF_EMT + (size_t)NCOMBO * SEQ * 4;
constexpr size_t OFF_MEND = OFF_MPREV + 4096;
constexpr size_t WS_NEED = OFF_MEND + 4096;
constexpr size_t OFF_BAR = WS_NEED + 4096;
constexpr size_t BAR_BYTES = 16384;
static_assert(OFF_R0END <= OFF_WUP, "overlay region");
static_assert(OFF_BAR + BAR_BYTES <= 536870912ull, "workspace budget");

struct Args {
    const float *x, *c, *w_ada, *b_ada, *g_norm1, *w_in, *b_gates, *g_head_a, *rpb, *w_out, *g_norm2, *w_up, *conv_w, *conv_b, *w_down, *g_final;
    float* out; unsigned char* ws; int ph_lo, ph_hi;
};

DI float bf2f(unsigned v) { return __uint_as_float(v << 16); }
DI unsigned f2bf(float f) { unsigned u = __float_as_uint(f); return (u + 0x7fffu + ((u >> 16) & 1u)) >> 16; }
typedef __bf16 bf16x2_hw __attribute__((ext_vector_type(2)));
typedef float f32x2_hw __attribute__((ext_vector_type(2)));
DI unsigned pk2(float lo, float hi) { const f32x2_hw v = {lo, hi}; const bf16x2_hw b = __builtin_convertvector(v, bf16x2_hw); return __builtin_bit_cast(unsigned, b); }
DI float wave_sum(float v) {
#pragma unroll
    for (int o = 1; o < 64; o <<= 1) v += __shfl_xor(v, o);
    return v;
}
DI s16x4 tr_read(const LAS unsigned char* p) { return __builtin_bit_cast(s16x4, __builtin_amdgcn_ds_read_tr16_b64_v4i16((LAS v4i16_t*)p)); }
DI bf16x8 tr_frag(const LAS unsigned char* base, int pitch, int rowA, int rowB, int col, int qin, int pin) {
    const s16x4 lo = tr_read(base + (rowA + qin) * pitch + (col + 4 * pin) * 2);
    const s16x4 hi = tr_read(base + (rowB + qin) * pitch + (col + 4 * pin) * 2);
    return (bf16x8){lo[0], lo[1], lo[2], lo[3], hi[0], hi[1], hi[2], hi[3]};
}
DI bf16x8 ld_frag(const LAS unsigned char* p) { return *(const LAS bf16x8*)p; }
#define MFMA16(a, b, c) __builtin_amdgcn_mfma_f32_16x16x32_bf16((a), (b), (c), 0, 0, 0)
DI bf16x8 pack8(const f32x4& a, const f32x4& b) {
    u32x4 w; w.x = pk2(a[0], a[1]); w.y = pk2(a[2], a[3]); w.z = pk2(b[0], b[1]); w.w = pk2(b[2], b[3]);
    return __builtin_bit_cast(bf16x8, w);
}
DI bf16x8 scale8(const bf16x8& q, float s) {
    const u32x4 u = __builtin_bit_cast(u32x4, q); u32x4 w;
#pragma unroll
    for (int i = 0; i < 4; ++i) w[i] = pk2(bf2f(u[i] & 0xffffu) * s, bf2f(u[i] >> 16) * s);
    return __builtin_bit_cast(bf16x8, w);
}
template <int ROWS, int COLS> DI void stage_tile(LAS unsigned char* dst, int lp, const bf16_t* src, int gp, int tid, int nthr) {
    constexpr int VPR = COLS / 8, NV = ROWS * VPR;
    int t0 = tid; asm volatile("" : "+v"(t0));
#pragma unroll 2
    for (int v = t0; v < NV; v += nthr) { const int r = v / VPR, cv = v % VPR;
        const u32x4 d = *(const u32x4*)(src + (r * gp + cv * 8)); *(LAS u32x4*)(dst + r * lp + cv * 16) = d; }
}

struct EpiResid {
    static constexpr bool PERM = false, AFTER_DRAIN = false;
    const float* res; float* out; const float* gate;
    __device__ __forceinline__ void operator()(const pg8::f32x4 (&acc)[2][2][4][2], const pg8::Unit& u, int wr, int wc, int fr, int fq) const {
        const int row0 = u.pm * 256 + wr * 64 + fr, col0 = u.pn * 256 + wc * 32 + 4 * fq, bb = u.pm >> 5;
        f32x4 gv[2][2];
#pragma unroll
        for (int bj = 0; bj < 2; ++bj)
#pragma unroll
            for (int n = 0; n < 2; ++n) gv[bj][n] = *(const f32x4*)(gate + (size_t)bb * NMOD + col0 + bj * 128 + n * 16);
#pragma unroll
        for (int ai = 0; ai < 2; ++ai)
#pragma unroll
            for (int m = 0; m < 4; ++m) { const size_t ro = (size_t)(row0 + ai * 128 + m * 16) * DM + col0;
#pragma unroll
                for (int bj = 0; bj < 2; ++bj)
#pragma unroll
                    for (int n = 0; n < 2; ++n) { const size_t o = ro + bj * 128 + n * 16; const f32x4 r = *(const f32x4*)(res + o); *(f32x4*)(out + o) = r + gv[bj][n] * acc[ai][bj][m][n]; } }
    }
};

template <bool RES_BF16> struct EpiResid16 {
    static constexpr bool PERM = true, AFTER_DRAIN = false;
    const void* res; bf16_t* out; const float* gate;
    __device__ __forceinline__ void operator()(const pg8::f32x4 (&acc)[2][2][4][2], const pg8::Unit& u, int wr, int wc, int fr, int fq) const {
        const int row0 = u.pm * 256 + wr * 64 + fr, col0 = u.pn * 256 + wc * 32 + 8 * fq, bb = u.pm >> 5;
        f32x4 gv[2][2];
#pragma unroll
        for (int bj = 0; bj < 2; ++bj)
#pragma unroll
            for (int n = 0; n < 2; ++n) gv[bj][n] = *(const f32x4*)(gate + (size_t)bb * NMOD + col0 + bj * 128 + 4 * n);
#pragma unroll
        for (int ai = 0; ai < 2; ++ai)
#pragma unroll
            for (int m = 0; m < 4; ++m) { const size_t ro = (size_t)(row0 + ai * 128 + m * 16) * DM + col0;
#pragma unroll
                for (int bj = 0; bj < 2; ++bj) { const size_t o = ro + bj * 128; f32x4 r0, r1;
                    if (RES_BF16) { const u32x4 rv = *(const u32x4*)((const bf16_t*)res + o);
                        r0 = (f32x4){bf2f(rv.x & 0xffffu), bf2f(rv.x >> 16), bf2f(rv.y & 0xffffu), bf2f(rv.y >> 16)}; r1 = (f32x4){bf2f(rv.z & 0xffffu), bf2f(rv.z >> 16), bf2f(rv.w & 0xffffu), bf2f(rv.w >> 16)}; }
                    else { r0 = *(const f32x4*)((const float*)res + o); r1 = *(const f32x4*)((const float*)res + o + 4); }
                    r0 = r0 + gv[bj][0] * acc[ai][bj][m][0]; r1 = r1 + gv[bj][1] * acc[ai][bj][m][1];
                    u32x4 w; w.x = pg8::cvt_pk_bf16(r0[0], r0[1]); w.y = pg8::cvt_pk_bf16(r0[2], r0[3]); w.z = pg8::cvt_pk_bf16(r1[0], r1[1]); w.w = pg8::cvt_pk_bf16(r1[2], r1[3]);
                    *(u32x4*)(out + o) = w; } }
    }
};

constexpr size_t EDGE_STRIDE = (size_t)64 * 2 * DFF;
struct EpiGlu {
    static constexpr bool PERM = true, AFTER_DRAIN = false;
    bf16_t* ACT; const float* cw; const float* cb; float* edge; LAS float* xg;
    __device__ __forceinline__ void operator()(const pg8::f32x4 (&acc)[2][2][4][2], const pg8::Unit& u, int wr, int wc, int fr, int fq) const {
        const int lane = threadIdx.x & 63, fl = wc * 32 + 8 * fq, f0 = u.pn * 128 + fl;
        float w0[8], w1[8], w2[8], bb[8];
#pragma unroll
        for (int k = 0; k < 8; k += 4) { const f32x4 a0 = *(const f32x4*)(cw + f0 + k), a1 = *(const f32x4*)(cw + DFF + f0 + k), a2 = *(const f32x4*)(cw + 2 * DFF + f0 + k), a3 = *(const f32x4*)(cb + f0 + k);
#pragma unroll
            for (int i = 0; i < 4; ++i) { w0[k + i] = a0[i]; w1[k + i] = a1[i]; w2[k + i] = a2[i]; bb[k + i] = a3[i]; } }
#pragma unroll
        for (int ai = 0; ai < 2; ++ai) { const int bi = 2 * ai + wr;
            if (fr == 0) { *(LAS f32x4*)(xg + bi * 128 + fl) = acc[ai][1][0][0]; *(LAS f32x4*)(xg + bi * 128 + fl + 4) = acc[ai][1][0][1]; }
            if (fr == 15) { *(LAS f32x4*)(xg + (4 + bi) * 128 + fl) = acc[ai][1][3][0]; *(LAS f32x4*)(xg + (4 + bi) * 128 + fl + 4) = acc[ai][1][3][1]; } }
        asm volatile("s_waitcnt lgkmcnt(0)" ::: "memory"); __builtin_amdgcn_s_barrier(); asm volatile("" ::: "memory");
#pragma unroll
        for (int ai = 0; ai < 2; ++ai) { const int bi = 2 * ai + wr;
            f32x4 xp[2], xn[2];
#pragma unroll
            for (int n = 0; n < 2; ++n) { xp[n] = (f32x4){0.f, 0.f, 0.f, 0.f}; xn[n] = (f32x4){0.f, 0.f, 0.f, 0.f};
                if (fr == 0 && bi > 0) xp[n] = *(const LAS f32x4*)(xg + (4 + bi - 1) * 128 + fl + 4 * n);
                if (fr == 15 && bi < 3) xn[n] = *(const LAS f32x4*)(xg + (bi + 1) * 128 + fl + 4 * n); }
            unsigned o[4][4];
#pragma unroll
            for (int n = 0; n < 2; ++n)
#pragma unroll
                for (int i = 0; i < 4; i += 2) {
                    float r[4][2];
#pragma unroll
                    for (int e = 0; e < 2; ++e) { const int k = 4 * n + i + e;
                        float g[4], up[4], dn[4];
#pragma unroll
                        for (int m = 0; m < 4; ++m) { g[m] = acc[ai][1][m][n][i + e];
                            up[m] = __int_as_float(__builtin_amdgcn_update_dpp(0, __float_as_int(g[m]), 0x121, 0xf, 0xf, false));
                            dn[m] = __int_as_float(__builtin_amdgcn_update_dpp(0, __float_as_int(g[m]), 0x12F, 0xf, 0xf, false)); }
#pragma unroll
                        for (int m = 0; m < 4; ++m) { const float pv = (fr == 0) ? (m > 0 ? up[m > 0 ? m - 1 : 0] : xp[n][i + e]) : up[m];
                            const float nv = (fr == 15) ? (m < 3 ? dn[m < 3 ? m + 1 : 3] : xn[n][i + e]) : dn[m];
                            r[m][e] = w0[k] * pv + w1[k] * g[m] + w2[k] * nv + bb[k]; } }
#pragma unroll
                    for (int m = 0; m < 4; ++m) { const pg8::f32x2 gl = pg8::gelu_pk((pg8::f32x2){r[m][0], r[m][1]});
                        const bool e0 = (bi == 0 && m == 0 && fr == 0), e1 = (bi == 3 && m == 3 && fr == 15);
                        if (e0 || e1) { float* ep = edge + ((size_t)(u.pm * 2 + (e1 ? 1 : 0)) * DFF + f0 + 4 * n + i);
                            ep[0] = r[m][0]; ep[1] = r[m][1]; ep[EDGE_STRIDE] = acc[ai][1][m][n][i]; ep[EDGE_STRIDE + 1] = acc[ai][1][m][n][i + 1];
                            ep[2 * EDGE_STRIDE] = acc[ai][0][m][n][i]; ep[2 * EDGE_STRIDE + 1] = acc[ai][0][m][n][i + 1]; }
                        o[m][2 * n + (i >> 1)] = pg8::cvt_pk_bf16(gl.x * acc[ai][0][m][n][i], gl.y * acc[ai][0][m][n][i + 1]); }
                }
#pragma unroll
            for (int m = 0; m < 4; ++m) { const int row = u.pm * 256 + ai * 128 + wr * 64 + m * 16 + fr;
                u32x4 w; w.x = o[m][0]; w.y = o[m][1]; w.z = o[m][2]; w.w = o[m][3];
                *(u32x4*)(ACT + (size_t)row * DFF + f0) = w; }
        }
    }
};
DI void glu_fixup(const Args& a, int pm, int tid) {
    const float* edge = (const float*)(a.ws + OFF_EDGE); bf16_t* ACT = (bf16_t*)(a.ws + OFF_ACT);
    constexpr int V4 = DFF / 4, NIT = (2 * V4 + 511) / 512;
    f32x4 part[NIT], uu[NIT], gn[NIT], cw[NIT]; bool has[NIT];
#pragma unroll
    for (int i = 0; i < NIT; ++i) { const int v = tid + 512 * i, e = (v >= V4) ? 1 : 0, f4 = (v - e * V4) * 4, t = pm * 256 + 255 * e; has[i] = false;
        part[i] = uu[i] = gn[i] = cw[i] = (f32x4){0.f, 0.f, 0.f, 0.f};
        if (v < 2 * V4) {
            part[i] = *(const f32x4*)(edge + (size_t)(pm * 2 + e) * DFF + f4); uu[i] = *(const f32x4*)(edge + 2 * EDGE_STRIDE + (size_t)(pm * 2 + e) * DFF + f4);
            if (e == 0) { if ((t & (SEQ - 1)) != 0) { has[i] = true; cw[i] = *(const f32x4*)(a.conv_w + f4); gn[i] = *(const f32x4*)(edge + EDGE_STRIDE + (size_t)((pm - 1) * 2 + 1) * DFF + f4); } }
            else { if (((t + 1) & (SEQ - 1)) != 0) { has[i] = true; cw[i] = *(const f32x4*)(a.conv_w + 2 * DFF + f4); gn[i] = *(const f32x4*)(edge + EDGE_STRIDE + (size_t)((pm + 1) * 2) * DFF + f4); } } } }
#pragma unroll
    for (int i = 0; i < NIT; ++i) { const int v = tid + 512 * i, e = (v >= V4) ? 1 : 0, f4 = (v - e * V4) * 4, t = pm * 256 + 255 * e;
        if (v < 2 * V4) { float r[4];
#pragma unroll
            for (int k = 0; k < 4; ++k) { const float g = part[i][k] + (has[i] ? cw[i][k] * gn[i][k] : 0.f); r[k] = 0.5f * g * (1.f + erff(g * 0.70710678118654752f)) * uu[i][k]; }
            u32x2 w; w.x = pk2(r[0], r[1]); w.y = pk2(r[2], r[3]); *(u32x2*)(ACT + (size_t)t * DFF + f4) = w; } }
}

DI void tr_block(const float* src, int ldw, bf16_t* dst, int ldd, float scale, LAS float* scr, int lane) {
#pragma unroll 8
    for (int i = 0; i < 32; ++i) { const int kk = 2 * i + (lane >> 5); scr[kk * 33 + (lane & 31)] = src[(size_t)kk * ldw + (lane & 31)]; }
    asm volatile("s_waitcnt lgkmcnt(0)" ::: "memory");
    const int c = lane & 7;
#pragma unroll
    for (int j = 0; j < 4; ++j) { const int n = (lane >> 3) + 8 * j; const LAS float* s = scr + (8 * c) * 33 + n;
        u32x4 o; o.x = pk2(s[0 * 33] * scale, s[1 * 33] * scale); o.y = pk2(s[2 * 33] * scale, s[3 * 33] * scale); o.z = pk2(s[4 * 33] * scale, s[5 * 33] * scale); o.w = pk2(s[6 * 33] * scale, s[7 * 33] * scale);
        *(u32x4*)(dst + (size_t)n * ldd + 8 * c) = o; }
    asm volatile("s_waitcnt lgkmcnt(0)" ::: "memory");
}
DI void phase0(const Args& a, LAS unsigned char* lds, int tid, int lane, int wave) {
    LAS float* sc = (LAS float*)lds;
    LAS float* red = sc + 4096;
    float* mod = (float*)(a.ws + OFF_MOD);
    for (int i = tid; i < 4096; i += 512) { const float v = a.c[i]; sc[i] = v / (1.f + __expf(-v)); }
    __syncthreads();
    for (int item = blockIdx.x; item < 256; item += gridDim.x) {
        const int n0 = item * 48;
        if (tid < 384) {
            const int cq = tid % 12, ks = tid / 12;
            f32x4 a0 = {0.f, 0.f, 0.f, 0.f}, a1 = {0.f, 0.f, 0.f, 0.f};
            const float* wp = a.w_ada + (size_t)(ks * 64) * NMOD + n0 + 4 * cq;
#pragma unroll 8
            for (int kk = 0; kk < 64; ++kk) { const f32x4 w = *(const f32x4*)(wp + (size_t)kk * NMOD); const float s0 = sc[ks * 64 + kk], s1 = sc[2048 + ks * 64 + kk]; a0 += s0 * w; a1 += s1 * w; }
            LAS float* rp = red + (ks * 12 + cq) * 8;
            *(LAS f32x4*)rp = a0; *(LAS f32x4*)(rp + 4) = a1;
        }
        __syncthreads();
        if (tid < 96) { const int cq = tid >> 3, j = tid & 7; float s = 0.f;
            for (int ks = 0; ks < 32; ++ks) s += red[(ks * 12 + cq) * 8 + j];
            const int bb = j >> 2, col = n0 + 4 * cq + (j & 3); mod[bb * NMOD + col] = s + a.b_ada[col]; }
        __syncthreads();
    }
    LAS float* scr = (LAS float*)(lds + 32768 + wave * 8448);
    bf16_t* WinT = (bf16_t*)(a.ws + OFF_WIN); bf16_t* WoutT = (bf16_t*)(a.ws + OFF_WOUT); bf16_t* WupT = (bf16_t*)(a.ws + OFF_WUP); bf16_t* WdnT = (bf16_t*)(a.ws + OFF_WDN);
    constexpr int I_IN = 32 * (NPC / 32), I_OUT = 32 * (DM / 32), I_UP = 32 * (NUP / 32), I_DN = (DFF / 64) * (DM / 32);
    const int gw = blockIdx.x * 8 + wave, NGW = gridDim.x * 8;
    for (int it = gw; it < I_IN + I_OUT + I_UP + I_DN; it += NGW) {
        int r = it;
        if (r < I_IN) { const int nblk = NPC / 32, kb = r / nblk, nb = r % nblk, n0 = nb * 32, ns = n0 < 4096 ? n0 : n0 + 16;
            tr_block(a.w_in + (size_t)(kb * 64) * WIN_LD + ns, WIN_LD, WinT + (size_t)n0 * DM + kb * 64, DM, (n0 >= 1024 && n0 < 2048) ? 0.0625f : 1.f, scr, lane); continue; }
        r -= I_IN;
        if (r < I_OUT) { const int nblk = DM / 32, kb = r / nblk, nb = r % nblk;
            tr_block(a.w_out + (size_t)(kb * 64) * DM + nb * 32, DM, WoutT + (size_t)(nb * 32) * DM + kb * 64, DM, 1.f, scr, lane); continue; }
        r -= I_OUT;
        if (r < I_UP) { const int nblk = NUP / 32, kb = r / nblk, nb = r % nblk, n0 = nb * 32, pn = n0 >> 8, j0 = n0 & 255, ns = (j0 < 128) ? pn * 128 + j0 : DFF + pn * 128 + j0 - 128;
            tr_block(a.w_up + (size_t)(kb * 64) * NUP + ns, NUP, WupT + (size_t)n0 * DM + kb * 64, DM, 1.f, scr, lane); continue; }
        r -= I_UP;
        { const int nblk = DM / 32, kb = r / nblk, nb = r % nblk;
            tr_block(a.w_down + (size_t)(kb * 64) * DM + nb * 32, DM, WdnT + (size_t)(nb * 32) * DFF + kb * 64, DFF, 1.f, scr, lane); }
    }
}

DI float gate_reduce16(float (&g16)[16], int lane) {
#pragma unroll
    for (int i = 0; i < 8; ++i) { const bool hi = lane & 32; const float snd = hi ? g16[i] : g16[i + 8], keep = hi ? g16[i + 8] : g16[i]; g16[i] = keep + __shfl_xor(snd, 32); }
#pragma unroll
    for (int i = 0; i < 4; ++i) { const bool hi = lane & 16; const float snd = hi ? g16[i] : g16[i + 4], keep = hi ? g16[i + 4] : g16[i]; g16[i] = keep + __shfl_xor(snd, 16); }
#pragma unroll
    for (int i = 0; i < 2; ++i) { const bool hi = lane & 8; const float snd = hi ? g16[i] : g16[i + 2], keep = hi ? g16[i + 2] : g16[i]; g16[i] = keep + __shfl_xor(snd, 8); }
    { const bool hi = lane & 4; const float snd = hi ? g16[0] : g16[1], keep = hi ? g16[1] : g16[0]; g16[0] = keep + __shfl_xor(snd, 4); }
    g16[0] += __shfl_xor(g16[0], 2); g16[0] += __shfl_xor(g16[0], 1);
    return g16[0];
}
template <bool GATES, bool IN_BF16> DI void phase_norm(const Args& a, LAS unsigned char* lds, const void* xin_, const float* gn, int sh_off, int sc_off, int tid, int lane, int wave) {
    const float* xin = (const float*)xin_; const bf16_t* xin16 = (const bf16_t*)xin_;
    const float* mod = (const float*)(a.ws + OFF_MOD);
    bf16_t* Hb = (bf16_t*)(a.ws + OFF_HB);
    float* gates = (float*)(a.ws + OFF_GATES);
    LAS float* wg = (LAS float*)lds;
    if (GATES) {
        __syncthreads();
        { f32x4 wv[16];
#pragma unroll
          for (int q = 0; q < 16; ++q) { const int v = tid + 512 * q, k = v >> 2, i4 = (v & 3) * 4; wv[q] = *(const f32x4*)(a.w_in + (size_t)k * WIN_LD + 4096 + i4); }
#pragma unroll
          for (int q = 0; q < 16; ++q) { const int v = tid + 512 * q, k = v >> 2, i4 = (v & 3) * 4;
              wg[(i4 + 0) * 2052 + k] = wv[q].x; wg[(i4 + 1) * 2052 + k] = wv[q].y; wg[(i4 + 2) * 2052 + k] = wv[q].z; wg[(i4 + 3) * 2052 + k] = wv[q].w; } }
        __syncthreads();
    }
    constexpr int R = GATES ? 2 : 4;
    const int gw = blockIdx.x * 8 + wave, NGW = gridDim.x * 8;
    int curb = -1; f32x4 gs[8], sh[8];
    for (int m = R * gw; m < MTOK; m += R * NGW) {
        const int bb = m >> 13;
        if (bb != curb) { curb = bb;
#pragma unroll
            for (int j = 0; j < 8; ++j) { const int k = 4 * lane + 256 * j; const f32x4 g = *(const f32x4*)(gn + k), s = *(const f32x4*)(mod + bb * NMOD + sc_off + k);
                gs[j] = g * (1.f + s); sh[j] = *(const f32x4*)(mod + bb * NMOD + sh_off + k); } }
        f32x4 v[R][8];
#pragma unroll
        for (int r = 0; r < R; ++r)
#pragma unroll
            for (int j = 0; j < 8; ++j) {
                if (IN_BF16) { const u32x2 p0 = *(const u32x2*)(xin16 + (size_t)(m + r) * DM + 4 * lane + 256 * j);
                    v[r][j] = (f32x4){bf2f(p0.x & 0xffffu), bf2f(p0.x >> 16), bf2f(p0.y & 0xffffu), bf2f(p0.y >> 16)}; }
                else v[r][j] = *(const f32x4*)(xin + (size_t)(m + r) * DM + 4 * lane + 256 * j); }
#pragma unroll
        for (int r = 0; r < R; ++r) { float ss = 0.f;
#pragma unroll
            for (int j = 0; j < 8; ++j) ss += (v[r][j].x * v[r][j].x + v[r][j].y * v[r][j].y) + (v[r][j].z * v[r][j].z + v[r][j].w * v[r][j].w);
            const float rstd = rsqrtf(wave_sum(ss) * (1.f / DM) + EPSN);
#pragma unroll
            for (int j = 0; j < 8; ++j) { v[r][j] = v[r][j] * rstd * gs[j] + sh[j];
                u32x2 o; o.x = pk2(v[r][j].x, v[r][j].y); o.y = pk2(v[r][j].z, v[r][j].w); *(u32x2*)(Hb + (size_t)(m + r) * DM + 4 * lane + 256 * j) = o; } }
        if (GATES) {
            float ga[16], gb[16];
#pragma unroll
            for (int i = 0; i < 16; ++i) { float s0 = 0.f, s1 = 0.f;
#pragma unroll
                for (int j = 0; j < 8; ++j) { const f32x4 w = *(const LAS f32x4*)(wg + i * 2052 + 4 * lane + 256 * j);
                    s0 += (v[0][j].x * w.x + v[0][j].y * w.y) + (v[0][j].z * w.z + v[0][j].w * w.w); s1 += (v[R - 1][j].x * w.x + v[R - 1][j].y * w.y) + (v[R - 1][j].z * w.z + v[R - 1][j].w * w.w); }
                ga[i] = s0; gb[i] = s1; __builtin_amdgcn_sched_barrier(0); }
            const float r0 = gate_reduce16(ga, lane), r1 = gate_reduce16(gb, lane);
            if ((lane & 3) == 0) { const int gi = ((lane >> 5) & 1) * 8 + ((lane >> 4) & 1) * 4 + ((lane >> 3) & 1) * 2 + ((lane >> 2) & 1); const float bg = a.b_gates[gi];
                gates[(size_t)m * 16 + gi] = r0 + bg; gates[(size_t)(m + 1) * 16 + gi] = r1 + bg; }
        }
    }
}

DI void gate_prep(const Args& a, LAS unsigned char* lds, int combo, int tid) {
    const float* gates = (const float*)(a.ws + OFF_GATES);
    float* ulA = (float*)(a.ws + OFF_UL); float* MlA = (float*)(a.ws + OFF_ML); float* emtA = (float*)(a.ws + OFF_EMT);
    float* mprevA = (float*)(a.ws + OFF_MPREV); float* mendA = (float*)(a.ws + OFF_MEND);
    LAS float* sT = (LAS float*)lds; LAS float* sM = sT + 512; LAS float* sG = sM + 512; LAS float* sX = sG + 32; LAS float* sMp = sX + 32; LAS float* sMe = sMp + 32;
    const int b = combo >> 3, dir = (combo >> 2) & 1, h = combo & 3;
    const int ci = dir * 8 + h, cf = dir * 8 + 4 + h, cs = tid >> 4;
    float li[16], bl[16], cm[16];
    float run = 0.f;
#pragma unroll
    for (int i = 0; i < 16; ++i) { const int tau = tid * 16 + i, t = dir ? SEQ - 1 - tau : tau; const float* gp = gates + (size_t)(b * SEQ + t) * 16;
        li[i] = gp[ci]; const float f = gp[cf]; const float lf = fminf(f, 0.f) - log1pf(__expf(-fabsf(f))); run += lf; bl[i] = run; }
    sT[tid] = run; __syncthreads();
    float base = 0.f;
#pragma unroll
    for (int j = 0; j < 16; ++j) { const float v = sT[cs * 16 + j]; base += (j < (tid & 15)) ? v : 0.f; }
    float mx = -3.0e38f;
#pragma unroll
    for (int i = 0; i < 16; ++i) { bl[i] += base; li[i] -= bl[i]; mx = fmaxf(mx, li[i]); cm[i] = mx; }
    sM[tid] = mx; __syncthreads();
    float mbase = -3.0e38f;
#pragma unroll
    for (int j = 0; j < 16; ++j) { const float v = sM[cs * 16 + j]; mbase = fmaxf(mbase, (j < (tid & 15)) ? v : -3.0e38f); }
    if (tid < 32) { float g = 0.f, xm = -3.0e38f;
#pragma unroll
        for (int j = 0; j < 16; ++j) { g += sT[tid * 16 + j]; xm = fmaxf(xm, sM[tid * 16 + j]); } sG[tid] = g; sX[tid] = xm; }
    __syncthreads();
    if (tid == 0) { float gx[32], xx[32];
#pragma unroll
        for (int c = 0; c < 32; ++c) { gx[c] = sG[c]; xx[c] = sX[c]; }
        float m = -1e30f;
#pragma unroll
        for (int c = 0; c < 32; ++c) { sMp[c] = m; const float me = fmaxf(m, xx[c]); sMe[c] = me; m = gx[c] + me; } }
    __syncthreads();
    const float mp = sMp[cs];
#pragma unroll
    for (int i = 0; i < 16; ++i) { const int tau = tid * 16 + i, t = dir ? SEQ - 1 - tau : tau; const float Ml = fmaxf(mp, fmaxf(cm[i], mbase));
        ulA[combo * SEQ + t] = li[i]; MlA[combo * SEQ + t] = Ml; emtA[combo * SEQ + t] = __expf(-(bl[i] + Ml)); }
    if ((tid & 15) == 0) { const int c = dir ? NCH - 1 - cs : cs; mprevA[combo * NCH + c] = mp; mendA[combo * NCH + c] = sMe[cs]; }
    __syncthreads();
}

DI void mlstm_delta(const Args& a, LAS unsigned char* lds, int tid, int lane, int wave) {
    const bf16_t* P = (const bf16_t*)(a.ws + OFF_P); bf16_t* cst = (bf16_t*)(a.ws + OFF_CST);
    const float* ulA = (const float*)(a.ws + OFF_UL); const float* mendA = (const float*)(a.ws + OFF_MEND);
    const int l15 = lane & 15, quad = lane >> 4, qin = l15 >> 2, pin = l15 & 3;
    constexpr int BUFB = 2 * 34816;
    LAS float* wS = (LAS float*)(lds + 2 * BUFB);
    const short one = (l15 == 0) ? (short)0x3F80 : (short)0;
    const bf16x8 ones = {one, one, one, one, one, one, one, one};
    for (int item = blockIdx.x; item < NCOMBO * NCH; item += gridDim.x) {
        const int combo = item / NCH, c = item % NCH, b = combo >> 3, h = combo & 3;
        const float mend = mendA[combo * NCH + c];
        __syncthreads();
        if (tid < 256) wS[tid] = __expf(ulA[combo * SEQ + c * LCH + tid] - mend);
        f32x4 acc[17][2];
#pragma unroll
        for (int m = 0; m < 17; ++m) { acc[m][0] = (f32x4){0.f, 0.f, 0.f, 0.f}; acc[m][1] = (f32x4){0.f, 0.f, 0.f, 0.f}; }
        const bf16_t* Pk = P + (size_t)(b * SEQ + c * LCH) * NPC + 1024 + h * 256;
        u32x4 pre[8];
#define DL_LOAD(sb_) do { int t0_ = tid; asm volatile("" : "+v"(t0_)); const bf16_t* src_ = Pk + (unsigned)(((sb_) * 64 + (t0_ >> 5)) * NPC + (t0_ & 31) * 8); \
        _Pragma("unroll") for (int i_ = 0; i_ < 4; ++i_) { pre[i_] = *(const u32x4*)(src_ + i_ * 16 * NPC); pre[4 + i_] = *(const u32x4*)(src_ + i_ * 16 * NPC + 1024); } } while (0)
#define DL_STORE(sb_) do { int t0_ = tid; asm volatile("" : "+v"(t0_)); LAS unsigned char* d_ = lds + ((sb_) & 1) * BUFB + (t0_ >> 5) * 544 + (t0_ & 31) * 16; \
        _Pragma("unroll") for (int i_ = 0; i_ < 4; ++i_) { const float w_ = wS[(sb_) * 64 + (t0_ >> 5) + 16 * i_]; \
            *(LAS bf16x8*)(d_ + i_ * 16 * 544) = scale8(__builtin_bit_cast(bf16x8, pre[i_]), w_); *(LAS u32x4*)(d_ + 34816 + i_ * 16 * 544) = pre[4 + i_]; } } while (0)
        DL_LOAD(0);
        __syncthreads();
        DL_STORE(0);
        __syncthreads();
#pragma unroll 1
        for (int sb = 0; sb < 4; ++sb) {
            const LAS unsigned char* Kt = lds + (sb & 1) * BUFB; const LAS unsigned char* Vt = Kt + 34816;
            if (sb + 1 < 4) DL_LOAD(sb + 1);
#pragma unroll 1
            for (int kk = 0; kk < 2; ++kk) {
                bf16x8 bfr[2];
#pragma unroll
                for (int n = 0; n < 2; ++n) bfr[n] = tr_frag(Kt, 544, kk * 32 + 4 * quad, kk * 32 + 16 + 4 * quad, wave * 32 + n * 16, qin, pin);
#pragma unroll
                for (int m = 0; m < 16; ++m) { const bf16x8 afr = tr_frag(Vt, 544, kk * 32 + 4 * quad, kk * 32 + 16 + 4 * quad, m * 16, qin, pin);
                    acc[m][0] = MFMA16(bfr[0], afr, acc[m][0]); acc[m][1] = MFMA16(bfr[1], afr, acc[m][1]); if ((m & 3) == 3) __builtin_amdgcn_sched_barrier(0); }
                acc[16][0] = MFMA16(bfr[0], ones, acc[16][0]); acc[16][1] = MFMA16(bfr[1], ones, acc[16][1]);
            }
            if (sb + 1 < 4) DL_STORE(sb + 1);
            __syncthreads();
        }
#undef DL_LOAD
#undef DL_STORE
        int loff = l15 * 256 + wave * 32 + 4 * quad; asm volatile("" : "+v"(loff));
        bf16_t* dst = cst + (size_t)item * ST_ELEMS + loff;
#pragma unroll
        for (int m = 0; m < 17; ++m) {
#pragma unroll
            for (int n = 0; n < 2; ++n) { u32x2 w; w.x = pk2(acc[m][n][0], acc[m][n][1]); w.y = pk2(acc[m][n][2], acc[m][n][3]); *(u32x2*)(dst + (16 * m) * 256 + 16 * n) = w; }
            __builtin_amdgcn_sched_barrier(0); }
    }
}

DI void mlstm_scan(const Args& a, int tid) {
    bf16_t* cst = (bf16_t*)(a.ws + OFF_CST);
    const float* mprevA = (const float*)(a.ws + OFF_MPREV); const float* mendA = (const float*)(a.ws + OFF_MEND);
    constexpr int VPS = ST_ELEMS / 8;
    const int gt = blockIdx.x * 512 + tid, NT = gridDim.x * 512;
    for (int v = gt; v < NCOMBO * VPS; v += NT) {
        const int combo = v / VPS, vi = v % VPS, dir = (combo >> 2) & 1;
        float st[8];
#pragma unroll
        for (int i = 0; i < 8; ++i) st[i] = 0.f;
        bf16_t* base = cst + (size_t)combo * NCH * ST_ELEMS + vi * 8;
        for (int cs0 = 0; cs0 < NCH; cs0 += 8) {
            u32x4 d[8]; float dec[8];
#pragma unroll
            for (int q = 0; q < 8; ++q) { const int c = dir ? NCH - 1 - (cs0 + q) : cs0 + q;
                d[q] = *(const u32x4*)(base + (size_t)c * ST_ELEMS); dec[q] = __expf(mprevA[combo * NCH + c] - mendA[combo * NCH + c]); }
#pragma unroll
            for (int q = 0; q < 8; ++q) { const int c = dir ? NCH - 1 - (cs0 + q) : cs0 + q;
                u32x4 o;
#pragma unroll
                for (int i = 0; i < 4; ++i) { o[i] = pk2(st[2 * i], st[2 * i + 1]); st[2 * i] = dec[q] * st[2 * i] + bf2f(d[q][i] & 0xffffu); st[2 * i + 1] = dec[q] * st[2 * i + 1] + bf2f(d[q][i] >> 16); }
                *(u32x4*)(base + (size_t)c * ST_ELEMS) = o; }
        }
    }
}

DI void nat_scores(f32x4 (&st)[4][2], const LAS unsigned char* T, const bf16x8 (&qf)[4], int kc0, int l15, int quad) {
#pragma unroll
    for (int k4 = 0; k4 < 4; ++k4)
#pragma unroll
        for (int mi = 0; mi < 2; ++mi) { f32x4 s = {0.f, 0.f, 0.f, 0.f};
#pragma unroll
            for (int ks = 0; ks < 4; ++ks) { s = MFMA16(ld_frag(T + (k4 * 64 + kc0 + 16 * mi + l15) * 272 + (ks * 32 + quad * 8) * 2), qf[ks], s); if (ks == 1) __builtin_amdgcn_sched_barrier(0); }
            st[k4][mi] = s; __builtin_amdgcn_sched_barrier(0); }
}
DI float nat_mask(f32x4 (&st)[4][2], const LAS float* rpbS, int kr0, int rs, int r, const bool (&sel)[4], const int (&dcb)[4], float scale) {
    float mx = -3.0e38f;
#pragma unroll
    for (int k4 = 0; k4 < 4; ++k4) { const int dr = rs + kr0 + k4 - r + 7;
#pragma unroll
        for (int rr = 0; rr < 4; ++rr) { const float sv = (sel[rr] ? st[k4][0][rr] : st[k4][1][rr]) * scale + rpbS[dr * 31 + dcb[rr]]; st[k4][0][rr] = sv; mx = fmaxf(mx, sv); } }
    mx = fmaxf(mx, __shfl_xor(mx, 16)); mx = fmaxf(mx, __shfl_xor(mx, 32));
    return mx;
}
DI float nat_exp(bf16x8 (&pf)[4], f32x4 (&st)[4][2], const bool (&sel)[4], float m) {
    float sum = 0.f;
#pragma unroll
    for (int k4 = 0; k4 < 4; ++k4) { f32x4 p0, p1;
#pragma unroll
        for (int rr = 0; rr < 4; ++rr) { const float p = __expf(st[k4][0][rr] - m); sum += p; p0[rr] = sel[rr] ? p : 0.f; p1[rr] = sel[rr] ? 0.f : p; }
        pf[k4] = pack8(p0, p1); }
    return sum;
}
DI void nat_pv(f32x4 (&o)[8], const bf16x8 (&pf)[4], const LAS unsigned char* T, int kc0, int quad, int qin, int pin) {
#pragma unroll
    for (int k4 = 0; k4 < 4; ++k4) {
#pragma unroll
        for (int n = 0; n < 8; ++n) { o[n] = MFMA16(tr_frag(T + k4 * 64 * 272, 272, kc0 + 4 * quad, kc0 + 16 + 4 * quad, 16 * n, qin, pin), pf[k4], o[n]); if ((n & 3) == 3) __builtin_amdgcn_sched_barrier(0); } }
}
DI void natten(const Args& a, LAS unsigned char* lds, int tid, int lane, int wave) {
    const bf16_t* P = (const bf16_t*)(a.ws + OFF_P); bf16_t* mixed = (bf16_t*)(a.ws + OFF_HB);
    const int l15 = lane & 15, quad = lane >> 4, qin = l15 >> 2, pin = l15 & 3;
    const int hw = wave >> 2, j = wave & 3, htid = tid & 255;
    LAS unsigned char* T = lds + hw * 69632;
    LAS float* rpbS = (LAS float*)(lds + 139264) + hw * 480;
    const int kc0 = (j == 0) ? 0 : (j == 1) ? 8 : (j == 2) ? 24 : 32;
    const float scale = 0.08838834764831845f;
    const int nit = (1024 - (int)blockIdx.x + (int)gridDim.x - 1) / (int)gridDim.x;
    if (nit <= 0) return;
    __syncthreads();
    { const int h0 = (blockIdx.x & 3) * 2 + hw; for (int i = htid; i < 465; i += 256) rpbS[i] = a.rpb[h0 * 465 + i]; }
    u32x4 pre[16];
    const bool xmap = (gridDim.x == 256);
#define NAT_ITEM(k_) (xmap ? ((((int)blockIdx.x & 7) >> 2) << 9) | ((32 * (k_) + ((int)blockIdx.x >> 3)) << 2) | ((int)blockIdx.x & 3) : (int)blockIdx.x + (k_) * (int)gridDim.x)
#define NAT_LOAD(g_) do { const int it_ = NAT_ITEM((g_) >> 2), sp_ = (g_) & 3; const int b_ = it_ >> 9, r_ = (it_ >> 2) & 127, h_ = (it_ & 3) * 2 + hw; \
        const int rs_ = min(max(r_ - 4, 0), 120); int t0_ = htid; asm volatile("" : "+v"(t0_)); \
        const bf16_t* src_ = P + (unsigned)((b_ * SEQ + (rs_ + 4 * (sp_ & 1)) * 64) * NPC + ((sp_ >> 1) ? 6144 : 5120) + h_ * 128 + ((t0_ >> 4) * NPC + (t0_ & 15) * 8)); \
        _Pragma("unroll") for (int i_ = 0; i_ < 16; ++i_) pre[i_] = *(const u32x4*)(src_ + i_ * 16 * NPC); } while (0)
#define NAT_STORE() do { int t0_ = htid; asm volatile("" : "+v"(t0_)); LAS unsigned char* d_ = T + (t0_ >> 4) * 272 + (t0_ & 15) * 16; \
        _Pragma("unroll") for (int i_ = 0; i_ < 16; ++i_) *(LAS u32x4*)(d_ + i_ * 16 * 272) = pre[i_]; } while (0)
    NAT_LOAD(0); NAT_STORE();
    __syncthreads();
#pragma unroll 1
    for (int k = 0; k < nit; ++k) {
        const int item = NAT_ITEM(k);
        const int b = item >> 9, r = (item >> 2) & 127, h = (item & 3) * 2 + hw;
        int l15g = l15; asm volatile("" : "+v"(l15g));
        const int rs = min(max(r - 4, 0), 120), qcol = 16 * j + l15g;
        const int tokq = b * SEQ + r * 64 + qcol;
        bf16x8 qf[4]; f32x4 st[4][2]; bf16x8 pf0[4], pf1[4];
#pragma unroll
        for (int ks = 0; ks < 4; ++ks) qf[ks] = *(const bf16x8*)(P + (unsigned)(tokq * NPC + 4096 + h * 128 + ks * 32 + quad * 8));
        const int cs = min(max(qcol - 8, 0), 48);
        bool sel[4]; int dcb[4];
#pragma unroll
        for (int rr = 0; rr < 4; ++rr) { sel[rr] = (4 * quad + rr >= cs - kc0); dcb[rr] = kc0 + 4 * quad + rr + (sel[rr] ? 0 : 16) - qcol + 15; }
        NAT_LOAD(4 * k + 1);
        nat_scores(st, T, qf, kc0, l15, quad);
        const float m0 = nat_mask(st, rpbS, 0, rs, r, sel, dcb, scale);
        float sum0 = nat_exp(pf0, st, sel, m0);
        __syncthreads(); NAT_STORE(); __syncthreads();
        NAT_LOAD(4 * k + 2);
        nat_scores(st, T, qf, kc0, l15, quad);
        const float m1 = nat_mask(st, rpbS, 4, rs, r, sel, dcb, scale);
        const float M = fmaxf(m0, m1), f0 = __expf(m0 - M);
        float sum1 = nat_exp(pf1, st, sel, M);
        float tot = sum0 * f0 + sum1;
        tot += __shfl_xor(tot, 16); tot += __shfl_xor(tot, 32);
        const float inv = 1.f / tot;
        __syncthreads(); NAT_STORE(); __syncthreads();
        f32x4 o[8];
#pragma unroll
        for (int n = 0; n < 8; ++n) o[n] = (f32x4){0.f, 0.f, 0.f, 0.f};
        NAT_LOAD(4 * k + 3);
        nat_pv(o, pf0, T, kc0, quad, qin, pin);
#pragma unroll
        for (int n = 0; n < 8; ++n) o[n] = o[n] * f0;
        __syncthreads(); NAT_STORE(); __syncthreads();
        if (k + 1 < nit) NAT_LOAD(4 * k + 4);
        nat_pv(o, pf1, T, kc0, quad, qin, pin);
#pragma unroll
        for (int n = 0; n < 8; ++n) { u32x2 w; w.x = pk2(o[n][0] * inv, o[n][1] * inv); w.y = pk2(o[n][2] * inv, o[n][3] * inv);
            *(u32x2*)(mixed + (unsigned)(tokq * DM + 1024 + h * 128 + 16 * n + 4 * quad)) = w; }
        __syncthreads();
        if (k + 1 < nit) NAT_STORE();
        __syncthreads();
    }
#undef NAT_LOAD
#undef NAT_ITEM
#undef NAT_STORE
}

DI void mlstm_out(const Args& a, LAS unsigned char* lds, int tid, int lane, int wave) {
    const bf16_t* P = (const bf16_t*)(a.ws + OFF_P); const bf16_t* cst = (const bf16_t*)(a.ws + OFF_CST); bf16_t* mixed = (bf16_t*)(a.ws + OFF_HB);
    const float* ulA = (const float*)(a.ws + OFF_UL); const float* MlA = (const float*)(a.ws + OFF_ML); const float* emtA = (const float*)(a.ws + OFF_EMT);
    const float* mprevA = (const float*)(a.ws + OFF_MPREV);
    const int l15 = lane & 15, quad = lane >> 4, qin = l15 >> 2, pin = l15 & 3;
    constexpr int BUFB = 33792 + 34816;
    LAS float* ulS2 = (LAS float*)(lds + 2 * BUFB);
    const short one = (l15 == 0) ? (short)0x3F80 : (short)0;
    const bf16x8 ones = {one, one, one, one, one, one, one, one};
    for (int item = blockIdx.x; item < 512; item += gridDim.x) {
        const int bh = item >> 6, c = (item >> 1) & 31, half = item & 1, b = bh >> 2, h = bh & 3;
        int l15i = l15, tt = tid; asm volatile("" : "+v"(l15i), "+v"(tt));
        const int t_loc = 128 * half + 16 * wave + l15i;
        const size_t tok = (size_t)b * SEQ + c * LCH + t_loc;
        const int n0 = 2 * half + 2;
        __syncthreads();
        { const int d = tt >> 8; ulS2[tt] = ulA[((b * 2 + d) * 4 + h) * SEQ + c * LCH + (tt & 255)]; }
        u32x4 pre[8];
#define STEP_DEC(s_, dir_, st_, idx_) do { int r_ = (s_); dir_ = 0; if (r_ >= n0 + 4) { r_ -= n0 + 4; dir_ = 1; } const int nk_ = dir_ ? 4 - 2 * half : n0; st_ = (r_ >= nk_); idx_ = st_ ? r_ - nk_ : (dir_ ? 2 * half + r_ : r_); } while (0)
#define STEP_LOAD(s_) do { int dir_, st_, idx_; STEP_DEC(s_, dir_, st_, idx_); int t0_ = tid; asm volatile("" : "+v"(t0_)); \
        if (!st_) { const bf16_t* src_ = P + ((size_t)b * SEQ + c * LCH + 64 * idx_) * NPC + 1024 + h * 256 + ((t0_ >> 5) * NPC + (t0_ & 31) * 8); \
            _Pragma("unroll") for (int i_ = 0; i_ < 4; ++i_) { pre[i_] = *(const u32x4*)(src_ + i_ * 16 * NPC); pre[4 + i_] = *(const u32x4*)(src_ + i_ * 16 * NPC + 1024); } } \
        else { const bf16_t* src_ = cst + (size_t)(((b * 2 + dir_) * 4 + h) * NCH + c) * ST_ELEMS + 64 * idx_ + ((t0_ >> 3) * 256 + (t0_ & 7) * 8); \
            _Pragma("unroll") for (int i_ = 0; i_ < 4; ++i_) pre[i_] = *(const u32x4*)(src_ + i_ * 64 * 256); \
            if (t0_ < 128) pre[4] = *(const u32x4*)(src_ + 4 * 64 * 256); } } while (0)
#define STEP_STORE(s_) do { int dir_, st_, idx_; STEP_DEC(s_, dir_, st_, idx_); LAS unsigned char* bp_ = lds + ((s_) & 1) * BUFB; int t0_ = tid; asm volatile("" : "+v"(t0_)); \
        if (!st_) { LAS unsigned char* d_ = bp_ + (t0_ >> 5) * 528 + (t0_ & 31) * 16; \
            _Pragma("unroll") for (int i_ = 0; i_ < 4; ++i_) { *(LAS u32x4*)(d_ + i_ * 16 * 528) = pre[i_]; *(LAS u32x4*)(bp_ + 33792 + ((t0_ >> 5) + 16 * i_) * 544 + (t0_ & 31) * 16) = pre[4 + i_]; } } \
        else { LAS unsigned char* d_ = bp_ + (t0_ >> 3) * 144 + (t0_ & 7) * 16; \
            _Pragma("unroll") for (int i_ = 0; i_ < 4; ++i_) *(LAS u32x4*)(d_ + i_ * 64 * 144) = pre[i_]; \
            if (t0_ < 128) *(LAS u32x4*)(d_ + 4 * 64 * 144) = pre[4]; } } while (0)
        bf16x8 qf[8];
        { int qo = h * 256 + quad * 8; asm volatile("" : "+v"(qo)); const bf16_t* qp = P + tok * NPC + qo;
#pragma unroll
          for (int ks = 0; ks < 8; ++ks) qf[ks] = *(const bf16x8*)(qp + ks * 32); }
        STEP_LOAD(0); STEP_STORE(0);
        __syncthreads();
        f32x4 acc[17]; float Ml = 0.f, emt = 1.f, aa = 0.f;
#pragma unroll 1
        for (int s = 0; s < 14; ++s) {
            int dir, st, idx; STEP_DEC(s, dir, st, idx);
            const LAS unsigned char* T0 = lds + (s & 1) * BUFB; const LAS unsigned char* T1 = T0 + 33792;
            const LAS float* ulS = ulS2 + dir * 256;
            if (s == 0 || s == n0 + 4) {
                const int combo = (b * 2 + dir) * 4 + h;
                Ml = MlA[combo * SEQ + c * LCH + t_loc]; emt = emtA[combo * SEQ + c * LCH + t_loc]; aa = __expf(mprevA[combo * NCH + c] - Ml);
#pragma unroll
                for (int m = 0; m < 17; ++m) acc[m] = (f32x4){0.f, 0.f, 0.f, 0.f};
            }
            if (s + 1 < 14) STEP_LOAD(s + 1);
            if (!st && (dir ? (64 * idx + 63 >= 128 * half + 16 * wave) : (64 * idx <= 128 * half + 16 * wave + 15))) {
                const int jb = idx;
                f32x4 sc[4];
#pragma unroll
                for (int mi = 0; mi < 4; ++mi) sc[mi] = (f32x4){0.f, 0.f, 0.f, 0.f};
#pragma unroll
                for (int mi = 0; mi < 4; ++mi) {
#pragma unroll
                    for (int ks = 0; ks < 8; ++ks) { sc[mi] = MFMA16(ld_frag(T0 + (16 * mi + l15) * 528 + (32 * ks + 8 * quad) * 2), qf[ks], sc[mi]); if (ks == 3) __builtin_amdgcn_sched_barrier(0); }
                    __builtin_amdgcn_sched_barrier(0); }
#pragma unroll
                for (int mi = 0; mi < 4; ++mi) { const int s0 = 64 * jb + 16 * mi + 4 * quad; const f32x4 uv = *(const LAS f32x4*)(ulS + s0);
#pragma unroll
                    for (int rr = 0; rr < 4; ++rr) { const int s_loc = s0 + rr; const bool valid = dir ? (s_loc >= t_loc) : (s_loc <= t_loc);
                        const float e = __expf(fminf(uv[rr] - Ml, 0.f)); sc[mi][rr] *= valid ? e : 0.f; } }
#pragma unroll
                for (int kk = 0; kk < 2; ++kk) { const bf16x8 pf = pack8(sc[2 * kk], sc[2 * kk + 1]);
                    bf16x8 f0 = tr_frag(T1, 544, 32 * kk + 4 * quad, 32 * kk + 16 + 4 * quad, 0, qin, pin), f1 = tr_frag(T1, 544, 32 * kk + 4 * quad, 32 * kk + 16 + 4 * quad, 16, qin, pin);
#pragma unroll
                    for (int n = 0; n < 16; n += 2) {
                        bf16x8 g0 = f0, g1 = f1;
                        if (n + 2 < 16) { g0 = tr_frag(T1, 544, 32 * kk + 4 * quad, 32 * kk + 16 + 4 * quad, 16 * (n + 2), qin, pin); g1 = tr_frag(T1, 544, 32 * kk + 4 * quad, 32 * kk + 16 + 4 * quad, 16 * (n + 3), qin, pin); }
                        acc[n] = MFMA16(f0, pf, acc[n]); acc[n + 1] = MFMA16(f1, pf, acc[n + 1]);
                        f0 = g0; f1 = g1; __builtin_amdgcn_sched_barrier(0); }
                    acc[16] = MFMA16(ones, pf, acc[16]); }
            } else if (st) {
                const int db = idx;
                bf16x8 aq[2];
                aq[0] = (db == 0) ? qf[0] : (db == 1) ? qf[2] : (db == 2) ? qf[4] : qf[6];
                aq[1] = (db == 0) ? qf[1] : (db == 1) ? qf[3] : (db == 2) ? qf[5] : qf[7];
                aq[0] = scale8(aq[0], aa); aq[1] = scale8(aq[1], aa);
#pragma unroll
                for (int kk = 0; kk < 2; ++kk) {
                    const LAS unsigned char* sp = T0 + l15 * 144 + (32 * kk + 8 * quad) * 2;
                    bf16x8 f0 = ld_frag(sp), f1 = ld_frag(sp + 16 * 144);
#pragma unroll
                    for (int m = 0; m < 16; m += 2) {
                        bf16x8 g0 = f0, g1 = f1;
                        if (m + 2 < 17) g0 = ld_frag(sp + 16 * (m + 2) * 144);
                        if (m + 3 < 17) g1 = ld_frag(sp + 16 * (m + 3) * 144);
                        acc[m] = MFMA16(f0, aq[kk], acc[m]); acc[m + 1] = MFMA16(f1, aq[kk], acc[m + 1]);
                        f0 = g0; f1 = g1; __builtin_amdgcn_sched_barrier(0); }
                    acc[16] = MFMA16(f0, aq[kk], acc[16]); }
            }
            if (s + 1 < 14) STEP_STORE(s + 1);
            if (s == n0 + 3 || s == 13) {
                const float den = __shfl(acc[16][0], l15);
                const float dn = 1.f / fmaxf(fabsf(den), emt);
                int moff = h * 256 + 4 * quad; asm volatile("" : "+v"(moff));
                bf16_t* mrow = mixed + tok * DM + moff;
                if (dir == 0) {
#pragma unroll
                    for (int n = 0; n < 16; ++n) { u32x2 w; w.x = pk2(acc[n][0] * dn, acc[n][1] * dn); w.y = pk2(acc[n][2] * dn, acc[n][3] * dn); *(u32x2*)(mrow + 16 * n) = w; }
                } else {
                    float ss = 0.f;
#pragma unroll
                    for (int n = 0; n < 16; ++n) { const u32x2 hf = *(const u32x2*)(mrow + 16 * n);
                        acc[n][0] = acc[n][0] * dn + bf2f(hf.x & 0xffffu); acc[n][1] = acc[n][1] * dn + bf2f(hf.x >> 16);
                        acc[n][2] = acc[n][2] * dn + bf2f(hf.y & 0xffffu); acc[n][3] = acc[n][3] * dn + bf2f(hf.y >> 16);
                        ss += (acc[n][0] * acc[n][0] + acc[n][1] * acc[n][1]) + (acc[n][2] * acc[n][2] + acc[n][3] * acc[n][3]); if ((n & 3) == 3) __builtin_amdgcn_sched_barrier(0); }
                    ss += __shfl_xor(ss, 16); ss += __shfl_xor(ss, 32);
                    const float rstd = rsqrtf(ss * (1.f / 256.f) + EPSN);
                    __builtin_amdgcn_sched_barrier(0);
                    int eb = h * 256 + 4 * quad; asm volatile("" : "+v"(eb));
                    const float* gp = a.g_head_a + eb; const bf16_t* ovp = P + tok * NPC + 3072 + eb;
#pragma unroll
                    for (int n = 0; n < 16; ++n) { const f32x4 g = *(const f32x4*)(gp + 16 * n);
                        const u32x2 ov = *(const u32x2*)(ovp + 16 * n);
                        const float o0 = bf2f(ov.x & 0xffffu), o1 = bf2f(ov.x >> 16), o2 = bf2f(ov.y & 0xffffu), o3 = bf2f(ov.y >> 16);
                        u32x2 w; w.x = pk2(acc[n][0] * rstd * g.x * __builtin_amdgcn_rcpf(1.f + __expf(-o0)), acc[n][1] * rstd * g.y * __builtin_amdgcn_rcpf(1.f + __expf(-o1)));
                        w.y = pk2(acc[n][2] * rstd * g.z * __builtin_amdgcn_rcpf(1.f + __expf(-o2)), acc[n][3] * rstd * g.w * __builtin_amdgcn_rcpf(1.f + __expf(-o3)));
                        *(u32x2*)(mrow + 16 * n) = w; __builtin_amdgcn_sched_barrier(0); }
                }
            }
            __syncthreads();
        }
#undef STEP_DEC
#undef STEP_LOAD
#undef STEP_STORE
    }
}

DI void phase_act(const Args& a, int tid) {
    bf16_t* UG = (bf16_t*)(a.ws + OFF_UG);
    constexpr int NV = DFF / 8, RUN = 16, NRUN = MTOK / RUN;
    const int gt = blockIdx.x * 512 + tid, NT = gridDim.x * 512;
    for (int it = gt; it < NRUN * NV; it += NT) {
        const int vv = it % NV, run = it / NV, f0 = vv * 8, t0 = run * RUN;
        float w0[8], w1[8], w2[8], cb[8];
#pragma unroll
        for (int i = 0; i < 8; ++i) { w0[i] = a.conv_w[f0 + i]; w1[i] = a.conv_w[DFF + f0 + i]; w2[i] = a.conv_w[2 * DFF + f0 + i]; cb[i] = a.conv_b[f0 + i]; }
        const u32x4 zero = {0u, 0u, 0u, 0u};
        const bf16_t* G = UG + DFF + f0;
        u32x4 gp = ((t0 & (SEQ - 1)) == 0) ? zero : *(const u32x4*)(G + (size_t)(t0 - 1) * NUP);
        u32x4 gc = *(const u32x4*)(G + (size_t)t0 * NUP);
        for (int i = 0; i < RUN; ++i) { const int t = t0 + i;
            const u32x4 gn = (((t + 1) & (SEQ - 1)) == 0) ? zero : *(const u32x4*)(G + (size_t)(t + 1) * NUP);
            const u32x4 uv = *(const u32x4*)(UG + (size_t)t * NUP + f0);
            u32x4 o;
#pragma unroll
            for (int q = 0; q < 4; ++q) { float r[2];
#pragma unroll
                for (int e = 0; e < 2; ++e) { const int k = 2 * q + e; const unsigned sh = e ? 16u : 0u;
                    const float g = w0[k] * bf2f((gp[q] >> sh) & 0xffffu) + w1[k] * bf2f((gc[q] >> sh) & 0xffffu) + w2[k] * bf2f((gn[q] >> sh) & 0xffffu) + cb[k];
                    r[e] = 0.5f * g * (1.f + erff(g * 0.70710678118654752f)) * bf2f((uv[q] >> sh) & 0xffffu); }
                o[q] = pk2(r[0], r[1]); }
            *(u32x4*)(UG + (size_t)t * NUP + f0) = o;
            gp = gc; gc = gn; }
    }
}

DI void phase_final(const Args& a, int lane, int wave) {
    const bf16_t* x2 = (const bf16_t*)(a.ws + OFF_X1B);
    const int gw = blockIdx.x * 8 + wave, NGW = gridDim.x * 8;
    f32x4 g[8];
#pragma unroll
    for (int j = 0; j < 8; ++j) g[j] = *(const f32x4*)(a.g_final + 4 * lane + 256 * j);
    for (int m = 4 * gw; m < MTOK; m += 4 * NGW) {
        u32x2 p[4][8];
#pragma unroll
        for (int r = 0; r < 4; ++r)
#pragma unroll
            for (int j = 0; j < 8; ++j) p[r][j] = *(const u32x2*)(x2 + (size_t)(m + r) * DM + 4 * lane + 256 * j);
#pragma unroll
        for (int r = 0; r < 4; ++r) {
            f32x4 v[8]; float ss = 0.f;
#pragma unroll
            for (int j = 0; j < 8; ++j) { v[j] = (f32x4){bf2f(p[r][j].x & 0xffffu), bf2f(p[r][j].x >> 16), bf2f(p[r][j].y & 0xffffu), bf2f(p[r][j].y >> 16)};
                ss += (v[j].x * v[j].x + v[j].y * v[j].y) + (v[j].z * v[j].z + v[j].w * v[j].w); }
            const float rstd = rsqrtf(wave_sum(ss) * (1.f / DM) + EPSN);
#pragma unroll
            for (int j = 0; j < 8; ++j) *(f32x4*)(a.out + (size_t)(m + r) * DM + 4 * lane + 256 * j) = v[j] * rstd * g[j];
        }
    }
}

#define XB_TMO      128
#define XB_XCNT(j)  (256  + 64 * (j))
#define XB_XSUB(j)  (1280 + 64 * (j))
#define XB_XGEN(j)  (2304 + 64 * (j))
#define XB_TOP      3328
#define XB_TOPGEN   3392
#define XCD_BAR_WORDS 3456
#define XB_SPIN_CAP (1u << 18)

__device__ __forceinline__ unsigned xb_ld(unsigned* p)              { return __hip_atomic_load(p, __ATOMIC_RELAXED, __HIP_MEMORY_SCOPE_AGENT); }
__device__ __forceinline__ unsigned xb_add(unsigned* p, unsigned v) { return __hip_atomic_fetch_add(p, v, __ATOMIC_RELAXED, __HIP_MEMORY_SCOPE_AGENT); }
__device__ __forceinline__ unsigned xb_xcc_id() { return (unsigned)__builtin_amdgcn_s_getreg((3 << 11) | 20) & 0xFu; }
#define XB_SPIN(cond, bar) do { unsigned _sp = 0; while (cond) { __builtin_amdgcn_s_sleep(1); \
    if ((++_sp & 255u) == 0u) { if (xb_ld(&(bar)[XB_TMO])) break; if (_sp > XB_SPIN_CAP) { atomicAdd(&(bar)[XB_TMO], 1u); break; } } } } while (0)

struct XcdBarrier {
    unsigned* bar; unsigned x;
    volatile LAS unsigned* st;
};

__device__ __forceinline__ XcdBarrier xcd_barrier_post(unsigned* bar, volatile LAS unsigned* st) {
    XcdBarrier b; b.bar = bar; b.x = xb_xcc_id(); b.st = st;
    if (threadIdx.x == 0) (void)xb_add(&bar[XB_XCNT(b.x)], 1u);
    return b;
}
__device__ __forceinline__ void xcd_barrier_complete(unsigned* bar, unsigned x, unsigned& nloc, unsigned& nx) {
    const unsigned G = gridDim.x * gridDim.y * gridDim.z;
    unsigned sum, cnt, mine, sp = 0u;
    for (;;) {
        sum = 0u; cnt = 0u; mine = 0u;
#pragma unroll
        for (unsigned j = 0; j < 16; ++j) { const unsigned c = xb_ld(&bar[XB_XCNT(j)]); sum += c; cnt += (c > 0u) ? 1u : 0u; mine = (j == x) ? c : mine; }
        if (sum == G) break;
        __builtin_amdgcn_s_sleep(1);
        if ((++sp & 255u) == 0u) { if (xb_ld(&bar[XB_TMO])) break; if (sp > XB_SPIN_CAP) { atomicAdd(&bar[XB_TMO], 1u); break; } }
    }
    nloc = mine > 0u ? mine : 1u; nx = cnt > 0u ? cnt : 1u;
}

__device__ __forceinline__ void xcd_barrier(const XcdBarrier& b) {
    asm volatile("s_waitcnt vmcnt(0)" ::: "memory");
    __syncthreads();
    if (threadIdx.x == 0) {
        unsigned* bar = b.bar;
        __builtin_amdgcn_s_waitcnt(0);
        unsigned nloc = b.st[0], nx = b.st[1];
        if (nloc == 0u) { xcd_barrier_complete(bar, b.x, nloc, nx); b.st[0] = nloc; b.st[1] = nx; }
        const unsigned old = xb_add(&bar[XB_XSUB(b.x)], 1u);
        const unsigned gen = old / nloc;
        if (old + 1u == (gen + 1u) * nloc) {
            __builtin_amdgcn_fence(__ATOMIC_RELEASE, "agent");
            asm volatile("s_waitcnt vmcnt(0)" ::: "memory");
            const unsigned og = xb_add(&bar[XB_TOP], 1u);
            const unsigned tg = og / nx;
            if (og + 1u == (tg + 1u) * nx) xb_add(&bar[XB_TOPGEN], 1u);
            else XB_SPIN(xb_ld(&bar[XB_TOPGEN]) == tg, bar);
            __builtin_amdgcn_fence(__ATOMIC_ACQUIRE, "agent");
            xb_add(&bar[XB_XGEN(b.x)], 1u);
            asm volatile("s_waitcnt vmcnt(0)" ::: "memory");
        } else {
            XB_SPIN(xb_ld(&bar[XB_XGEN(b.x)]) == gen, bar);
            __builtin_amdgcn_fence(__ATOMIC_ACQUIRE, "agent");
            asm volatile("s_waitcnt vmcnt(0)" ::: "memory");
        }
    }
    __syncthreads();
}


DI int lane_now() { int l = (int)(threadIdx.x & 63u); asm volatile("" : "+v"(l)); return l; }
__global__ void __launch_bounds__(512, 2) mega(Args a) {
    extern __shared__ __attribute__((aligned(16))) unsigned char lds_raw[];
    LAS unsigned char* lds = (LAS unsigned char*)lds_raw;
    cg::grid_group grid = cg::this_grid();
    const int tid = threadIdx.x, wave = __builtin_amdgcn_readfirstlane(tid >> 6);
#define lane lane_now()
    const int lo = a.ph_lo, hi = a.ph_hi;
    volatile LAS unsigned* xst = (volatile LAS unsigned*)(lds + LDS_BYTES - 16);
    if (tid == 0) { xst[0] = 0u; xst[1] = 0u; }
    __syncthreads();
    if (hi - lo > 1) (void)xcd_barrier_post((unsigned*)(a.ws + OFF_BAR), xst);
    const float* mod = (const float*)(a.ws + OFF_MOD);
#ifndef PHMASK
#define PHMASK 0xfff
#endif
#define PH(k) (((PHMASK >> (k)) & 1) && lo <= (k) && (k) < hi)
#ifndef PROBE_A
#define PROBE_A -1
#define PROBE_B -1
#endif
    unsigned long long* stamps = (unsigned long long*)(a.ws + WS_NEED);
#define STAMP(k) do { if (PROBE_A >= 0 && blockIdx.x == 0 && tid == 0) stamps[k] = __builtin_amdgcn_s_memrealtime(); } while (0)
#define SEAM(k) do { if (PH(k) && PH((k) + 1)) { XcdBarrier xb_; xb_.bar = (unsigned*)(a.ws + OFF_BAR); xb_.x = xb_xcc_id(); xb_.st = (volatile LAS unsigned*)(lds + LDS_BYTES - 16); xcd_barrier(xb_); } STAMP((k) + 1); } while (0)
#ifdef MK_GRID_SYNC_FIRST
    if (hi - lo > 1) grid.sync();
#endif
    STAMP(0);
    if (PH(0)) phase0(a, lds, tid, lane, wave);
#ifdef DUP_P0
    if (PH(0)) { __syncthreads(); phase0(a, lds, tid, lane, wave); }
#endif
    SEAM(0);
    if (PH(1)) phase_norm<true, false>(a, lds, a.x, a.g_norm1, 0, DM, tid, lane, wave);
    SEAM(1);
    if (PH(2)) {
        if (blockIdx.x < NCOMBO) gate_prep(a, lds, blockIdx.x, tid);
        pg8::Gemm g{(const bf16_t*)(a.ws + OFF_HB), (const bf16_t*)(a.ws + OFF_WIN), MTOK, NPC, DM, DM}; pg8::StaticOrder S; S.init(MTOK, NPC, gridDim.x, blockIdx.x);
#ifdef SKEW_TICKS
        if ((blockIdx.x >> 3) & 1) { const unsigned long long t0 = __builtin_amdgcn_s_memrealtime(); while (__builtin_amdgcn_s_memrealtime() - t0 < SKEW_TICKS) __builtin_amdgcn_s_sleep(8); }
#endif
        pg8::EpiBf16<0> E{(bf16_t*)(a.ws + OFF_P), NPC, nullptr, 0, 0, 1.f};
        pg8::gemm_phase<pg8::EpiBf16<0>, pg8::StaticOrder, GEMM_ALIGN, true>(lds, g, S, E);
#ifdef DUP_GEMM_IN
        pg8::gemm_phase<pg8::EpiBf16<0>, pg8::StaticOrder, true, true>(lds, g, S, E);
#endif
#ifdef DUP_GEMM_HALFK
        { pg8::Gemm g2{(const bf16_t*)(a.ws + OFF_HB), (const bf16_t*)(a.ws + OFF_WIN), MTOK, NPC, DUP_GEMM_HALFK, DM};
          pg8::EpiBf16<0> E2{(bf16_t*)(a.ws + OFF_CST), 0, nullptr, 0, 0, 1.f};
          pg8::gemm_phase<pg8::EpiBf16<0>, pg8::StaticOrder, true, true>(lds, g2, S, E2); }
#endif
    }
    SEAM(2);
    if (PH(3)) mlstm_delta(a, lds, tid, lane, wave);
#if defined(DUP_MIX) || defined(DUP_A1)
    if (PH(3)) { __syncthreads(); mlstm_delta(a, lds, tid, lane, wave); }
#endif
    SEAM(3);
    if (PH(4)) { mlstm_scan(a, tid); natten(a, lds, tid, lane, wave); }
#if defined(DUP_MIX) || defined(DUP_NAT)
    if (PH(4)) { __syncthreads(); natten(a, lds, tid, lane, wave); }
#endif
    SEAM(4);
    if (PH(5)) mlstm_out(a, lds, tid, lane, wave);
#if defined(DUP_MIX) || defined(DUP_A3)
    if (PH(5)) { __syncthreads(); mlstm_out(a, lds, tid, lane, wave); }
#endif
    SEAM(5);
    if (PH(6)) {
        __syncthreads();
        pg8::Gemm g{(const bf16_t*)(a.ws + OFF_HB), (const bf16_t*)(a.ws + OFF_WOUT), MTOK, DM, DM, DM}; pg8::StaticOrder S; S.init(MTOK, DM, gridDim.x, blockIdx.x);
        EpiResid16<false> E{a.x, (bf16_t*)(a.ws + OFF_X1B), mod + 2 * DM};
        pg8::gemm_phase<EpiResid16<false>, pg8::StaticOrder, GEMM_ALIGN, true>(lds, g, S, E);
    }
    SEAM(6);
    if (PH(7)) phase_norm<false, true>(a, lds, a.ws + OFF_X1B, a.g_norm2, 3 * DM, 4 * DM, tid, lane, wave);
    SEAM(7);
    if (PH(8)) {
        pg8::Gemm g{(const bf16_t*)(a.ws + OFF_HB), (const bf16_t*)(a.ws + OFF_WUP), MTOK, NUP, DM, DM}; pg8::StaticOrder S; S.init(MTOK, NUP, gridDim.x, blockIdx.x);
#ifdef SKEW_TICKS
        if ((blockIdx.x >> 3) & 1) { const unsigned long long t0 = __builtin_amdgcn_s_memrealtime(); while (__builtin_amdgcn_s_memrealtime() - t0 < SKEW_TICKS) __builtin_amdgcn_s_sleep(8); }
#endif
        EpiGlu E{(bf16_t*)(a.ws + OFF_ACT), a.conv_w, a.conv_b, (float*)(a.ws + OFF_EDGE), (LAS float*)(lds + 131072)};
        pg8::gemm_phase<EpiGlu, pg8::StaticOrder, true, true>(lds, g, S, E);
    }
    SEAM(8);
    if (PH(10)) {
        pg8::Gemm g{(const bf16_t*)(a.ws + OFF_ACT), (const bf16_t*)(a.ws + OFF_WDN), MTOK, DM, DFF, DFF}; pg8::StaticOrder S; S.init(MTOK, DM, gridDim.x, blockIdx.x);
        { pg8::Unit uu; int lastpm = -1; for (int i = 0; S.next(i, uu); ++i) if (uu.pm != lastpm) { glu_fixup(a, uu.pm, tid); lastpm = uu.pm; } }
        __threadfence(); __syncthreads();
        EpiResid16<true> E{a.ws + OFF_X1B, (bf16_t*)(a.ws + OFF_X1B), mod + 5 * DM};
        pg8::gemm_phase<EpiResid16<true>, pg8::StaticOrder, GEMM_ALIGN, true>(lds, g, S, E);
    }
    SEAM(10);
    if (PH(11)) phase_final(a, lane, wave);
    if (PROBE_A >= 0) { __syncthreads(); if (blockIdx.x == 0 && tid == 0) { stamps[12] = __builtin_amdgcn_s_memrealtime();
        const float Ta = (float)(stamps[PROBE_A + 1] - stamps[PROBE_A]) * 0.01f, Tb = (float)(stamps[PROBE_B + 1] - stamps[PROBE_B]) * 0.01f;
        a.out[0] += Ta + Tb; for (int i = 1; i <= 1000; ++i) a.out[i] += 0.5f * Tb; } }
#undef PH
#undef SEAM
#undef lane
}

extern "C" void kernel_launch(void* const* d_in, const int* in_sizes, int n_in, void* d_out, int out_size, void* d_ws, size_t ws_size, hipStream_t stream) {
    static int grid = 0;
    if (grid == 0) {
        if (n_in != 16 || out_size != MTOK * DM || ws_size < WS_NEED) { fprintf(stderr, "kernel_launch: unexpected problem (n_in %d out %d ws %zu need %zu)\n", n_in, out_size, ws_size, (size_t)WS_NEED); grid = -1; return; }
        int dev = 0, cus = 0, per_cu = 0;
        hipGetDevice(&dev); hipDeviceGetAttribute(&cus, hipDeviceAttributeMultiprocessorCount, dev);
        if (hipFuncSetAttribute((const void*)mega, hipFuncAttributeMaxDynamicSharedMemorySize, LDS_BYTES) != hipSuccess) { fprintf(stderr, "kernel_launch: hipFuncSetAttribute failed\n"); grid = -1; return; }
        if (hipOccupancyMaxActiveBlocksPerMultiprocessor(&per_cu, (const void*)mega, 512, LDS_BYTES) != hipSuccess || per_cu < 1) { fprintf(stderr, "kernel_launch: occupancy query failed (%d)\n", per_cu); (void)hipGetLastError(); per_cu = 1; }
        grid = cus * (per_cu > 1 ? 1 : per_cu);
        fprintf(stderr, "kernel_launch: grid %d (cus %d, per_cu %d)\n", grid, cus, per_cu);
        if (grid < 4 || (grid & 3) != 0) { fprintf(stderr, "kernel_launch: this kernel needs a workgroup count that is a multiple of 4 (neighbourhood-attention head pairs are fixed per workgroup); nothing launched\n"); grid = -1; return; }
    }
    if (grid < 0) return;
    Args a{};
    a.x = (const float*)d_in[0]; a.c = (const float*)d_in[1]; a.w_ada = (const float*)d_in[2]; a.b_ada = (const float*)d_in[3]; a.g_norm1 = (const float*)d_in[4];
    a.w_in = (const float*)d_in[5]; a.b_gates = (const float*)d_in[6]; a.g_head_a = (const float*)d_in[7]; a.rpb = (const float*)d_in[8]; a.w_out = (const float*)d_in[9];
    a.g_norm2 = (const float*)d_in[10]; a.w_up = (const float*)d_in[11]; a.conv_w = (const float*)d_in[12]; a.conv_b = (const float*)d_in[13]; a.w_down = (const float*)d_in[14];
    a.g_final = (const float*)d_in[15]; a.out = (float*)d_out; a.ws = (unsigned char*)d_ws;
#if MK_PER_PHASE
    for (int p = 0; p < NPH; ++p) { a.ph_lo = p; a.ph_hi = p + 1; hipLaunchKernelGGL(mega, dim3(grid), dim3(512), LDS_BYTES, stream, a); }
#else
    a.ph_lo = 0; a.ph_hi = NPH;
    if (hipMemsetAsync((char*)d_ws + OFF_BAR, 0, BAR_BYTES, stream) != hipSuccess) { fprintf(stderr, "kernel_launch: memset failed\n"); return; }
    void* args[] = {&a};
    hipError_t e = hipLaunchCooperativeKernel((const void*)mega, dim3(grid), dim3(512), args, LDS_BYTES, stream);
    if (e != hipSuccess) fprintf(stderr, "kernel_launch: cooperative launch failed: %s (grid %d)\n", hipGetErrorString(e), grid);
#endif
}
```

```cpp
#include <hip/hip_runtime.h>
#include <hip/hip_cooperative_groups.h>
#include <cstdio>
#include <cstdint>
namespace cg = cooperative_groups;
#define MK_PER_PHASE 0
#define PG8_WGM 4
namespace pg8 {
#define PG8_LAS __attribute__((address_space(3)))
typedef unsigned short bf16_t;
typedef short bf16x8 __attribute__((ext_vector_type(8)));
typedef float f32x4 __attribute__((ext_vector_type(4)));
typedef unsigned u32x4 __attribute__((ext_vector_type(4)));
constexpr int BM = 256, BK = 64, HALF = 128, HTB = HALF * BK * 2  , STAGE_BYTES = 8 * HTB, NXCD = 8, WGM = PG8_WGM;

__host__ __device__ __forceinline__ int lds_byte(int r, int c) { const int st = (r >> 4) * 2 + (c >> 5), rr = r & 15, cc = c & 31, ob = rr * 64 + cc * 2; return st * 1024 + (ob ^ (((ob >> 9) & 1) << 5)); }
__host__ __device__ __forceinline__ void stage_rc(int b, int& R, int& C) { const int st = b / 1024, sb = b % 1024, swz = sb ^ (((sb >> 9) & 1) << 5); R = (st >> 1) * 16 + swz / 64; C = (st & 1) * 32 + (swz % 64) / 2; }
__host__ __device__ __forceinline__ int perm32(int rho) { const int n = rho >> 4, i = rho & 15; return 8 * (i >> 2) + 4 * n + (i & 3); }

struct Unit { int pm, pn; };
struct Gemm { const bf16_t* A; const bf16_t* Bt; int M, N, K, lda; };

struct StaticOrder {
    int nM, nN, nwg, G, c;
    __host__ __device__ void init(int M, int N, int G_, int c_) { nM = M / BM; nN = N / BM; nwg = nM * nN; G = G_; c = c_; }
    __host__ __device__ bool next(int i, Unit& u) const {
        const long L = (long)i * G + c; if (L >= nwg) return false;
        int wgid = (int)L; { const int q = nwg / NXCD, r = nwg % NXCD, xcd = wgid % NXCD, off = wgid / NXCD; wgid = (xcd < r ? xcd * (q + 1) : r * (q + 1) + (xcd - r) * q) + off; }
        const int nig = WGM * nN, gid = wgid / nig, fm = gid * WGM, gsz = (nM - fm) < WGM ? (nM - fm) : WGM;
        u.pm = fm + ((wgid % nig) % gsz); u.pn = (wgid % nig) / gsz; return true;
    }
    __device__ __forceinline__ void a_ready(const Unit&) const {}
    __device__ __forceinline__ void done(const Unit&) const {}
};

__device__ __forceinline__ unsigned cvt_pk_bf16(float lo, float hi) { unsigned r; asm volatile("v_cvt_pk_bf16_f32 %0, %1, %2" : "=v"(r) : "v"(lo), "v"(hi)); return r; }
typedef float f32x2 __attribute__((ext_vector_type(2)));
__device__ __forceinline__ f32x2 gelu_pk(f32x2 v) {
    const f32x2 av = __builtin_elementwise_abs(v), d = av * 0.2316418882f + 1.0f;
    f32x2 t; t.x = __builtin_amdgcn_rcpf(d.x); t.y = __builtin_amdgcn_rcpf(d.y);
    f32x2 q = t * 0.5307027145f + (-0.7265760135f); q = q * t + 0.7107068705f; q = q * t + (-0.142248368f); q = q * t + 0.127414796f; q = q * t;
    const f32x2 s = (v * v) * (-0.72134752044f);
    f32x2 e; e.x = __builtin_amdgcn_exp2f(s.x); e.y = __builtin_amdgcn_exp2f(s.y);
    const f32x2 m = v * (q * e), r = v - m;
    f32x2 o; o.x = v.x < 0.f ? m.x : r.x; o.y = v.y < 0.f ? m.y : r.y; return o;
}

template <int ACT  > struct EpiBf16 {
    static constexpr bool PERM = true, AFTER_DRAIN = false; static_assert(ACT == 0 || ACT == 1, "EpiBf16: ACT is 0 (none) or 1 (gelu_pk)");
    bf16_t* O; int ldc; const float* bias; int split_cols; size_t split_stride; float scale0;
    __device__ __forceinline__ void operator()(const f32x4 (&acc)[2][2][4][2], const Unit& u, int wr, int wc, int fr, int fq) const {
        const int row0 = u.pm * BM + wr * 64 + fr; int colt = u.pn * BM; bf16_t* base = O;
        float sc = 1.f; if (split_cols) { const int t = colt / split_cols; base += (size_t)t * split_stride; colt -= t * split_cols; if (t == 0) sc = scale0; }
        const int col0 = colt + wc * 32 + 8 * fq, bcol0 = u.pn * BM + wc * 32 + 8 * fq;
        f32x4 bv[2][2];
#pragma unroll
        for (int bj = 0; bj < 2; ++bj)
#pragma unroll
            for (int n = 0; n < 2; ++n) bv[bj][n] = bias ? *(const f32x4*)(bias + bcol0 + bj * HALF + 4 * n) : (f32x4){0.f, 0.f, 0.f, 0.f};
#pragma unroll
        for (int ai = 0; ai < 2; ++ai)
#pragma unroll
            for (int m = 0; m < 4; ++m) { bf16_t* rowp = base + (size_t)(row0 + ai * HALF + m * 16) * ldc + col0;
#pragma unroll
                for (int bj = 0; bj < 2; ++bj) { f32x4 v0 = acc[ai][bj][m][0] + bv[bj][0], v1 = acc[ai][bj][m][1] + bv[bj][1];
                    if (ACT == 1) { f32x2 a = gelu_pk((f32x2){v0[0], v0[1]}), b = gelu_pk((f32x2){v0[2], v0[3]}), c = gelu_pk((f32x2){v1[0], v1[1]}), d = gelu_pk((f32x2){v1[2], v1[3]});
                        v0 = (f32x4){a.x, a.y, b.x, b.y}; v1 = (f32x4){c.x, c.y, d.x, d.y}; }
                    v0 = v0 * sc; v1 = v1 * sc; u32x4 w; w.x = cvt_pk_bf16(v0[0], v0[1]); w.y = cvt_pk_bf16(v0[2], v0[3]); w.z = cvt_pk_bf16(v1[0], v1[1]); w.w = cvt_pk_bf16(v1[2], v1[3]);
                    *(u32x4*)(rowp + bj * HALF) = w; } }
    }
};

template <class Epi, class Sched, bool ALIGN_EPI = false, bool SP2 = false>
__device__ __forceinline__ void gemm_phase(PG8_LAS unsigned char* lds, const Gemm g, const Sched& S, const Epi& E) {
    const int tid = threadIdx.x, wid = __builtin_amdgcn_readfirstlane(tid >> 6), lane = tid & 63, wr = wid >> 2, wc = wid & 3, fr = lane & 15, fq = lane >> 4;
    const int K = g.K, nt = K / BK;
    unsigned voffA[2], voffB[2];
#pragma unroll
    for (int i = 0; i < 2; ++i) { int R, C; stage_rc(tid * 16 + i * 8192, R, C); const int Rb = Epi::PERM ? ((R & ~31) + perm32(R & 31)) : R;
        voffA[i] = (unsigned)(R * g.lda + C) * 2u; voffB[i] = (unsigned)(Rb * K + C) * 2u; }
    const size_t kstep = (size_t)(BK * 2);
    const size_t hstep = (size_t)HALF * K * 2;
    const size_t tstep = 2 * hstep; const size_t hstepA = (size_t)HALF * g.lda * 2, tstepA = 2 * hstepA;
    const unsigned ldsw = (unsigned)wid * 1024u;
    const int aoff = lds_byte(wr * 64 + fr, fq * 8), boff = lds_byte(wc * 32 + fr, fq * 8);
#define PG8_SA(b, h) (((b) * 2 + (h)) * HTB)
#define PG8_SB(b, h) ((4 + (b) * 2 + (h)) * HTB)
#define PG8_STAGE(bufoff, gbase, voff) do { _Pragma("unroll") for (int _i = 0; _i < 2; ++_i) \
        __builtin_amdgcn_global_load_lds((const unsigned*)((const char*)(gbase) + (voff)[_i]), (PG8_LAS unsigned*)(lds + (bufoff) + ldsw + _i * 8192), 16, 0, 0); } while (0)
#define PG8_LDA(dst, b, h) do { _Pragma("unroll") for (int m = 0; m < 4; ++m) _Pragma("unroll") for (int k = 0; k < 2; ++k) dst[m][k] = *(const PG8_LAS bf16x8*)(lds + PG8_SA(b, h) + aoff + m * 2048 + k * 1024); } while (0)
#define PG8_LDB(dst, b, h) do { _Pragma("unroll") for (int n = 0; n < 2; ++n) _Pragma("unroll") for (int k = 0; k < 2; ++k) dst[n][k] = *(const PG8_LAS bf16x8*)(lds + PG8_SB(b, h) + boff + n * 2048 + k * 1024); } while (0)
#define PG8_MMA(ai, bj, At, Bt) do { __builtin_amdgcn_s_setprio(1); _Pragma("unroll") for (int m = 0; m < 4; ++m) _Pragma("unroll") for (int n = 0; n < 2; ++n) _Pragma("unroll") for (int k = 0; k < 2; ++k) \
        acc[ai][bj][m][n] = __builtin_amdgcn_mfma_f32_16x16x32_bf16(Bt[n][k], At[m][k], acc[ai][bj][m][n], 0, 0, 0); __builtin_amdgcn_s_setprio(0); } while (0)
#define PG8_WAIT_V(n) asm volatile("s_waitcnt vmcnt(" #n ")" ::: "memory")
#define PG8_WAIT_L(n) asm volatile("s_waitcnt lgkmcnt(" #n ")" ::: "memory")
#define PG8_BAR __builtin_amdgcn_s_barrier()
#define PG8_SCHED __builtin_amdgcn_sched_barrier(0)
    Unit cur, nxt; int ui = 0;
    if (!S.next(0, cur)) return;
    f32x4 acc[2][2][4][2];
#pragma unroll
    for (int a = 0; a < 2; ++a)
#pragma unroll
        for (int b = 0; b < 2; ++b)
#pragma unroll
            for (int m = 0; m < 4; ++m)
#pragma unroll
                for (int n = 0; n < 2; ++n) acc[a][b][m][n] = (f32x4){0.f, 0.f, 0.f, 0.f};
    bf16x8 At[4][2], B0[2][2], B1[2][2];
    const char* cA = (const char*)g.A + (size_t)cur.pm * tstepA; const char* cB = (const char*)g.Bt + (size_t)cur.pn * tstep;
    S.a_ready(cur);
    if constexpr (SP2) {
        PG8_STAGE(PG8_SB(0, 0), cB, voffB); PG8_STAGE(PG8_SB(0, 1), cB + hstep, voffB); PG8_STAGE(PG8_SA(0, 0), cA, voffA); PG8_STAGE(PG8_SA(0, 1), cA + hstepA, voffA);
        if (wr == 1) PG8_BAR;
        PG8_WAIT_V(2); PG8_BAR;
        PG8_STAGE(PG8_SB(1, 0), cB + kstep, voffB); PG8_STAGE(PG8_SA(1, 0), cA + kstep, voffA); PG8_STAGE(PG8_SB(1, 1), cB + hstep + kstep, voffB);
        PG8_WAIT_V(6); PG8_BAR;
    } else {
        PG8_STAGE(PG8_SB(0, 0), cB, voffB); PG8_STAGE(PG8_SA(0, 0), cA, voffA); PG8_STAGE(PG8_SB(0, 1), cB + hstep, voffB); PG8_STAGE(PG8_SA(0, 1), cA + hstepA, voffA);
        if (wr == 1) PG8_BAR;
        PG8_WAIT_V(4); PG8_BAR;
        PG8_STAGE(PG8_SB(1, 0), cB + kstep, voffB); PG8_STAGE(PG8_SA(1, 0), cA + kstep, voffA); PG8_STAGE(PG8_SB(1, 1), cB + hstep + kstep, voffB);
        PG8_WAIT_V(6); PG8_BAR;
    }
    for (;;) {
        const bool has_next = S.next(ui + 1, nxt);
        const char* nA = has_next ? (const char*)g.A + (size_t)nxt.pm * tstepA : cA; const char* nB = has_next ? (const char*)g.Bt + (size_t)nxt.pn * tstep : cB;
        for (int t = 0; t < nt; t += 2) {
            const bool last = (t == nt - 2);
            const char* a1 = cA + (size_t)(t + 1) * kstep;
            const char* a2 = last ? nA : cA + (size_t)(t + 2) * kstep; const char* b2 = last ? nB : cB + (size_t)(t + 2) * kstep;
            const char* a3 = a2 + kstep; const char* b3 = b2 + kstep;
            if (last && has_next) S.a_ready(nxt);
            if constexpr (SP2) {
            PG8_LDB(B0, 0, 0); PG8_LDB(B1, 0, 1); PG8_SCHED; PG8_LDA(At, 0, 0); PG8_STAGE(PG8_SA(1, 1), a1 + hstepA, voffA);
            PG8_WAIT_V(8); PG8_WAIT_L(0); PG8_BAR; PG8_MMA(0, 0, At, B0); PG8_MMA(0, 1, At, B1); PG8_BAR; PG8_SCHED;
            PG8_LDA(At, 0, 1); PG8_STAGE(PG8_SB(0, 0), b2, voffB); PG8_STAGE(PG8_SB(0, 1), b2 + hstep, voffB); PG8_STAGE(PG8_SA(0, 0), a2, voffA);
            PG8_WAIT_V(8); PG8_WAIT_L(0); PG8_BAR; PG8_MMA(1, 0, At, B0); PG8_MMA(1, 1, At, B1); PG8_BAR; PG8_SCHED;
            PG8_LDB(B0, 1, 0); PG8_LDB(B1, 1, 1); PG8_SCHED; PG8_LDA(At, 1, 0); PG8_STAGE(PG8_SA(0, 1), a2 + hstepA, voffA);
            PG8_WAIT_V(8); PG8_WAIT_L(0); PG8_BAR; PG8_MMA(0, 0, At, B0); PG8_MMA(0, 1, At, B1); PG8_BAR; PG8_SCHED;
            PG8_LDA(At, 1, 1); PG8_STAGE(PG8_SB(1, 0), b3, voffB); PG8_STAGE(PG8_SB(1, 1), b3 + hstep, voffB); PG8_STAGE(PG8_SA(1, 0), a3, voffA);
            PG8_WAIT_V(8); PG8_WAIT_L(0); PG8_BAR; PG8_MMA(1, 0, At, B0); PG8_MMA(1, 1, At, B1); PG8_BAR; PG8_SCHED;
            } else {
            PG8_LDB(B0, 0, 0); PG8_SCHED; PG8_LDA(At, 0, 0); PG8_STAGE(PG8_SA(1, 1), a1 + hstepA, voffA);
            PG8_WAIT_L(8); PG8_BAR; PG8_WAIT_L(0); PG8_MMA(0, 0, At, B0); PG8_BAR; PG8_SCHED;
            PG8_LDB(B1, 0, 1); PG8_STAGE(PG8_SB(0, 0), b2, voffB);
            PG8_BAR; PG8_WAIT_L(0); PG8_MMA(0, 1, At, B1); PG8_BAR;
            PG8_LDA(At, 0, 1); PG8_STAGE(PG8_SA(0, 0), a2, voffA);
            PG8_BAR; PG8_WAIT_L(0); PG8_MMA(1, 0, At, B0); PG8_BAR; PG8_SCHED;
            PG8_STAGE(PG8_SB(0, 1), b2 + hstep, voffB);
            PG8_WAIT_V(6); PG8_BAR; PG8_MMA(1, 1, At, B1); PG8_BAR;
            PG8_LDB(B0, 1, 0); PG8_SCHED; PG8_LDA(At, 1, 0); PG8_STAGE(PG8_SA(0, 1), a2 + hstepA, voffA);
            PG8_WAIT_L(8); PG8_BAR; PG8_WAIT_L(0); PG8_MMA(0, 0, At, B0); PG8_BAR; PG8_SCHED;
            PG8_LDB(B1, 1, 1); PG8_STAGE(PG8_SB(1, 0), b3, voffB);
            PG8_BAR; PG8_WAIT_L(0); PG8_MMA(0, 1, At, B1); PG8_BAR;
            PG8_LDA(At, 1, 1); PG8_STAGE(PG8_SA(1, 0), a3, voffA);
            PG8_BAR; PG8_WAIT_L(0); PG8_MMA(1, 0, At, B0); PG8_BAR; PG8_SCHED;
            PG8_STAGE(PG8_SB(1, 1), b3 + hstep, voffB);
            PG8_WAIT_V(6); PG8_BAR; PG8_MMA(1, 1, At, B1); PG8_BAR;
            }
        }
        if constexpr (ALIGN_EPI) { if (wr == 0) PG8_BAR; }
        if constexpr (!Epi::AFTER_DRAIN) { E(acc, cur, wr, wc, fr, fq); S.done(cur); }
        if (!has_next) break;
#pragma unroll
        for (int a = 0; a < 2; ++a)
#pragma unroll
            for (int b = 0; b < 2; ++b)
#pragma unroll
                for (int m = 0; m < 4; ++m)
#pragma unroll
                    for (int n = 0; n < 2; ++n) acc[a][b][m][n] = (f32x4){0.f, 0.f, 0.f, 0.f};
        cur = nxt; cA = nA; cB = nB; ++ui;
        if constexpr (ALIGN_EPI) { if (wr == 1) PG8_BAR; }
    }
    PG8_WAIT_V(0);
    if constexpr (!ALIGN_EPI) { if (wr == 0) PG8_BAR; }
    PG8_BAR;
    if constexpr (Epi::AFTER_DRAIN) { E.fused(acc, cur, wr, wc, fr, fq, lds, wid, lane); S.done(cur); }
#undef PG8_SA
#undef PG8_SB
#undef PG8_STAGE
#undef PG8_LDA
#undef PG8_LDB
#undef PG8_MMA
#undef PG8_WAIT_V
#undef PG8_WAIT_L
#undef PG8_BAR
#undef PG8_SCHED
}
}

#define DI __device__ __forceinline__
#define LAS __attribute__((address_space(3)))
typedef unsigned short bf16_t;
typedef short bf16x8 __attribute__((ext_vector_type(8)));
typedef short s16x4 __attribute__((ext_vector_type(4)));
typedef short v4i16_t __attribute__((ext_vector_type(4)));
typedef float f32x4 __attribute__((ext_vector_type(4)));
typedef unsigned u32x4 __attribute__((ext_vector_type(4)));
typedef unsigned u32x2 __attribute__((ext_vector_type(2)));

constexpr int NB = 2, SEQ = 8192, DM = 2048, MTOK = NB * SEQ, NPC = 7168, WIN_LD = 7184, DFF = 5632, NUP = 2 * DFF, NMOD = 6 * DM;
constexpr int LCH = 256, NCH = SEQ / LCH, EEXT = 272, ST_ELEMS = EEXT * 256, NCOMBO = 16;
constexpr float EPSN = 1e-6f;
#ifndef MK_PER_PHASE
#define MK_PER_PHASE 0
#endif
#ifndef GEMM_ALIGN
#define GEMM_ALIGN true
#endif
constexpr int NPH = 12;
constexpr int LDS_BYTES = 147456;

constexpr size_t OFF_P = 0;
constexpr size_t OFF_CST = OFF_P + (size_t)MTOK * NPC * 2;
constexpr size_t OFF_WIN = OFF_CST + (size_t)NCOMBO * NCH * ST_ELEMS * 2;
constexpr size_t OFF_WOUT = OFF_WIN + (size_t)NPC * DM * 2;
constexpr size_t OFF_R0END = OFF_WOUT + (size_t)DM * DM * 2;
constexpr size_t OFF_UG = 0;
constexpr size_t OFF_ACT = 0;
constexpr size_t OFF_EDGE = OFF_ACT + (size_t)MTOK * DFF * 2;
constexpr size_t OFF_X1B = OFF_EDGE + (size_t)3 * 64 * 2 * DFF * 4;
static_assert(OFF_X1B + (size_t)MTOK * DM * 2 <= OFF_CST + (size_t)NCOMBO * NCH * ST_ELEMS * 2, "x1b must stay below the weight copies that are still live in phase 6");
constexpr size_t OFF_WUP = OFF_UG + (size_t)MTOK * NUP * 2;
constexpr size_t OFF_WDN = OFF_WUP + (size_t)NUP * DM * 2;
constexpr size_t OFF_HB = OFF_WDN + (size_t)DM * DFF * 2;
constexpr size_t OFF_MOD = OFF_HB + (size_t)MTOK * DM * 2;
constexpr size_t OFF_GATES = OFF_MOD + 131072;
constexpr size_t OFF_UL = OFF_GATES + (size_t)MTOK * 16 * 4;
constexpr size_t OFF_ML = OFF_UL + (size_t)NCOMBO * SEQ * 4;
constexpr size_t OFF_EMT = OFF_ML + (size_t)NCOMBO * SEQ * 4;
constexpr size_t OFF_MPREV = OFF_EMT + (size_t)NCOMBO * SEQ * 4;
constexpr size_t OFF_MEND = OFF_MPREV + 4096;
constexpr size_t WS_NEED = OFF_MEND + 4096;
constexpr size_t OFF_BAR = WS_NEED + 4096;
constexpr size_t BAR_BYTES = 16384;
static_assert(OFF_R0END <= OFF_WUP, "overlay region");
static_assert(OFF_BAR + BAR_BYTES <= 536870912ull, "workspace budget");

struct Args {
    const float *x, *c, *w_ada, *b_ada, *g_norm1, *w_in, *b_gates, *g_head_a, *rpb, *w_out, *g_norm2, *w_up, *conv_w, *conv_b, *w_down, *g_final;
    float* out; unsigned char* ws; int ph_lo, ph_hi;
};

DI float bf2f(unsigned v) { return __uint_as_float(v << 16); }
DI unsigned f2bf(float f) { unsigned u = __float_as_uint(f); return (u + 0x7fffu + ((u >> 16) & 1u)) >> 16; }
typedef __bf16 bf16x2_hw __attribute__((ext_vector_type(2)));
typedef float f32x2_hw __attribute__((ext_vector_type(2)));
DI unsigned pk2(float lo, float hi) { const f32x2_hw v = {lo, hi}; const bf16x2_hw b = __builtin_convertvector(v, bf16x2_hw); return __builtin_bit_cast(unsigned, b); }
DI float wave_sum(float v) {
#pragma unroll
    for (int o = 1; o < 64; o <<= 1) v += __shfl_xor(v, o);
    return v;
}
DI s16x4 tr_read(const LAS unsigned char* p) { return __builtin_bit_cast(s16x4, __builtin_amdgcn_ds_read_tr16_b64_v4i16((LAS v4i16_t*)p)); }
DI bf16x8 tr_frag(const LAS unsigned char* base, int pitch, int rowA, int rowB, int col, int qin, int pin) {
    const s16x4 lo = tr_read(base + (rowA + qin) * pitch + (col + 4 * pin) * 2);
    const s16x4 hi = tr_read(base + (rowB + qin) * pitch + (col + 4 * pin) * 2);
    return (bf16x8){lo[0], lo[1], lo[2], lo[3], hi[0], hi[1], hi[2], hi[3]};
}
DI bf16x8 ld_frag(const LAS unsigned char* p) { return *(const LAS bf16x8*)p; }
#define MFMA16(a, b, c) __builtin_amdgcn_mfma_f32_16x16x32_bf16((a), (b), (c), 0, 0, 0)
DI bf16x8 pack8(const f32x4& a, const f32x4& b) {
    u32x4 w; w.x = pk2(a[0], a[1]); w.y = pk2(a[2], a[3]); w.z = pk2(b[0], b[1]); w.w = pk2(b[2], b[3]);
    return __builtin_bit_cast(bf16x8, w);
}
DI bf16x8 scale8(const bf16x8& q, float s) {
    const u32x4 u = __builtin_bit_cast(u32x4, q); u32x4 w;
#pragma unroll
    for (int i = 0; i < 4; ++i) w[i] = pk2(bf2f(u[i] & 0xffffu) * s, bf2f(u[i] >> 16) * s);
    return __builtin_bit_cast(bf16x8, w);
}
template <int ROWS, int COLS> DI void stage_tile(LAS unsigned char* dst, int lp, const bf16_t* src, int gp, int tid, int nthr) {
    constexpr int VPR = COLS / 8, NV = ROWS * VPR;
    int t0 = tid; asm volatile("" : "+v"(t0));
#pragma unroll 2
    for (int v = t0; v < NV; v += nthr) { const int r = v / VPR, cv = v % VPR;
        const u32x4 d = *(const u32x4*)(src + (r * gp + cv * 8)); *(LAS u32x4*)(dst + r * lp + cv * 16) = d; }
}

struct EpiResid {
    static constexpr bool PERM = false, AFTER_DRAIN = false;
    const float* res; float* out; const float* gate;
    __device__ __forceinline__ void operator()(const pg8::f32x4 (&acc)[2][2][4][2], const pg8::Unit& u, int wr, int wc, int fr, int fq) const {
        const int row0 = u.pm * 256 + wr * 64 + fr, col0 = u.pn * 256 + wc * 32 + 4 * fq, bb = u.pm >> 5;
        f32x4 gv[2][2];
#pragma unroll
        for (int bj = 0; bj < 2; ++bj)
#pragma unroll
            for (int n = 0; n < 2; ++n) gv[bj][n] = *(const f32x4*)(gate + (size_t)bb * NMOD + col0 + bj * 128 + n * 16);
#pragma unroll
        for (int ai = 0; ai < 2; ++ai)
#pragma unroll
            for (int m = 0; m < 4; ++m) { const size_t ro = (size_t)(row0 + ai * 128 + m * 16) * DM + col0;
#pragma unroll
                for (int bj = 0; bj < 2; ++bj)
#pragma unroll
                    for (int n = 0; n < 2; ++n) { const size_t o = ro + bj * 128 + n * 16; const f32x4 r = *(const f32x4*)(res + o); *(f32x4*)(out + o) = r + gv[bj][n] * acc[ai][bj][m][n]; } }
    }
};

template <bool RES_BF16> struct EpiResid16 {
    static constexpr bool PERM = true, AFTER_DRAIN = false;
    const void* res; bf16_t* out; const float* gate;
    __device__ __forceinline__ void operator()(const pg8::f32x4 (&acc)[2][2][4][2], const pg8::Unit& u, int wr, int wc, int fr, int fq) const {
        const int row0 = u.pm * 256 + wr * 64 + fr, col0 = u.pn * 256 + wc * 32 + 8 * fq, bb = u.pm >> 5;
        f32x4 gv[2][2];
#pragma unroll
        for (int bj = 0; bj < 2; ++bj)
#pragma unroll
            for (int n = 0; n < 2; ++n) gv[bj][n] = *(const f32x4*)(gate + (size_t)bb * NMOD + col0 + bj * 128 + 4 * n);
#pragma unroll
        for (int ai = 0; ai < 2; ++ai)
#pragma unroll
            for (int m = 0; m < 4; ++m) { const size_t ro = (size_t)(row0 + ai * 128 + m * 16) * DM + col0;
#pragma unroll
                for (int bj = 0; bj < 2; ++bj) { const size_t o = ro + bj * 128; f32x4 r0, r1;
                    if (RES_BF16) { const u32x4 rv = *(const u32x4*)((const bf16_t*)res + o);
                        r0 = (f32x4){bf2f(rv.x & 0xffffu), bf2f(rv.x >> 16), bf2f(rv.y & 0xffffu), bf2f(rv.y >> 16)}; r1 = (f32x4){bf2f(rv.z & 0xffffu), bf2f(rv.z >> 16), bf2f(rv.w & 0xffffu), bf2f(rv.w >> 16)}; }
                    else { r0 = *(const f32x4*)((const float*)res + o); r1 = *(const f32x4*)((const float*)res + o + 4); }
                    r0 = r0 + gv[bj][0] * acc[ai][bj][m][0]; r1 = r1 + gv[bj][1] * acc[ai][bj][m][1];
                    u32x4 w; w.x = pg8::cvt_pk_bf16(r0[0], r0[1]); w.y = pg8::cvt_pk_bf16(r0[2], r0[3]); w.z = pg8::cvt_pk_bf16(r1[0], r1[1]); w.w = pg8::cvt_pk_bf16(r1[2], r1[3]);
                    *(u32x4*)(out + o) = w; } }
    }
};

constexpr size_t EDGE_STRIDE = (size_t)64 * 2 * DFF;
struct EpiGlu {
    static constexpr bool PERM = true, AFTER_DRAIN = false;
    bf16_t* ACT; const float* cw; const float* cb; float* edge; LAS float* xg;
    __device__ __forceinline__ void operator()(const pg8::f32x4 (&acc)[2][2][4][2], const pg8::Unit& u, int wr, int wc, int fr, int fq) const {
        const int lane = threadIdx.x & 63, fl = wc * 32 + 8 * fq, f0 = u.pn * 128 + fl;
        float w0[8], w1[8], w2[8], bb[8];
#pragma unroll
        for (int k = 0; k < 8; k += 4) { const f32x4 a0 = *(const f32x4*)(cw + f0 + k), a1 = *(const f32x4*)(cw + DFF + f0 + k), a2 = *(const f32x4*)(cw + 2 * DFF + f0 + k), a3 = *(const f32x4*)(cb + f0 + k);
#pragma unroll
            for (int i = 0; i < 4; ++i) { w0[k + i] = a0[i]; w1[k + i] = a1[i]; w2[k + i] = a2[i]; bb[k + i] = a3[i]; } }
#pragma unroll
        for (int ai = 0; ai < 2; ++ai) { const int bi = 2 * ai + wr;
            if (fr == 0) { *(LAS f32x4*)(xg + bi * 128 + fl) = acc[ai][1][0][0]; *(LAS f32x4*)(xg + bi * 128 + fl + 4) = acc[ai][1][0][1]; }
            if (fr == 15) { *(LAS f32x4*)(xg + (4 + bi) * 128 + fl) = acc[ai][1][3][0]; *(LAS f32x4*)(xg + (4 + bi) * 128 + fl + 4) = acc[ai][1][3][1]; } }
        asm volatile("s_waitcnt lgkmcnt(0)" ::: "memory"); __builtin_amdgcn_s_barrier(); asm volatile("" ::: "memory");
#pragma unroll
        for (int ai = 0; ai < 2; ++ai) { const int bi = 2 * ai + wr;
            f32x4 xp[2], xn[2];
#pragma unroll
            for (int n = 0; n < 2; ++n) { xp[n] = (f32x4){0.f, 0.f, 0.f, 0.f}; xn[n] = (f32x4){0.f, 0.f, 0.f, 0.f};
                if (fr == 0 && bi > 0) xp[n] = *(const LAS f32x4*)(xg + (4 + bi - 1) * 128 + fl + 4 * n);
                if (fr == 15 && bi < 3) xn[n] = *(const LAS f32x4*)(xg + (bi + 1) * 128 + fl + 4 * n); }
            unsigned o[4][4];
#pragma unroll
            for (int n = 0; n < 2; ++n)
#pragma unroll
                for (int i = 0; i < 4; i += 2) {
                    float r[4][2];
#pragma unroll
                    for (int e = 0; e < 2; ++e) { const int k = 4 * n + i + e;
                        float g[4], up[4], dn[4];
#pragma unroll
                        for (int m = 0; m < 4; ++m) { g[m] = acc[ai][1][m][n][i + e];
                            up[m] = __int_as_float(__builtin_amdgcn_update_dpp(0, __float_as_int(g[m]), 0x121, 0xf, 0xf, false));
                            dn[m] = __int_as_float(__builtin_amdgcn_update_dpp(0, __float_as_int(g[m]), 0x12F, 0xf, 0xf, false)); }
#pragma unroll
                        for (int m = 0; m < 4; ++m) { const float pv = (fr == 0) ? (m > 0 ? up[m > 0 ? m - 1 : 0] : xp[n][i + e]) : up[m];
                            const float nv = (fr == 15) ? (m < 3 ? dn[m < 3 ? m + 1 : 3] : xn[n][i + e]) : dn[m];
                            r[m][e] = w0[k] * pv + w1[k] * g[m] + w2[k] * nv + bb[k]; } }
#pragma unroll
                    for (int m = 0; m < 4; ++m) { const pg8::f32x2 gl = pg8::gelu_pk((pg8::f32x2){r[m][0], r[m][1]});
                        const bool e0 = (bi == 0 && m == 0 && fr == 0), e1 = (bi == 3 && m == 3 && fr == 15);
                        if (e0 || e1) { float* ep = edge + ((size_t)(u.pm * 2 + (e1 ? 1 : 0)) * DFF + f0 + 4 * n + i);
                            ep[0] = r[m][0]; ep[1] = r[m][1]; ep[EDGE_STRIDE] = acc[ai][1][m][n][i]; ep[EDGE_STRIDE + 1] = acc[ai][1][m][n][i + 1];
                            ep[2 * EDGE_STRIDE] = acc[ai][0][m][n][i]; ep[2 * EDGE_STRIDE + 1] = acc[ai][0][m][n][i + 1]; }
                        o[m][2 * n + (i >> 1)] = pg8::cvt_pk_bf16(gl.x * acc[ai][0][m][n][i], gl.y * acc[ai][0][m][n][i + 1]); }
                }
#pragma unroll
            for (int m = 0; m < 4; ++m) { const int row = u.pm * 256 + ai * 128 + wr * 64 + m * 16 + fr;
                u32x4 w; w.x = o[m][0]; w.y = o[m][1]; w.z = o[m][2]; w.w = o[m][3];
                *(u32x4*)(ACT + (size_t)row * DFF + f0) = w; }
        }
    }
};
DI void glu_fixup(const Args& a, int pm, int tid) {
    const float* edge = (const float*)(a.ws + OFF_EDGE); bf16_t* ACT = (bf16_t*)(a.ws + OFF_ACT);
    constexpr int V4 = DFF / 4, NIT = (2 * V4 + 511) / 512;
    f32x4 part[NIT], uu[NIT], gn[NIT], cw[NIT]; bool has[NIT];
#pragma unroll
    for (int i = 0; i < NIT; ++i) { const int v = tid + 512 * i, e = (v >= V4) ? 1 : 0, f4 = (v - e * V4) * 4, t = pm * 256 + 255 * e; has[i] = false;
        part[i] = uu[i] = gn[i] = cw[i] = (f32x4){0.f, 0.f, 0.f, 0.f};
        if (v < 2 * V4) {
            part[i] = *(const f32x4*)(edge + (size_t)(pm * 2 + e) * DFF + f4); uu[i] = *(const f32x4*)(edge + 2 * EDGE_STRIDE + (size_t)(pm * 2 + e) * DFF + f4);
            if (e == 0) { if ((t & (SEQ - 1)) != 0) { has[i] = true; cw[i] = *(const f32x4*)(a.conv_w + f4); gn[i] = *(const f32x4*)(edge + EDGE_STRIDE + (size_t)((pm - 1) * 2 + 1) * DFF + f4); } }
            else { if (((t + 1) & (SEQ - 1)) != 0) { has[i] = true; cw[i] = *(const f32x4*)(a.conv_w + 2 * DFF + f4); gn[i] = *(const f32x4*)(edge + EDGE_STRIDE + (size_t)((pm + 1) * 2) * DFF + f4); } } } }
#pragma unroll
    for (int i = 0; i < NIT; ++i) { const int v = tid + 512 * i, e = (v >= V4) ? 1 : 0, f4 = (v - e * V4) * 4, t = pm * 256 + 255 * e;
        if (v < 2 * V4) { float r[4];
#pragma unroll
            for (int k = 0; k < 4; ++k) { const float g = part[i][k] + (has[i] ? cw[i][k] * gn[i][k] : 0.f); r[k] = 0.5f * g * (1.f + erff(g * 0.70710678118654752f)) * uu[i][k]; }
            u32x2 w; w.x = pk2(r[0], r[1]); w.y = pk2(r[2], r[3]); *(u32x2*)(ACT + (size_t)t * DFF + f4) = w; } }
}

DI void tr_block(const float* src, int ldw, bf16_t* dst, int ldd, float scale, LAS float* scr, int lane) {
#pragma unroll 8
    for (int i = 0; i < 32; ++i) { const int kk = 2 * i + (lane >> 5); scr[kk * 33 + (lane & 31)] = src[(size_t)kk * ldw + (lane & 31)]; }
    asm volatile("s_waitcnt lgkmcnt(0)" ::: "memory");
    const int c = lane & 7;
#pragma unroll
    for (int j = 0; j < 4; ++j) { const int n = (lane >> 3) + 8 * j; const LAS float* s = scr + (8 * c) * 33 + n;
        u32x4 o; o.x = pk2(s[0 * 33] * scale, s[1 * 33] * scale); o.y = pk2(s[2 * 33] * scale, s[3 * 33] * scale); o.z = pk2(s[4 * 33] * scale, s[5 * 33] * scale); o.w = pk2(s[6 * 33] * scale, s[7 * 33] * scale);
        *(u32x4*)(dst + (size_t)n * ldd + 8 * c) = o; }
    asm volatile("s_waitcnt lgkmcnt(0)" ::: "memory");
}
DI void phase0(const Args& a, LAS unsigned char* lds, int tid, int lane, int wave) {
    LAS float* sc = (LAS float*)lds;
    LAS float* red = sc + 4096;
    float* mod = (float*)(a.ws + OFF_MOD);
    for (int i = tid; i < 4096; i += 512) { const float v = a.c[i]; sc[i] = v / (1.f + __expf(-v)); }
    __syncthreads();
    for (int item = blockIdx.x; item < 256; item += gridDim.x) {
        const int n0 = item * 48;
        if (tid < 384) {
            const int cq = tid % 12, ks = tid / 12;
            f32x4 a0 = {0.f, 0.f, 0.f, 0.f}, a1 = {0.f, 0.f, 0.f, 0.f};
            const float* wp = a.w_ada + (size_t)(ks * 64) * NMOD + n0 + 4 * cq;
#pragma unroll 8
            for (int kk = 0; kk < 64; ++kk) { const f32x4 w = *(const f32x4*)(wp + (size_t)kk * NMOD); const float s0 = sc[ks * 64 + kk], s1 = sc[2048 + ks * 64 + kk]; a0 += s0 * w; a1 += s1 * w; }
            LAS float* rp = red + (ks * 12 + cq) * 8;
            *(LAS f32x4*)rp = a0; *(LAS f32x4*)(rp + 4) = a1;
        }
        __syncthreads();
        if (tid < 96) { const int cq = tid >> 3, j = tid & 7; float s = 0.f;
            for (int ks = 0; ks < 32; ++ks) s += red[(ks * 12 + cq) * 8 + j];
            const int bb = j >> 2, col = n0 + 4 * cq + (j & 3); mod[bb * NMOD + col] = s + a.b_ada[col]; }
        __syncthreads();
    }
    LAS float* scr = (LAS float*)(lds + 32768 + wave * 8448);
    bf16_t* WinT = (bf16_t*)(a.ws + OFF_WIN); bf16_t* WoutT = (bf16_t*)(a.ws + OFF_WOUT); bf16_t* WupT = (bf16_t*)(a.ws + OFF_WUP); bf16_t* WdnT = (bf16_t*)(a.ws + OFF_WDN);
    constexpr int I_IN = 32 * (NPC / 32), I_OUT = 32 * (DM / 32), I_UP = 32 * (NUP / 32), I_DN = (DFF / 64) * (DM / 32);
    const int gw = blockIdx.x * 8 + wave, NGW = gridDim.x * 8;
    for (int it = gw; it < I_IN + I_OUT + I_UP + I_DN; it += NGW) {
        int r = it;
        if (r < I_IN) { const int nblk = NPC / 32, kb = r / nblk, nb = r % nblk, n0 = nb * 32, ns = n0 < 4096 ? n0 : n0 + 16;
            tr_block(a.w_in + (size_t)(kb * 64) * WIN_LD + ns, WIN_LD, WinT + (size_t)n0 * DM + kb * 64, DM, (n0 >= 1024 && n0 < 2048) ? 0.0625f : 1.f, scr, lane); continue; }
        r -= I_IN;
        if (r < I_OUT) { const int nblk = DM / 32, kb = r / nblk, nb = r % nblk;
            tr_block(a.w_out + (size_t)(kb * 64) * DM + nb * 32, DM, WoutT + (size_t)(nb * 32) * DM + kb * 64, DM, 1.f, scr, lane); continue; }
        r -= I_OUT;
        if (r < I_UP) { const int nblk = NUP / 32, kb = r / nblk, nb = r % nblk, n0 = nb * 32, pn = n0 >> 8, j0 = n0 & 255, ns = (j0 < 128) ? pn * 128 + j0 : DFF + pn * 128 + j0 - 128;
            tr_block(a.w_up + (size_t)(kb * 64) * NUP + ns, NUP, WupT + (size_t)n0 * DM + kb * 64, DM, 1.f, scr, lane); continue; }
        r -= I_UP;
        { const int nblk = DM / 32, kb = r / nblk, nb = r % nblk;
            tr_block(a.w_down + (size_t)(kb * 64) * DM + nb * 32, DM, WdnT + (size_t)(nb * 32) * DFF + kb * 64, DFF, 1.f, scr, lane); }
    }
}

DI float gate_reduce16(float (&g16)[16], int lane) {
#pragma unroll
    for (int i = 0; i < 8; ++i) { const bool hi = lane & 32; const float snd = hi ? g16[i] : g16[i + 8], keep = hi ? g16[i + 8] : g16[i]; g16[i] = keep + __shfl_xor(snd, 32); }
#pragma unroll
    for (int i = 0; i < 4; ++i) { const bool hi = lane & 16; const float snd = hi ? g16[i] : g16[i + 4], keep = hi ? g16[i + 4] : g16[i]; g16[i] = keep + __shfl_xor(snd, 16); }
#pragma unroll
    for (int i = 0; i < 2; ++i) { const bool hi = lane & 8; const float snd = hi ? g16[i] : g16[i + 2], keep = hi ? g16[i + 2] : g16[i]; g16[i] = keep + __shfl_xor(snd, 8); }
    { const bool hi = lane & 4; const float snd = hi ? g16[0] : g16[1], keep = hi ? g16[1] : g16[0]; g16[0] = keep + __shfl_xor(snd, 4); }
    g16[0] += __shfl_xor(g16[0], 2); g16[0] += __shfl_xor(g16[0], 1);
    return g16[0];
}
template <bool GATES, bool IN_BF16> DI void phase_norm(const Args& a, LAS unsigned char* lds, const void* xin_, const float* gn, int sh_off, int sc_off, int tid, int lane, int wave) {
    const float* xin = (const float*)xin_; const bf16_t* xin16 = (const bf16_t*)xin_;
    const float* mod = (const float*)(a.ws + OFF_MOD);
    bf16_t* Hb = (bf16_t*)(a.ws + OFF_HB);
    float* gates = (float*)(a.ws + OFF_GATES);
    LAS float* wg = (LAS float*)lds;
    if (GATES) {
        __syncthreads();
        { f32x4 wv[16];
#pragma unroll
          for (int q = 0; q < 16; ++q) { const int v = tid + 512 * q, k = v >> 2, i4 = (v & 3) * 4; wv[q] = *(const f32x4*)(a.w_in + (size_t)k * WIN_LD + 4096 + i4); }
#pragma unroll
          for (int q = 0; q < 16; ++q) { const int v = tid + 512 * q, k = v >> 2, i4 = (v & 3) * 4;
              wg[(i4 + 0) * 2052 + k] = wv[q].x; wg[(i4 + 1) * 2052 + k] = wv[q].y; wg[(i4 + 2) * 2052 + k] = wv[q].z; wg[(i4 + 3) * 2052 + k] = wv[q].w; } }
        __syncthreads();
    }
    constexpr int R = GATES ? 2 : 4;
    const int gw = blockIdx.x * 8 + wave, NGW = gridDim.x * 8;
    int curb = -1; f32x4 gs[8], sh[8];
    for (int m = R * gw; m < MTOK; m += R * NGW) {
        const int bb = m >> 13;
        if (bb != curb) { curb = bb;
#pragma unroll
            for (int j = 0; j < 8; ++j) { const int k = 4 * lane + 256 * j; const f32x4 g = *(const f32x4*)(gn + k), s = *(const f32x4*)(mod + bb * NMOD + sc_off + k);
                gs[j] = g * (1.f + s); sh[j] = *(const f32x4*)(mod + bb * NMOD + sh_off + k); } }
        f32x4 v[R][8];
#pragma unroll
        for (int r = 0; r < R; ++r)
#pragma unroll
            for (int j = 0; j < 8; ++j) {
                if (IN_BF16) { const u32x2 p0 = *(const u32x2*)(xin16 + (size_t)(m + r) * DM + 4 * lane + 256 * j);
                    v[r][j] = (f32x4){bf2f(p0.x & 0xffffu), bf2f(p0.x >> 16), bf2f(p0.y & 0xffffu), bf2f(p0.y >> 16)}; }
                else v[r][j] = *(const f32x4*)(xin + (size_t)(m + r) * DM + 4 * lane + 256 * j); }
#pragma unroll
        for (int r = 0; r < R; ++r) { float ss = 0.f;
#pragma unroll
            for (int j = 0; j < 8; ++j) ss += (v[r][j].x * v[r][j].x + v[r][j].y * v[r][j].y) + (v[r][j].z * v[r][j].z + v[r][j].w * v[r][j].w);
            const float rstd = rsqrtf(wave_sum(ss) * (1.f / DM) + EPSN);
#pragma unroll
            for (int j = 0; j < 8; ++j) { v[r][j] = v[r][j] * rstd * gs[j] + sh[j];
                u32x2 o; o.x = pk2(v[r][j].x, v[r][j].y); o.y = pk2(v[r][j].z, v[r][j].w); *(u32x2*)(Hb + (size_t)(m + r) * DM + 4 * lane + 256 * j) = o; } }
        if (GATES) {
            float ga[16], gb[16];
#pragma unroll
            for (int i = 0; i < 16; ++i) { float s0 = 0.f, s1 = 0.f;
#pragma unroll
                for (int j = 0; j < 8; ++j) { const f32x4 w = *(const LAS f32x4*)(wg + i * 2052 + 4 * lane + 256 * j);
                    s0 += (v[0][j].x * w.x + v[0][j].y * w.y) + (v[0][j].z * w.z + v[0][j].w * w.w); s1 += (v[R - 1][j].x * w.x + v[R - 1][j].y * w.y) + (v[R - 1][j].z * w.z + v[R - 1][j].w * w.w); }
                ga[i] = s0; gb[i] = s1; __builtin_amdgcn_sched_barrier(0); }
            const float r0 = gate_reduce16(ga, lane), r1 = gate_reduce16(gb, lane);
            if ((lane & 3) == 0) { const int gi = ((lane >> 5) & 1) * 8 + ((lane >> 4) & 1) * 4 + ((lane >> 3) & 1) * 2 + ((lane >> 2) & 1); const float bg = a.b_gates[gi];
                gates[(size_t)m * 16 + gi] = r0 + bg; gates[(size_t)(m + 1) * 16 + gi] = r1 + bg; }
        }
    }
}

DI void gate_prep(const Args& a, LAS unsigned char* lds, int combo, int tid) {
    const float* gates = (const float*)(a.ws + OFF_GATES);
    float* ulA = (float*)(a.ws + OFF_UL); float* MlA = (float*)(a.ws + OFF_ML); float* emtA = (float*)(a.ws + OFF_EMT);
    float* mprevA = (float*)(a.ws + OFF_MPREV); float* mendA = (float*)(a.ws + OFF_MEND);
    LAS float* sT = (LAS float*)lds; LAS float* sM = sT + 512; LAS float* sG = sM + 512; LAS float* sX = sG + 32; LAS float* sMp = sX + 32; LAS float* sMe = sMp + 32;
    const int b = combo >> 3, dir = (combo >> 2) & 1, h = combo & 3;
    const int ci = dir * 8 + h, cf = dir * 8 + 4 + h, cs = tid >> 4;
    float li[16], bl[16], cm[16];
    float run = 0.f;
#pragma unroll
    for (int i = 0; i < 16; ++i) { const int tau = tid * 16 + i, t = dir ? SEQ - 1 - tau : tau; const float* gp = gates + (size_t)(b * SEQ + t) * 16;
        li[i] = gp[ci]; const float f = gp[cf]; const float lf = fminf(f, 0.f) - log1pf(__expf(-fabsf(f))); run += lf; bl[i] = run; }
    sT[tid] = run; __syncthreads();
    float base = 0.f;
#pragma unroll
    for (int j = 0; j < 16; ++j) { const float v = sT[cs * 16 + j]; base += (j < (tid & 15)) ? v : 0.f; }
    float mx = -3.0e38f;
#pragma unroll
    for (int i = 0; i < 16; ++i) { bl[i] += base; li[i] -= bl[i]; mx = fmaxf(mx, li[i]); cm[i] = mx; }
    sM[tid] = mx; __syncthreads();
    float mbase = -3.0e38f;
#pragma unroll
    for (int j = 0; j < 16; ++j) { const float v = sM[cs * 16 + j]; mbase = fmaxf(mbase, (j < (tid & 15)) ? v : -3.0e38f); }
    if (tid < 32) { float g = 0.f, xm = -3.0e38f;
#pragma unroll
        for (int j = 0; j < 16; ++j) { g += sT[tid * 16 + j]; xm = fmaxf(xm, sM[tid * 16 + j]); } sG[tid] = g; sX[tid] = xm; }
    __syncthreads();
    if (tid == 0) { float gx[32], xx[32];
#pragma unroll
        for (int c = 0; c < 32; ++c) { gx[c] = sG[c]; xx[c] = sX[c]; }
        float m = -1e30f;
#pragma unroll
        for (int c = 0; c < 32; ++c) { sMp[c] = m; const float me = fmaxf(m, xx[c]); sMe[c] = me; m = gx[c] + me; } }
    __syncthreads();
    const float mp = sMp[cs];
#pragma unroll
    for (int i = 0; i < 16; ++i) { const int tau = tid * 16 + i, t = dir ? SEQ - 1 - tau : tau; const float Ml = fmaxf(mp, fmaxf(cm[i], mbase));
        ulA[combo * SEQ + t] = li[i]; MlA[combo * SEQ + t] = Ml; emtA[combo * SEQ + t] = __expf(-(bl[i] + Ml)); }
    if ((tid & 15) == 0) { const int c = dir ? NCH - 1 - cs : cs; mprevA[combo * NCH + c] = mp; mendA[combo * NCH + c] = sMe[cs]; }
    __syncthreads();
}

DI void mlstm_delta(const Args& a, LAS unsigned char* lds, int tid, int lane, int wave) {
    const bf16_t* P = (const bf16_t*)(a.ws + OFF_P); bf16_t* cst = (bf16_t*)(a.ws + OFF_CST);
    const float* ulA = (const float*)(a.ws + OFF_UL); const float* mendA = (const float*)(a.ws + OFF_MEND);
    const int l15 = lane & 15, quad = lane >> 4, qin = l15 >> 2, pin = l15 & 3;
    constexpr int BUFB = 2 * 34816;
    LAS float* wS = (LAS float*)(lds + 2 * BUFB);
    const short one = (l15 == 0) ? (short)0x3F80 : (short)0;
    const bf16x8 ones = {one, one, one, one, one, one, one, one};
    for (int item = blockIdx.x; item < NCOMBO * NCH; item += gridDim.x) {
        const int combo = item / NCH, c = item % NCH, b = combo >> 3, h = combo & 3;
        const float mend = mendA[combo * NCH + c];
        __syncthreads();
        if (tid < 256) wS[tid] = __expf(ulA[combo * SEQ + c * LCH + tid] - mend);
        f32x4 acc[17][2];
#pragma unroll
        for (int m = 0; m < 17; ++m) { acc[m][0] = (f32x4){0.f, 0.f, 0.f, 0.f}; acc[m][1] = (f32x4){0.f, 0.f, 0.f, 0.f}; }
        const bf16_t* Pk = P + (size_t)(b * SEQ + c * LCH) * NPC + 1024 + h * 256;
        u32x4 pre[8];
#define DL_LOAD(sb_) do { int t0_ = tid; asm volatile("" : "+v"(t0_)); const bf16_t* src_ = Pk + (unsigned)(((sb_) * 64 + (t0_ >> 5)) * NPC + (t0_ & 31) * 8); \
        _Pragma("unroll") for (int i_ = 0; i_ < 4; ++i_) { pre[i_] = *(const u32x4*)(src_ + i_ * 16 * NPC); pre[4 + i_] = *(const u32x4*)(src_ + i_ * 16 * NPC + 1024); } } while (0)
#define DL_STORE(sb_) do { int t0_ = tid; asm volatile("" : "+v"(t0_)); LAS unsigned char* d_ = lds + ((sb_) & 1) * BUFB + (t0_ >> 5) * 544 + (t0_ & 31) * 16; \
        _Pragma("unroll") for (int i_ = 0; i_ < 4; ++i_) { const float w_ = wS[(sb_) * 64 + (t0_ >> 5) + 16 * i_]; \
            *(LAS bf16x8*)(d_ + i_ * 16 * 544) = scale8(__builtin_bit_cast(bf16x8, pre[i_]), w_); *(LAS u32x4*)(d_ + 34816 + i_ * 16 * 544) = pre[4 + i_]; } } while (0)
        DL_LOAD(0);
        __syncthreads();
        DL_STORE(0);
        __syncthreads();
#pragma unroll 1
        for (int sb = 0; sb < 4; ++sb) {
            const LAS unsigned char* Kt = lds + (sb & 1) * BUFB; const LAS unsigned char* Vt = Kt + 34816;
            if (sb + 1 < 4) DL_LOAD(sb + 1);
#pragma unroll 1
            for (int kk = 0; kk < 2; ++kk) {
                bf16x8 bfr[2];
#pragma unroll
                for (int n = 0; n < 2; ++n) bfr[n] = tr_frag(Kt, 544, kk * 32 + 4 * quad, kk * 32 + 16 + 4 * quad, wave * 32 + n * 16, qin, pin);
#pragma unroll
                for (int m = 0; m < 16; ++m) { const bf16x8 afr = tr_frag(Vt, 544, kk * 32 + 4 * quad, kk * 32 + 16 + 4 * quad, m * 16, qin, pin);
                    acc[m][0] = MFMA16(bfr[0], afr, acc[m][0]); acc[m][1] = MFMA16(bfr[1], afr, acc[m][1]); if ((m & 3) == 3) __builtin_amdgcn_sched_barrier(0); }
                acc[16][0] = MFMA16(bfr[0], ones, acc[16][0]); acc[16][1] = MFMA16(bfr[1], ones, acc[16][1]);
            }
            if (sb + 1 < 4) DL_STORE(sb + 1);
            __syncthreads();
        }
#undef DL_LOAD
#undef DL_STORE
        int loff = l15 * 256 + wave * 32 + 4 * quad; asm volatile("" : "+v"(loff));
        bf16_t* dst = cst + (size_t)item * ST_ELEMS + loff;
#pragma unroll
        for (int m = 0; m < 17; ++m) {
#pragma unroll
            for (int n = 0; n < 2; ++n) { u32x2 w; w.x = pk2(acc[m][n][0], acc[m][n][1]); w.y = pk2(acc[m][n][2], acc[m][n][3]); *(u32x2*)(dst + (16 * m) * 256 + 16 * n) = w; }
            __builtin_amdgcn_sched_barrier(0); }
    }
}

DI void mlstm_scan(const Args& a, int tid) {
    bf16_t* cst = (bf16_t*)(a.ws + OFF_CST);
    const float* mprevA = (const float*)(a.ws + OFF_MPREV); const float* mendA = (const float*)(a.ws + OFF_MEND);
    constexpr int VPS = ST_ELEMS / 8;
    const int gt = blockIdx.x * 512 + tid, NT = gridDim.x * 512;
    for (int v = gt; v < NCOMBO * VPS; v += NT) {
        const int combo = v / VPS, vi = v % VPS, dir = (combo >> 2) & 1;
        float st[8];
#pragma unroll
        for (int i = 0; i < 8; ++i) st[i] = 0.f;
        bf16_t* base = cst + (size_t)combo * NCH * ST_ELEMS + vi * 8;
        for (int cs0 = 0; cs0 < NCH; cs0 += 8) {
            u32x4 d[8]; float dec[8];
#pragma unroll
            for (int q = 0; q < 8; ++q) { const int c = dir ? NCH - 1 - (cs0 + q) : cs0 + q;
                d[q] = *(const u32x4*)(base + (size_t)c * ST_ELEMS); dec[q] = __expf(mprevA[combo * NCH + c] - mendA[combo * NCH + c]); }
#pragma unroll
            for (int q = 0; q < 8; ++q) { const int c = dir ? NCH - 1 - (cs0 + q) : cs0 + q;
                u32x4 o;
#pragma unroll
                for (int i = 0; i < 4; ++i) { o[i] = pk2(st[2 * i], st[2 * i + 1]); st[2 * i] = dec[q] * st[2 * i] + bf2f(d[q][i] & 0xffffu); st[2 * i + 1] = dec[q] * st[2 * i + 1] + bf2f(d[q][i] >> 16); }
                *(u32x4*)(base + (size_t)c * ST_ELEMS) = o; }
        }
    }
}

DI void nat_scores(f32x4 (&st)[4][2], const LAS unsigned char* T, const bf16x8 (&qf)[4], int kc0, int l15, int quad) {
#pragma unroll
    for (int k4 = 0; k4 < 4; ++k4)
#pragma unroll
        for (int mi = 0; mi < 2; ++mi) { f32x4 s = {0.f, 0.f, 0.f, 0.f};
#pragma unroll
            for (int ks = 0; ks < 4; ++ks) { s = MFMA16(ld_frag(T + (k4 * 64 + kc0 + 16 * mi + l15) * 272 + (ks * 32 + quad * 8) * 2), qf[ks], s); if (ks == 1) __builtin_amdgcn_sched_barrier(0); }
            st[k4][mi] = s; __builtin_amdgcn_sched_barrier(0); }
}
DI float nat_mask(f32x4 (&st)[4][2], const LAS float* rpbS, int kr0, int rs, int r, const bool (&sel)[4], const int (&dcb)[4], float scale) {
    float mx = -3.0e38f;
#pragma unroll
    for (int k4 = 0; k4 < 4; ++k4) { const int dr = rs + kr0 + k4 - r + 7;
#pragma unroll
        for (int rr = 0; rr < 4; ++rr) { const float sv = (sel[rr] ? st[k4][0][rr] : st[k4][1][rr]) * scale + rpbS[dr * 31 + dcb[rr]]; st[k4][0][rr] = sv; mx = fmaxf(mx, sv); } }
    mx = fmaxf(mx, __shfl_xor(mx, 16)); mx = fmaxf(mx, __shfl_xor(mx, 32));
    return mx;
}
DI float nat_exp(bf16x8 (&pf)[4], f32x4 (&st)[4][2], const bool (&sel)[4], float m) {
    float sum = 0.f;
#pragma unroll
    for (int k4 = 0; k4 < 4; ++k4) { f32x4 p0, p1;
#pragma unroll
        for (int rr = 0; rr < 4; ++rr) { const float p = __expf(st[k4][0][rr] - m); sum += p; p0[rr] = sel[rr] ? p : 0.f; p1[rr] = sel[rr] ? 0.f : p; }
        pf[k4] = pack8(p0, p1); }
    return sum;
}
DI void nat_pv(f32x4 (&o)[8], const bf16x8 (&pf)[4], const LAS unsigned char* T, int kc0, int quad, int qin, int pin) {
#pragma unroll
    for (int k4 = 0; k4 < 4; ++k4) {
#pragma unroll
        for (int n = 0; n < 8; ++n) { o[n] = MFMA16(tr_frag(T + k4 * 64 * 272, 272, kc0 + 4 * quad, kc0 + 16 + 4 * quad, 16 * n, qin, pin), pf[k4], o[n]); if ((n & 3) == 3) __builtin_amdgcn_sched_barrier(0); } }
}
DI void natten(const Args& a, LAS unsigned char* lds, int tid, int lane, int wave) {
    const bf16_t* P = (const bf16_t*)(a.ws + OFF_P); bf16_t* mixed = (bf16_t*)(a.ws + OFF_HB);
    const int l15 = lane & 15, quad = lane >> 4, qin = l15 >> 2, pin = l15 & 3;
    const int hw = wave >> 2, j = wave & 3, htid = tid & 255;
    LAS unsigned char* T = lds + hw * 69632;
    LAS float* rpbS = (LAS float*)(lds + 139264) + hw * 480;
    const int kc0 = (j == 0) ? 0 : (j == 1) ? 8 : (j == 2) ? 24 : 32;
    const float scale = 0.08838834764831845f;
    const int nit = (1024 - (int)blockIdx.x + (int)gridDim.x - 1) / (int)gridDim.x;
    if (nit <= 0) return;
    __syncthreads();
    { const int h0 = (blockIdx.x & 3) * 2 + hw; for (int i = htid; i < 465; i += 256) rpbS[i] = a.rpb[h0 * 465 + i]; }
    u32x4 pre[16];
    const bool xmap = (gridDim.x == 256);
#define NAT_ITEM(k_) (xmap ? ((((int)blockIdx.x & 7) >> 2) << 9) | ((32 * (k_) + ((int)blockIdx.x >> 3)) << 2) | ((int)blockIdx.x & 3) : (int)blockIdx.x + (k_) * (int)gridDim.x)
#define NAT_LOAD(g_) do { const int it_ = NAT_ITEM((g_) >> 2), sp_ = (g_) & 3; const int b_ = it_ >> 9, r_ = (it_ >> 2) & 127, h_ = (it_ & 3) * 2 + hw; \
        const int rs_ = min(max(r_ - 4, 0), 120); int t0_ = htid; asm volatile("" : "+v"(t0_)); \
        const bf16_t* src_ = P + (unsigned)((b_ * SEQ + (rs_ + 4 * (sp_ & 1)) * 64) * NPC + ((sp_ >> 1) ? 6144 : 5120) + h_ * 128 + ((t0_ >> 4) * NPC + (t0_ & 15) * 8)); \
        _Pragma("unroll") for (int i_ = 0; i_ < 16; ++i_) pre[i_] = *(const u32x4*)(src_ + i_ * 16 * NPC); } while (0)
#define NAT_STORE() do { int t0_ = htid; asm volatile("" : "+v"(t0_)); LAS unsigned char* d_ = T + (t0_ >> 4) * 272 + (t0_ & 15) * 16; \
        _Pragma("unroll") for (int i_ = 0; i_ < 16; ++i_) *(LAS u32x4*)(d_ + i_ * 16 * 272) = pre[i_]; } while (0)
    NAT_LOAD(0); NAT_STORE();
    __syncthreads();
#pragma unroll 1
    for (int k = 0; k < nit; ++k) {
        const int item = NAT_ITEM(k);
        const int b = item >> 9, r = (item >> 2) & 127, h = (item & 3) * 2 + hw;
        int l15g = l15; asm volatile("" : "+v"(l15g));
        const int rs = min(max(r - 4, 0), 120), qcol = 16 * j + l15g;
        const int tokq = b * SEQ + r * 64 + qcol;
        bf16x8 qf[4]; f32x4 st[4][2]; bf16x8 pf0[4], pf1[4];
#pragma unroll
        for (int ks = 0; ks < 4; ++ks) qf[ks] = *(const bf16x8*)(P + (unsigned)(tokq * NPC + 4096 + h * 128 + ks * 32 + quad * 8));
        const int cs = min(max(qcol - 8, 0), 48);
        bool sel[4]; int dcb[4];
#pragma unroll
        for (int rr = 0; rr < 4; ++rr) { sel[rr] = (4 * quad + rr >= cs - kc0); dcb[rr] = kc0 + 4 * quad + rr + (sel[rr] ? 0 : 16) - qcol + 15; }
        NAT_LOAD(4 * k + 1);
        nat_scores(st, T, qf, kc0, l15, quad);
        const float m0 = nat_mask(st, rpbS, 0, rs, r, sel, dcb, scale);
        float sum0 = nat_exp(pf0, st, sel, m0);
        __syncthreads(); NAT_STORE(); __syncthreads();
        NAT_LOAD(4 * k + 2);
        nat_scores(st, T, qf, kc0, l15, quad);
        const float m1 = nat_mask(st, rpbS, 4, rs, r, sel, dcb, scale);
        const float M = fmaxf(m0, m1), f0 = __expf(m0 - M);
        float sum1 = nat_exp(pf1, st, sel, M);
        float tot = sum0 * f0 + sum1;
        tot += __shfl_xor(tot, 16); tot += __shfl_xor(tot, 32);
        const float inv = 1.f / tot;
        __syncthreads(); NAT_STORE(); __syncthreads();
        f32x4 o[8];
#pragma unroll
        for (int n = 0; n < 8; ++n) o[n] = (f32x4){0.f, 0.f, 0.f, 0.f};
        NAT_LOAD(4 * k + 3);
        nat_pv(o, pf0, T, kc0, quad, qin, pin);
#pragma unroll
        for (int n = 0; n < 8; ++n) o[n] = o[n] * f0;
        __syncthreads(); NAT_STORE(); __syncthreads();
        if (k + 1 < nit) NAT_LOAD(4 * k + 4);
        nat_pv(o, pf1, T, kc0, quad, qin, pin);
#pragma unroll
        for (int n = 0; n < 8; ++n) { u32x2 w; w.x = pk2(o[n][0] * inv, o[n][1] * inv); w.y = pk2(o[n][2] * inv, o[n][3] * inv);
            *(u32x2*)(mixed + (unsigned)(tokq * DM + 1024 + h * 128 + 16 * n + 4 * quad)) = w; }
        __syncthreads();
        if (k + 1 < nit) NAT_STORE();
        __syncthreads();
    }
#undef NAT_LOAD
#undef NAT_ITEM
#undef NAT_STORE
}

DI void mlstm_out(const Args& a, LAS unsigned char* lds, int tid, int lane, int wave) {
    const bf16_t* P = (const bf16_t*)(a.ws + OFF_P); const bf16_t* cst = (const bf16_t*)(a.ws + OFF_CST); bf16_t* mixed = (bf16_t*)(a.ws + OFF_HB);
    const float* ulA = (const float*)(a.ws + OFF_UL); const float* MlA = (const float*)(a.ws + OFF_ML); const float* emtA = (const float*)(a.ws + OFF_EMT);
    const float* mprevA = (const float*)(a.ws + OFF_MPREV);
    const int l15 = lane & 15, quad = lane >> 4, qin = l15 >> 2, pin = l15 & 3;
    constexpr int BUFB = 33792 + 34816;
    LAS float* ulS2 = (LAS float*)(lds + 2 * BUFB);
    const short one = (l15 == 0) ? (short)0x3F80 : (short)0;
    const bf16x8 ones = {one, one, one, one, one, one, one, one};
    for (int item = blockIdx.x; item < 512; item += gridDim.x) {
        const int bh = item >> 6, c = (item >> 1) & 31, half = item & 1, b = bh >> 2, h = bh & 3;
        int l15i = l15, tt = tid; asm volatile("" : "+v"(l15i), "+v"(tt));
        const int t_loc = 128 * half + 16 * wave + l15i;
        const size_t tok = (size_t)b * SEQ + c * LCH + t_loc;
        const int n0 = 2 * half + 2;
        __syncthreads();
        { const int d = tt >> 8; ulS2[tt] = ulA[((b * 2 + d) * 4 + h) * SEQ + c * LCH + (tt & 255)]; }
        u32x4 pre[8];
#define STEP_DEC(s_, dir_, st_, idx_) do { int r_ = (s_); dir_ = 0; if (r_ >= n0 + 4) { r_ -= n0 + 4; dir_ = 1; } const int nk_ = dir_ ? 4 - 2 * half : n0; st_ = (r_ >= nk_); idx_ = st_ ? r_ - nk_ : (dir_ ? 2 * half + r_ : r_); } while (0)
#define STEP_LOAD(s_) do { int dir_, st_, idx_; STEP_DEC(s_, dir_, st_, idx_); int t0_ = tid; asm volatile("" : "+v"(t0_)); \
        if (!st_) { const bf16_t* src_ = P + ((size_t)b * SEQ + c * LCH + 64 * idx_) * NPC + 1024 + h * 256 + ((t0_ >> 5) * NPC + (t0_ & 31) * 8); \
            _Pragma("unroll") for (int i_ = 0; i_ < 4; ++i_) { pre[i_] = *(const u32x4*)(src_ + i_ * 16 * NPC); pre[4 + i_] = *(const u32x4*)(src_ + i_ * 16 * NPC + 1024); } } \
        else { const bf16_t* src_ = cst + (size_t)(((b * 2 + dir_) * 4 + h) * NCH + c) * ST_ELEMS + 64 * idx_ + ((t0_ >> 3) * 256 + (t0_ & 7) * 8); \
            _Pragma("unroll") for (int i_ = 0; i_ < 4; ++i_) pre[i_] = *(const u32x4*)(src_ + i_ * 64 * 256); \
            if (t0_ < 128) pre[4] = *(const u32x4*)(src_ + 4 * 64 * 256); } } while (0)
#define STEP_STORE(s_) do { int dir_, st_, idx_; STEP_DEC(s_, dir_, st_, idx_); LAS unsigned char* bp_ = lds + ((s_) & 1) * BUFB; int t0_ = tid; asm volatile("" : "+v"(t0_)); \
        if (!st_) { LAS unsigned char* d_ = bp_ + (t0_ >> 5) * 528 + (t0_ & 31) * 16; \
            _Pragma("unroll") for (int i_ = 0; i_ < 4; ++i_) { *(LAS u32x4*)(d_ + i_ * 16 * 528) = pre[i_]; *(LAS u32x4*)(bp_ + 33792 + ((t0_ >> 5) + 16 * i_) * 544 + (t0_ & 31) * 16) = pre[4 + i_]; } } \
        else { LAS unsigned char* d_ = bp_ + (t0_ >> 3) * 144 + (t0_ & 7) * 16; \
            _Pragma("unroll") for (int i_ = 0; i_ < 4; ++i_) *(LAS u32x4*)(d_ + i_ * 64 * 144) = pre[i_]; \
            if (t0_ < 128) *(LAS u32x4*)(d_ + 4 * 64 * 144) = pre[4]; } } while (0)
        bf16x8 qf[8];
        { int qo = h * 256 + quad * 8; asm volatile("" : "+v"(qo)); const bf16_t* qp = P + tok * NPC + qo;
#pragma unroll
          for (int ks = 0; ks < 8; ++ks) qf[ks] = *(const bf16x8*)(qp + ks * 32); }
        STEP_LOAD(0); STEP_STORE(0);
        __syncthreads();
        f32x4 acc[17]; float Ml = 0.f, emt = 1.f, aa = 0.f;
#pragma unroll 1
        for (int s = 0; s < 14; ++s) {
            int dir, st, idx; STEP_DEC(s, dir, st, idx);
            const LAS unsigned char* T0 = lds + (s & 1) * BUFB; const LAS unsigned char* T1 = T0 + 33792;
            const LAS float* ulS = ulS2 + dir * 256;
            if (s == 0 || s == n0 + 4) {
                const int combo = (b * 2 + dir) * 4 + h;
                Ml = MlA[combo * SEQ + c * LCH + t_loc]; emt = emtA[combo * SEQ + c * LCH + t_loc]; aa = __expf(mprevA[combo * NCH + c] - Ml);
#pragma unroll
                for (int m = 0; m < 17; ++m) acc[m] = (f32x4){0.f, 0.f, 0.f, 0.f};
            }
            if (s + 1 < 14) STEP_LOAD(s + 1);
            if (!st && (dir ? (64 * idx + 63 >= 128 * half + 16 * wave) : (64 * idx <= 128 * half + 16 * wave + 15))) {
                const int jb = idx;
                f32x4 sc[4];
#pragma unroll
                for (int mi = 0; mi < 4; ++mi) sc[mi] = (f32x4){0.f, 0.f, 0.f, 0.f};
#pragma unroll
                for (int mi = 0; mi < 4; ++mi) {
#pragma unroll
                    for (int ks = 0; ks < 8; ++ks) { sc[mi] = MFMA16(ld_frag(T0 + (16 * mi + l15) * 528 + (32 * ks + 8 * quad) * 2), qf[ks], sc[mi]); if (ks == 3) __builtin_amdgcn_sched_barrier(0); }
                    __builtin_amdgcn_sched_barrier(0); }
#pragma unroll
                for (int mi = 0; mi < 4; ++mi) { const int s0 = 64 * jb + 16 * mi + 4 * quad; const f32x4 uv = *(const LAS f32x4*)(ulS + s0);
#pragma unroll
                    for (int rr = 0; rr < 4; ++rr) { const int s_loc = s0 + rr; const bool valid = dir ? (s_loc >= t_loc) : (s_loc <= t_loc);
                        const float e = __expf(fminf(uv[rr] - Ml, 0.f)); sc[mi][rr] *= valid ? e : 0.f; } }
#pragma unroll
                for (int kk = 0; kk < 2; ++kk) { const bf16x8 pf = pack8(sc[2 * kk], sc[2 * kk + 1]);
                    bf16x8 f0 = tr_frag(T1, 544, 32 * kk + 4 * quad, 32 * kk + 16 + 4 * quad, 0, qin, pin), f1 = tr_frag(T1, 544, 32 * kk + 4 * quad, 32 * kk + 16 + 4 * quad, 16, qin, pin);
#pragma unroll
                    for (int n = 0; n < 16; n += 2) {
                        bf16x8 g0 = f0, g1 = f1;
                        if (n + 2 < 16) { g0 = tr_frag(T1, 544, 32 * kk + 4 * quad, 32 * kk + 16 + 4 * quad, 16 * (n + 2), qin, pin); g1 = tr_frag(T1, 544, 32 * kk + 4 * quad, 32 * kk + 16 + 4 * quad, 16 * (n + 3), qin, pin); }
                        acc[n] = MFMA16(f0, pf, acc[n]); acc[n + 1] = MFMA16(f1, pf, acc[n + 1]);
                        f0 = g0; f1 = g1; __builtin_amdgcn_sched_barrier(0); }
                    acc[16] = MFMA16(ones, pf, acc[16]); }
            } else if (st) {
                const int db = idx;
                bf16x8 aq[2];
                aq[0] = (db == 0) ? qf[0] : (db == 1) ? qf[2] : (db == 2) ? qf[4] : qf[6];
                aq[1] = (db == 0) ? qf[1] : (db == 1) ? qf[3] : (db == 2) ? qf[5] : qf[7];
                aq[0] = scale8(aq[0], aa); aq[1] = scale8(aq[1], aa);
#pragma unroll
                for (int kk = 0; kk < 2; ++kk) {
                    const LAS unsigned char* sp = T0 + l15 * 144 + (32 * kk + 8 * quad) * 2;
                    bf16x8 f0 = ld_frag(sp), f1 = ld_frag(sp + 16 * 144);
#pragma unroll
                    for (int m = 0; m < 16; m += 2) {
                        bf16x8 g0 = f0, g1 = f1;
                        if (m + 2 < 17) g0 = ld_frag(sp + 16 * (m + 2) * 144);
                        if (m + 3 < 17) g1 = ld_frag(sp + 16 * (m + 3) * 144);
                        acc[m] = MFMA16(f0, aq[kk], acc[m]); acc[m + 1] = MFMA16(f1, aq[kk], acc[m + 1]);
                        f0 = g0; f1 = g1; __builtin_amdgcn_sched_barrier(0); }
                    acc[16] = MFMA16(f0, aq[kk], acc[16]); }
            }
            if (s + 1 < 14) STEP_STORE(s + 1);
            if (s == n0 + 3 || s == 13) {
                const float den = __shfl(acc[16][0], l15);
                const float dn = 1.f / fmaxf(fabsf(den), emt);
                int moff = h * 256 + 4 * quad; asm volatile("" : "+v"(moff));
                bf16_t* mrow = mixed + tok * DM + moff;
                if (dir == 0) {
#pragma unroll
                    for (int n = 0; n < 16; ++n) { u32x2 w; w.x = pk2(acc[n][0] * dn, acc[n][1] * dn); w.y = pk2(acc[n][2] * dn, acc[n][3] * dn); *(u32x2*)(mrow + 16 * n) = w; }
                } else {
                    float ss = 0.f;
#pragma unroll
                    for (int n = 0; n < 16; ++n) { const u32x2 hf = *(const u32x2*)(mrow + 16 * n);
                        acc[n][0] = acc[n][0] * dn + bf2f(hf.x & 0xffffu); acc[n][1] = acc[n][1] * dn + bf2f(hf.x >> 16);
                        acc[n][2] = acc[n][2] * dn + bf2f(hf.y & 0xffffu); acc[n][3] = acc[n][3] * dn + bf2f(hf.y >> 16);
                        ss += (acc[n][0] * acc[n][0] + acc[n][1] * acc[n][1]) + (acc[n][2] * acc[n][2] + acc[n][3] * acc[n][3]); if ((n & 3) == 3) __builtin_amdgcn_sched_barrier(0); }
                    ss += __shfl_xor(ss, 16); ss += __shfl_xor(ss, 32);
                    const float rstd = rsqrtf(ss * (1.f / 256.f) + EPSN);
                    __builtin_amdgcn_sched_barrier(0);
                    int eb = h * 256 + 4 * quad; asm volatile("" : "+v"(eb));
                    const float* gp = a.g_head_a + eb; const bf16_t* ovp = P + tok * NPC + 3072 + eb;
#pragma unroll
                    for (int n = 0; n < 16; ++n) { const f32x4 g = *(const f32x4*)(gp + 16 * n);
                        const u32x2 ov = *(const u32x2*)(ovp + 16 * n);
                        const float o0 = bf2f(ov.x & 0xffffu), o1 = bf2f(ov.x >> 16), o2 = bf2f(ov.y & 0xffffu), o3 = bf2f(ov.y >> 16);
                        u32x2 w; w.x = pk2(acc[n][0] * rstd * g.x * __builtin_amdgcn_rcpf(1.f + __expf(-o0)), acc[n][1] * rstd * g.y * __builtin_amdgcn_rcpf(1.f + __expf(-o1)));
                        w.y = pk2(acc[n][2] * rstd * g.z * __builtin_amdgcn_rcpf(1.f + __expf(-o2)), acc[n][3] * rstd * g.w * __builtin_amdgcn_rcpf(1.f + __expf(-o3)));
                        *(u32x2*)(mrow + 16 * n) = w; __builtin_amdgcn_sched_barrier(0); }
                }
            }
            __syncthreads();
        }
#undef STEP_DEC
#undef STEP_LOAD
#undef STEP_STORE
    }
}

DI void phase_act(const Args& a, int tid) {
    bf16_t* UG = (bf16_t*)(a.ws + OFF_UG);
    constexpr int NV = DFF / 8, RUN = 16, NRUN = MTOK / RUN;
    const int gt = blockIdx.x * 512 + tid, NT = gridDim.x * 512;
    for (int it = gt; it < NRUN * NV; it += NT) {
        const int vv = it % NV, run = it / NV, f0 = vv * 8, t0 = run * RUN;
        float w0[8], w1[8], w2[8], cb[8];
#pragma unroll
        for (int i = 0; i < 8; ++i) { w0[i] = a.conv_w[f0 + i]; w1[i] = a.conv_w[DFF + f0 + i]; w2[i] = a.conv_w[2 * DFF + f0 + i]; cb[i] = a.conv_b[f0 + i]; }
        const u32x4 zero = {0u, 0u, 0u, 0u};
        const bf16_t* G = UG + DFF + f0;
        u32x4 gp = ((t0 & (SEQ - 1)) == 0) ? zero : *(const u32x4*)(G + (size_t)(t0 - 1) * NUP);
        u32x4 gc = *(const u32x4*)(G + (size_t)t0 * NUP);
        for (int i = 0; i < RUN; ++i) { const int t = t0 + i;
            const u32x4 gn = (((t + 1) & (SEQ - 1)) == 0) ? zero : *(const u32x4*)(G + (size_t)(t + 1) * NUP);
            const u32x4 uv = *(const u32x4*)(UG + (size_t)t * NUP + f0);
            u32x4 o;
#pragma unroll
            for (int q = 0; q < 4; ++q) { float r[2];
#pragma unroll
                for (int e = 0; e < 2; ++e) { const int k = 2 * q + e; const unsigned sh = e ? 16u : 0u;
                    const float g = w0[k] * bf2f((gp[q] >> sh) & 0xffffu) + w1[k] * bf2f((gc[q] >> sh) & 0xffffu) + w2[k] * bf2f((gn[q] >> sh) & 0xffffu) + cb[k];
                    r[e] = 0.5f * g * (1.f + erff(g * 0.70710678118654752f)) * bf2f((uv[q] >> sh) & 0xffffu); }
                o[q] = pk2(r[0], r[1]); }
            *(u32x4*)(UG + (size_t)t * NUP + f0) = o;
            gp = gc; gc = gn; }
    }
}

DI void phase_final(const Args& a, int lane, int wave) {
    const bf16_t* x2 = (const bf16_t*)(a.ws + OFF_X1B);
    const int gw = blockIdx.x * 8 + wave, NGW = gridDim.x * 8;
    f32x4 g[8];
#pragma unroll
    for (int j = 0; j < 8; ++j) g[j] = *(const f32x4*)(a.g_final + 4 * lane + 256 * j);
    for (int m = 4 * gw; m < MTOK; m += 4 * NGW) {
        u32x2 p[4][8];
#pragma unroll
        for (int r = 0; r < 4; ++r)
#pragma unroll
            for (int j = 0; j < 8; ++j) p[r][j] = *(const u32x2*)(x2 + (size_t)(m + r) * DM + 4 * lane + 256 * j);
#pragma unroll
        for (int r = 0; r < 4; ++r) {
            f32x4 v[8]; float ss = 0.f;
#pragma unroll
            for (int j = 0; j < 8; ++j) { v[j] = (f32x4){bf2f(p[r][j].x & 0xffffu), bf2f(p[r][j].x >> 16), bf2f(p[r][j].y & 0xffffu), bf2f(p[r][j].y >> 16)};
                ss += (v[j].x * v[j].x + v[j].y * v[j].y) + (v[j].z * v[j].z + v[j].w * v[j].w); }
            const float rstd = rsqrtf(wave_sum(ss) * (1.f / DM) + EPSN);
#pragma unroll
            for (int j = 0; j < 8; ++j) *(f32x4*)(a.out + (size_t)(m + r) * DM + 4 * lane + 256 * j) = v[j] * rstd * g[j];
        }
    }
}

#define XB_TMO      128
#define XB_XCNT(j)  (256  + 64 * (j))
#define XB_XSUB(j)  (1280 + 64 * (j))
#define XB_XGEN(j)  (2304 + 64 * (j))
#define XB_TOP      3328
#define XB_TOPGEN   3392
#define XCD_BAR_WORDS 3456
#define XB_SPIN_CAP (1u << 18)

__device__ __forceinline__ unsigned xb_ld(unsigned* p)              { return __hip_atomic_load(p, __ATOMIC_RELAXED, __HIP_MEMORY_SCOPE_AGENT); }
__device__ __forceinline__ unsigned xb_add(unsigned* p, unsigned v) { return __hip_atomic_fetch_add(p, v, __ATOMIC_RELAXED, __HIP_MEMORY_SCOPE_AGENT); }
__device__ __forceinline__ unsigned xb_xcc_id() { return (unsigned)__builtin_amdgcn_s_getreg((3 << 11) | 20) & 0xFu; }
#define XB_SPIN(cond, bar) do { unsigned _sp = 0; while (cond) { __builtin_amdgcn_s_sleep(1); \
    if ((++_sp & 255u) == 0u) { if (xb_ld(&(bar)[XB_TMO])) break; if (_sp > XB_SPIN_CAP) { atomicAdd(&(bar)[XB_TMO], 1u); break; } } } } while (0)

struct XcdBarrier {
    unsigned* bar; unsigned x;
    volatile LAS unsigned* st;
};

__device__ __forceinline__ XcdBarrier xcd_barrier_post(unsigned* bar, volatile LAS unsigned* st) {
    XcdBarrier b; b.bar = bar; b.x = xb_xcc_id(); b.st = st;
    if (threadIdx.x == 0) (void)xb_add(&bar[XB_XCNT(b.x)], 1u);
    return b;
}
__device__ __forceinline__ void xcd_barrier_complete(unsigned* bar, unsigned x, unsigned& nloc, unsigned& nx) {
    const unsigned G = gridDim.x * gridDim.y * gridDim.z;
    unsigned sum, cnt, mine, sp = 0u;
    for (;;) {
        sum = 0u; cnt = 0u; mine = 0u;
#pragma unroll
        for (unsigned j = 0; j < 16; ++j) { const unsigned c = xb_ld(&bar[XB_XCNT(j)]); sum += c; cnt += (c > 0u) ? 1u : 0u; mine = (j == x) ? c : mine; }
        if (sum == G) break;
        __builtin_amdgcn_s_sleep(1);
        if ((++sp & 255u) == 0u) { if (xb_ld(&bar[XB_TMO])) break; if (sp > XB_SPIN_CAP) { atomicAdd(&bar[XB_TMO], 1u); break; } }
    }
    nloc = mine > 0u ? mine : 1u; nx = cnt > 0u ? cnt : 1u;
}

__device__ __forceinline__ void xcd_barrier(const XcdBarrier& b) {
    asm volatile("s_waitcnt vmcnt(0)" ::: "memory");
    __syncthreads();
    if (threadIdx.x == 0) {
        unsigned* bar = b.bar;
        __builtin_amdgcn_s_waitcnt(0);
        unsigned nloc = b.st[0], nx = b.st[1];
        if (nloc == 0u) { xcd_barrier_complete(bar, b.x, nloc, nx); b.st[0] = nloc; b.st[1] = nx; }
        const unsigned old = xb_add(&bar[XB_XSUB(b.x)], 1u);
        const unsigned gen = old / nloc;
        if (old + 1u == (gen + 1u) * nloc) {
            __builtin_amdgcn_fence(__ATOMIC_RELEASE, "agent");
            asm volatile("s_waitcnt vmcnt(0)" ::: "memory");
            const unsigned og = xb_add(&bar[XB_TOP], 1u);
            const unsigned tg = og / nx;
            if (og + 1u == (tg + 1u) * nx) xb_add(&bar[XB_TOPGEN], 1u);
            else XB_SPIN(xb_ld(&bar[XB_TOPGEN]) == tg, bar);
            __builtin_amdgcn_fence(__ATOMIC_ACQUIRE, "agent");
            xb_add(&bar[XB_XGEN(b.x)], 1u);
            asm volatile("s_waitcnt vmcnt(0)" ::: "memory");
        } else {
            XB_SPIN(xb_ld(&bar[XB_XGEN(b.x)]) == gen, bar);
            __builtin_amdgcn_fence(__ATOMIC_ACQUIRE, "agent");
            asm volatile("s_waitcnt vmcnt(0)" ::: "memory");
        }
    }
    __syncthreads();
}


DI int lane_now() { int l = (int)(threadIdx.x & 63u); asm volatile("" : "+v"(l)); return l; }
__global__ void __launch_bounds__(512, 2) mega(Args a) {
    extern __shared__ __attribute__((aligned(16))) unsigned char lds_raw[];
    LAS unsigned char* lds = (LAS unsigned char*)lds_raw;
    cg::grid_group grid = cg::this_grid();
    const int tid = threadIdx.x, wave = __builtin_amdgcn_readfirstlane(tid >> 6);
#define lane lane_now()
    const int lo = a.ph_lo, hi = a.ph_hi;
    volatile LAS unsigned* xst = (volatile LAS unsigned*)(lds + LDS_BYTES - 16);
    if (tid == 0) { xst[0] = 0u; xst[1] = 0u; }
    __syncthreads();
    if (hi - lo > 1) (void)xcd_barrier_post((unsigned*)(a.ws + OFF_BAR), xst);
    const float* mod = (const float*)(a.ws + OFF_MOD);
#ifndef PHMASK
#define PHMASK 0xfff
#endif
#define PH(k) (((PHMASK >> (k)) & 1) && lo <= (k) && (k) < hi)
#ifndef PROBE_A
#define PROBE_A -1
#define PROBE_B -1
#endif
    unsigned long long* stamps = (unsigned long long*)(a.ws + WS_NEED);
#define STAMP(k) do { if (PROBE_A >= 0 && blockIdx.x == 0 && tid == 0) stamps[k] = __builtin_amdgcn_s_memrealtime(); } while (0)
#define SEAM(k) do { if (PH(k) && PH((k) + 1)) { XcdBarrier xb_; xb_.bar = (unsigned*)(a.ws + OFF_BAR); xb_.x = xb_xcc_id(); xb_.st = (volatile LAS unsigned*)(lds + LDS_BYTES - 16); xcd_barrier(xb_); } STAMP((k) + 1); } while (0)
#ifdef MK_GRID_SYNC_FIRST
    if (hi - lo > 1) grid.sync();
#endif
    STAMP(0);
    if (PH(0)) phase0(a, lds, tid, lane, wave);
#ifdef DUP_P0
    if (PH(0)) { __syncthreads(); phase0(a, lds, tid, lane, wave); }
#endif
    SEAM(0);
    if (PH(1)) phase_norm<true, false>(a, lds, a.x, a.g_norm1, 0, DM, tid, lane, wave);
    SEAM(1);
    if (PH(2)) {
        if (blockIdx.x < NCOMBO) gate_prep(a, lds, blockIdx.x, tid);
        pg8::Gemm g{(const bf16_t*)(a.ws + OFF_HB), (const bf16_t*)(a.ws + OFF_WIN), MTOK, NPC, DM, DM}; pg8::StaticOrder S; S.init(MTOK, NPC, gridDim.x, blockIdx.x);
#ifdef SKEW_TICKS
        if ((blockIdx.x >> 3) & 1) { const unsigned long long t0 = __builtin_amdgcn_s_memrealtime(); while (__builtin_amdgcn_s_memrealtime() - t0 < SKEW_TICKS) __builtin_amdgcn_s_sleep(8); }
#endif
        pg8::EpiBf16<0> E{(bf16_t*)(a.ws + OFF_P), NPC, nullptr, 0, 0, 1.f};
        pg8::gemm_phase<pg8::EpiBf16<0>, pg8::StaticOrder, GEMM_ALIGN, true>(lds, g, S, E);
#ifdef DUP_GEMM_IN
        pg8::gemm_phase<pg8::EpiBf16<0>, pg8::StaticOrder, true, true>(lds, g, S, E);
#endif
#ifdef DUP_GEMM_HALFK
        { pg8::Gemm g2{(const bf16_t*)(a.ws + OFF_HB), (const bf16_t*)(a.ws + OFF_WIN), MTOK, NPC, DUP_GEMM_HALFK, DM};
          pg8::EpiBf16<0> E2{(bf16_t*)(a.ws + OFF_CST), 0, nullptr, 0, 0, 1.f};
          pg8::gemm_phase<pg8::EpiBf16<0>, pg8::StaticOrder, true, true>(lds, g2, S, E2); }
#endif
    }
    SEAM(2);
    if (PH(3)) mlstm_delta(a, lds, tid, lane, wave);
#if defined(DUP_MIX) || defined(DUP_A1)
    if (PH(3)) { __syncthreads(); mlstm_delta(a, lds, tid, lane, wave); }
#endif
    SEAM(3);
    if (PH(4)) { mlstm_scan(a, tid); natten(a, lds, tid, lane, wave); }
#if defined(DUP_MIX) || defined(DUP_NAT)
    if (PH(4)) { __syncthreads(); natten(a, lds, tid, lane, wave); }
#endif
    SEAM(4);
    if (PH(5)) mlstm_out(a, lds, tid, lane, wave);
#if defined(DUP_MIX) || defined(DUP_A3)
    if (PH(5)) { __syncthreads(); mlstm_out(a, lds, tid, lane, wave); }
#endif
    SEAM(5);
    if (PH(6)) {
        __syncthreads();
        pg8::Gemm g{(const bf16_t*)(a.ws + OFF_HB), (const bf16_t*)(a.ws + OFF_WOUT), MTOK, DM, DM, DM}; pg8::StaticOrder S; S.init(MTOK, DM, gridDim.x, blockIdx.x);
        EpiResid16<false> E{a.x, (bf16_t*)(a.ws + OFF_X1B), mod + 2 * DM};
        pg8::gemm_phase<EpiResid16<false>, pg8::StaticOrder, GEMM_ALIGN, true>(lds, g, S, E);
    }
    SEAM(6);
    if (PH(7)) phase_norm<false, true>(a, lds, a.ws + OFF_X1B, a.g_norm2, 3 * DM, 4 * DM, tid, lane, wave);
    SEAM(7);
    if (PH(8)) {
        pg8::Gemm g{(const bf16_t*)(a.ws + OFF_HB), (const bf16_t*)(a.ws + OFF_WUP), MTOK, NUP, DM, DM}; pg8::StaticOrder S; S.init(MTOK, NUP, gridDim.x, blockIdx.x);
#ifdef SKEW_TICKS
        if ((blockIdx.x >> 3) & 1) { const unsigned long long t0 = __builtin_amdgcn_s_memrealtime(); while (__builtin_amdgcn_s_memrealtime() - t0 < SKEW_TICKS) __builtin_amdgcn_s_sleep(8); }
#endif
        EpiGlu E{(bf16_t*)(a.ws + OFF_ACT), a.conv_w, a.conv_b, (float*)(a.ws + OFF_EDGE), (LAS float*)(lds + 131072)};
        pg8::gemm_phase<EpiGlu, pg8::StaticOrder, true, true>(lds, g, S, E);
    }
    SEAM(8);
    if (PH(10)) {
        pg8::Gemm g{(const bf16_t*)(a.ws + OFF_ACT), (const bf16_t*)(a.ws + OFF_WDN), MTOK, DM, DFF, DFF}; pg8::StaticOrder S; S.init(MTOK, DM, gridDim.x, blockIdx.x);
        { pg8::Unit uu; int lastpm = -1; for (int i = 0; S.next(i, uu); ++i) if (uu.pm != lastpm) { glu_fixup(a, uu.pm, tid); lastpm = uu.pm; } }
        __threadfence(); __syncthreads();
        EpiResid16<true> E{a.ws + OFF_X1B, (bf16_t*)(a.ws + OFF_X1B), mod + 5 * DM};
        pg8::gemm_phase<EpiResid16<true>, pg8::StaticOrder, GEMM_ALIGN, true>(lds, g, S, E);
    }
    SEAM(10);
    if (PH(11)) phase_final(a, lane, wave);
    if (PROBE_A >= 0) { __syncthreads(); if (blockIdx.x == 0 && tid == 0) { stamps[12] = __builtin_amdgcn_s_memrealtime();
        const float Ta = (float)(stamps[PROBE_A + 1] - stamps[PROBE_A]) * 0.01f, Tb = (float)(stamps[PROBE_B + 1] - stamps[PROBE_B]) * 0.01f;
        a.out[0] += Ta + Tb; for (int i = 1; i <= 1000; ++i) a.out[i] += 0.5f * Tb; } }
#undef PH
#undef SEAM
#undef lane
}

extern "C" void kernel_launch(void* const* d_in, const int* in_sizes, int n_in, void* d_out, int out_size, void* d_ws, size_t ws_size, hipStream_t stream) {
    static int grid = 0;
    if (grid == 0) {
        if (n_in != 16 || out_size != MTOK * DM || ws_size < WS_NEED) { fprintf(stderr, "kernel_launch: unexpected problem (n_in %d out %d ws %zu need %zu)\n", n_in, out_size, ws_size, (size_t)WS_NEED); grid = -1; return; }
        int dev = 0, cus = 0, per_cu = 0;
        hipGetDevice(&dev); hipDeviceGetAttribute(&cus, hipDeviceAttributeMultiprocessorCount, dev);
        if (hipFuncSetAttribute((const void*)mega, hipFuncAttributeMaxDynamicSharedMemorySize, LDS_BYTES) != hipSuccess) { fprintf(stderr, "kernel_launch: hipFuncSetAttribute failed\n"); grid = -1; return; }
        if (hipOccupancyMaxActiveBlocksPerMultiprocessor(&per_cu, (const void*)mega, 512, LDS_BYTES) != hipSuccess || per_cu < 1) { fprintf(stderr, "kernel_launch: occupancy query failed (%d)\n", per_cu); (void)hipGetLastError(); per_cu = 1; }
        grid = cus * (per_cu > 1 ? 1 : per_cu);
        fprintf(stderr, "kernel_launch: grid %d (cus %d, per_cu %d)\n", grid, cus, per_cu);
        if (grid < 4 || (grid & 3) != 0) { fprintf(stderr, "kernel_launch: this kernel needs a workgroup count that is a multiple of 4 (neighbourhood-attention head pairs are fixed per workgroup); nothing launched\n"); grid = -1; return; }
    }
    if (grid < 0) return;
    Args a{};
    a.x = (const float*)d_in[0]; a.c = (const float*)d_in[1]; a.w_ada = (const float*)d_in[2]; a.b_ada = (const float*)d_in[3]; a.g_norm1 = (const float*)d_in[4];
    a.w_in = (const float*)d_in[5]; a.b_gates = (const float*)d_in[6]; a.g_head_a = (const float*)d_in[7]; a.rpb = (const float*)d_in[8]; a.w_out = (const float*)d_in[9];
    a.g_norm2 = (const float*)d_in[10]; a.w_up = (const float*)d_in[11]; a.conv_w = (const float*)d_in[12]; a.conv_b = (const float*)d_in[13]; a.w_down = (const float*)d_in[14];
    a.g_final = (const float*)d_in[15]; a.out = (float*)d_out; a.ws = (unsigned char*)d_ws;
#if MK_PER_PHASE
    for (int p = 0; p < NPH; ++p) { a.ph_lo = p; a.ph_hi = p + 1; hipLaunchKernelGGL(mega, dim3(grid), dim3(512), LDS_BYTES, stream, a); }
#else
    a.ph_lo = 0; a.ph_hi = NPH;
    if (hipMemsetAsync((char*)d_ws + OFF_BAR, 0, BAR_BYTES, stream) != hipSuccess) { fprintf(stderr, "kernel_launch: memset failed\n"); return; }
    void* args[] = {&a};
    hipError_t e = hipLaunchCooperativeKernel((const void*)mega, dim3(grid), dim3(512), args, LDS_BYTES, stream);
    if (e != hipSuccess) fprintf(stderr, "kernel_launch: cooperative launch failed: %s (grid %d)\n", hipGetErrorString(e), grid);
#endif
}
```
